# Optimizing an MI355X kernel written in HIP

```python
import math, functools
import jax, jax.numpy as jnp
from jax import lax
import numpy as np

D_MODEL = 2048
BATCH = 8
SEQ = 2048
DEPTH = 2

GRID_W = 64
CTX_LEN = 256
Q_BLOCK = 128
ROPE_THETA = 10000.0
HEAD_DIM = 128
DIFF_HEADS = D_MODEL // (2 * HEAD_DIM)
DIFF_QK_DIM = HEAD_DIM // 2
DIFF_V_DIM = HEAD_DIM
GQA_HEADS = D_MODEL // (2 * HEAD_DIM)
GQA_KV_HEADS = GQA_HEADS // 4
AB_IN_WIDTH = 2 * DIFF_HEADS * 2 * DIFF_QK_DIM + DIFF_HEADS * DIFF_V_DIM + (GQA_HEADS + 2 * GQA_KV_HEADS) * HEAD_DIM
MIX_WIDTH = DIFF_HEADS * DIFF_V_DIM + GQA_HEADS * HEAD_DIM
MLA_HEADS = D_MODEL // HEAD_DIM
MLA_Q_RANK = 512
MLA_KV_RANK = 512
MLA_NOPE_DIM = 128
MLA_ROPE_DIM = 64
MLA_V_DIM = 128
MLA_DOWN_WIDTH = MLA_Q_RANK + MLA_KV_RANK + MLA_ROPE_DIM
N_EXPERTS = 64
EXPERT_DIM = 512
TOP_K = 8
N_GROUPS = 8
TOPK_GROUPS = 4
ROUTE_SCALE = 2.5
EXPERT_BLOCK = 128
ALPHA = (2 * DEPTH) ** 0.25
BETA = (8 * DEPTH) ** -0.25
N_EVEN = (DEPTH + 1) // 2
N_ODD = DEPTH // 2

kernel_name = 'hybrid_diffgqa_mla_moe_dit'


def rms_norm(x, g, eps=1e-6):
    xf = x.astype(jnp.float32)
    y = xf * lax.rsqrt(jnp.mean(xf * xf, axis=-1, keepdims=True) + eps)
    return (y * g.astype(jnp.float32)).astype(x.dtype)


def layer_norm(x, g, b, eps=1e-5):
    xf = x.astype(jnp.float32)
    xc = xf - jnp.mean(xf, axis=-1, keepdims=True)
    var = jnp.mean(xc * xc, axis=-1, keepdims=True)
    return (xc * lax.rsqrt(var + eps) * g.astype(jnp.float32) + b.astype(jnp.float32)).astype(x.dtype)


def axial_angles(rows, rot_dim):
    t = jnp.arange(rows * GRID_W)
    row = (t // GRID_W).astype(jnp.float32)
    col = (t % GRID_W).astype(jnp.float32)
    axis_dim = rot_dim // 2
    inv_freq = 1.0 / (ROPE_THETA ** (jnp.arange(0, axis_dim, 2, dtype=jnp.float32) / axis_dim))
    return row[:, None] * inv_freq, col[:, None] * inv_freq


def rope_1d(x, ang):
    a = ang.reshape((ang.shape[0],) + (1,) * (x.ndim - 3) + (ang.shape[1],))
    cos = jnp.cos(a).astype(x.dtype)
    sin = jnp.sin(a).astype(x.dtype)
    x1, x2 = jnp.split(x, 2, axis=-1)
    return jnp.concatenate([x1 * cos - x2 * sin, x2 * cos + x1 * sin], axis=-1)


def axial_rope(x, angs):
    xr, xc = jnp.split(x, 2, axis=-1)
    return jnp.concatenate([rope_1d(xr, angs[0]), rope_1d(xc, angs[1])], axis=-1)


def sweep_query_blocks(attend, q):
    B, L = q.shape[0], q.shape[1]
    nb = L // Q_BLOCK
    qb = jnp.moveaxis(q.reshape((B, nb, Q_BLOCK) + q.shape[2:]), 1, 0)
    out = lax.map(attend, qb)
    return jnp.moveaxis(out, 0, 1).reshape((B, L) + out.shape[3:])


def diff_attend(q, k, v, lam):
    logits = jnp.einsum('bqhid,bkhid->bhiqk', q, k).astype(jnp.float32) * (DIFF_QK_DIM ** -0.5)
    p = jax.nn.softmax(logits, axis=-1)
    a = (p[:, :, 0] - lam * p[:, :, 1]).astype(v.dtype)
    return jnp.einsum('bhqk,bkhd->bqhd', a, v)


def gqa_attend(q, k, v, scale):
    B, Lq, Hq, d = q.shape
    Hk = k.shape[2]
    qg = q.reshape(B, Lq, Hk, Hq // Hk, d)
    logits = jnp.einsum('bqhgd,bkhd->bhgqk', qg, k).astype(jnp.float32) * scale
    p = jax.nn.softmax(logits, axis=-1).astype(v.dtype)
    o = jnp.einsum('bhgqk,bkhd->bqhgd', p, v)
    return o.reshape(B, Lq, Hq, v.shape[-1])


def split_ab(proj):
    B, L = proj.shape[0], proj.shape[1]
    sizes = (DIFF_HEADS * 2 * DIFF_QK_DIM, DIFF_HEADS * 2 * DIFF_QK_DIM, DIFF_HEADS * DIFF_V_DIM,
             GQA_HEADS * HEAD_DIM, GQA_KV_HEADS * HEAD_DIM, GQA_KV_HEADS * HEAD_DIM)
    qa, ka, va, qb, kb, vb = jnp.split(proj, np.cumsum(sizes)[:-1].tolist(), axis=-1)
    return (qa.reshape(B, L, DIFF_HEADS, 2, DIFF_QK_DIM), ka.reshape(B, L, DIFF_HEADS, 2, DIFF_QK_DIM),
            va.reshape(B, L, DIFF_HEADS, DIFF_V_DIM), qb.reshape(B, L, GQA_HEADS, HEAD_DIM),
            kb.reshape(B, L, GQA_KV_HEADS, HEAD_DIM), vb.reshape(B, L, GQA_KV_HEADS, HEAD_DIM))


def mixer_diff_gqa(h_lat, h_ctx, w_in, w_out, lam_params, subln_g, q_norm_g, k_norm_g,
                   lam_init, angs64, angs128, need_ctx):
    qa_l, ka_l, va_l, qb_l, kb_l, vb_l = split_ab(h_lat @ w_in)
    qa_c, ka_c, va_c, qb_c, kb_c, vb_c = split_ab(h_ctx @ w_in)
    qb_l, qb_c = rms_norm(qb_l, q_norm_g), rms_norm(qb_c, q_norm_g)
    kb_l, kb_c = rms_norm(kb_l, k_norm_g), rms_norm(kb_c, k_norm_g)
    qa_l, ka_l = axial_rope(qa_l, angs64), axial_rope(ka_l, angs64)
    qb_l, kb_l = axial_rope(qb_l, angs128), axial_rope(kb_l, angs128)
    lp = lam_params.astype(jnp.float32)
    lam = jnp.exp(jnp.sum(lp[0] * lp[1])) - jnp.exp(jnp.sum(lp[2] * lp[3])) + lam_init

    def heads_out(qa, ka, va, qb, kb, vb):
        B, L = qa.shape[0], qa.shape[1]
        oa = sweep_query_blocks(lambda qblk: diff_attend(qblk, ka, va, lam), qa)
        oa = rms_norm(oa, subln_g, 1e-5) * (1.0 - lam_init)
        ob = sweep_query_blocks(lambda qblk: gqa_attend(qblk, kb, vb, HEAD_DIM ** -0.5), qb)
        merged = jnp.concatenate([oa.reshape(B, L, -1), ob.reshape(B, L, -1)], axis=-1)
        return merged @ w_out

    y_lat = heads_out(qa_l, jnp.concatenate([ka_c, ka_l], 1), jnp.concatenate([va_c, va_l], 1),
                      qb_l, jnp.concatenate([kb_c, kb_l], 1), jnp.concatenate([vb_c, vb_l], 1))
    y_ctx = heads_out(qa_c, ka_c, va_c, qb_c, kb_c, vb_c) if need_ctx else None
    return y_lat, y_ctx


def mixer_mla(h_lat, h_ctx, w_down, q_norm_g, w_uq, kv_norm_g, w_ukv, w_o, angs64, need_ctx):
    def project(h):
        B, L = h.shape[0], h.shape[1]
        cq, ckv, k_pe = jnp.split(h @ w_down, [MLA_Q_RANK, MLA_Q_RANK + MLA_KV_RANK], axis=-1)
        q = (rms_norm(cq, q_norm_g) @ w_uq).reshape(B, L, MLA_HEADS, MLA_NOPE_DIM + MLA_ROPE_DIM)
        kv = (rms_norm(ckv, kv_norm_g) @ w_ukv).reshape(B, L, MLA_HEADS, MLA_NOPE_DIM + MLA_V_DIM)
        q_nope, q_pe = jnp.split(q, [MLA_NOPE_DIM], axis=-1)
        k_nope, v = jnp.split(kv, [MLA_NOPE_DIM], axis=-1)
        return q_nope, q_pe, k_nope, k_pe[:, :, None, :], v

    def assemble(nope, pe):
        return jnp.concatenate([nope, jnp.broadcast_to(pe, nope.shape[:3] + (MLA_ROPE_DIM,))], axis=-1)

    ql_n, ql_pe, kl_n, kl_pe, v_l = project(h_lat)
    ql_pe, kl_pe = axial_rope(ql_pe, angs64), axial_rope(kl_pe, angs64)
    qc_n, qc_pe, kc_n, kc_pe, v_c = project(h_ctx)
    q_l, k_l = assemble(ql_n, ql_pe), assemble(kl_n, kl_pe)
    q_c, k_c = assemble(qc_n, qc_pe), assemble(kc_n, kc_pe)
    scale = (MLA_NOPE_DIM + MLA_ROPE_DIM) ** -0.5

    def heads_out(q, k, v):
        B, L = q.shape[0], q.shape[1]
        o = sweep_query_blocks(lambda qblk: gqa_attend(qblk, k, v, scale), q)
        return o.reshape(B, L, -1) @ w_o

    y_lat = heads_out(q_l, jnp.concatenate([k_c, k_l], 1), jnp.concatenate([v_c, v_l], 1))
    y_ctx = heads_out(q_c, k_c, v_c) if need_ctx else None
    return y_lat, y_ctx


def swiglu(h, w_in, w_out):
    g, u = jnp.split(h @ w_in, 2, axis=-1)
    return (jax.nn.silu(g) * u) @ w_out


def moe_ffn(h, router_w, router_bias, w_in, w_out, sh_in, sh_out):
    T, D = h.shape
    scores = jax.nn.sigmoid((h @ router_w).astype(jnp.float32))
    biased = scores + router_bias.astype(jnp.float32)
    grouped = biased.reshape(T, N_GROUPS, N_EXPERTS // N_GROUPS)
    group_score = lax.top_k(grouped, 2)[0].sum(axis=-1)
    _, top_groups = lax.top_k(group_score, TOPK_GROUPS)
    group_ok = (top_groups[..., None] == jnp.arange(N_GROUPS)).any(axis=1)
    expert_ok = jnp.repeat(group_ok, N_EXPERTS // N_GROUPS, axis=-1)
    _, top_e = lax.top_k(jnp.where(expert_ok, biased, -jnp.inf), TOP_K)
    gate = jnp.take_along_axis(scores, top_e, axis=-1)
    gate = gate / jnp.sum(gate, axis=-1, keepdims=True) * ROUTE_SCALE

    TK = T * TOP_K
    flat_e = top_e.reshape(-1).astype(jnp.int32)
    order = jnp.argsort(flat_e, stable=True)
    sorted_e = flat_e[order]
    counts = jnp.bincount(flat_e, length=N_EXPERTS)
    starts = jnp.cumsum(counts) - counts
    padded = (counts + EXPERT_BLOCK - 1) // EXPERT_BLOCK * EXPERT_BLOCK
    pad_ends = jnp.cumsum(padded)
    pad_starts = pad_ends - padded
    dest = pad_starts[sorted_e] + (jnp.arange(TK, dtype=jnp.int32) - starts[sorted_e])
    n_blocks = -(-TK // EXPERT_BLOCK) + N_EXPERTS
    P = n_blocks * EXPERT_BLOCK
    slot_tok = jnp.full((P,), T, dtype=jnp.int32).at[dest].set((order // TOP_K).astype(jnp.int32))
    slot_w = jnp.zeros((P,), h.dtype).at[dest].set(gate.reshape(-1)[order].astype(h.dtype))
    block_e = jnp.minimum(jnp.searchsorted(pad_ends, jnp.arange(n_blocks) * EXPERT_BLOCK, side='right'),
                          N_EXPERTS - 1)
    h_pad = jnp.concatenate([h, jnp.zeros((1, D), h.dtype)], axis=0)

    def run_block(args):
        tok, wts, e = args
        return swiglu(h_pad[tok], w_in[e], w_out[e]) * wts[:, None]

    out = lax.map(run_block, (slot_tok.reshape(n_blocks, EXPERT_BLOCK),
                              slot_w.reshape(n_blocks, EXPERT_BLOCK), block_e))
    routed = jax.ops.segment_sum(out.reshape(P, D), slot_tok, num_segments=T + 1)[:T]
    return routed + swiglu(h, sh_in, sh_out)


def setup_inputs(seed: int = 0) -> dict:
    key = jax.random.key(seed)
    ks = iter(jax.random.split(key, 32))

    def normal(shape, scale):
        return jax.random.normal(next(ks), shape, jnp.float32) * scale

    def gain(shape):
        return 1.0 + normal(shape, 0.05)

    D, F = D_MODEL, EXPERT_DIM
    return {
        'x': normal((BATCH, SEQ, D), 1.0),
        'c': normal((BATCH, D), 1.0),
        'ctx': normal((BATCH, CTX_LEN, D), 1.0),
        'c_ctx': normal((D,), 1.0),
        'ada_w': normal((DEPTH, D, 6 * D), 0.015),
        'ada_b': normal((DEPTH, 6 * D), 0.02),
        'ln_mix_g': gain((DEPTH, D)),
        'ln_mix_b': normal((DEPTH, D), 0.02),
        'ln_ffn_g': gain((DEPTH, D)),
        'ln_ffn_b': normal((DEPTH, D), 0.02),
        'ab_w_in': normal((N_EVEN, D, AB_IN_WIDTH), D ** -0.5),
        'ab_w_out': normal((N_EVEN, MIX_WIDTH, D), MIX_WIDTH ** -0.5 * BETA),
        'diff_lambda': normal((N_EVEN, 4, DIFF_QK_DIM), 0.1),
        'diff_subln_g': gain((N_EVEN, DIFF_V_DIM)),
        'gqa_q_norm_g': gain((N_EVEN, HEAD_DIM)),
        'gqa_k_norm_g': gain((N_EVEN, HEAD_DIM)),
        'mla_w_down': normal((N_ODD, D, MLA_DOWN_WIDTH), D ** -0.5),
        'mla_q_norm_g': gain((N_ODD, MLA_Q_RANK)),
        'mla_w_uq': normal((N_ODD, MLA_Q_RANK, MLA_HEADS * (MLA_NOPE_DIM + MLA_ROPE_DIM)), MLA_Q_RANK ** -0.5),
        'mla_kv_norm_g': gain((N_ODD, MLA_KV_RANK)),
        'mla_w_ukv': normal((N_ODD, MLA_KV_RANK, MLA_HEADS * (MLA_NOPE_DIM + MLA_V_DIM)), MLA_KV_RANK ** -0.5),
        'mla_w_o': normal((N_ODD, MLA_HEADS * MLA_V_DIM, D), (MLA_HEADS * MLA_V_DIM) ** -0.5 * BETA),
        'router_w': normal((DEPTH, D, N_EXPERTS), D ** -0.5),
        'router_bias': normal((DEPTH, N_EXPERTS), 0.01),
        'expert_w_in': normal((DEPTH, N_EXPERTS, D, 2 * F), D ** -0.5),
        'expert_w_out': normal((DEPTH, N_EXPERTS, F, D), F ** -0.5 * BETA),
        'shared_w_in': normal((DEPTH, D, 2 * F), D ** -0.5),
        'shared_w_out': normal((DEPTH, F, D), F ** -0.5 * BETA),
    }


def reference(x, c, ctx, c_ctx, ada_w, ada_b, ln_mix_g, ln_mix_b, ln_ffn_g, ln_ffn_b,
              ab_w_in, ab_w_out, diff_lambda, diff_subln_g, gqa_q_norm_g, gqa_k_norm_g,
              mla_w_down, mla_q_norm_g, mla_w_uq, mla_kv_norm_g, mla_w_ukv, mla_w_o,
              router_w, router_bias, expert_w_in, expert_w_out, shared_w_in, shared_w_out):
    B, S, D = x.shape
    C = ctx.shape[1]
    rows = S // GRID_W
    angs64 = axial_angles(rows, 64)
    angs128 = axial_angles(rows, HEAD_DIM)
    c_act = jax.nn.silu(c)
    cc_act = jax.nn.silu(c_ctx)
    for layer in range(DEPTH):
        need_ctx = layer < DEPTH - 1
        i = layer // 2
        mod_lat = c_act @ ada_w[layer] + ada_b[layer]
        mod_ctx = cc_act @ ada_w[layer] + ada_b[layer]
        sh1, sc1, g1, sh2, sc2, g2 = jnp.split(mod_lat[:, None, :], 6, axis=-1)
        csh1, csc1, cg1, csh2, csc2, cg2 = jnp.split(mod_ctx, 6, axis=-1)

        h_lat = x * (1.0 + sc1) + sh1
        h_ctx = ctx * (1.0 + csc1) + csh1
        if layer % 2 == 0:
            y_lat, y_ctx = mixer_diff_gqa(h_lat, h_ctx, ab_w_in[i], ab_w_out[i], diff_lambda[i], diff_subln_g[i],
                                          gqa_q_norm_g[i], gqa_k_norm_g[i], 0.8 - 0.6 * math.exp(-0.3 * layer),
                                          angs64, angs128, need_ctx)
        else:
            y_lat, y_ctx = mixer_mla(h_lat, h_ctx, mla_w_down[i], mla_q_norm_g[i], mla_w_uq[i], mla_kv_norm_g[i],
                                     mla_w_ukv[i], mla_w_o[i], angs64, need_ctx)
        x = layer_norm(ALPHA * x + g1 * y_lat, ln_mix_g[layer], ln_mix_b[layer])
        if need_ctx:
            ctx = layer_norm(ALPHA * ctx + cg1 * y_ctx, ln_mix_g[layer], ln_mix_b[layer])

        h_lat = (x * (1.0 + sc2) + sh2).reshape(B * S, D)
        if need_ctx:
            h_ctx = (ctx * (1.0 + csc2) + csh2).reshape(B * C, D)
            tokens = jnp.concatenate([h_ctx, h_lat], axis=0)
        else:
            tokens = h_lat
        y = moe_ffn(tokens, router_w[layer], router_bias[layer], expert_w_in[layer], expert_w_out[layer],
                    shared_w_in[layer], shared_w_out[layer])
        x = layer_norm(ALPHA * x + g2 * y[tokens.shape[0] - B * S:].reshape(B, S, D),
                       ln_ffn_g[layer], ln_ffn_b[layer])
        if need_ctx:
            ctx = layer_norm(ALPHA * ctx + cg2 * y[:B * C].reshape(B, C, D), ln_ffn_g[layer], ln_ffn_b[layer])
    return x
```

```cpp
#include <hip/hip_runtime.h>
#include <cstdio>
#include <cstdint>

#ifndef MK_ONE_LAUNCH
#define MK_ONE_LAUNCH 1
#endif

#define LAS __attribute__((address_space(3)))
typedef unsigned short bf16_t;
typedef short bf16x8 __attribute__((ext_vector_type(8)));
typedef short s16x4 __attribute__((ext_vector_type(4)));
typedef float f32x4 __attribute__((ext_vector_type(4)));
typedef float f32x2 __attribute__((ext_vector_type(2)));
typedef float f32x16 __attribute__((ext_vector_type(16)));
typedef unsigned u32x4 __attribute__((ext_vector_type(4)));
typedef unsigned u32x2 __attribute__((ext_vector_type(2)));
typedef int i32x4 __attribute__((ext_vector_type(4)));

constexpr int D = 2048, NB = 8, SEQ = 2048, CTXL = 256, RPB = SEQ + CTXL  ;
constexpr int T_ALL = NB * RPB  , T_LAT = NB * SEQ  ;
constexpr int NEXP = 64, FDIM = 512, TOPK = 8;
constexpr int ABW = 4608, QA_OFF = 0, KA_OFF = 1024, VA_OFF = 2048, QB_OFF = 3072, KB_OFF = 4096, VB_OFF = 4352;
constexpr int DOWN_N = 1280  , UQ_N = 3072, UKV_N = 4096;
constexpr float ALPHA = 1.41421356237f;
constexpr float LAM_INIT0 = 0.2f;
constexpr int LIST_CAP = T_ALL;
constexpr int MAX_TILES = 712;

constexpr size_t al4k(size_t x) { return (x + 4095) & ~(size_t)4095; }
constexpr size_t WS_CTL = 0, CTL_BYTES = 1u << 20;
constexpr size_t WS_TAB = WS_CTL + CTL_BYTES;
constexpr size_t WS_MOD = WS_TAB + (1u << 16);
constexpr size_t WS_W_IN = WS_MOD + (1u << 20);
constexpr size_t WS_W_OUT = WS_W_IN + al4k((size_t)ABW * D * 2);
constexpr size_t WS_W_DOWN = WS_W_OUT + al4k((size_t)D * D * 2);
constexpr size_t WS_W_UQ = WS_W_DOWN + al4k((size_t)DOWN_N * D * 2);
constexpr size_t WS_W_UKV = WS_W_UQ + al4k((size_t)UQ_N * 512 * 2);
constexpr size_t WS_W_O = WS_W_UKV + al4k((size_t)UKV_N * 512 * 2);
constexpr size_t WS_ROUTER = WS_W_O + al4k((size_t)D * D * 2);
constexpr size_t EXP_IN_BYTES = (size_t)1024 * D  , EXP_OUT_BYTES = (size_t)D * FDIM  ;
constexpr size_t WS_EXP_IN = WS_ROUTER + al4k((size_t)2 * 64 * D * 2);
constexpr size_t WS_EXP_OUT = WS_EXP_IN + (size_t)2 * 65 * EXP_IN_BYTES;
constexpr size_t WS_X = WS_EXP_OUT + (size_t)2 * 65 * EXP_OUT_BYTES;
constexpr size_t WS_H = WS_X + (size_t)T_ALL * D * 4;
constexpr size_t WS_PROJ = WS_H + (size_t)T_ALL * D * 2;
constexpr size_t WS_OA = WS_PROJ + (size_t)T_ALL * ABW * 2;
constexpr size_t WS_MERGED = WS_OA + (size_t)T_ALL * D * 2;
constexpr size_t WS_Y1 = WS_MERGED + (size_t)T_ALL * D * 2;
constexpr size_t P_MAX = (size_t)MAX_TILES * 256;
constexpr size_t WS_HMID = WS_Y1 + (size_t)T_ALL * D * 2;
constexpr size_t WS_Y2P = WS_HMID + P_MAX * FDIM * 2;
constexpr size_t WS_LIST = WS_Y2P + P_MAX * D * 2;
constexpr size_t WS_TOKSLOT = WS_LIST + (size_t)64 * LIST_CAP * 4;
constexpr size_t WS_GATE = WS_TOKSLOT + (size_t)T_ALL * 8 * 4;
constexpr size_t WS_DOWN = WS_GATE + (size_t)T_ALL * 8 * 4;
constexpr size_t WS_CQN = WS_DOWN + (size_t)T_ALL * DOWN_N * 2;
constexpr size_t WS_CKVN = WS_CQN + (size_t)T_ALL * 512 * 2;
constexpr size_t WS_KPE = WS_CKVN + (size_t)T_ALL * 512 * 2;
constexpr size_t WS_QM = WS_KPE + (size_t)T_ALL * 64 * 2;
constexpr size_t WS_KVM = WS_QM + (size_t)T_ALL * UQ_N * 2;
constexpr size_t WS_SW = WS_KVM + (size_t)T_ALL * UKV_N * 2;
constexpr size_t WS_H8 = WS_SW + al4k((size_t)2 * 65 * 1024 * 4);
constexpr size_t WS_SA = WS_H8 + (size_t)T_ALL * D;
constexpr size_t WS_SWD = WS_SA + al4k((size_t)T_ALL * 4);
constexpr int SWD_IN = 0, SWD_OUT = 4608, SWD_DOWN = 6656, SWD_UQ = 7936, SWD_UKV = 11008, SWD_O = 15104, SWD_N = 17152;
constexpr size_t WS_SW2 = WS_SWD + al4k((size_t)SWD_N * 4);
constexpr size_t WS_SCQ = WS_SW2 + al4k((size_t)2 * 65 * 2048 * 4);
constexpr size_t WS_SCKV = WS_SCQ + al4k((size_t)T_ALL * 4);
constexpr size_t WS_SMG = WS_SCKV + al4k((size_t)T_ALL * 4);
constexpr size_t WS_SHM = WS_SMG + al4k((size_t)T_ALL * 4);
constexpr size_t WS_HM8 = WS_SHM + al4k(P_MAX * 4);
constexpr size_t WS_MG8 = WS_HM8 + P_MAX * FDIM;
constexpr size_t WS_END = WS_MG8 + (size_t)T_ALL * D;
constexpr size_t TAB64R = 0, TAB64C = 4096, TAB128R = 12288, TAB128C = 20480;
constexpr int CW_BAR = 4096, CW_CNT = 16384;

constexpr int RING_BYTES = 131072;
constexpr int IDXC_OFF = 131072, IDXC_UNITS = 16;
constexpr int TTAB_OFF = IDXC_OFF + IDXC_UNITS * 1024;
constexpr int MISC_OFF = TTAB_OFF + 4096;
constexpr int LDS_BYTES = 163840;
constexpr int BARW_OFF = LDS_BYTES - 16;
constexpr int SCL_OFF = MISC_OFF + 2048;

#define RLX_AGENT __ATOMIC_RELAXED, __HIP_MEMORY_SCOPE_AGENT
__device__ __forceinline__ unsigned f2bf(float f) { unsigned u = __builtin_bit_cast(unsigned, f); return (u + 0x7fffu + ((u >> 16) & 1u)) >> 16; }
__device__ __forceinline__ unsigned pk2(float lo, float hi) { return f2bf(lo) | (f2bf(hi) << 16); }
__device__ __forceinline__ float bf2f(unsigned short b) { return __builtin_bit_cast(float, ((unsigned)b) << 16); }
__device__ __forceinline__ float bflo(unsigned w) { return __builtin_bit_cast(float, w << 16); }
__device__ __forceinline__ float bfhi(unsigned w) { return __builtin_bit_cast(float, w & 0xffff0000u); }
__device__ __forceinline__ unsigned cvt_pk_bf16(float lo, float hi) { unsigned r; asm volatile("v_cvt_pk_bf16_f32 %0, %1, %2" : "=v"(r) : "v"(lo), "v"(hi)); return r; }
__device__ __forceinline__ float wave_sum(float v) {
#pragma unroll
    for (int o = 1; o < 64; o <<= 1) v += __shfl_xor(v, o);
    return v;
}

#define XB_TMO      128
#define XB_XCNT(j)  (256  + 64 * (j))
#define XB_XSUB(j)  (1280 + 64 * (j))
#define XB_XGEN(j)  (2304 + 64 * (j))
#define XB_TOP      3328
#define XB_TOPGEN   3392
#define XCD_BAR_WORDS 3456
#define XB_SPIN_CAP (1u << 18)
__device__ __forceinline__ unsigned xb_ld(unsigned* p)              { return __hip_atomic_load(p, __ATOMIC_RELAXED, __HIP_MEMORY_SCOPE_AGENT); }
__device__ __forceinline__ unsigned xb_add(unsigned* p, unsigned v) { return __hip_atomic_fetch_add(p, v, __ATOMIC_RELAXED, __HIP_MEMORY_SCOPE_AGENT); }
__device__ __forceinline__ unsigned xb_xcc_id() { return (unsigned)__builtin_amdgcn_s_getreg((3 << 11) | 20) & 0xFu; }
#define XB_SPIN(cond, bar) do { unsigned _sp = 0; while (cond) { __builtin_amdgcn_s_sleep(1); \
    if ((++_sp & 255u) == 0u) { if (xb_ld(&(bar)[XB_TMO])) break; if (_sp > XB_SPIN_CAP) { atomicAdd(&(bar)[XB_TMO], 1u); break; } } } } while (0)
struct XcdBarrier { unsigned* bar; unsigned x; volatile LAS unsigned* st; };
__device__ __forceinline__ XcdBarrier xcd_barrier_post(unsigned* bar, volatile LAS unsigned* st) {
    XcdBarrier b; b.bar = bar; b.x = xb_xcc_id(); b.st = st;
    if (threadIdx.x == 0) (void)xb_add(&bar[XB_XCNT(b.x)], 1u);
    return b;
}
__device__ __forceinline__ void xcd_barrier_complete(unsigned* bar, unsigned x, unsigned& nloc, unsigned& nx) {
    const unsigned G = gridDim.x * gridDim.y * gridDim.z;
    unsigned sum, cnt, mine, sp = 0u;
    for (;;) {
        sum = 0u; cnt = 0u; mine = 0u;
#pragma unroll
        for (unsigned j = 0; j < 16; ++j) { const unsigned c = xb_ld(&bar[XB_XCNT(j)]); sum += c; cnt += (c > 0u) ? 1u : 0u; mine = (j == x) ? c : mine; }
        if (sum == G) break;
        __builtin_amdgcn_s_sleep(1);
        if ((++sp & 255u) == 0u) { if (xb_ld(&bar[XB_TMO])) break; if (sp > XB_SPIN_CAP) { atomicAdd(&bar[XB_TMO], 1u); break; } }
    }
    nloc = mine > 0u ? mine : 1u; nx = cnt > 0u ? cnt : 1u;
}
__device__ __forceinline__ void xcd_barrier(const XcdBarrier& b) {
    asm volatile("s_waitcnt vmcnt(0)" ::: "memory");
    __syncthreads();
    if (threadIdx.x == 0) {
        unsigned* bar = b.bar;
        __builtin_amdgcn_s_waitcnt(0);
        unsigned nloc = b.st[0], nx = b.st[1];
        if (nloc == 0u) { xcd_barrier_complete(bar, b.x, nloc, nx); b.st[0] = nloc; b.st[1] = nx; }
        const unsigned old = xb_add(&bar[XB_XSUB(b.x)], 1u);
        const unsigned gen = old / nloc;
        if (old + 1u == (gen + 1u) * nloc) {
            __builtin_amdgcn_fence(__ATOMIC_RELEASE, "agent");
            asm volatile("s_waitcnt vmcnt(0)" ::: "memory");
            const unsigned og = xb_add(&bar[XB_TOP], 1u);
            const unsigned tg = og / nx;
            if (og + 1u == (tg + 1u) * nx) xb_add(&bar[XB_TOPGEN], 1u);
            else XB_SPIN(xb_ld(&bar[XB_TOPGEN]) == tg, bar);
            __builtin_amdgcn_fence(__ATOMIC_ACQUIRE, "agent");
            xb_add(&bar[XB_XGEN(b.x)], 1u);
            asm volatile("s_waitcnt vmcnt(0)" ::: "memory");
        } else {
            XB_SPIN(xb_ld(&bar[XB_XGEN(b.x)]) == gen, bar);
            __builtin_amdgcn_fence(__ATOMIC_ACQUIRE, "agent");
            asm volatile("s_waitcnt vmcnt(0)" ::: "memory");
        }
    }
    __syncthreads();
}

namespace pg8 {
constexpr int BM = 256, BK = 64, HALF = 128, HTB = HALF * BK * 2, STAGE_BYTES = 8 * HTB;
__device__ __forceinline__ int lds_byte(int r, int c) { const int st = (r >> 4) * 2 + (c >> 5), rr = r & 15, cc = c & 31, ob = rr * 64 + cc * 2; return st * 1024 + (ob ^ (((ob >> 9) & 1) << 5)); }
__device__ __forceinline__ void stage_rc(int b, int& R, int& C) { const int st = b / 1024, sb = b % 1024, swz = sb ^ (((sb >> 9) & 1) << 5); R = (st >> 1) * 16 + swz / 64; C = (st & 1) * 32 + (swz % 64) / 2; }
__device__ __forceinline__ int perm32(int rho) { const int n = rho >> 4, i = rho & 15; return 8 * (i >> 2) + 4 * n + (i & 3); }

struct Unit { int row0; int pn; int e; const char* B; };

struct SchedDense {
    int nM, nN, nwg, G, c, latmap; const char* Bt; size_t tstepB;
    __device__ __forceinline__ void init(int nM_, int nN_, int G_, int c_, int latmap_, const bf16_t* Bt_, int K) { nM = nM_; nN = nN_; nwg = nM * nN; G = G_; c = c_; latmap = latmap_; Bt = (const char*)Bt_; tstepB = (size_t)BM * K * 2; }
    __device__ __forceinline__ bool next(int i, Unit& u) const {
        const long L = (long)i * G + c; if (L >= nwg) return false;
        int wgid = (int)L; { const int q = nwg / 8, r = nwg % 8, xcd = wgid % 8, off = wgid / 8; wgid = (xcd < r ? xcd * (q + 1) : r * (q + 1) + (xcd - r) * q) + off; }
        const int nig = 8 * nN, gid = wgid / nig, fm = gid * 8, gsz = (nM - fm) < 8 ? (nM - fm) : 8;
        int pm = fm + ((wgid % nig) % gsz); u.pn = (wgid % nig) / gsz;
        if (latmap) pm = (pm >> 3) * 9 + 1 + (pm & 7);
        u.row0 = pm * BM; u.e = 0; u.B = Bt + (size_t)u.pn * tstepB; return true;
    }
};
template <int NN, size_t GSTRIDE, size_t TSTEPB> struct SchedMoe {
    int ntiles, G, vcu; const LAS int* ttab; const char* Bt;
    __device__ __forceinline__ bool next(int i, Unit& u) const {
        const int L = i * G + vcu; if (L >= ntiles * NN) return false;
        const int tile = L / NN; u.pn = L - tile * NN; const int e = ttab[tile] >> 16;
        u.row0 = tile * BM; u.e = e; u.B = Bt + (size_t)e * GSTRIDE + (size_t)u.pn * TSTEPB; return true;
    }
};
struct EpiBf16 {
    static constexpr bool PERM = true; static constexpr int NVM = 16;
    bf16_t* O; int ldc;
    __device__ __forceinline__ const float* sa_src(const Unit& u, int ui, int r) const { return (const float*)O; }
    __device__ __forceinline__ const float* sw_src(const Unit& u, int c) const { return (const float*)O; }
    __device__ __forceinline__ void operator()(const f32x4 (&acc)[2][2][4][2], const Unit& u, int ui, int wr, int wc, int fr, int fq, const LAS float* scl) const {
        const int row0 = u.row0 + wr * 64 + fr, col0 = u.pn * BM + wc * 32 + 8 * fq;
#pragma unroll
        for (int ai = 0; ai < 2; ++ai)
#pragma unroll
            for (int m = 0; m < 4; ++m) { bf16_t* rowp = O + (size_t)(row0 + ai * HALF + m * 16) * ldc + col0;
#pragma unroll
                for (int bj = 0; bj < 2; ++bj) { const f32x4 v0 = acc[ai][bj][m][0], v1 = acc[ai][bj][m][1];
                    u32x4 w; w.x = cvt_pk_bf16(v0[0], v0[1]); w.y = cvt_pk_bf16(v0[2], v0[3]); w.z = cvt_pk_bf16(v1[0], v1[1]); w.w = cvt_pk_bf16(v1[2], v1[3]);
                    *(u32x4*)(rowp + bj * HALF) = w; } }
    }
};
__device__ __forceinline__ float silu_mul(float g, float u) { return g * __builtin_amdgcn_rcpf(1.0f + __builtin_amdgcn_exp2f(-1.4426950408889634f * g)) * u; }
template <int SWG> struct EpiI8Bf16 {
    static constexpr bool PERM = true; static constexpr int NVM = 16;
    bf16_t* O; int ldc; const float* SA; const float* SW;
    __device__ __forceinline__ const float* sa_src(const Unit& u, int ui, int r) const { return SA + u.row0 + r; }
    __device__ __forceinline__ const float* sw_src(const Unit& u, int c) const { return SW + (size_t)u.e * SWG + u.pn * BM + c; }
    __device__ __forceinline__ void operator()(const i32x4 (&acc)[2][2][4][2], const Unit& u, int ui, int wr, int wc, int fr, int fq, const LAS float* scl) const {
        const int lrow = wr * 64 + fr, row0 = u.row0 + lrow, col0 = u.pn * BM + wc * 32 + 8 * fq;
#pragma unroll
        for (int bj = 0; bj < 2; ++bj) { const f32x4 w0 = *(const LAS f32x4*)(scl + 256 + bj * HALF + wc * 32 + 8 * fq), w1 = *(const LAS f32x4*)(scl + 256 + bj * HALF + wc * 32 + 8 * fq + 4);
#pragma unroll
            for (int ai = 0; ai < 2; ++ai)
#pragma unroll
                for (int m = 0; m < 4; ++m) { const int r = row0 + ai * HALF + m * 16; bf16_t* rowp = O + (size_t)r * ldc + col0 + bj * HALF; const float sa = scl[lrow + ai * HALF + m * 16];
                    const i32x4 v0 = acc[ai][bj][m][0], v1 = acc[ai][bj][m][1]; const f32x4 s0 = w0 * sa, s1 = w1 * sa;
                    const f32x4 f0 = __builtin_convertvector(v0, f32x4) * s0, f1 = __builtin_convertvector(v1, f32x4) * s1;
                    u32x4 w; w.x = cvt_pk_bf16(f0[0], f0[1]); w.y = cvt_pk_bf16(f0[2], f0[3]); w.z = cvt_pk_bf16(f1[0], f1[1]); w.w = cvt_pk_bf16(f1[2], f1[3]);
                    *(u32x4*)rowp = w; } }
    }
};
template <int SWG> struct EpiI8Fp8 {
    static constexpr bool PERM = true; static constexpr int NVM = 16;
    unsigned char* O; int ldc; const float* SA; const float* SW;
    __device__ __forceinline__ const float* sa_src(const Unit& u, int ui, int r) const { return SA + u.row0 + r; }
    __device__ __forceinline__ const float* sw_src(const Unit& u, int c) const { return SW + (size_t)u.e * SWG + u.pn * BM + c; }
    __device__ __forceinline__ void operator()(const i32x4 (&acc)[2][2][4][2], const Unit& u, int ui, int wr, int wc, int fr, int fq, const LAS float* scl) const {
        const int lrow = wr * 64 + fr, row0 = u.row0 + lrow, col0 = u.pn * BM + wc * 32 + 8 * fq;
#pragma unroll
        for (int bj = 0; bj < 2; ++bj) { const f32x4 w0 = *(const LAS f32x4*)(scl + 256 + bj * HALF + wc * 32 + 8 * fq), w1 = *(const LAS f32x4*)(scl + 256 + bj * HALF + wc * 32 + 8 * fq + 4);
#pragma unroll
            for (int ai = 0; ai < 2; ++ai)
#pragma unroll
                for (int m = 0; m < 4; ++m) { const int r = row0 + ai * HALF + m * 16; unsigned char* rowp = O + (size_t)r * ldc + col0 + bj * HALF; const float sa = scl[lrow + ai * HALF + m * 16];
                    const i32x4 v0 = acc[ai][bj][m][0], v1 = acc[ai][bj][m][1]; const f32x4 s0 = w0 * sa, s1 = w1 * sa;
                    const f32x4 f0 = __builtin_convertvector(v0, f32x4) * s0, f1 = __builtin_convertvector(v1, f32x4) * s1;
                    int lo = 0, hi = 0;
                    lo = __builtin_amdgcn_cvt_pk_fp8_f32(f0[0], f0[1], lo, false); lo = __builtin_amdgcn_cvt_pk_fp8_f32(f0[2], f0[3], lo, true);
                    hi = __builtin_amdgcn_cvt_pk_fp8_f32(f1[0], f1[1], hi, false); hi = __builtin_amdgcn_cvt_pk_fp8_f32(f1[2], f1[3], hi, true);
                    *(u32x2*)rowp = (u32x2){(unsigned)lo, (unsigned)hi}; } }
    }
};
struct EpiSwigluI8 {
    static constexpr bool PERM = true; static constexpr int NVM = 8;
    unsigned char* O; int ldc; const float* SA; const float* SW; const LAS int* idxc;
    __device__ __forceinline__ const float* sa_src(const Unit& u, int ui, int r) const { return SA + idxc[(ui & (IDXC_UNITS - 1)) * 256 + r]; }
    __device__ __forceinline__ const float* sw_src(const Unit& u, int c) const { return SW + (size_t)u.e * 1024 + u.pn * BM + c; }
    __device__ __forceinline__ void operator()(const i32x4 (&acc)[2][2][4][2], const Unit& u, int ui, int wr, int wc, int fr, int fq, const LAS float* scl) const {
        const int lrow = wr * 64 + fr, row0 = u.row0 + lrow, col0 = u.pn * HALF + wc * 32 + 8 * fq;
        const LAS float* sw = scl + 256 + wc * 32 + 8 * fq;
        const f32x4 wg0 = *(const LAS f32x4*)sw, wg1 = *(const LAS f32x4*)(sw + 4), wu0 = *(const LAS f32x4*)(sw + HALF), wu1 = *(const LAS f32x4*)(sw + HALF + 4);
#pragma unroll
        for (int ai = 0; ai < 2; ++ai)
#pragma unroll
            for (int m = 0; m < 4; ++m) { unsigned char* rowp = O + (size_t)(row0 + ai * HALF + m * 16) * ldc + col0;
                const float sa = scl[lrow + ai * HALF + m * 16];
                const i32x4 g0 = acc[ai][0][m][0], g1 = acc[ai][0][m][1], u0 = acc[ai][1][m][0], u1 = acc[ai][1][m][1];
                float o[8];
#pragma unroll
                for (int j = 0; j < 4; ++j) { o[j] = silu_mul((float)g0[j] * (sa * wg0[j]), (float)u0[j] * (sa * wu0[j])); o[4 + j] = silu_mul((float)g1[j] * (sa * wg1[j]), (float)u1[j] * (sa * wu1[j])); }
                int lo = 0, hi = 0;
                lo = __builtin_amdgcn_cvt_pk_fp8_f32(o[0], o[1], lo, false); lo = __builtin_amdgcn_cvt_pk_fp8_f32(o[2], o[3], lo, true);
                hi = __builtin_amdgcn_cvt_pk_fp8_f32(o[4], o[5], hi, false); hi = __builtin_amdgcn_cvt_pk_fp8_f32(o[6], o[7], hi, true);
                *(u32x2*)rowp = (u32x2){(unsigned)lo, (unsigned)hi}; }
    }
};

template <bool I8> struct AccT { typedef f32x4 T; };
template <> struct AccT<true> { typedef i32x4 T; };
__device__ __forceinline__ f32x4 mma16(bf16x8 b, bf16x8 a, f32x4 c) { return __builtin_amdgcn_mfma_f32_16x16x32_bf16(b, a, c, 0, 0, 0); }
__device__ __forceinline__ i32x4 mma16(bf16x8 b, bf16x8 a, i32x4 c) { return __builtin_amdgcn_mfma_i32_16x16x64_i8(__builtin_bit_cast(i32x4, b), __builtin_bit_cast(i32x4, a), c, 0, 0, 0); }
template <class Epi, class Sched, bool GATHER, bool I8 = false>
__device__ __forceinline__ void gemm_phase(LAS unsigned char* lds, const void* Abase, const int K, const Sched& S, const Epi& E, const LAS int* idxc, const int tid) {
    const int wid = __builtin_amdgcn_readfirstlane(tid >> 6), lane = tid & 63, wr = wid >> 2, wc = wid & 3, fr = lane & 15, fq = lane >> 4;
    const int RB = I8 ? K : K * 2, nt = RB / 128;
    int Ri[2], Ci[2]; unsigned voffB[2];
#pragma unroll
    for (int i = 0; i < 2; ++i) { int R, C; stage_rc(tid * 16 + i * 8192, R, C); Ri[i] = R; Ci[i] = C; const int Rb = Epi::PERM ? ((R & ~31) + perm32(R & 31)) : R; voffB[i] = (unsigned)(Rb * RB + C * 2); }
    const size_t kstep = 128;
    const size_t hstep = (size_t)HALF * RB;
    const unsigned ldsw = (unsigned)wid * 1024u;
    const int aoff = lds_byte(wr * 64 + fr, fq * 8), boff = lds_byte(wc * 32 + fr, fq * 8);
#define PG8_SA(b, h) (((b) * 2 + (h)) * HTB)
#define PG8_SB(b, h) ((4 + (b) * 2 + (h)) * HTB)
#define PG8_STAGE(bufoff, gbase, voff) do { _Pragma("unroll") for (int _i = 0; _i < 2; ++_i) \
        __builtin_amdgcn_global_load_lds((const unsigned*)((const char*)(gbase) + (voff)[_i]), (LAS unsigned*)(lds + (bufoff) + ldsw + _i * 8192), 16, 0, 0); } while (0)
#define PG8_LDA(dst, b, h) do { _Pragma("unroll") for (int m = 0; m < 4; ++m) _Pragma("unroll") for (int k = 0; k < 2; ++k) dst[m][k] = *(const LAS bf16x8*)(lds + PG8_SA(b, h) + aoff + m * 2048 + k * 1024); } while (0)
#define PG8_LDB(dst, b, h) do { _Pragma("unroll") for (int n = 0; n < 2; ++n) _Pragma("unroll") for (int k = 0; k < 2; ++k) dst[n][k] = *(const LAS bf16x8*)(lds + PG8_SB(b, h) + boff + n * 2048 + k * 1024); } while (0)
#define PG8_MMA(ai, bj, At, Bt) do { __builtin_amdgcn_s_setprio(1); _Pragma("unroll") for (int m = 0; m < 4; ++m) _Pragma("unroll") for (int n = 0; n < 2; ++n) _Pragma("unroll") for (int k = 0; k < 2; ++k) \
        acc[ai][bj][m][n] = mma16(Bt[n][k], At[m][k], acc[ai][bj][m][n]); __builtin_amdgcn_s_setprio(0); } while (0)
#define PG8_WAIT_V(n) asm volatile("s_waitcnt vmcnt(" #n ")" ::: "memory")
#define PG8_WAIT_L(n) asm volatile("s_waitcnt lgkmcnt(" #n ")" ::: "memory")
#define PG8_BAR __builtin_amdgcn_s_barrier()
#define PG8_SCHED __builtin_amdgcn_sched_barrier(0)
#define PG8_MKA(dst, ui, u_) do { _Pragma("unroll") for (int _h = 0; _h < 2; ++_h) _Pragma("unroll") for (int _i = 0; _i < 2; ++_i) { \
        if constexpr (GATHER) dst[_h][_i] = (unsigned)idxc[((ui) & (IDXC_UNITS - 1)) * 256 + _h * HALF + Ri[_i]] * (unsigned)RB + (unsigned)(Ci[_i] * 2); \
        else dst[_h][_i] = (unsigned)((_h * HALF + Ri[_i]) * RB + Ci[_i] * 2); } } while (0)
    Unit cur, nxt; int ui = 0;
    if (!S.next(0, cur)) return;
    LAS float* const sclb = (LAS float*)(lds + SCL_OFF);
#define PG8_SCALES(u_, ui_) do { const float* _src = (wid < 4) ? E.sa_src(u_, ui_, wid * 64 + lane) : E.sw_src(u_, (wid - 4) * 64 + lane); \
        __builtin_amdgcn_global_load_lds((const unsigned*)_src, (LAS unsigned*)(sclb + ((ui_) & 1) * 512 + wid * 64), 4, 0, 0); } while (0)
    constexpr int NEPI = Epi::NVM;
    typedef typename AccT<I8>::T acc_t;
    acc_t acc[2][2][4][2];
#pragma unroll
    for (int a = 0; a < 2; ++a)
#pragma unroll
        for (int b = 0; b < 2; ++b)
#pragma unroll
            for (int m = 0; m < 4; ++m)
#pragma unroll
                for (int n = 0; n < 2; ++n) acc[a][b][m][n] = acc_t{};
    bf16x8 At[4][2], B0[2][2], B1[2][2];
    unsigned curA[2][2], nxtA[2][2];
    PG8_MKA(curA, 0, cur);
    PG8_SCALES(cur, 0);
    const char* cA = GATHER ? (const char*)Abase : (const char*)Abase + (size_t)cur.row0 * RB; const char* cB = cur.B;
    PG8_STAGE(PG8_SB(0, 0), cB, voffB); PG8_STAGE(PG8_SB(0, 1), cB + hstep, voffB); PG8_STAGE(PG8_SA(0, 0), cA, curA[0]); PG8_STAGE(PG8_SA(0, 1), cA, curA[1]);
    if (wr == 1) PG8_BAR;
    PG8_WAIT_V(2); PG8_BAR;
    PG8_STAGE(PG8_SB(1, 0), cB + kstep, voffB); PG8_STAGE(PG8_SA(1, 0), cA + kstep, curA[0]); PG8_STAGE(PG8_SB(1, 1), cB + hstep + kstep, voffB);
    PG8_WAIT_V(6); PG8_BAR;
    for (;;) {
        const bool has_next = S.next(ui + 1, nxt);
        const char* nA = has_next ? (GATHER ? (const char*)Abase : (const char*)Abase + (size_t)nxt.row0 * RB) : cA; const char* nB = has_next ? nxt.B : cB;
        if constexpr (GATHER) { if (has_next) { PG8_MKA(nxtA, ui + 1, nxt); } else {
#pragma unroll
            for (int h = 0; h < 2; ++h)
#pragma unroll
                for (int i = 0; i < 2; ++i) nxtA[h][i] = curA[h][i]; } }
#pragma unroll 1
        for (int t = 0; t < nt; t += 2) {
            const bool last = (t == nt - 2);
            const char* a1 = cA + (size_t)(t + 1) * kstep;
            const char* a2 = last ? nA : cA + (size_t)(t + 2) * kstep; const char* b2 = last ? nB : cB + (size_t)(t + 2) * kstep;
            const char* a3 = a2 + kstep; const char* b3 = b2 + kstep;
            unsigned s0[2], s1[2];
#pragma unroll
            for (int i = 0; i < 2; ++i) { if constexpr (GATHER) { s0[i] = last ? nxtA[0][i] : curA[0][i]; s1[i] = last ? nxtA[1][i] : curA[1][i]; } else { s0[i] = curA[0][i]; s1[i] = curA[1][i]; } }
            const bool relax = (t == 0) && (ui > 0);
            PG8_LDB(B0, 0, 0); PG8_LDB(B1, 0, 1); PG8_SCHED; PG8_LDA(At, 0, 0); PG8_STAGE(PG8_SA(1, 1), a1, curA[1]);
            if (relax) { if constexpr (NEPI == 16) PG8_WAIT_V(24); else PG8_WAIT_V(16); } else PG8_WAIT_V(8);
            PG8_WAIT_L(0); PG8_BAR; PG8_MMA(0, 0, At, B0); PG8_MMA(0, 1, At, B1); PG8_BAR; PG8_SCHED;
            PG8_LDA(At, 0, 1); PG8_STAGE(PG8_SB(0, 0), b2, voffB); PG8_STAGE(PG8_SB(0, 1), b2 + hstep, voffB); PG8_STAGE(PG8_SA(0, 0), a2, s0);
            if (relax) { if constexpr (NEPI == 16) PG8_WAIT_V(24); else PG8_WAIT_V(16); } else PG8_WAIT_V(8);
            PG8_WAIT_L(0); PG8_BAR; PG8_MMA(1, 0, At, B0); PG8_MMA(1, 1, At, B1); PG8_BAR; PG8_SCHED;
            PG8_LDB(B0, 1, 0); PG8_LDB(B1, 1, 1); PG8_SCHED; PG8_LDA(At, 1, 0); PG8_STAGE(PG8_SA(0, 1), a2, s1);
            PG8_WAIT_V(8); PG8_WAIT_L(0); PG8_BAR; PG8_MMA(0, 0, At, B0); PG8_MMA(0, 1, At, B1); PG8_BAR; PG8_SCHED;
            PG8_LDA(At, 1, 1); PG8_STAGE(PG8_SB(1, 0), b3, voffB); PG8_STAGE(PG8_SB(1, 1), b3 + hstep, voffB); PG8_STAGE(PG8_SA(1, 0), a3, s0);
            PG8_WAIT_V(8); PG8_WAIT_L(0); PG8_BAR; PG8_MMA(1, 0, At, B0); PG8_MMA(1, 1, At, B1); PG8_BAR; PG8_SCHED;
        }
        if (wr == 0) PG8_BAR;
        E(acc, cur, ui, wr, wc, fr, fq, sclb + (ui & 1) * 512);
        if (!has_next) break;
#pragma unroll
        for (int a = 0; a < 2; ++a)
#pragma unroll
            for (int b = 0; b < 2; ++b)
#pragma unroll
                for (int m = 0; m < 4; ++m)
#pragma unroll
                    for (int n = 0; n < 2; ++n) acc[a][b][m][n] = acc_t{};
        cur = nxt; cA = nA; cB = nB; ++ui;
        PG8_SCALES(cur, ui);
        if constexpr (GATHER) {
#pragma unroll
            for (int h = 0; h < 2; ++h)
#pragma unroll
                for (int i = 0; i < 2; ++i) curA[h][i] = nxtA[h][i]; }
        if (wr == 1) PG8_BAR;
    }
    PG8_WAIT_V(0);
    PG8_BAR;
#undef PG8_SA
#undef PG8_SB
#undef PG8_STAGE
#undef PG8_LDA
#undef PG8_LDB
#undef PG8_MMA
#undef PG8_WAIT_V
#undef PG8_WAIT_L
#undef PG8_BAR
#undef PG8_SCHED
#undef PG8_MKA
#undef PG8_SCALES
}
}

namespace att {
constexpr int DV = 128, NW = 8, QBLK = 32, KVBLK = 64;
constexpr float THR = 8.f;
#define SBAR() __builtin_amdgcn_sched_barrier(0)
__device__ __forceinline__ int crow(int r, int hi) { return (r & 3) + 8 * (r >> 2) + 4 * hi; }
template <int DQK> struct Cfg {
    static constexpr int NQ = DQK / 16, SHM_K = KVBLK * DQK * 2, KCH = DQK / 64;
    static constexpr int RB0 = DQK >= 128 ? 256 : 128;
    static constexpr int KCH0 = DQK >= 128 ? 2 : 1, KCH1 = DQK == 192 ? 1 : 0, REG1 = KVBLK * RB0;
    static constexpr float SCALE = DQK == 64 ? 0.125f : (DQK == 128 ? 0.088388347648318440f : 0.072168783648703220f);
};
constexpr int SHM_V = KVBLK * DV * 2;

template <int DQK> __device__ __forceinline__ void partialSM(f32x16& p0, f32x16& p1, float& m_reg, float& mn, float& alpha) {
    constexpr float SCALE = Cfg<DQK>::SCALE, C = SCALE * 1.4426950408889634f;
    float pmax = p0[0];
#pragma unroll
    for (int r = 1; r < 16; ++r) pmax = fmaxf(pmax, p0[r]);
#pragma unroll
    for (int r = 0; r < 16; ++r) pmax = fmaxf(pmax, p1[r]);
    { auto rr = __builtin_amdgcn_permlane32_swap(__float_as_uint(pmax), __float_as_uint(pmax), false, false);
      pmax = fmaxf(__uint_as_float(rr[0]), __uint_as_float(rr[1])); }
    if (__builtin_expect(__all(pmax - m_reg <= THR / SCALE), 1)) { mn = m_reg; alpha = 1.f; }
    else { mn = fmaxf(m_reg, pmax); alpha = __builtin_amdgcn_exp2f((m_reg - mn) * C); m_reg = mn; }
    const float mnC = -mn * C;
#pragma unroll
    for (int r = 0; r < 16; ++r) p0[r] = fmaf(p0[r], C, mnC);
#pragma unroll
    for (int r = 0; r < 16; ++r) p1[r] = fmaf(p1[r], C, mnC);
#pragma unroll
    for (int r = 0; r < 16; ++r) p0[r] = __builtin_amdgcn_exp2f(p0[r]);
}
__device__ __forceinline__ void finishSM(f32x16& p0, f32x16& p1, float alpha, float& l_reg, bf16x8& pa0, bf16x8& pa1, bf16x8& pa2, bf16x8& pa3) {
#pragma unroll
    for (int r = 0; r < 16; ++r) p1[r] = __builtin_amdgcn_exp2f(p1[r]);
    float ps = 0;
#pragma unroll
    for (int r = 0; r < 16; ++r) ps += p0[r];
#pragma unroll
    for (int r = 0; r < 16; ++r) ps += p1[r];
    { auto rr = __builtin_amdgcn_permlane32_swap(__float_as_uint(ps), __float_as_uint(ps), false, false);
      ps = __uint_as_float(rr[0]) + __uint_as_float(rr[1]); }
    l_reg = l_reg * alpha + ps;
#define PK4(P, BASE, OUT) do { unsigned a0 = cvt_pk_bf16(P[BASE + 0], P[BASE + 1]), a1 = cvt_pk_bf16(P[BASE + 2], P[BASE + 3]);   \
    unsigned b0 = cvt_pk_bf16(P[BASE + 4], P[BASE + 5]), b1 = cvt_pk_bf16(P[BASE + 6], P[BASE + 7]);                              \
    auto r0 = __builtin_amdgcn_permlane32_swap(a0, b0, false, false); auto r1 = __builtin_amdgcn_permlane32_swap(a1, b1, false, false); \
    u32x4 w = {r0[0], r1[0], r0[1], r1[1]}; OUT = *reinterpret_cast<bf16x8*>(&w); } while (0)
    PK4(p0, 0, pa0); PK4(p0, 8, pa1); PK4(p1, 0, pa2); PK4(p1, 8, pa3);
#undef PK4
}
template <int DQK> __device__ __forceinline__ void qkt(f32x16& p0, f32x16& p1, const char* Ks, const bf16x8* qr, const char* qx, int r32, int hi) {
    p0 = f32x16{}; p1 = f32x16{};
    constexpr int RB0 = Cfg<DQK>::RB0;
#pragma unroll
    for (int d0 = 0; d0 < Cfg<DQK>::NQ; ++d0) {
        bf16x8 b0, b1, q;
        if (d0 < 8) { const int cb = (d0 * 16 + hi * 8) * 2;
            const int sw = (RB0 == 256 ? (r32 & 15) : ((r32 >> 1) & 7)) << 4;
            b0 = *reinterpret_cast<const bf16x8*>(Ks + r32 * RB0 + (cb ^ sw));
            b1 = *reinterpret_cast<const bf16x8*>(Ks + (32 + r32) * RB0 + (cb ^ sw));
            q = qr[d0 < 8 ? d0 : 0];
        } else { const int cb = ((d0 - 8) * 16 + hi * 8) * 2;
            const int sw = ((r32 >> 1) & 7) << 4;
            b0 = *reinterpret_cast<const bf16x8*>(Ks + Cfg<DQK>::REG1 + r32 * 128 + (cb ^ sw));
            b1 = *reinterpret_cast<const bf16x8*>(Ks + Cfg<DQK>::REG1 + (32 + r32) * 128 + (cb ^ sw));
            q = *reinterpret_cast<const bf16x8*>(qx + (d0 - 8) * 1024);
        }
        p0 = __builtin_amdgcn_mfma_f32_32x32x16_bf16(b0, q, p0, 0, 0, 0);
        p1 = __builtin_amdgcn_mfma_f32_32x32x16_bf16(b1, q, p1, 0, 0, 0); }
}
__device__ __forceinline__ int v_rd_base(int lane) { return ((lane & 3) << 3) | (((lane >> 2) & 3) << 6) | (((lane >> 4) & 1) << 5) | (((lane >> 5) & 1) << 8); }
constexpr int v_rd_off(int d0, int ks, int half) { return d0 * 512 + ks * 4096 + half * 2048; }
template <int OFF> __device__ __forceinline__ s16x4 tr_read(int vb) {
    s16x4 r; asm volatile("ds_read_b64_tr_b16 %0, %1 offset:%2" : "=&v"(r) : "v"(vb), "i"(OFF) : "memory"); return r;
}
template <int D0> __device__ __forceinline__ void pv_one(f32x16& od, int vb, bf16x8 pa0, bf16x8 pa1, bf16x8 pa2, bf16x8 pa3) {
    const s16x4 l0 = tr_read<v_rd_off(D0, 0, 0)>(vb), h0 = tr_read<v_rd_off(D0, 0, 1)>(vb), l1 = tr_read<v_rd_off(D0, 1, 0)>(vb), h1 = tr_read<v_rd_off(D0, 1, 1)>(vb);
    const s16x4 l2 = tr_read<v_rd_off(D0, 2, 0)>(vb), h2 = tr_read<v_rd_off(D0, 2, 1)>(vb), l3 = tr_read<v_rd_off(D0, 3, 0)>(vb), h3 = tr_read<v_rd_off(D0, 3, 1)>(vb);
    asm volatile("s_waitcnt lgkmcnt(0)" ::: "memory"); SBAR();
#define PK(L, H) (bf16x8){L[0], L[1], L[2], L[3], H[0], H[1], H[2], H[3]}
    od = __builtin_amdgcn_mfma_f32_32x32x16_bf16(pa0, PK(l0, h0), od, 0, 0, 0);
    od = __builtin_amdgcn_mfma_f32_32x32x16_bf16(pa1, PK(l1, h1), od, 0, 0, 0);
    od = __builtin_amdgcn_mfma_f32_32x32x16_bf16(pa2, PK(l2, h2), od, 0, 0, 0);
    od = __builtin_amdgcn_mfma_f32_32x32x16_bf16(pa3, PK(l3, h3), od, 0, 0, 0);
#undef PK
}
__device__ __forceinline__ void pv_d0(f32x16* o, int vb, bf16x8 pa0, bf16x8 pa1, bf16x8 pa2, bf16x8 pa3) {
    pv_one<0>(o[0], vb, pa0, pa1, pa2, pa3); pv_one<1>(o[1], vb, pa0, pa1, pa2, pa3); pv_one<2>(o[2], vb, pa0, pa1, pa2, pa3); pv_one<3>(o[3], vb, pa0, pa1, pa2, pa3);
}

template <int DQK, bool PIPE, bool QROPE>
__device__ __forceinline__ void attn_unit(const bf16_t* __restrict__ Qb, int ldq, const bf16_t* __restrict__ K0, int ldk0, const bf16_t* __restrict__ K1, int ldk1,
                                          const bf16_t* __restrict__ Vh, int ldv, bf16_t* __restrict__ Ob, int ldo, int nkeys, int qpos0, const f32x2* ropeR, const f32x2* ropeC,
                                          char* lds, LAS unsigned char* ldsl, const int tid) {
    using C = Cfg<DQK>; constexpr int NQ = C::NQ, SHM_K = C::SHM_K, NB = PIPE ? 3 : 2, KCH0 = C::KCH0, KCH1 = C::KCH1;
    const int wid = __builtin_amdgcn_readfirstlane(tid >> 6), lane = tid & 63, r32 = lane & 31, hi = lane >> 5;
    char* V_lds = lds; char* K_lds = lds + NB * SHM_V;
    float* ws = (float*)(lds + NB * SHM_V + NB * SHM_K) + wid * 64; float* li_l = ws; float* al_l = ws + 32;
    float m_reg = -1e30f, l_reg = 0; f32x16 o[4] = {}; constexpr int NQR = NQ < 8 ? NQ : 8; bf16x8 qr[NQR];
    char* qx = lds + NB * SHM_V + NB * SHM_K + 2048 + wid * 4096 + lane * 16;
    const bf16_t* Qw = Qb + (long)(wid * QBLK + r32) * ldq + hi * 8;
#pragma unroll
    for (int d0 = 0; d0 < NQR; ++d0) qr[d0] = *reinterpret_cast<const bf16x8*>(Qw + d0 * 16);
    if constexpr (QROPE) {
        static_assert(DQK == 192, "QROPE: MLA layout");
        const int pos = qpos0 + wid * QBLK + r32, gr = pos >> 6, gc = pos & 63;
#pragma unroll
        for (int blk = 0; blk < 2; ++blk) { const f32x2* tb = (blk == 0 ? ropeR + gr * 16 : ropeC + gc * 16) + hi * 8;
            bf16x8 x1 = *reinterpret_cast<const bf16x8*>(Qw + (8 + 2 * blk) * 16), x2 = *reinterpret_cast<const bf16x8*>(Qw + (9 + 2 * blk) * 16);
#pragma unroll
            for (int i = 0; i < 8; ++i) { const f32x2 cs = tb[i]; const float a = bf2f((unsigned short)x1[i]), b = bf2f((unsigned short)x2[i]);
                x1[i] = (short)f2bf(a * cs.x - b * cs.y); x2[i] = (short)f2bf(b * cs.x + a * cs.y); }
            *reinterpret_cast<bf16x8*>(qx + (2 * blk) * 1024) = x1; *reinterpret_cast<bf16x8*>(qx + (2 * blk + 1) * 1024) = x2; }
    } else { static_assert(NQ <= 8, "fragments beyond 8 need the LDS path"); }
    unsigned voffv[2], koff[KCH0 + (KCH1 ? 1 : 0)];
#pragma unroll
    for (int i = 0; i < 2; ++i) { const int st = 4 * wid + 2 * i + (lane >> 5), kk = (st >> 2) * 8 + ((lane & 31) >> 2), k = (kk & ~0xC) | ((kk & 4) << 1) | ((kk & 8) >> 1), c = (st & 3) * 32 + (lane & 3) * 8;
        voffv[i] = (unsigned)(k * ldv + c) * 2u; }
#pragma unroll
    for (int i = 0; i < KCH0; ++i) { const int sgm = KCH0 * wid + i; int row, q; if (C::RB0 == 256) { row = 4 * sgm + (lane >> 4); q = lane & 15; } else { row = 8 * sgm + (lane >> 3); q = lane & 7; }
        koff[i] = (unsigned)(row * ldk0 + (q ^ (C::RB0 == 256 ? (row & 15) : ((row >> 1) & 7))) * 8) * 2u; }
    if constexpr (KCH1) { const int row = 8 * wid + (lane >> 3), q = lane & 7; koff[KCH0] = (unsigned)(row * ldk1 + (q ^ ((row >> 1) & 7)) * 8) * 2u; }
    const int vb0 = (int)(uintptr_t)V_lds + v_rd_base(lane);
    LAS unsigned char* Vl = ldsl; LAS unsigned char* Kl = ldsl + NB * SHM_V;
#define GLDS(gp, lp) __builtin_amdgcn_global_load_lds((const unsigned*)(gp), (LAS unsigned*)(lp), 16, 0, 0)
#define DMA(k0, b) do { const char* _vb = (const char*)(Vh + (long)(k0) * ldv); const char* _kb0 = (const char*)(K0 + (long)(k0) * ldk0); \
    _Pragma("unroll") for (int _i = 0; _i < 2; ++_i) GLDS(_vb + voffv[_i], Vl + (b) * SHM_V + (2 * wid + _i) * 1024); \
    _Pragma("unroll") for (int _i = 0; _i < KCH0; ++_i) GLDS(_kb0 + koff[_i], Kl + (b) * SHM_K + (KCH0 * wid + _i) * 1024); \
    if constexpr (KCH1) { const char* _kb1 = (const char*)(K1 + (long)(k0) * ldk1); GLDS(_kb1 + koff[KCH0], Kl + (b) * SHM_K + C::REG1 + wid * 1024); } } while (0)
#define VM0() asm volatile("s_waitcnt vmcnt(0)" ::: "memory")
#define RESC(a) do { if (__any((a) < 1.f)) { if (hi == 0) al_l[r32] = (a); asm volatile("s_waitcnt lgkmcnt(0)" ::: "memory"); \
    _Pragma("unroll") for (int d = 0; d < 4; ++d) _Pragma("unroll") for (int r = 0; r < 16; ++r) o[d][r] *= al_l[crow(r, hi)]; } } while (0)
    bf16x8 pa0, pa1, pa2, pa3; const int NT = nkeys / KVBLK;
    if constexpr (PIPE) {
        f32x16 pA0, pA1, pB0, pB1; float mnA, mnB, alA, alB;
        int bc = 1, bp = 0, bn = 2;
        DMA(0, 0); DMA(KVBLK, 1); VM0(); __syncthreads();
        qkt<DQK>(pA0, pA1, K_lds, qr, qx, r32, hi); partialSM<DQK>(pA0, pA1, m_reg, mnA, alA);
#define STEP(PC0, PC1, mnC, alC, PP0, PP1, alP, j) do { \
        if ((j) + 1 < NT) DMA(((j) + 1) * KVBLK, bn); \
        SBAR(); qkt<DQK>(PC0, PC1, K_lds + bc * SHM_K, qr, qx, r32, hi); \
        finishSM(PP0, PP1, alP, l_reg, pa0, pa1, pa2, pa3); SBAR(); \
        pv_d0(o, vb0 + bp * SHM_V, pa0, pa1, pa2, pa3); partialSM<DQK>(PC0, PC1, m_reg, mnC, alC); \
        RESC(alC); VM0(); __syncthreads(); \
        { const int _t = bp; bp = bc; bc = bn; bn = _t; } } while (0)
        int j = 1;
        for (; j + 1 < NT; j += 2) { STEP(pB0, pB1, mnB, alB, pA0, pA1, alA, j); STEP(pA0, pA1, mnA, alA, pB0, pB1, alB, j + 1); }
        STEP(pB0, pB1, mnB, alB, pA0, pA1, alA, j);
#undef STEP
        finishSM(pB0, pB1, alB, l_reg, pa0, pa1, pa2, pa3); SBAR();
        pv_d0(o, vb0 + bp * SHM_V, pa0, pa1, pa2, pa3);
    } else {
        f32x16 p0, p1; float mn, al;
        DMA(0, 0); VM0(); __syncthreads();
        for (int j = 0; j < NT; ++j) {
            const int bs = j & 1;
            if (j + 1 < NT) DMA((j + 1) * KVBLK, bs ^ 1);
            SBAR(); qkt<DQK>(p0, p1, K_lds + bs * SHM_K, qr, qx, r32, hi); partialSM<DQK>(p0, p1, m_reg, mn, al);
            RESC(al);
            finishSM(p0, p1, al, l_reg, pa0, pa1, pa2, pa3); SBAR();
            pv_d0(o, vb0 + bs * SHM_V, pa0, pa1, pa2, pa3);
            VM0(); __syncthreads();
        }
    }
    if (hi == 0) li_l[r32] = l_reg; asm volatile("s_waitcnt lgkmcnt(0)" ::: "memory");
    float rli[16];
#pragma unroll
    for (int r = 0; r < 16; ++r) rli[r] = __builtin_amdgcn_rcpf(li_l[crow(r, hi)]);
    bf16_t* Ow = Ob + (long)(wid * QBLK) * ldo;
#pragma unroll
    for (int r = 0; r < 16; ++r) { const int orow = crow(r, hi);
#pragma unroll
        for (int d0 = 0; d0 < 4; ++d0) Ow[(long)orow * ldo + d0 * 32 + r32] = (bf16_t)f2bf(o[d0][r] * rli[r]); }
    asm volatile("s_waitcnt vmcnt(0)" ::: "memory");
    __syncthreads();
#undef GLDS
#undef DMA
#undef VM0
#undef RESC
}
}

struct Args { const float* in[28]; float* out; unsigned char* ws; int ph_lo, ph_hi; };
typedef const __attribute__((address_space(4))) Args* KArgs;
struct Frame {
    LAS unsigned char* lds; char* ldsg;
    unsigned* ctl; unsigned char* ws; KArgs ka;
    int tid, lane, wave, vcu, G, gw, NGW;
};
#define PHASE_BEGIN(F) __syncthreads(); Frame P = (F); { int _l; asm volatile("v_mbcnt_lo_u32_b32 %0, -1, 0\n\tv_mbcnt_hi_u32_b32 %0, -1, %0" : "=v"(_l)); long _z = 0; asm volatile("" : "+s"(_z)); unsigned char* _w = (F).ka->ws + _z; P.ws = _w; P.ctl = (unsigned*)_w;     \
    P.lane = _l; P.tid = P.wave * 64 + _l; P.gw = P.vcu * 8 + P.wave; }
enum { I_X = 0, I_C, I_CTX, I_CCTX, I_ADAW, I_ADAB, I_LNMG, I_LNMB, I_LNFG, I_LNFB, I_ABWIN, I_ABWOUT, I_DLAM, I_SUBLN, I_QNG, I_KNG,
       I_MDOWN, I_MQNG, I_MUQ, I_MKVNG, I_MUKV, I_MWO, I_RW, I_RB, I_EWIN, I_EWOUT, I_SWIN, I_SWOUT };

__device__ __forceinline__ int tok_row(int layer, int t) { return layer ? (t >> 11) * RPB + CTXL + (t & 2047) : t; }

__constant__ float INV128[32] = { 1.f, 0.749894202f, 0.562341332f, 0.421696514f, 0.316227764f, 0.237137392f, 0.177827939f, 0.133352146f, 0.100000001f, 0.0749894157f, 0.0562341288f, 0.0421696492f,
    0.0316227786f, 0.0237137359f, 0.0177827943f, 0.0133352149f, 0.00999999978f, 0.00749894232f, 0.00562341325f, 0.00421696482f, 0.00316227786f, 0.00237137382f, 0.00177827943f, 0.00133352145f,
    0.00100000005f, 0.000749894185f, 0.000562341302f, 0.000421696546f, 0.000316227786f, 0.000237137385f, 0.00017782794f, 0.00013335215f };

__device__ __forceinline__ f32x2 sincos_d(double a) {
    const double twopi = 6.283185307179586476925287;
    const double k = __builtin_rint(a / twopi); const double r = a - k * twopi, r2 = r * r;
    double ts = r, tc = 1.0, ss = r, cc = 1.0;
#pragma unroll 1
    for (int n = 1; n <= 15; ++n) { tc *= -r2 / (double)((2 * n - 1) * (2 * n)); cc += tc; ts *= -r2 / (double)((2 * n) * (2 * n + 1)); ss += ts; }
    return (f32x2){(float)cc, (float)ss};
}

__device__ __forceinline__ int fresh_lane() { int l; asm volatile("v_mbcnt_lo_u32_b32 %0, -1, 0\n\tv_mbcnt_hi_u32_b32 %0, -1, %0" : "=v"(l)); return l; }
__device__ __forceinline__ int fresh_tid(const Frame& F) { return F.wave * 64 + fresh_lane(); }
__device__ __forceinline__ void transpose_item(const float* W, int K, int N, bf16_t* WT, int k0, int n0, int drow0, LAS float* scr, int lane) {
#pragma unroll 8
    for (int i = 0; i < 32; ++i) { const int kk = 2 * i + (lane >> 5); scr[kk * 33 + (lane & 31)] = W[(size_t)(k0 + kk) * N + n0 + (lane & 31)]; }
    asm volatile("s_waitcnt lgkmcnt(0)" ::: "memory");
    const int c = lane & 7;
#pragma unroll
    for (int j = 0; j < 4; ++j) { const int n = (lane >> 3) + 8 * j; const LAS float* s = scr + (8 * c) * 33 + n;
        u32x4 o; o.x = pk2(s[0 * 33], s[1 * 33]); o.y = pk2(s[2 * 33], s[3 * 33]); o.z = pk2(s[4 * 33], s[5 * 33]); o.w = pk2(s[6 * 33], s[7 * 33]);
        *(u32x4*)(WT + (size_t)(drow0 + n) * K + k0 + 8 * c) = o; }
    asm volatile("s_waitcnt lgkmcnt(0)" ::: "memory");
}
struct QItem { const float* W; int N, n0, drow; signed char* Q; float* SW; };
template <int KW, int NC, class Dec>
__device__ __forceinline__ void quant_loop(Frame& F, int nitems, const Dec& dec) {
    LAS unsigned short* scr = (LAS unsigned short*)(F.lds + F.wave * 16384);
    LAS float* PM = (LAS float*)(F.lds + 131072);
    constexpr int K = 8 * KW, CH = KW / 16, LPR = NC / 4, RPI = 64 / LPR, NL = KW / RPI;
    static_assert(KW * NC * 2 <= 16384 && (NC == 32 || NC == 64), "quant_loop tile");
    const int k0 = F.wave * KW, rg = F.lane / LPR, c4 = (F.lane % LPR) * 4;
    f32x4 regs[NL]; QItem cur, nxt;
    int it = F.vcu; if (it >= nitems) return;
    dec(it, cur);
#pragma unroll
    for (int i = 0; i < NL; ++i) regs[i] = *(const f32x4*)(cur.W + (size_t)(k0 + RPI * i + rg) * cur.N + cur.n0 + c4);
    for (;;) {
        f32x4 am = {0.f, 0.f, 0.f, 0.f};
#pragma unroll
        for (int i = 0; i < NL; ++i) { const f32x4 w = regs[i]; am[0] = fmaxf(am[0], fabsf(w[0])); am[1] = fmaxf(am[1], fabsf(w[1])); am[2] = fmaxf(am[2], fabsf(w[2])); am[3] = fmaxf(am[3], fabsf(w[3]));
            const int sw = (((RPI * i) >> 4) & 15) << 1;
            const unsigned lo = pk2(w[0], w[1]), hi = pk2(w[2], w[3]);
            *(LAS u32x2*)(scr + (RPI * i + rg) * NC + (c4 ^ (sw & 28))) = (sw & 2) ? (u32x2){hi, lo} : (u32x2){lo, hi}; }
#pragma unroll
        for (int q = 0; q < 4; ++q) { float v = am[q];
#pragma unroll
            for (int o = LPR; o < 64; o <<= 1) v = fmaxf(v, __shfl_xor(v, o));
            am[q] = v; }
        if (F.lane < LPR) *(LAS f32x4*)(PM + F.wave * NC + c4) = am;
        __syncthreads();
        if (F.tid < NC) { float m = 0.f;
#pragma unroll
            for (int w = 0; w < 8; ++w) m = fmaxf(m, PM[w * NC + F.tid]);
            PM[512 + F.tid] = m > 0.f ? 127.0f / m : 0.f; cur.SW[cur.drow + F.tid] = m * (1.0f / 127.0f); }
        __syncthreads();
        const int itn = it + F.G; const bool has_next = itn < nitems;
        if (has_next) { dec(itn, nxt);
#pragma unroll
            for (int i = 0; i < NL; ++i) regs[i] = *(const f32x4*)(nxt.W + (size_t)(k0 + RPI * i + rg) * nxt.N + nxt.n0 + c4); }
#pragma unroll 1
        for (int pass = 0; pass < NC * CH / 64; ++pass) { const int cidx = pass * 64 + F.lane, n = cidx / CH, kb = (cidx % CH) * 16; const float inv = PM[512 + n]; u32x4 o;
#pragma unroll
            for (int d = 0; d < 4; ++d) { unsigned wv = 0;
#pragma unroll
                for (int e = 0; e < 4; ++e) { const float v = bf2f(scr[(kb + d * 4 + e) * NC + (n ^ (((kb >> 4) & 15) << 1))]) * inv; int q = (int)__builtin_rintf(v); q = q > 127 ? 127 : (q < -127 ? -127 : q); wv |= ((unsigned)q & 0xffu) << (8 * e); }
                o[d] = wv; }
            *(u32x4*)(cur.Q + (size_t)(cur.drow + n) * K + k0 + kb) = o; }
        __syncthreads();
        if (!has_next) break;
        it = itn; cur = nxt;
    }
}
struct Dec256 { KArgs ka; unsigned char* ws;
    __device__ __forceinline__ void operator()(int it, QItem& p) const { float* SWD = (float*)(ws + WS_SWD);
        if (it < 4160) { const int m = it >> 5, l = m / 65, e = m - l * 65; p.n0 = (it & 31) * 32; p.N = 1024;
            p.W = (e < 64) ? ka->in[I_EWIN] + ((size_t)l * 64 + e) * 2048 * 1024 : ka->in[I_SWIN] + (size_t)l * 2048 * 1024;
            p.drow = (p.n0 < 512) ? ((p.n0 >> 7) * 256 + (p.n0 & 127)) : (((p.n0 - 512) >> 7) * 256 + 128 + ((p.n0 - 512) & 127));
            p.Q = (signed char*)(ws + WS_EXP_IN + (size_t)m * EXP_IN_BYTES); p.SW = (float*)(ws + WS_SW) + (size_t)m * 1024; }
        else { int r = it - 4160;
            if (r < 144) { p.W = ka->in[I_ABWIN]; p.N = ABW; p.Q = (signed char*)(ws + WS_W_IN); p.SW = SWD + SWD_IN; }
            else if ((r -= 144) < 64) { p.W = ka->in[I_ABWOUT]; p.N = 2048; p.Q = (signed char*)(ws + WS_W_OUT); p.SW = SWD + SWD_OUT; }
            else if ((r -= 64) < 34) { p.W = ka->in[I_MDOWN]; p.N = 1088; p.Q = (signed char*)(ws + WS_W_DOWN); p.SW = SWD + SWD_DOWN; }
            else { r -= 34; p.W = ka->in[I_MWO]; p.N = 2048; p.Q = (signed char*)(ws + WS_W_O); p.SW = SWD + SWD_O; }
            p.n0 = r * 32; p.drow = p.n0; } }
};
struct Dec64 { KArgs ka; unsigned char* ws;
    __device__ __forceinline__ void operator()(int it, QItem& p) const { float* SWD = (float*)(ws + WS_SWD);
        if (it < 4160) { const int m = it >> 5, l = m / 65, e = m - l * 65; p.n0 = (it & 31) * 64; p.N = 2048;
            p.W = (e < 64) ? ka->in[I_EWOUT] + ((size_t)l * 64 + e) * 512 * 2048 : ka->in[I_SWOUT] + (size_t)l * 512 * 2048;
            p.Q = (signed char*)(ws + WS_EXP_OUT + (size_t)m * EXP_OUT_BYTES); p.SW = (float*)(ws + WS_SW2) + (size_t)m * 2048; }
        else { int r = it - 4160;
            if (r < 48) { p.W = ka->in[I_MUQ]; p.N = UQ_N; p.Q = (signed char*)(ws + WS_W_UQ); p.SW = SWD + SWD_UQ; }
            else { r -= 48; p.W = ka->in[I_MUKV]; p.N = UKV_N; p.Q = (signed char*)(ws + WS_W_UKV); p.SW = SWD + SWD_UKV; }
            p.n0 = r * 64; }
        p.drow = p.n0; }
};
__device__ __forceinline__ void transpose_matrix(Frame& F, const float* W, int K, int N, bf16_t* WT, int mode, int& cursor) {
    LAS float* scr = (LAS float*)(F.lds + F.wave * 16384);
    const int nblk = N / 32, nitems = (K / 64) * nblk;
    int it = (F.gw - cursor) % F.NGW; if (it < 0) it += F.NGW;
    for (; it < nitems; it += F.NGW) { const int kb = it / nblk, nb = it % nblk, n0 = nb * 32;
        int drow = n0; if (mode == 1) drow = (n0 < 512) ? ((n0 >> 7) * 256 + (n0 & 127)) : (((n0 - 512) >> 7) * 256 + 128 + ((n0 - 512) & 127));
        transpose_item(W, K, N, WT, kb * 64, n0, drow, scr, F.lane); }
    cursor = (cursor + nitems) % F.NGW;
}

__device__ __forceinline__ void p0_prologue(Frame& F) {
    {
        LAS float* act = (LAS float*)F.lds;
        LAS float* part = (LAS float*)(F.lds + 9 * 2048 * 4);
        for (int i = F.tid; i < 9 * 2048; i += 512) { const int m = i >> 11, k = i & 2047; const float v = (m < 8) ? F.ka->in[I_C][m * 2048 + k] : F.ka->in[I_CCTX][k]; act[i] = v / (1.0f + __expf(-v)); }
        __syncthreads();
        float* MOD = (float*)(F.ws + WS_MOD);
        const int l16 = F.lane & 15, kg = (F.tid >> 4);
        for (int item = F.vcu; item < 2 * 192; item += F.G) {
            const int layer = item / 192, n0 = (item % 192) * 64;
            const float* W = F.ka->in[I_ADAW] + (size_t)layer * 2048 * 12288 + n0 + l16 * 4;
            f32x4 acc[9];
#pragma unroll
            for (int m = 0; m < 9; ++m) acc[m] = (f32x4){0.f, 0.f, 0.f, 0.f};
#pragma unroll 4
            for (int j = 0; j < 64; ++j) { const int k = kg + 32 * j; const f32x4 w = *(const f32x4*)(W + (size_t)k * 12288);
#pragma unroll
                for (int m = 0; m < 9; ++m) acc[m] += w * act[m * 2048 + k]; }
#pragma unroll
            for (int m = 0; m < 9; ++m)
#pragma unroll
                for (int q = 0; q < 4; ++q) { float v = acc[m][q]; v += __shfl_xor(v, 16); v += __shfl_xor(v, 32); acc[m][q] = v; }
            if (F.lane < 16) {
#pragma unroll
                for (int m = 0; m < 9; ++m) *(LAS f32x4*)(part + (F.wave * 9 + m) * 64 + l16 * 4) = acc[m]; }
            __syncthreads();
            for (int i = F.tid; i < 9 * 64; i += 512) { const int m = i >> 6, n = i & 63; float s = 0.f;
#pragma unroll
                for (int w = 0; w < 8; ++w) s += part[(w * 9 + m) * 64 + n];
                MOD[((size_t)layer * 9 + m) * 12288 + n0 + n] = s + F.ka->in[I_ADAB][layer * 12288 + n0 + n]; }
            __syncthreads();
        }
    }
    {
        f32x2* tab = (f32x2*)(F.ws + WS_TAB);
        for (int i = F.gw * 64 + F.lane; i < 512 + 1024 + 1024 + 2048; i += F.NGW * 64) {
            int pos, f; double inv; f32x2* dst;
            if (i < 512) { pos = i >> 4; f = i & 15; inv = (double)INV128[2 * f]; dst = tab + TAB64R / 8 + i; }
            else if (i < 1536) { const int j = i - 512; pos = j >> 4; f = j & 15; inv = (double)INV128[2 * f]; dst = tab + TAB64C / 8 + j; }
            else if (i < 2560) { const int j = i - 1536; pos = j >> 5; f = j & 31; inv = (double)INV128[f]; dst = tab + TAB128R / 8 + j; }
            else { const int j = i - 2560; pos = j >> 5; f = j & 31; inv = (double)INV128[f]; dst = tab + TAB128C / 8 + j; }
            *dst = sincos_d((double)(float)((float)pos * (float)inv));
        }
        u32x4* z = (u32x4*)(F.ws + WS_W_DOWN + (size_t)1088 * D);
        for (int i = F.gw * 64 + F.lane; i < (DOWN_N - 1088) * D / 16; i += F.NGW * 64) z[i] = (u32x4){0u, 0u, 0u, 0u};
        for (int i = F.gw * 64 + F.lane; i < DOWN_N - 1088; i += F.NGW * 64) ((float*)(F.ws + WS_SWD))[SWD_DOWN + 1088 + i] = 0.f;
    }
    {
        { Dec256 d{F.ka, F.ws}; quant_loop<256, 32>(F, 4160 + 144 + 64 + 34 + 64, d); }
        __syncthreads();
        { Dec64 d{F.ka, F.ws}; quant_loop<64, 64>(F, 4160 + 48 + 64, d); }
        __syncthreads();
        int cursor = 0;
        for (int l = 0; l < 2; ++l) transpose_matrix(F, F.ka->in[I_RW] + (size_t)l * 2048 * 64, 2048, 64, (bf16_t*)(F.ws + WS_ROUTER + (size_t)l * 64 * 2048 * 2), 0, cursor);
    }
}

__device__ __forceinline__ const float* x_src(Frame& F, int layer, int r) {
    if (layer) return (const float*)(F.ws + WS_X) + (size_t)r * D;
    const int b = r / RPB, i = r - b * RPB;
    return (i < CTXL) ? F.ka->in[I_CTX] + ((size_t)b * CTXL + i) * D : F.ka->in[I_X] + ((size_t)b * SEQ + (i - CTXL)) * D;
}
__device__ __forceinline__ const float* mod_row(Frame& F, int layer, int r) { const int b = r / RPB, i = r - b * RPB; return (const float*)(F.ws + WS_MOD) + ((size_t)layer * 9 + ((i < CTXL) ? 8 : b)) * 12288; }

__device__ __forceinline__ void ld8f(const float* p, float (&v)[8]) { const f32x4 a = *(const f32x4*)p, b = *(const f32x4*)(p + 4); v[0] = a[0]; v[1] = a[1]; v[2] = a[2]; v[3] = a[3]; v[4] = b[0]; v[5] = b[1]; v[6] = b[2]; v[7] = b[3]; }
__device__ __forceinline__ void ld8f_nt(const float* p, float (&v)[8]) { const f32x4 a = __builtin_nontemporal_load((const f32x4*)p), b = __builtin_nontemporal_load((const f32x4*)(p + 4)); v[0] = a[0]; v[1] = a[1]; v[2] = a[2]; v[3] = a[3]; v[4] = b[0]; v[5] = b[1]; v[6] = b[2]; v[7] = b[3]; }
__device__ __forceinline__ void ld8l(const LAS float* p, float (&v)[8]) { const f32x4 a = *(const LAS f32x4*)p, b = *(const LAS f32x4*)(p + 4); v[0] = a[0]; v[1] = a[1]; v[2] = a[2]; v[3] = a[3]; v[4] = b[0]; v[5] = b[1]; v[6] = b[2]; v[7] = b[3]; }
__device__ __forceinline__ void st8f(float* p, const float (&v)[8]) { *(f32x4*)p = (f32x4){v[0], v[1], v[2], v[3]}; *(f32x4*)(p + 4) = (f32x4){v[4], v[5], v[6], v[7]}; }
__device__ __forceinline__ void unpk8(const u32x4 w, float (&v)[8]) {
#pragma unroll
    for (int e = 0; e < 4; ++e) { v[2 * e] = bflo(w[e]); v[2 * e + 1] = bfhi(w[e]); } }
__device__ __forceinline__ void unfp8(const u32x2 w, float (&v)[8]) {
#pragma unroll
    for (int d = 0; d < 2; ++d) { const f32x2 a = __builtin_amdgcn_cvt_pk_f32_fp8((int)w[d], false), b = __builtin_amdgcn_cvt_pk_f32_fp8((int)w[d], true); v[4 * d] = a.x; v[4 * d + 1] = a.y; v[4 * d + 2] = b.x; v[4 * d + 3] = b.y; } }
__device__ __forceinline__ u32x4 pk8(const float (&v)[8]) { u32x4 w;
#pragma unroll
    for (int e = 0; e < 4; ++e) w[e] = pk2(v[2 * e], v[2 * e + 1]);
    return w; }

__device__ __forceinline__ void quant_row_store(const float (&v)[4][8], signed char* dst, float* scale, int lane) {
    float am = 0.f;
#pragma unroll
    for (int j = 0; j < 4; ++j)
#pragma unroll
        for (int e = 0; e < 8; ++e) am = fmaxf(am, fabsf(v[j][e]));
#pragma unroll
    for (int o = 1; o < 64; o <<= 1) am = fmaxf(am, __shfl_xor(am, o));
    const float inv = am > 0.f ? 127.0f / am : 0.f;
    if (lane == 0) *scale = am * (1.0f / 127.0f);
#pragma unroll
    for (int j = 0; j < 4; ++j) { u32x2 w;
#pragma unroll
        for (int d = 0; d < 2; ++d) { unsigned wv = 0;
#pragma unroll
            for (int e = 0; e < 4; ++e) { int qv = (int)__builtin_rintf(v[j][d * 4 + e] * inv); qv = qv > 127 ? 127 : (qv < -127 ? -127 : qv); wv |= ((unsigned)qv & 0xffu) << (8 * e); }
            w[d] = wv; }
        *(u32x2*)(dst + 512 * j + 8 * lane) = w; }
}
__device__ __forceinline__ void quant_row512_store(const float (&v)[8], signed char* dst, float* scale, int lane) {
    float am = 0.f;
#pragma unroll
    for (int e = 0; e < 8; ++e) am = fmaxf(am, fabsf(v[e]));
#pragma unroll
    for (int o = 1; o < 64; o <<= 1) am = fmaxf(am, __shfl_xor(am, o));
    const float inv = am > 0.f ? 127.0f / am : 0.f;
    if (lane == 0) *scale = am * (1.0f / 127.0f);
    u32x2 w;
#pragma unroll
    for (int d = 0; d < 2; ++d) { unsigned wv = 0;
#pragma unroll
        for (int e = 0; e < 4; ++e) { int qv = (int)__builtin_rintf(v[d * 4 + e] * inv); qv = qv > 127 ? 127 : (qv < -127 ? -127 : qv); wv |= ((unsigned)qv & 0xffu) << (8 * e); }
        w[d] = wv; }
    *(u32x2*)(dst + 8 * lane) = w;
}

template <int R> __device__ __forceinline__ void p1_rows(Frame& F, int t0, int i) {
    const LAS float* PA = (const LAS float*)F.lds;
    float x[R][4][8]; int var[R];
#pragma unroll
    for (int q = 0; q < R; ++q) { const int r = t0 + i + 8 * q; const float* xs = x_src(F, 0, r); var[q] = ((r % RPB) < CTXL) ? 2 : 0;
#pragma unroll
        for (int j = 0; j < 4; ++j) ld8f_nt(xs + 512 * j + 8 * F.lane, x[q][j]); }
#pragma unroll
    for (int q = 0; q < R; ++q) { const int r = t0 + i + 8 * q;
#pragma unroll
        for (int j = 0; j < 4; ++j) { const int c = 512 * j + 8 * F.lane; float sh[8], sc[8]; ld8l(PA + var[q] * 2048 + c, sh); ld8l(PA + (var[q] + 1) * 2048 + c, sc);
#pragma unroll
            for (int e = 0; e < 8; ++e) x[q][j][e] = x[q][j][e] * (1.0f + sc[e]) + sh[e]; }
        quant_row_store(x[q], (signed char*)(F.ws + WS_H8) + (size_t)r * D, (float*)(F.ws + WS_SA) + r, F.lane); }
}
__device__ __forceinline__ void p1_modulate(Frame& F) {
    LAS float* PA = (LAS float*)F.lds;
    constexpr int BR = 72, nblk = T_ALL / BR;
    const float* MOD = (const float*)(F.ws + WS_MOD);
    for (int blk = F.vcu; blk < nblk; blk += F.G) {
        const int t0 = blk * BR, b = t0 / RPB;
        __syncthreads();
        { const int c = F.tid * 4; const float* mb = MOD + (size_t)b * 12288; const float* mc = MOD + (size_t)8 * 12288;
          *(LAS f32x4*)(PA + c) = *(const f32x4*)(mb + c); *(LAS f32x4*)(PA + 2048 + c) = *(const f32x4*)(mb + 2048 + c);
          *(LAS f32x4*)(PA + 4096 + c) = *(const f32x4*)(mc + c); *(LAS f32x4*)(PA + 6144 + c) = *(const f32x4*)(mc + 2048 + c); }
        __syncthreads();
        for (int i = F.wave; i < BR; i += 16) { if (i + 8 < BR) p1_rows<2>(F, t0, i); else p1_rows<1>(F, t0, i); }
    }
}

__device__ __forceinline__ void p_post_ab(Frame& F) {
    bf16_t* P = (bf16_t*)(F.ws + WS_PROJ);
    const f32x2* t64r = (const f32x2*)(F.ws + WS_TAB + TAB64R); const f32x2* t64c = (const f32x2*)(F.ws + WS_TAB + TAB64C);
    const f32x2* t128r = (const f32x2*)(F.ws + WS_TAB + TAB128R); const f32x2* t128c = (const f32x2*)(F.ws + WS_TAB + TAB128C);
    const float* qg = F.ka->in[I_QNG]; const float* kg = F.ka->in[I_KNG];
    for (int r = F.gw; r < T_ALL; r += F.NGW) {
        const int b = r / RPB, i = r - b * RPB; const bool lat = i >= CTXL; const int pos = i - CTXL, gr = pos >> 6, gc = pos & 63;
        bf16_t* row = P + (size_t)r * ABW;
        if (lat) {
            bf16_t* blk = row + F.lane * 32; const f32x2* tb = (F.lane & 1) ? t64c + gc * 16 : t64r + gr * 16;
            u32x4 w[4];
#pragma unroll
            for (int q = 0; q < 4; ++q) w[q] = *(const u32x4*)(blk + 8 * q);
#pragma unroll
            for (int q = 0; q < 2; ++q)
#pragma unroll
                for (int e = 0; e < 4; ++e) { const unsigned a = w[q][e], bq = w[q + 2][e]; const f32x2 c0 = tb[q * 8 + e * 2], c1 = tb[q * 8 + e * 2 + 1];
                    const float a0 = bflo(a), a1 = bfhi(a), b0 = bflo(bq), b1 = bfhi(bq);
                    w[q][e] = pk2(a0 * c0.x - b0 * c0.y, a1 * c1.x - b1 * c1.y); w[q + 2][e] = pk2(b0 * c0.x + a0 * c0.y, b1 * c1.x + a1 * c1.y); }
#pragma unroll
            for (int q = 0; q < 4; ++q) *(u32x4*)(blk + 8 * q) = w[q];
        }
#pragma unroll
        for (int pass = 0; pass < 2; ++pass) {
            const int head = pass * 8 + (F.lane >> 3), s = F.lane & 7; const bool act = head < 10;
            bf16_t* hp = row + (head < 8 ? QB_OFF + head * 128 : KB_OFF + (head - 8) * 128); const float* g = head < 8 ? qg : kg;
            float v[4][4]; float ss = 0.f;
            if (act) {
#pragma unroll
                for (int q = 0; q < 4; ++q) { const int c = (q >> 1) * 64 + (q & 1) * 32 + s * 4; const u32x2 w = *(const u32x2*)(hp + c);
                    v[q][0] = bflo(w.x); v[q][1] = bfhi(w.x); v[q][2] = bflo(w.y); v[q][3] = bfhi(w.y);
#pragma unroll
                    for (int e = 0; e < 4; ++e) ss += v[q][e] * v[q][e]; }
            }
            ss += __shfl_xor(ss, 1); ss += __shfl_xor(ss, 2); ss += __shfl_xor(ss, 4);
            if (act) {
                const float rs = 1.0f / sqrtf(ss * (1.0f / 128.0f) + 1e-6f);
#pragma unroll
                for (int q = 0; q < 4; ++q) { const int c = (q >> 1) * 64 + (q & 1) * 32 + s * 4;
#pragma unroll
                    for (int e = 0; e < 4; ++e) v[q][e] = v[q][e] * rs * g[c + e]; }
                if (lat) {
#pragma unroll
                    for (int half = 0; half < 2; ++half) { const f32x2* tb = (half ? t128c + gc * 32 : t128r + gr * 32) + s * 4;
#pragma unroll
                        for (int e = 0; e < 4; ++e) { const f32x2 cs = tb[e]; const float a = v[half * 2][e], bq = v[half * 2 + 1][e];
                            v[half * 2][e] = a * cs.x - bq * cs.y; v[half * 2 + 1][e] = bq * cs.x + a * cs.y; } }
                }
#pragma unroll
                for (int q = 0; q < 4; ++q) { const int c = (q >> 1) * 64 + (q & 1) * 32 + s * 4; u32x2 w; w.x = pk2(v[q][0], v[q][1]); w.y = pk2(v[q][2], v[q][3]); *(u32x2*)(hp + c) = w; }
            }
        }
    }
}

__device__ __forceinline__ void p_attn_ab(Frame& F) {
    const bf16_t* P = (const bf16_t*)(F.ws + WS_PROJ); bf16_t* MG = (bf16_t*)(F.ws + WS_MERGED); bf16_t* OA = (bf16_t*)(F.ws + WS_OA);
    for (int u = F.vcu; u < 512 + 64; u += F.G) {
        int b, h, q0, nk;
        if (u < 512) { const int grp = u >> 5, w = u & 31; b = grp >> 1; h = (grp & 1) * 4 + (w >> 3); q0 = CTXL + (w & 7) * 256; nk = RPB; }
        else { const int v = u - 512; b = v >> 3; h = v & 7; q0 = 0; nk = CTXL; }
        const size_t kr = (size_t)b * RPB, qr = kr + q0; const int kvh = h >> 2;
        att::attn_unit<128, true, false>(P + qr * ABW + QB_OFF + h * 128, ABW, P + kr * ABW + KB_OFF + kvh * 128, ABW, nullptr, 0, P + kr * ABW + VB_OFF + kvh * 128, ABW,
                                             MG + qr * D + 1024 + h * 128, D, nk, 0, nullptr, nullptr, F.ldsg, F.lds, F.tid);
    }
    for (int u = F.vcu; u < 1024 + 128; u += F.G) {
        int b, vh, q0, nk;
        if (u < 1024) { const int grp = u >> 4, w = u & 15; b = grp >> 3; vh = (grp & 7) * 2 + (w >> 3); q0 = CTXL + (w & 7) * 256; nk = RPB; }
        else { const int v = u - 1024; b = v >> 4; vh = v & 15; q0 = 0; nk = CTXL; }
        const size_t kr = (size_t)b * RPB, qr = kr + q0;
        att::attn_unit<64, true, false>(P + qr * ABW + QA_OFF + vh * 64, ABW, P + kr * ABW + KA_OFF + vh * 64, ABW, nullptr, 0, P + kr * ABW + VA_OFF + (vh >> 1) * 128, ABW,
                                            OA + qr * D + vh * 128, D, nk, 0, nullptr, nullptr, F.ldsg, F.lds, F.tid);
    }
}

__device__ __forceinline__ void p_diff_combine(Frame& F) {
    const bf16_t* OA = (const bf16_t*)(F.ws + WS_OA); const bf16_t* MG = (const bf16_t*)(F.ws + WS_MERGED);
    signed char* MG8 = (signed char*)(F.ws + WS_MG8); float* SMG = (float*)(F.ws + WS_SMG);
    const float* lp = F.ka->in[I_DLAM]; const float* sg = F.ka->in[I_SUBLN];
    const float d1 = wave_sum(lp[F.lane] * lp[64 + F.lane]), d2 = wave_sum(lp[128 + F.lane] * lp[192 + F.lane]);
    const float lam = __expf(d1) - __expf(d2) + LAM_INIT0;
    const int h = F.lane >> 3, s = F.lane & 7;
    float g[16];
#pragma unroll
    for (int e = 0; e < 16; ++e) g[e] = sg[s * 16 + e] * (1.0f - LAM_INIT0);
    for (int r = F.gw; r < T_ALL; r += F.NGW) {
        const bf16_t* o1 = OA + (size_t)r * D + (2 * h) * 128 + s * 16; const bf16_t* o2 = o1 + 128; const bf16_t* ob = MG + (size_t)r * D + 1024 + h * 128 + s * 16;
        float v[16], vb[16]; float ss = 0.f;
#pragma unroll
        for (int q = 0; q < 2; ++q) { const u32x4 a = *(const u32x4*)(o1 + 8 * q), bq = *(const u32x4*)(o2 + 8 * q), cq = *(const u32x4*)(ob + 8 * q);
#pragma unroll
            for (int e = 0; e < 4; ++e) { v[q * 8 + 2 * e] = bflo(a[e]) - lam * bflo(bq[e]); v[q * 8 + 2 * e + 1] = bfhi(a[e]) - lam * bfhi(bq[e]); vb[q * 8 + 2 * e] = bflo(cq[e]); vb[q * 8 + 2 * e + 1] = bfhi(cq[e]); } }
#pragma unroll
        for (int e = 0; e < 16; ++e) ss += v[e] * v[e];
        ss += __shfl_xor(ss, 1); ss += __shfl_xor(ss, 2); ss += __shfl_xor(ss, 4);
        const float rs = 1.0f / sqrtf(ss * (1.0f / 128.0f) + 1e-5f);
        float am = 0.f;
#pragma unroll
        for (int e = 0; e < 16; ++e) { v[e] = v[e] * rs * g[e]; am = fmaxf(am, fmaxf(fabsf(v[e]), fabsf(vb[e]))); }
#pragma unroll
        for (int o = 1; o < 64; o <<= 1) am = fmaxf(am, __shfl_xor(am, o));
        const float inv = am > 0.f ? 127.0f / am : 0.f;
        if (F.lane == 0) SMG[r] = am * (1.0f / 127.0f);
        u32x4 wa, wb;
#pragma unroll
        for (int d = 0; d < 4; ++d) { unsigned x = 0, y = 0;
#pragma unroll
            for (int e = 0; e < 4; ++e) { int qa = (int)__builtin_rintf(v[d * 4 + e] * inv), qb = (int)__builtin_rintf(vb[d * 4 + e] * inv);
                qa = qa > 127 ? 127 : (qa < -127 ? -127 : qa); qb = qb > 127 ? 127 : (qb < -127 ? -127 : qb); x |= ((unsigned)qa & 0xffu) << (8 * e); y |= ((unsigned)qb & 0xffu) << (8 * e); }
            wa[d] = x; wb[d] = y; }
        *(u32x4*)(MG8 + (size_t)r * D + h * 128 + s * 16) = wa; *(u32x4*)(MG8 + (size_t)r * D + 1024 + h * 128 + s * 16) = wb;
    }
}

__device__ __forceinline__ void p_quant_merged(Frame& F) {
    const bf16_t* MG = (const bf16_t*)(F.ws + WS_MERGED);
    for (int t = F.gw; t < T_LAT; t += F.NGW) { const int r = tok_row(1, t); float v[4][8];
#pragma unroll
        for (int j = 0; j < 4; ++j) unpk8(*(const u32x4*)(MG + (size_t)r * D + 512 * j + 8 * F.lane), v[j]);
        quant_row_store(v, (signed char*)(F.ws + WS_MG8) + (size_t)r * D, (float*)(F.ws + WS_SMG) + r, F.lane); }
}

__device__ __forceinline__ void p_post_down(Frame& F) {
    const bf16_t* DN = (const bf16_t*)(F.ws + WS_DOWN); bf16_t* KPE = (bf16_t*)(F.ws + WS_KPE);
    const f32x2* t64r = (const f32x2*)(F.ws + WS_TAB + TAB64R); const f32x2* t64c = (const f32x2*)(F.ws + WS_TAB + TAB64C);
    const float* qg = F.ka->in[I_MQNG]; const float* kvg = F.ka->in[I_MKVNG];
    for (int r = F.gw; r < T_ALL; r += F.NGW) {
        const int b = r / RPB, i = r - b * RPB; const bool lat = i >= CTXL; const int pos = i - CTXL, gr = pos >> 6, gc = pos & 63;
        const bf16_t* row = DN + (size_t)r * DOWN_N;
#pragma unroll
        for (int which = 0; which < 2; ++which) {
            const u32x4 w = *(const u32x4*)(row + which * 512 + F.lane * 8); float v[8];
#pragma unroll
            for (int e = 0; e < 4; ++e) { v[2 * e] = bflo(w[e]); v[2 * e + 1] = bfhi(w[e]); }
            float ss = 0.f;
#pragma unroll
            for (int e = 0; e < 8; ++e) ss += v[e] * v[e];
            ss = wave_sum(ss); const float rs = 1.0f / sqrtf(ss * (1.0f / 512.0f) + 1e-6f); const float* g = (which ? kvg : qg) + F.lane * 8;
#pragma unroll
            for (int e = 0; e < 8; ++e) v[e] = v[e] * rs * g[e];
            quant_row512_store(v, (signed char*)(F.ws + (which ? WS_CKVN : WS_CQN)) + (size_t)r * 512, (float*)(F.ws + (which ? WS_SCKV : WS_SCQ)) + r, F.lane);
        }
        if (F.lane < 32) {
            const int blk = F.lane >> 4, f = F.lane & 15; const float a = bf2f(row[1024 + blk * 32 + f]), bq = bf2f(row[1024 + blk * 32 + 16 + f]);
            float oa = a, ob = bq;
            if (lat) { const f32x2 cs = blk ? t64c[gc * 16 + f] : t64r[gr * 16 + f]; oa = a * cs.x - bq * cs.y; ob = bq * cs.x + a * cs.y; }
            KPE[(size_t)r * 64 + blk * 32 + f] = (bf16_t)f2bf(oa); KPE[(size_t)r * 64 + blk * 32 + 16 + f] = (bf16_t)f2bf(ob);
        }
    }
}

__device__ __forceinline__ void p_attn_mla(Frame& F) {
    const bf16_t* QM = (const bf16_t*)(F.ws + WS_QM); const bf16_t* KVM = (const bf16_t*)(F.ws + WS_KVM); const bf16_t* KPE = (const bf16_t*)(F.ws + WS_KPE); bf16_t* MG = (bf16_t*)(F.ws + WS_MERGED);
    const f32x2* t64r = (const f32x2*)(F.ws + WS_TAB + TAB64R); const f32x2* t64c = (const f32x2*)(F.ws + WS_TAB + TAB64C);
    for (int u = F.vcu; u < 1024; u += F.G) {
        const int grp = u >> 3, b = grp >> 4, h = grp & 15, qb = u & 7; const size_t kr = (size_t)b * RPB, qr = kr + CTXL + qb * 256;
        att::attn_unit<192, true, true>(QM + qr * UQ_N + h * 192, UQ_N, KVM + kr * UKV_N + h * 256, UKV_N, KPE + kr * 64, 64, KVM + kr * UKV_N + h * 256 + 128, UKV_N,
                                           MG + qr * D + h * 128, D, RPB, qb * 256, t64r, t64c, F.ldsg, F.lds, F.tid);
    }
}

template <int R> __device__ __forceinline__ void ln1_rows(Frame& F, int layer, int t0, int i) {
    const LAS float* PA = (const LAS float*)F.lds;
    const unsigned char* Y1 = (const unsigned char*)(F.ws + WS_Y1); bf16_t* XB = (bf16_t*)(F.ws + WS_X); bf16_t* H = (bf16_t*)(F.ws + WS_H);
    float v[R][4][8]; u32x2 yw[R][4]; int var[R], rr[R];
#pragma unroll
    for (int q = 0; q < R; ++q) { const int r = tok_row(layer, t0 + i + 8 * q); rr[q] = r; const float* xs = x_src(F, 0, r); var[q] = (layer == 0 && (r % RPB) < CTXL) ? 3 : 0;
#pragma unroll
        for (int j = 0; j < 4; ++j) { if (layer == 0) ld8f_nt(xs + 512 * j + 8 * F.lane, v[q][j]); else unpk8(*(const u32x4*)(XB + (size_t)r * D + 512 * j + 8 * F.lane), v[q][j]); yw[q][j] = __builtin_nontemporal_load((const u32x2*)(Y1 + (size_t)r * D + 512 * j + 8 * F.lane)); } }
#pragma unroll
    for (int q = 0; q < R; ++q) {
        float s = 0.f;
#pragma unroll
        for (int j = 0; j < 4; ++j) { const int c = 512 * j + 8 * F.lane; float g1[8], y[8]; ld8l(PA + (2 + var[q]) * 2048 + c, g1); unfp8(yw[q][j], y);
#pragma unroll
            for (int e = 0; e < 8; ++e) { v[q][j][e] = v[q][j][e] * ALPHA + g1[e] * y[e]; s += v[q][j][e]; } }
        const float mean = wave_sum(s) * (1.0f / D); float s2 = 0.f;
#pragma unroll
        for (int j = 0; j < 4; ++j)
#pragma unroll
            for (int e = 0; e < 8; ++e) { v[q][j][e] -= mean; s2 += v[q][j][e] * v[q][j][e]; }
        const float rstd = 1.0f / sqrtf(wave_sum(s2) * (1.0f / D) + 1e-5f);
#pragma unroll
        for (int j = 0; j < 4; ++j) { const int c = 512 * j + 8 * F.lane; float a[8], bq[8], xo[8], h[8];
            ld8l(PA + c, a); ld8l(PA + 2048 + c, bq);
#pragma unroll
            for (int e = 0; e < 8; ++e) xo[e] = v[q][j][e] * rstd * a[e] + bq[e];
            *(u32x4*)(XB + (size_t)rr[q] * D + c) = pk8(xo);
            ld8l(PA + (3 + var[q]) * 2048 + c, a); ld8l(PA + (4 + var[q]) * 2048 + c, bq);
#pragma unroll
            for (int e = 0; e < 8; ++e) { h[e] = v[q][j][e] * rstd * a[e] + bq[e]; v[q][j][e] = h[e]; }
            *(u32x4*)(H + (size_t)rr[q] * D + c) = pk8(h); }
        quant_row_store(v[q], (signed char*)(F.ws + WS_H8) + (size_t)rr[q] * D, (float*)(F.ws + WS_SA) + rr[q], F.lane);
    }
}
__device__ __forceinline__ void p_ln1(Frame& F, int layer) {
    LAS float* PA = (LAS float*)F.lds;
    const int NT = layer ? T_LAT : T_ALL, BR = layer ? 64 : 72, nblk = NT / BR, rpb = layer ? SEQ : RPB;
    const float* lg = F.ka->in[I_LNMG] + layer * D; const float* lb = F.ka->in[I_LNMB] + layer * D; const float* MOD = (const float*)(F.ws + WS_MOD) + (size_t)layer * 9 * 12288;
    for (int blk = F.vcu; blk < nblk; blk += F.G) {
        const int t0 = blk * BR, b = t0 / rpb;
        __syncthreads();
        { const int c = F.tid * 4; const f32x4 g = *(const f32x4*)(lg + c), bb = *(const f32x4*)(lb + c);
          *(LAS f32x4*)(PA + c) = g; *(LAS f32x4*)(PA + 2048 + c) = bb;
#pragma unroll
          for (int vv = 0; vv < 2; ++vv) { const float* m = MOD + (size_t)(vv ? 8 : b) * 12288; const f32x4 g1 = *(const f32x4*)(m + 2 * 2048 + c), sh2 = *(const f32x4*)(m + 3 * 2048 + c), sc2 = *(const f32x4*)(m + 4 * 2048 + c);
              *(LAS f32x4*)(PA + (2 + 3 * vv) * 2048 + c) = g1; *(LAS f32x4*)(PA + (3 + 3 * vv) * 2048 + c) = g * (1.0f + sc2); *(LAS f32x4*)(PA + (4 + 3 * vv) * 2048 + c) = bb * (1.0f + sc2) + sh2; } }
        __syncthreads();
        for (int i = F.wave; i < BR; i += 16) { if (i + 8 < BR) ln1_rows<2>(F, layer, t0, i); else ln1_rows<1>(F, layer, t0, i); }
    }
}

__device__ __forceinline__ void p_router(Frame& F, int layer) {
    const int NT = layer ? T_LAT : T_ALL, ngroups = NT / 32;
    const bf16_t* H = (const bf16_t*)(F.ws + WS_H); const bf16_t* RT = (const bf16_t*)(F.ws + WS_ROUTER + (size_t)layer * 64 * 2048 * 2);
    const float* rb = F.ka->in[I_RB] + layer * 64;
    int* LIST = (int*)(F.ws + WS_LIST); int* TS = (int*)(F.ws + WS_TOKSLOT); float* GATE = (float*)(F.ws + WS_GATE);
    unsigned* CNT = F.ctl + CW_CNT + layer * 64 * 16;
    LAS float* part = (LAS float*)F.lds;
    LAS float* SC = (LAS float*)(F.lds + 65536);
    LAS float* BS = (LAS float*)(F.lds + 65536 + 8448);
    LAS int* hist = (LAS int*)(F.lds + 65536 + 2 * 8448);
    LAS int* base = hist + 64;
    LAS int* SEL = base + 64;
    const int r32 = F.lane & 31, hi = F.lane >> 5;
    if (F.tid < 64) hist[F.tid] = 0;
    __syncthreads();
    int gi = 0;
    for (int g = F.vcu; g < ngroups; g += F.G, ++gi) {
        const int t0 = g * 32;
        {
            const bf16_t* ap = H + (size_t)tok_row(layer, t0 + r32) * D + F.wave * 256 + hi * 8;
            const bf16_t* b0p = RT + (size_t)r32 * D + F.wave * 256 + hi * 8; const bf16_t* b1p = b0p + (size_t)32 * D;
            f32x16 a0 = {}, a1 = {};
#pragma unroll
            for (int k = 0; k < 16; ++k) { const bf16x8 a = *(const bf16x8*)(ap + k * 16), w0 = *(const bf16x8*)(b0p + k * 16), w1 = *(const bf16x8*)(b1p + k * 16);
                a0 = __builtin_amdgcn_mfma_f32_32x32x16_bf16(a, w0, a0, 0, 0, 0); a1 = __builtin_amdgcn_mfma_f32_32x32x16_bf16(a, w1, a1, 0, 0, 0); }
#pragma unroll
            for (int r = 0; r < 16; ++r) { const int row = att::crow(r, hi); part[(F.wave * 32 + row) * 64 + r32] = a0[r]; part[(F.wave * 32 + row) * 64 + 32 + r32] = a1[r]; }
        }
        __syncthreads();
        for (int i = F.tid; i < 2048; i += 512) { float s = 0.f;
#pragma unroll
            for (int w = 0; w < 8; ++w) s += part[w * 2048 + i];
            const float sg = 1.0f / (1.0f + __expf(-s)); const int tk = i >> 6, e = i & 63; SC[tk * 65 + e] = sg; BS[tk * 65 + e] = sg + rb[e]; }
        __syncthreads();
        if (F.tid < 32) {
            const LAS float* bs = BS + F.tid * 65; const LAS float* sc = SC + F.tid * 65;
            float bv[64];
#pragma unroll
            for (int e = 0; e < 64; ++e) bv[e] = bs[e];
            float gs[8];
#pragma unroll
            for (int gq = 0; gq < 8; ++gq) { float m1 = -INFINITY, m2 = -INFINITY;
#pragma unroll
                for (int j = 0; j < 8; ++j) { const float v = bv[gq * 8 + j]; const float lo = fminf(v, m1); m1 = fmaxf(v, m1); m2 = fmaxf(m2, lo); }
                gs[gq] = m1 + m2; }
            unsigned gmask = 0u;
#pragma unroll
            for (int it = 0; it < 4; ++it) { float best = -INFINITY; int bi = 0;
#pragma unroll
                for (int gq = 0; gq < 8; ++gq) { const bool ok = !((gmask >> gq) & 1u) && gs[gq] > best; best = ok ? gs[gq] : best; bi = ok ? gq : bi; }
                gmask |= 1u << bi; }
#pragma unroll
            for (int e = 0; e < 64; ++e) bv[e] = ((gmask >> (e >> 3)) & 1u) ? bv[e] : -INFINITY;
            int sel[8]; float gv[8]; float gsum = 0.f;
#pragma unroll
            for (int k = 0; k < 8; ++k) { float best = -INFINITY; int be = 0;
#pragma unroll
                for (int e = 0; e < 64; ++e) { const bool ok = bv[e] > best; best = ok ? bv[e] : best; be = ok ? e : be; }
#pragma unroll
                for (int e = 0; e < 64; ++e) bv[e] = (e == be) ? -INFINITY : bv[e];
                sel[k] = be; gv[k] = sc[be]; gsum += gv[k]; }
            const int r = tok_row(layer, t0 + F.tid); const float inv = 2.5f / gsum;
#pragma unroll
            for (int k = 0; k < 8; ++k) { const int lp = atomicAdd((int*)(hist + sel[k]), 1); SEL[((gi & 3) * 32 + F.tid) * 8 + k] = (sel[k] << 16) | lp; GATE[(size_t)r * 8 + k] = gv[k] * inv; }
        }
        __syncthreads();
    }
    if (F.tid < 64) base[F.tid] = (int)__hip_atomic_fetch_add(CNT + F.tid * 16, (unsigned)hist[F.tid], RLX_AGENT);
    __syncthreads();
    gi = 0;
    for (int g = F.vcu; g < ngroups; g += F.G, ++gi) {
        if (F.tid < 256) { const int tk = F.tid >> 3, k = F.tid & 7; const int v = SEL[((gi & 3) * 32 + tk) * 8 + k], e = v >> 16, pos = base[e] + (v & 0xffff); const int r = tok_row(layer, g * 32 + tk);
            LIST[(size_t)e * LIST_CAP + pos] = r; TS[(size_t)r * 8 + k] = (e << 16) | pos; }
    }
    __syncthreads();
}

__device__ __forceinline__ int moe_tables(Frame& F, int layer) {
    LAS int* MISC = (LAS int*)(F.lds + MISC_OFF); LAS int* TT = (LAS int*)(F.lds + TTAB_OFF);
    const int NT = layer ? T_LAT : T_ALL;
    __syncthreads();
    if (F.wave == 0) {
        const unsigned* CNT = F.ctl + CW_CNT + layer * 64 * 16;
        const int c = (int)__hip_atomic_load(CNT + F.lane * 16, RLX_AGENT); const int nt = (c + 255) >> 8;
        int inc = nt;
#pragma unroll
        for (int o = 1; o < 64; o <<= 1) { const int v = __shfl_up(inc, o); if (F.lane >= o) inc += v; }
        const int start = inc - nt; MISC[F.lane] = start; MISC[80 + F.lane] = c;
        if (F.lane == 63) { MISC[64] = inc; MISC[65] = inc + NT / 256; }
    }
    __syncthreads();
    const int s64 = MISC[64], total = MISC[65];
    for (int tile = F.tid; tile < total; tile += 512) {
        int lo = 0, hi = 64;
#pragma unroll
        for (int it = 0; it < 7; ++it) { const int mid = (lo + hi + 1) >> 1; const bool ok = MISC[mid] <= tile; lo = ok ? mid : lo; hi = ok ? hi : mid - 1; }
        TT[tile] = (lo << 16) | (tile - MISC[lo]); }
    (void)s64;
    __syncthreads();
    return total;
}

__device__ __forceinline__ void p_moe_gemm1(Frame& F, int layer) {
    const int total = moe_tables(F, layer);
    LAS int* MISC = (LAS int*)(F.lds + MISC_OFF); LAS int* TT = (LAS int*)(F.lds + TTAB_OFF); LAS int* IDX = (LAS int*)(F.lds + IDXC_OFF);
    const int* LIST = (const int*)(F.ws + WS_LIST);
    typedef pg8::SchedMoe<4, EXP_IN_BYTES, (size_t)256 * D> Sch; Sch S; S.ntiles = total; S.G = F.G; S.vcu = F.vcu; S.ttab = TT; S.Bt = (const char*)(F.ws + WS_EXP_IN + (size_t)layer * 65 * EXP_IN_BYTES);
    {
        pg8::Unit u; const int fallback = tok_row(layer, 0);
        for (int i = 0; i < IDXC_UNITS && S.next(i, u); ++i) {
            if (F.tid < 256) { const int tile = u.row0 >> 8, tv = TT[tile], e = tv >> 16, p = (tv & 0xffff) * 256 + F.tid;
                int src; if (e < 64) src = (p < MISC[80 + e]) ? LIST[(size_t)e * LIST_CAP + p] : fallback; else src = tok_row(layer, p);
                IDX[i * 256 + F.tid] = src; }
        }
        __syncthreads();
    }
    pg8::EpiSwigluI8 E{(unsigned char*)(F.ws + WS_HMID), FDIM, (const float*)(F.ws + WS_SA), (const float*)(F.ws + WS_SW) + (size_t)layer * 65 * 1024, IDX};
    pg8::gemm_phase<pg8::EpiSwigluI8, Sch, true, true>(F.lds, (const void*)(F.ws + WS_H8), D, S, E, IDX, fresh_tid(F));
}
__device__ __forceinline__ void p_quant_hmid(Frame& F, int layer) {
    const int total = moe_tables(F, layer), nrows = total * 256;
    const unsigned char* HM = (const unsigned char*)(F.ws + WS_HMID); signed char* HM8 = (signed char*)(F.ws + WS_HM8); float* SHM = (float*)(F.ws + WS_SHM);
    for (int r0 = F.gw * 4; r0 < nrows; r0 += F.NGW * 4) {
        u32x2 w[4];
#pragma unroll
        for (int q = 0; q < 4; ++q) w[q] = *(const u32x2*)(HM + (size_t)(r0 + q) * FDIM + 8 * F.lane);
#pragma unroll
        for (int q = 0; q < 4; ++q) { float v[8]; unfp8(w[q], v); quant_row512_store(v, HM8 + (size_t)(r0 + q) * FDIM, SHM + r0 + q, F.lane); }
    }
}
__device__ __forceinline__ void p_moe_gemm2(Frame& F, int layer) {
    const int total = moe_tables(F, layer);
    LAS int* TT = (LAS int*)(F.lds + TTAB_OFF);
    typedef pg8::SchedMoe<8, EXP_OUT_BYTES, (size_t)256 * FDIM> Sch; Sch S; S.ntiles = total; S.G = F.G; S.vcu = F.vcu; S.ttab = TT; S.Bt = (const char*)(F.ws + WS_EXP_OUT + (size_t)layer * 65 * EXP_OUT_BYTES);
    pg8::EpiI8Fp8<2048> E{(unsigned char*)(F.ws + WS_Y2P), D, (const float*)(F.ws + WS_SHM), (const float*)(F.ws + WS_SW2) + (size_t)layer * 65 * 2048};
    pg8::gemm_phase<pg8::EpiI8Fp8<2048>, Sch, false, true>(F.lds, (const void*)(F.ws + WS_HM8), FDIM, S, E, nullptr, fresh_tid(F));
}

__device__ __forceinline__ void p_combine_ln2(Frame& F, int layer) {
    (void)moe_tables(F, layer);
    LAS int* MISC = (LAS int*)(F.lds + MISC_OFF); LAS float* PA = (LAS float*)F.lds;
    const int NT = layer ? T_LAT : T_ALL, BR = layer ? 64 : 72, nblk = NT / BR, rpb = layer ? SEQ : RPB;
    const unsigned char* Y2 = (const unsigned char*)(F.ws + WS_Y2P);     const int* TS = (const int*)(F.ws + WS_TOKSLOT); const float* GATE = (const float*)(F.ws + WS_GATE);
    bf16_t* XB = (bf16_t*)(F.ws + WS_X); float* OUT = F.ka->out;
    const int sh0 = MISC[64] * 256;
    for (int blk = F.vcu; blk < nblk; blk += F.G) {
        const int t0 = blk * BR, b = t0 / rpb;
        __syncthreads();
        { int z = 0; asm volatile("" : "+s"(z));
          const float* lg = F.ka->in[I_LNFG + z] + layer * D; const float* lb = F.ka->in[I_LNFB + z] + layer * D; const float* MOD = (const float*)(F.ka->ws + WS_MOD) + z;
          const int c = fresh_tid(F) * 4; const f32x4 g = *(const f32x4*)(lg + c), bb = *(const f32x4*)(lb + c);
          *(LAS f32x4*)(PA + c) = g; *(LAS f32x4*)(PA + 2048 + c) = bb;
#pragma unroll
          for (int vv = 0; vv < 2; ++vv) { const float* m = MOD + ((size_t)layer * 9 + (vv ? 8 : b)) * 12288; const float* m1 = MOD + ((size_t)9 + (vv ? 8 : b)) * 12288;
              const f32x4 g2 = *(const f32x4*)(m + 5 * 2048 + c), sh1 = *(const f32x4*)(m1 + c), sc1 = *(const f32x4*)(m1 + 2048 + c);
              *(LAS f32x4*)(PA + (2 + 3 * vv) * 2048 + c) = g2; *(LAS f32x4*)(PA + (3 + 3 * vv) * 2048 + c) = g * (1.0f + sc1); *(LAS f32x4*)(PA + (4 + 3 * vv) * 2048 + c) = bb * (1.0f + sc1) + sh1; } }
        __syncthreads();
        int r = tok_row(layer, t0 + F.wave); int tsv = 0; float gtv = 0.f;
        { const int l0 = fresh_lane(); if (l0 < 8) { tsv = TS[(size_t)r * 8 + l0]; gtv = GATE[(size_t)r * 8 + l0]; } }
        for (int i = F.wave; i < BR; i += 8) {
            const int t = t0 + i, var = (layer == 0 && (r % RPB) < CTXL) ? 3 : 0;
            const int ln = fresh_lane();
            float xv[4][8]; float y[4][8]; const int tsc = tsv; const int gtc = __builtin_bit_cast(int, gtv);
#define YROW(k) (Y2 + (size_t)(__builtin_amdgcn_readfirstlane(MISC[__builtin_amdgcn_readlane(tsc, (k)) >> 16]) * 256 + (__builtin_amdgcn_readlane(tsc, (k)) & 0xffff)) * D)
#define GK(k) __builtin_bit_cast(float, __builtin_amdgcn_readlane(gtc, (k)))
            const int rcur = r;
            {
                u32x2 yw[5][4];
#pragma unroll
                for (int k = 0; k < 4; ++k)
#pragma unroll
                    for (int j = 0; j < 4; ++j) yw[k][j] = __builtin_nontemporal_load((const u32x2*)(YROW(k) + 8 * ln + 512 * j));
                { const unsigned char* yr = Y2 + (size_t)(sh0 + t) * D + 8 * ln;
#pragma unroll
                  for (int j = 0; j < 4; ++j) yw[4][j] = __builtin_nontemporal_load((const u32x2*)(yr + 512 * j)); }
                if (i + 8 < BR) { r = tok_row(layer, t + 8); if (ln < 8) { tsv = TS[(size_t)r * 8 + ln]; gtv = GATE[(size_t)r * 8 + ln]; } }
#pragma unroll
                for (int j = 0; j < 4; ++j) { float tmp[8]; unfp8(yw[4][j], y[j]);
#pragma unroll
                    for (int k = 0; k < 4; ++k) { unfp8(yw[k][j], tmp);
#pragma unroll
                        for (int e = 0; e < 8; ++e) y[j][e] += GK(k) * tmp[e]; } }
            }
            asm volatile("" ::: "memory");
            {
                u32x2 yw[4][4];
#pragma unroll
                for (int k = 0; k < 4; ++k)
#pragma unroll
                    for (int j = 0; j < 4; ++j) yw[k][j] = __builtin_nontemporal_load((const u32x2*)(YROW(4 + k) + 8 * ln + 512 * j));
#pragma unroll
                for (int j = 0; j < 4; ++j) unpk8(*(const u32x4*)(XB + (size_t)rcur * D + 512 * j + 8 * ln), xv[j]);
#pragma unroll
                for (int j = 0; j < 4; ++j) { float tmp[8];
#pragma unroll
                    for (int k = 0; k < 4; ++k) { unfp8(yw[k][j], tmp);
#pragma unroll
                        for (int e = 0; e < 8; ++e) y[j][e] += GK(4 + k) * tmp[e]; } }
            }
#undef YROW
#undef GK
            float s = 0.f;
#pragma unroll
            for (int j = 0; j < 4; ++j) { const int c = 512 * j + 8 * ln; float g2[8];
                ld8l(PA + (2 + var) * 2048 + c, g2);
#pragma unroll
                for (int e = 0; e < 8; ++e) { xv[j][e] = xv[j][e] * ALPHA + g2[e] * y[j][e]; s += xv[j][e]; } }
            const float mean = wave_sum(s) * (1.0f / D); float s2 = 0.f;
#pragma unroll
            for (int j = 0; j < 4; ++j)
#pragma unroll
                for (int e = 0; e < 8; ++e) { xv[j][e] -= mean; s2 += xv[j][e] * xv[j][e]; }
            const float rstd = 1.0f / sqrtf(wave_sum(s2) * (1.0f / D) + 1e-5f);
#pragma unroll
            for (int j = 0; j < 4; ++j) { const int c = 512 * j + 8 * ln; float a[8], bq[8], xo[8];
                ld8l(PA + c, a); ld8l(PA + 2048 + c, bq);
#pragma unroll
                for (int e = 0; e < 8; ++e) xo[e] = xv[j][e] * rstd * a[e] + bq[e];
                if (layer == 0) { *(u32x4*)(XB + (size_t)rcur * D + c) = pk8(xo); ld8l(PA + (3 + var) * 2048 + c, a); ld8l(PA + (4 + var) * 2048 + c, bq);
#pragma unroll
                    for (int e = 0; e < 8; ++e) xv[j][e] = xv[j][e] * rstd * a[e] + bq[e]; }
                else st8f(OUT + (size_t)t * D + c, xo); }
            if (layer == 0) quant_row_store(xv, (signed char*)(F.ws + WS_H8) + (size_t)rcur * D, (float*)(F.ws + WS_SA) + rcur, ln);
        }
    }
}

__device__ __forceinline__ void p_dense(Frame& F, const bf16_t* A, const bf16_t* Bt, int K, int nM, int nN, int latmap, bf16_t* O, int ldc) {
    pg8::SchedDense S; S.init(nM, nN, F.G, (int)blockIdx.x, latmap, Bt, K);
    pg8::EpiBf16 E{O, ldc};
    pg8::gemm_phase<pg8::EpiBf16, pg8::SchedDense, false>(F.lds, A, K, S, E, nullptr, F.tid);
}
__device__ __forceinline__ void p_dense_i8_fp8(Frame& F, const void* A, const float* SA, const void* Bt, const float* SW, int K, int nM, int nN, int latmap, unsigned char* O, int ldc) {
    pg8::SchedDense S; S.init(nM, nN, F.G, (int)blockIdx.x, latmap, (const bf16_t*)Bt, K); S.tstepB = (size_t)256 * K;
    pg8::EpiI8Fp8<0> E{O, ldc, SA, SW};
    pg8::gemm_phase<pg8::EpiI8Fp8<0>, pg8::SchedDense, false, true>(F.lds, A, K, S, E, nullptr, fresh_tid(F));
}
__device__ __forceinline__ void p_dense_i8(Frame& F, const void* A, const float* SA, const void* Bt, const float* SW, int K, int nM, int nN, int latmap, bf16_t* O, int ldc) {
    pg8::SchedDense S; S.init(nM, nN, F.G, (int)blockIdx.x, latmap, (const bf16_t*)Bt, K); S.tstepB = (size_t)256 * K;
    pg8::EpiI8Bf16<0> E{O, ldc, SA, SW};
    pg8::gemm_phase<pg8::EpiI8Bf16<0>, pg8::SchedDense, false, true>(F.lds, A, K, S, E, nullptr, fresh_tid(F));
}

constexpr int N_PHASES = 26;

__global__ void __launch_bounds__(512, 2) mk_fwd(Args args) {
    extern __shared__ __attribute__((aligned(16))) unsigned char lds_raw[];
    Frame F;
    F.lds = (LAS unsigned char*)lds_raw; F.ldsg = (char*)lds_raw;
    F.tid = threadIdx.x; F.lane = F.tid & 63; F.wave = __builtin_amdgcn_readfirstlane(F.tid >> 6);
    F.G = gridDim.x; { const int bx = blockIdx.x; F.vcu = (F.G % 8 == 0) ? (bx % 8) * (F.G / 8) + bx / 8 : bx; }
    F.gw = F.vcu * 8 + F.wave; F.NGW = F.G * 8;
    F.ka = (KArgs)__builtin_amdgcn_kernarg_segment_ptr();
    F.ws = F.ka->ws; F.ctl = (unsigned*)F.ws;
    const int lo = args.ph_lo, hi = args.ph_hi;
    volatile LAS unsigned* bw = (volatile LAS unsigned*)(F.lds + BARW_OFF);
    if (F.tid < 4) bw[F.tid] = 0u;
    __syncthreads();
    XcdBarrier bar; bar.bar = F.ctl + CW_BAR; bar.x = 0; bar.st = bw;
    if (hi - lo > 1) bar = xcd_barrier_post(F.ctl + CW_BAR, bw);
#ifndef MK_ONLY
#define MK_ONLY -1
#endif
#ifndef MK_REPMASK
#define MK_REPMASK 0u
#endif
#define IN(k) ((MK_ONLY < 0 || MK_ONLY == (k)) && lo <= (k) && (k) < hi)
#define NREP(k) ((int)(((unsigned)MK_REPMASK >> (k)) & 1u) + 1)
#define SEAM(k) do { if (lo <= (k) && (k) + 1 < hi) xcd_barrier(bar); } while (0)

    if (IN(0)) for (int rep = 0; rep < NREP(0); ++rep) { PHASE_BEGIN(F); p0_prologue(P); } SEAM(0);
    if (IN(1)) for (int rep = 0; rep < NREP(1); ++rep) { PHASE_BEGIN(F); p1_modulate(P); } SEAM(1);
#if defined(MK_UNROLL_LAYERS)
#pragma unroll
#else
#pragma unroll 1
#endif
    for (int layer = 0; layer < 2; ++layer) {
        const int pb = 2 + 12 * layer;
        if (IN(pb + 0)) for (int rep = 0; rep < NREP(pb + 0); ++rep) { PHASE_BEGIN(F);
            p_dense_i8(P, P.ws + WS_H8, (const float*)(P.ws + WS_SA), P.ws + (layer == 0 ? WS_W_IN : WS_W_DOWN), (const float*)(P.ws + WS_SWD) + (layer == 0 ? SWD_IN : SWD_DOWN), D, T_ALL / 256, layer == 0 ? ABW / 256 : DOWN_N / 256, 0,
                       (bf16_t*)(P.ws + (layer == 0 ? WS_PROJ : WS_DOWN)), layer == 0 ? ABW : DOWN_N);
        } SEAM(pb + 0);
        if (IN(pb + 1)) for (int rep = 0; rep < NREP(pb + 1); ++rep) { PHASE_BEGIN(F); if (layer == 0) p_post_ab(P); else p_post_down(P); } SEAM(pb + 1);
        if (IN(pb + 2)) for (int rep = 0; rep < NREP(pb + 2); ++rep) { PHASE_BEGIN(F);
            if (layer == 0) p_attn_ab(P);
            else {
#pragma unroll 1
                for (int w = 0; w < 2; ++w) {
                    p_dense_i8(P, P.ws + (w == 0 ? WS_CQN : WS_CKVN), (const float*)(P.ws + (w == 0 ? WS_SCQ : WS_SCKV)), P.ws + (w == 0 ? WS_W_UQ : WS_W_UKV), (const float*)(P.ws + WS_SWD) + (w == 0 ? SWD_UQ : SWD_UKV), 512,
                               w == 0 ? T_LAT / 256 : T_ALL / 256, w == 0 ? UQ_N / 256 : UKV_N / 256, w == 0 ? 1 : 0, (bf16_t*)(P.ws + (w == 0 ? WS_QM : WS_KVM)), w == 0 ? UQ_N : UKV_N); }
            }
        } SEAM(pb + 2);
        if (IN(pb + 3)) for (int rep = 0; rep < NREP(pb + 3); ++rep) { PHASE_BEGIN(F); if (layer == 0) p_diff_combine(P); else p_attn_mla(P); } SEAM(pb + 3);
        if (layer == 1) { if (IN(pb + 4)) for (int rep = 0; rep < NREP(pb + 4); ++rep) { PHASE_BEGIN(F); p_quant_merged(P); } SEAM(pb + 4); }
        if (IN(pb + 5)) for (int rep = 0; rep < NREP(pb + 5); ++rep) { PHASE_BEGIN(F);
            p_dense_i8_fp8(P, P.ws + WS_MG8, (const float*)(P.ws + WS_SMG), P.ws + (layer == 0 ? WS_W_OUT : WS_W_O), (const float*)(P.ws + WS_SWD) + (layer == 0 ? SWD_OUT : SWD_O), D, layer == 0 ? T_ALL / 256 : T_LAT / 256, D / 256, layer,
                           (unsigned char*)(P.ws + WS_Y1), D);
        } SEAM(pb + 5);
        if (IN(pb + 6)) for (int rep = 0; rep < NREP(pb + 6); ++rep) { PHASE_BEGIN(F); p_ln1(P, layer); } SEAM(pb + 6);
        if (IN(pb + 7)) for (int rep = 0; rep < NREP(pb + 7); ++rep) { PHASE_BEGIN(F); p_router(P, layer); } SEAM(pb + 7);
        if (IN(pb + 8)) for (int rep = 0; rep < NREP(pb + 8); ++rep) { PHASE_BEGIN(F); p_moe_gemm1(P, layer); } SEAM(pb + 8);
        if (IN(pb + 9)) for (int rep = 0; rep < NREP(pb + 9); ++rep) { PHASE_BEGIN(F); p_quant_hmid(P, layer); } SEAM(pb + 9);
        if (IN(pb + 10)) for (int rep = 0; rep < NREP(pb + 10); ++rep) { PHASE_BEGIN(F); p_moe_gemm2(P, layer); } SEAM(pb + 10);
        if (IN(pb + 11)) for (int rep = 0; rep < NREP(pb + 11); ++rep) { PHASE_BEGIN(F); p_combine_ln2(P, layer); } SEAM(pb + 11);
    }
#undef IN
#undef SEAM
}

extern "C" void kernel_launch(void* const* d_in, const int* in_sizes, int n_in, void* d_out, int out_size, void* d_ws, size_t ws_size, hipStream_t stream) {
    static int grid = 0;
    if (grid == 0) {
        if (n_in != 28 || out_size != T_LAT * D || ws_size < WS_END) { fprintf(stderr, "kernel_launch: expected 28 inputs, out %d, ws >= %zu; got n_in %d out %d ws %zu\n", T_LAT * D, (size_t)WS_END, n_in, out_size, ws_size); grid = -1; return; }
        int dev = 0, cus = 0, per_cu = 0;
        if (hipGetDevice(&dev) != hipSuccess || hipDeviceGetAttribute(&cus, hipDeviceAttributeMultiprocessorCount, dev) != hipSuccess) { fprintf(stderr, "kernel_launch: device query failed\n"); grid = -1; return; }
        if (hipFuncSetAttribute((const void*)mk_fwd, hipFuncAttributeMaxDynamicSharedMemorySize, LDS_BYTES) != hipSuccess) { fprintf(stderr, "kernel_launch: hipFuncSetAttribute failed\n"); grid = -1; return; }
        if (hipOccupancyMaxActiveBlocksPerMultiprocessor(&per_cu, (const void*)mk_fwd, 512, LDS_BYTES) != hipSuccess || per_cu < 1) fprintf(stderr, "kernel_launch: occupancy query reports %d\n", per_cu);
        (void)hipGetLastError();
        grid = cus;
        if (grid != 256) fprintf(stderr, "kernel_launch: note: %d CUs (tuned for 256)\n", grid);
    }
    if (grid < 0) return;
    if (hipMemsetAsync((char*)d_ws + WS_CTL, 0, CTL_BYTES, stream) != hipSuccess) { fprintf(stderr, "kernel_launch: memset failed\n"); return; }
    Args a{};
    for (int i = 0; i < 28; ++i) a.in[i] = (const float*)d_in[i];
    a.out = (float*)d_out; a.ws = (unsigned char*)d_ws;
#if MK_ONE_LAUNCH
    a.ph_lo = 0; a.ph_hi = N_PHASES;
    hipLaunchKernelGGL(mk_fwd, dim3(grid), dim3(512), LDS_BYTES, stream, a);
#else
    for (int p = 0; p < N_PHASES; ++p) { a.ph_lo = p; a.ph_hi = p + 1; hipLaunchKernelGGL(mk_fwd, dim3(grid), dim3(512), LDS_BYTES, stream, a); }
#endif
    const hipError_t le = hipPeekAtLastError();
    if (le != hipSuccess) fprintf(stderr, "kernel_launch: launch failed: %s\n", hipGetErrorName(le));
}
```

```cpp
#include <hip/hip_runtime.h>
#include <cstdio>
#include <cstdint>

#ifndef MK_ONE_LAUNCH
#define MK_ONE_LAUNCH 1
#endif

#define LAS __attribute__((address_space(3)))
typedef unsigned short bf16_t;
typedef short bf16x8 __attribute__((ext_vector_type(8)));
typedef short s16x4 __attribute__((ext_vector_type(4)));
typedef float f32x4 __attribute__((ext_vector_type(4)));
typedef float f32x2 __attribute__((ext_vector_type(2)));
typedef float f32x16 __attribute__((ext_vector_type(16)));
typedef unsigned u32x4 __attribute__((ext_vector_type(4)));
typedef unsigned u32x2 __attribute__((ext_vector_type(2)));
typedef int i32x4 __attribute__((ext_vector_type(4)));

constexpr int D = 2048, NB = 8, SEQ = 2048, CTXL = 256, RPB = SEQ + CTXL  ;
constexpr int T_ALL = NB * RPB  , T_LAT = NB * SEQ  ;
constexpr int NEXP = 64, FDIM = 512, TOPK = 8;
constexpr int ABW = 4608, QA_OFF = 0, KA_OFF = 1024, VA_OFF = 2048, QB_OFF = 3072, KB_OFF = 4096, VB_OFF = 4352;
constexpr int DOWN_N = 1280  , UQ_N = 3072, UKV_N = 4096;
constexpr float ALPHA = 1.41421356237f;
constexpr float LAM_INIT0 = 0.2f;
constexpr int LIST_CAP = T_ALL;
constexpr int MAX_TILES = 712;

constexpr size_t al4k(size_t x) { return (x + 4095) & ~(size_t)4095; }
constexpr size_t WS_CTL = 0, CTL_BYTES = 1u << 20;
constexpr size_t WS_TAB = WS_CTL + CTL_BYTES;
constexpr size_t WS_MOD = WS_TAB + (1u << 16);
constexpr size_t WS_W_IN = WS_MOD + (1u << 20);
constexpr size_t WS_W_OUT = WS_W_IN + al4k((size_t)ABW * D * 2);
constexpr size_t WS_W_DOWN = WS_W_OUT + al4k((size_t)D * D * 2);
constexpr size_t WS_W_UQ = WS_W_DOWN + al4k((size_t)DOWN_N * D * 2);
constexpr size_t WS_W_UKV = WS_W_UQ + al4k((size_t)UQ_N * 512 * 2);
constexpr size_t WS_W_O = WS_W_UKV + al4k((size_t)UKV_N * 512 * 2);
constexpr size_t WS_ROUTER = WS_W_O + al4k((size_t)D * D * 2);
constexpr size_t EXP_IN_BYTES = (size_t)1024 * D  , EXP_OUT_BYTES = (size_t)D * FDIM  ;
constexpr size_t WS_EXP_IN = WS_ROUTER + al4k((size_t)2 * 64 * D * 2);
constexpr size_t WS_EXP_OUT = WS_EXP_IN + (size_t)2 * 65 * EXP_IN_BYTES;
constexpr size_t WS_X = WS_EXP_OUT + (size_t)2 * 65 * EXP_OUT_BYTES;
constexpr size_t WS_H = WS_X + (size_t)T_ALL * D * 4;
constexpr size_t WS_PROJ = WS_H + (size_t)T_ALL * D * 2;
constexpr size_t WS_OA = WS_PROJ + (size_t)T_ALL * ABW * 2;
constexpr size_t WS_MERGED = WS_OA + (size_t)T_ALL * D * 2;
constexpr size_t WS_Y1 = WS_MERGED + (size_t)T_ALL * D * 2;
constexpr size_t P_MAX = (size_t)MAX_TILES * 256;
constexpr size_t WS_HMID = WS_Y1 + (size_t)T_ALL * D * 2;
constexpr size_t WS_Y2P = WS_HMID + P_MAX * FDIM * 2;
constexpr size_t WS_LIST = WS_Y2P + P_MAX * D * 2;
constexpr size_t WS_TOKSLOT = WS_LIST + (size_t)64 * LIST_CAP * 4;
constexpr size_t WS_GATE = WS_TOKSLOT + (size_t)T_ALL * 8 * 4;
constexpr size_t WS_DOWN = WS_GATE + (size_t)T_ALL * 8 * 4;
constexpr size_t WS_CQN = WS_DOWN + (size_t)T_ALL * DOWN_N * 2;
constexpr size_t WS_CKVN = WS_CQN + (size_t)T_ALL * 512 * 2;
constexpr size_t WS_KPE = WS_CKVN + (size_t)T_ALL * 512 * 2;
constexpr size_t WS_QM = WS_KPE + (size_t)T_ALL * 64 * 2;
constexpr size_t WS_KVM = WS_QM + (size_t)T_ALL * UQ_N * 2;
constexpr size_t WS_SW = WS_KVM + (size_t)T_ALL * UKV_N * 2;
constexpr size_t WS_H8 = WS_SW + al4k((size_t)2 * 65 * 1024 * 4);
constexpr size_t WS_SA = WS_H8 + (size_t)T_ALL * D;
constexpr size_t WS_SWD = WS_SA + al4k((size_t)T_ALL * 4);
constexpr int SWD_IN = 0, SWD_OUT = 4608, SWD_DOWN = 6656, SWD_UQ = 7936, SWD_UKV = 11008, SWD_O = 15104, SWD_N = 17152;
constexpr size_t WS_SW2 = WS_SWD + al4k((size_t)SWD_N * 4);
constexpr size_t WS_SCQ = WS_SW2 + al4k((size_t)2 * 65 * 2048 * 4);
constexpr size_t WS_SCKV = WS_SCQ + al4k((size_t)T_ALL * 4);
constexpr size_t WS_SMG = WS_SCKV + al4k((size_t)T_ALL * 4);
constexpr size_t WS_SHM = WS_SMG + al4k((size_t)T_ALL * 4);
constexpr size_t WS_HM8 = WS_SHM + al4k(P_MAX * 4);
constexpr size_t WS_MG8 = WS_HM8 + P_MAX * FDIM;
constexpr size_t WS_END = WS_MG8 + (size_t)T_ALL * D;
constexpr size_t TAB64R = 0, TAB64C = 4096, TAB128R = 12288, TAB128C = 20480;
constexpr int CW_BAR = 4096, CW_CNT = 16384;
constexpr int CW_QW = 20480;
constexpr int QSLOT_OFF = 163776;

constexpr int RING_BYTES = 131072;
constexpr int IDXC_OFF = 131072, IDXC_UNITS = 16;
constexpr int TTAB_OFF = IDXC_OFF + IDXC_UNITS * 1024;
constexpr int MISC_OFF = TTAB_OFF + 4096;
constexpr int LDS_BYTES = 163840;
constexpr int BARW_OFF = LDS_BYTES - 16;
constexpr int SCL_OFF = MISC_OFF + 2048;

#define RLX_AGENT __ATOMIC_RELAXED, __HIP_MEMORY_SCOPE_AGENT
__device__ __forceinline__ unsigned f2bf(float f) { unsigned u = __builtin_bit_cast(unsigned, f); return (u + 0x7fffu + ((u >> 16) & 1u)) >> 16; }
__device__ __forceinline__ unsigned pk2(float lo, float hi) { return f2bf(lo) | (f2bf(hi) << 16); }
__device__ __forceinline__ float bf2f(unsigned short b) { return __builtin_bit_cast(float, ((unsigned)b) << 16); }
__device__ __forceinline__ float bflo(unsigned w) { return __builtin_bit_cast(float, w << 16); }
__device__ __forceinline__ float bfhi(unsigned w) { return __builtin_bit_cast(float, w & 0xffff0000u); }
__device__ __forceinline__ unsigned cvt_pk_bf16(float lo, float hi) { unsigned r; asm volatile("v_cvt_pk_bf16_f32 %0, %1, %2" : "=v"(r) : "v"(lo), "v"(hi)); return r; }
__device__ __forceinline__ unsigned q8x4(float a, float b, float c, float d, float inv) {
    unsigned w = 0;
    w = __builtin_amdgcn_cvt_pk_u8_f32(__builtin_rintf(fmaf(a, inv, 128.0f)), 0, w); w = __builtin_amdgcn_cvt_pk_u8_f32(__builtin_rintf(fmaf(b, inv, 128.0f)), 1, w);
    w = __builtin_amdgcn_cvt_pk_u8_f32(__builtin_rintf(fmaf(c, inv, 128.0f)), 2, w); w = __builtin_amdgcn_cvt_pk_u8_f32(__builtin_rintf(fmaf(d, inv, 128.0f)), 3, w);
    return w ^ 0x80808080u;
}
__device__ __forceinline__ float wave_sum(float v) {
#pragma unroll
    for (int o = 1; o < 64; o <<= 1) v += __shfl_xor(v, o);
    return v;
}

#define XB_TMO      128
#define XB_XCNT(j)  (256  + 64 * (j))
#define XB_XSUB(j)  (1280 + 64 * (j))
#define XB_XGEN(j)  (2304 + 64 * (j))
#define XB_TOP      3328
#define XB_TOPGEN   3392
#define XCD_BAR_WORDS 3456
#define XB_SPIN_CAP (1u << 18)
__device__ __forceinline__ unsigned xb_ld(unsigned* p)              { return __hip_atomic_load(p, __ATOMIC_RELAXED, __HIP_MEMORY_SCOPE_AGENT); }
__device__ __forceinline__ unsigned xb_add(unsigned* p, unsigned v) { return __hip_atomic_fetch_add(p, v, __ATOMIC_RELAXED, __HIP_MEMORY_SCOPE_AGENT); }
__device__ __forceinline__ unsigned xb_xcc_id() { return (unsigned)__builtin_amdgcn_s_getreg((3 << 11) | 20) & 0xFu; }
#define XB_SPIN(cond, bar) do { unsigned _sp = 0; while (cond) { __builtin_amdgcn_s_sleep(1); \
    if ((++_sp & 255u) == 0u) { if (xb_ld(&(bar)[XB_TMO])) break; if (_sp > XB_SPIN_CAP) { atomicAdd(&(bar)[XB_TMO], 1u); break; } } } } while (0)
struct XcdBarrier { unsigned* bar; unsigned x; volatile LAS unsigned* st; };
__device__ __forceinline__ XcdBarrier xcd_barrier_post(unsigned* bar, volatile LAS unsigned* st) {
    XcdBarrier b; b.bar = bar; b.x = xb_xcc_id(); b.st = st;
    if (threadIdx.x == 0) (void)xb_add(&bar[XB_XCNT(b.x)], 1u);
    return b;
}
__device__ __forceinline__ void xcd_barrier_complete(unsigned* bar, unsigned x, unsigned& nloc, unsigned& nx) {
    const unsigned G = gridDim.x * gridDim.y * gridDim.z;
    unsigned sum, cnt, mine, sp = 0u;
    for (;;) {
        sum = 0u; cnt = 0u; mine = 0u;
#pragma unroll
        for (unsigned j = 0; j < 16; ++j) { const unsigned c = xb_ld(&bar[XB_XCNT(j)]); sum += c; cnt += (c > 0u) ? 1u : 0u; mine = (j == x) ? c : mine; }
        if (sum == G) break;
        __builtin_amdgcn_s_sleep(1);
        if ((++sp & 255u) == 0u) { if (xb_ld(&bar[XB_TMO])) break; if (sp > XB_SPIN_CAP) { atomicAdd(&bar[XB_TMO], 1u); break; } }
    }
    nloc = mine > 0u ? mine : 1u; nx = cnt > 0u ? cnt : 1u;
}
__device__ __forceinline__ void xcd_barrier(const XcdBarrier& b) {
    asm volatile("s_waitcnt vmcnt(0)" ::: "memory");
    __syncthreads();
    if (threadIdx.x == 0) {
        unsigned* bar = b.bar;
        __builtin_amdgcn_s_waitcnt(0);
        unsigned nloc = b.st[0], nx = b.st[1];
        if (nloc == 0u) { xcd_barrier_complete(bar, b.x, nloc, nx); b.st[0] = nloc; b.st[1] = nx; }
        const unsigned old = xb_add(&bar[XB_XSUB(b.x)], 1u);
        const unsigned gen = old / nloc;
        if (old + 1u == (gen + 1u) * nloc) {
            __builtin_amdgcn_fence(__ATOMIC_RELEASE, "agent");
            asm volatile("s_waitcnt vmcnt(0)" ::: "memory");
            const unsigned og = xb_add(&bar[XB_TOP], 1u);
            const unsigned tg = og / nx;
            if (og + 1u == (tg + 1u) * nx) xb_add(&bar[XB_TOPGEN], 1u);
            else XB_SPIN(xb_ld(&bar[XB_TOPGEN]) == tg, bar);
            __builtin_amdgcn_fence(__ATOMIC_ACQUIRE, "agent");
            xb_add(&bar[XB_XGEN(b.x)], 1u);
            asm volatile("s_waitcnt vmcnt(0)" ::: "memory");
        } else {
            XB_SPIN(xb_ld(&bar[XB_XGEN(b.x)]) == gen, bar);
            __builtin_amdgcn_fence(__ATOMIC_ACQUIRE, "agent");
            asm volatile("s_waitcnt vmcnt(0)" ::: "memory");
        }
    }
    __syncthreads();
}

namespace pg8 {
constexpr int BM = 256, BK = 64, HALF = 128, HTB = HALF * BK * 2, STAGE_BYTES = 8 * HTB;
__device__ __forceinline__ int lds_byte(int r, int c) { const int st = (r >> 4) * 2 + (c >> 5), rr = r & 15, cc = c & 31, ob = rr * 64 + cc * 2; return st * 1024 + (ob ^ (((ob >> 9) & 1) << 5)); }
__device__ __forceinline__ void stage_rc(int b, int& R, int& C) { const int st = b / 1024, sb = b % 1024, swz = sb ^ (((sb >> 9) & 1) << 5); R = (st >> 1) * 16 + swz / 64; C = (st & 1) * 32 + (swz % 64) / 2; }
__device__ __forceinline__ int perm32(int rho) { const int n = rho >> 4, i = rho & 15; return 8 * (i >> 2) + 4 * n + (i & 3); }

struct Unit { int row0; int pn; int e; const char* B; };

struct SchedDense {
    int nM, nN, nwg, G, c, latmap; const char* Bt; size_t tstepB;
    __device__ __forceinline__ void init(int nM_, int nN_, int G_, int c_, int latmap_, const bf16_t* Bt_, int K) { nM = nM_; nN = nN_; nwg = nM * nN; G = G_; c = c_; latmap = latmap_; Bt = (const char*)Bt_; tstepB = (size_t)BM * K * 2; }
    __device__ __forceinline__ bool next(int i, Unit& u) const {
        const long L = (long)i * G + c; if (L >= nwg) return false;
        int wgid = (int)L; { const int q = nwg / 8, r = nwg % 8, xcd = wgid % 8, off = wgid / 8; wgid = (xcd < r ? xcd * (q + 1) : r * (q + 1) + (xcd - r) * q) + off; }
        const int nig = 8 * nN, gid = wgid / nig, fm = gid * 8, gsz = (nM - fm) < 8 ? (nM - fm) : 8;
        int pm = fm + ((wgid % nig) % gsz); u.pn = (wgid % nig) / gsz;
        if (latmap) pm = (pm >> 3) * 9 + 1 + (pm & 7);
        u.row0 = pm * BM; u.e = 0; u.B = Bt + (size_t)u.pn * tstepB; return true;
    }
};
template <int NN, size_t GSTRIDE, size_t TSTEPB> struct SchedMoe {
    int ntiles, G, vcu; const LAS int* ttab; const char* Bt;
    __device__ __forceinline__ bool next(int i, Unit& u) const {
        const int L = i * G + vcu; if (L >= ntiles * NN) return false;
        const int tile = L / NN; u.pn = L - tile * NN; const int e = ttab[tile] >> 16;
        u.row0 = tile * BM; u.e = e; u.B = Bt + (size_t)e * GSTRIDE + (size_t)u.pn * TSTEPB; return true;
    }
};
struct EpiBf16 {
    static constexpr bool PERM = true; static constexpr int NVM = 16;
    bf16_t* O; int ldc;
    __device__ __forceinline__ const float* sa_src(const Unit& u, int ui, int r) const { return (const float*)O; }
    __device__ __forceinline__ const float* sw_src(const Unit& u, int c) const { return (const float*)O; }
    __device__ __forceinline__ void operator()(const f32x4 (&acc)[2][2][4][2], const Unit& u, int ui, int wr, int wc, int fr, int fq, const LAS float* scl) const {
        const int row0 = u.row0 + wr * 64 + fr, col0 = u.pn * BM + wc * 32 + 8 * fq;
#pragma unroll
        for (int ai = 0; ai < 2; ++ai)
#pragma unroll
            for (int m = 0; m < 4; ++m) { bf16_t* rowp = O + (size_t)(row0 + ai * HALF + m * 16) * ldc + col0;
#pragma unroll
                for (int bj = 0; bj < 2; ++bj) { const f32x4 v0 = acc[ai][bj][m][0], v1 = acc[ai][bj][m][1];
                    u32x4 w; w.x = cvt_pk_bf16(v0[0], v0[1]); w.y = cvt_pk_bf16(v0[2], v0[3]); w.z = cvt_pk_bf16(v1[0], v1[1]); w.w = cvt_pk_bf16(v1[2], v1[3]);
                    *(u32x4*)(rowp + bj * HALF) = w; } }
    }
};
__device__ __forceinline__ float silu_mul(float g, float u) { return g * __builtin_amdgcn_rcpf(1.0f + __builtin_amdgcn_exp2f(-1.4426950408889634f * g)) * u; }
template <int SWG> struct EpiI8Bf16 {
    static constexpr bool PERM = true; static constexpr int NVM = 16;
    bf16_t* O; int ldc; const float* SA; const float* SW;
    __device__ __forceinline__ const float* sa_src(const Unit& u, int ui, int r) const { return SA + u.row0 + r; }
    __device__ __forceinline__ const float* sw_src(const Unit& u, int c) const { return SW + (size_t)u.e * SWG + u.pn * BM + c; }
    __device__ __forceinline__ void operator()(const i32x4 (&acc)[2][2][4][2], const Unit& u, int ui, int wr, int wc, int fr, int fq, const LAS float* scl) const {
        const int lrow = wr * 64 + fr, row0 = u.row0 + lrow, col0 = u.pn * BM + wc * 32 + 8 * fq;
#pragma unroll
        for (int bj = 0; bj < 2; ++bj) { const f32x4 w0 = *(const LAS f32x4*)(scl + 256 + bj * HALF + wc * 32 + 8 * fq), w1 = *(const LAS f32x4*)(scl + 256 + bj * HALF + wc * 32 + 8 * fq + 4);
#pragma unroll
            for (int ai = 0; ai < 2; ++ai)
#pragma unroll
                for (int m = 0; m < 4; ++m) { const int r = row0 + ai * HALF + m * 16; bf16_t* rowp = O + (size_t)r * ldc + col0 + bj * HALF; const float sa = scl[lrow + ai * HALF + m * 16];
                    const i32x4 v0 = acc[ai][bj][m][0], v1 = acc[ai][bj][m][1]; const f32x4 s0 = w0 * sa, s1 = w1 * sa;
                    const f32x4 f0 = __builtin_convertvector(v0, f32x4) * s0, f1 = __builtin_convertvector(v1, f32x4) * s1;
                    u32x4 w; w.x = cvt_pk_bf16(f0[0], f0[1]); w.y = cvt_pk_bf16(f0[2], f0[3]); w.z = cvt_pk_bf16(f1[0], f1[1]); w.w = cvt_pk_bf16(f1[2], f1[3]);
                    *(u32x4*)rowp = w; } }
    }
};
template <int SWG> struct EpiI8Fp8 {
    static constexpr bool PERM = true; static constexpr int NVM = 16;
    unsigned char* O; int ldc; const float* SA; const float* SW;
    __device__ __forceinline__ const float* sa_src(const Unit& u, int ui, int r) const { return SA + u.row0 + r; }
    __device__ __forceinline__ const float* sw_src(const Unit& u, int c) const { return SW + (size_t)u.e * SWG + u.pn * BM + c; }
    __device__ __forceinline__ void operator()(const i32x4 (&acc)[2][2][4][2], const Unit& u, int ui, int wr, int wc, int fr, int fq, const LAS float* scl) const {
        const int lrow = wr * 64 + fr, row0 = u.row0 + lrow, col0 = u.pn * BM + wc * 32 + 8 * fq;
#pragma unroll
        for (int bj = 0; bj < 2; ++bj) { const f32x4 w0 = *(const LAS f32x4*)(scl + 256 + bj * HALF + wc * 32 + 8 * fq), w1 = *(const LAS f32x4*)(scl + 256 + bj * HALF + wc * 32 + 8 * fq + 4);
#pragma unroll
            for (int ai = 0; ai < 2; ++ai)
#pragma unroll
                for (int m = 0; m < 4; ++m) { const int r = row0 + ai * HALF + m * 16; unsigned char* rowp = O + (size_t)r * ldc + col0 + bj * HALF; const float sa = scl[lrow + ai * HALF + m * 16];
                    const i32x4 v0 = acc[ai][bj][m][0], v1 = acc[ai][bj][m][1]; const f32x4 s0 = w0 * sa, s1 = w1 * sa;
                    const f32x4 f0 = __builtin_convertvector(v0, f32x4) * s0, f1 = __builtin_convertvector(v1, f32x4) * s1;
                    int lo = 0, hi = 0;
                    lo = __builtin_amdgcn_cvt_pk_fp8_f32(f0[0], f0[1], lo, false); lo = __builtin_amdgcn_cvt_pk_fp8_f32(f0[2], f0[3], lo, true);
                    hi = __builtin_amdgcn_cvt_pk_fp8_f32(f1[0], f1[1], hi, false); hi = __builtin_amdgcn_cvt_pk_fp8_f32(f1[2], f1[3], hi, true);
                    *(u32x2*)rowp = (u32x2){(unsigned)lo, (unsigned)hi}; } }
    }
};
struct EpiSwigluI8 {
    static constexpr bool PERM = true; static constexpr int NVM = 8;
    unsigned char* O; int ldc; const float* SA; const float* SW; const LAS int* idxc;
    __device__ __forceinline__ const float* sa_src(const Unit& u, int ui, int r) const { return SA + idxc[(ui & (IDXC_UNITS - 1)) * 256 + r]; }
    __device__ __forceinline__ const float* sw_src(const Unit& u, int c) const { return SW + (size_t)u.e * 1024 + u.pn * BM + c; }
    __device__ __forceinline__ void operator()(const i32x4 (&acc)[2][2][4][2], const Unit& u, int ui, int wr, int wc, int fr, int fq, const LAS float* scl) const {
        const int lrow = wr * 64 + fr, row0 = u.row0 + lrow, col0 = u.pn * HALF + wc * 32 + 8 * fq;
        const LAS float* sw = scl + 256 + wc * 32 + 8 * fq;
        const f32x4 wg0 = *(const LAS f32x4*)sw, wg1 = *(const LAS f32x4*)(sw + 4), wu0 = *(const LAS f32x4*)(sw + HALF), wu1 = *(const LAS f32x4*)(sw + HALF + 4);
#pragma unroll
        for (int ai = 0; ai < 2; ++ai)
#pragma unroll
            for (int m = 0; m < 4; ++m) { unsigned char* rowp = O + (size_t)(row0 + ai * HALF + m * 16) * ldc + col0;
                const float sa = scl[lrow + ai * HALF + m * 16];
                const i32x4 g0 = acc[ai][0][m][0], g1 = acc[ai][0][m][1], u0 = acc[ai][1][m][0], u1 = acc[ai][1][m][1];
                float o[8];
#pragma unroll
                for (int j = 0; j < 4; ++j) { o[j] = silu_mul((float)g0[j] * (sa * wg0[j]), (float)u0[j] * (sa * wu0[j])); o[4 + j] = silu_mul((float)g1[j] * (sa * wg1[j]), (float)u1[j] * (sa * wu1[j])); }
                int lo = 0, hi = 0;
                lo = __builtin_amdgcn_cvt_pk_fp8_f32(o[0], o[1], lo, false); lo = __builtin_amdgcn_cvt_pk_fp8_f32(o[2], o[3], lo, true);
                hi = __builtin_amdgcn_cvt_pk_fp8_f32(o[4], o[5], hi, false); hi = __builtin_amdgcn_cvt_pk_fp8_f32(o[6], o[7], hi, true);
                *(u32x2*)rowp = (u32x2){(unsigned)lo, (unsigned)hi}; }
    }
};

template <bool I8> struct AccT { typedef f32x4 T; };
template <> struct AccT<true> { typedef i32x4 T; };
__device__ __forceinline__ f32x4 mma16(bf16x8 b, bf16x8 a, f32x4 c) { return __builtin_amdgcn_mfma_f32_16x16x32_bf16(b, a, c, 0, 0, 0); }
__device__ __forceinline__ i32x4 mma16(bf16x8 b, bf16x8 a, i32x4 c) { return __builtin_amdgcn_mfma_i32_16x16x64_i8(__builtin_bit_cast(i32x4, b), __builtin_bit_cast(i32x4, a), c, 0, 0, 0); }
template <class Epi, class Sched, bool GATHER, bool I8 = false>
__device__ __forceinline__ void gemm_phase(LAS unsigned char* lds, const void* Abase, const int K, const Sched& S, const Epi& E, const LAS int* idxc, const int tid) {
    const int wid = __builtin_amdgcn_readfirstlane(tid >> 6), lane = tid & 63, wr = wid >> 2, wc = wid & 3, fr = lane & 15, fq = lane >> 4;
    const int RB = I8 ? K : K * 2, nt = RB / 128;
    int Ri[2], Ci[2]; unsigned voffB[2];
#pragma unroll
    for (int i = 0; i < 2; ++i) { int R, C; stage_rc(tid * 16 + i * 8192, R, C); Ri[i] = R; Ci[i] = C; const int Rb = Epi::PERM ? ((R & ~31) + perm32(R & 31)) : R; voffB[i] = (unsigned)(Rb * RB + C * 2); }
    const size_t kstep = 128;
    const size_t hstep = (size_t)HALF * RB;
    const unsigned ldsw = (unsigned)wid * 1024u;
    const int aoff = lds_byte(wr * 64 + fr, fq * 8), boff = lds_byte(wc * 32 + fr, fq * 8);
#define PG8_SA(b, h) (((b) * 2 + (h)) * HTB)
#define PG8_SB(b, h) ((4 + (b) * 2 + (h)) * HTB)
#define PG8_STAGE(bufoff, gbase, voff) do { _Pragma("unroll") for (int _i = 0; _i < 2; ++_i) \
        __builtin_amdgcn_global_load_lds((const unsigned*)((const char*)(gbase) + (voff)[_i]), (LAS unsigned*)(lds + (bufoff) + ldsw + _i * 8192), 16, 0, 0); } while (0)
#define PG8_LDA(dst, b, h) do { _Pragma("unroll") for (int m = 0; m < 4; ++m) _Pragma("unroll") for (int k = 0; k < 2; ++k) dst[m][k] = *(const LAS bf16x8*)(lds + PG8_SA(b, h) + aoff + m * 2048 + k * 1024); } while (0)
#define PG8_LDB(dst, b, h) do { _Pragma("unroll") for (int n = 0; n < 2; ++n) _Pragma("unroll") for (int k = 0; k < 2; ++k) dst[n][k] = *(const LAS bf16x8*)(lds + PG8_SB(b, h) + boff + n * 2048 + k * 1024); } while (0)
#define PG8_MMA(ai, bj, At, Bt) do { __builtin_amdgcn_s_setprio(1); _Pragma("unroll") for (int m = 0; m < 4; ++m) _Pragma("unroll") for (int n = 0; n < 2; ++n) _Pragma("unroll") for (int k = 0; k < 2; ++k) \
        acc[ai][bj][m][n] = mma16(Bt[n][k], At[m][k], acc[ai][bj][m][n]); __builtin_amdgcn_s_setprio(0); } while (0)
#define PG8_WAIT_V(n) asm volatile("s_waitcnt vmcnt(" #n ")" ::: "memory")
#define PG8_WAIT_L(n) asm volatile("s_waitcnt lgkmcnt(" #n ")" ::: "memory")
#define PG8_BAR __builtin_amdgcn_s_barrier()
#define PG8_SCHED __builtin_amdgcn_sched_barrier(0)
#define PG8_MKA(dst, ui, u_) do { _Pragma("unroll") for (int _h = 0; _h < 2; ++_h) _Pragma("unroll") for (int _i = 0; _i < 2; ++_i) { \
        if constexpr (GATHER) dst[_h][_i] = (unsigned)idxc[((ui) & (IDXC_UNITS - 1)) * 256 + _h * HALF + Ri[_i]] * (unsigned)RB + (unsigned)(Ci[_i] * 2); \
        else dst[_h][_i] = (unsigned)((_h * HALF + Ri[_i]) * RB + Ci[_i] * 2); } } while (0)
    Unit cur, nxt; int ui = 0;
    if (!S.next(0, cur)) return;
    LAS float* const sclb = (LAS float*)(lds + SCL_OFF);
#define PG8_SCALES(u_, ui_) do { const float* _src = (wid < 4) ? E.sa_src(u_, ui_, wid * 64 + lane) : E.sw_src(u_, (wid - 4) * 64 + lane); \
        __builtin_amdgcn_global_load_lds((const unsigned*)_src, (LAS unsigned*)(sclb + ((ui_) & 1) * 512 + wid * 64), 4, 0, 0); } while (0)
    constexpr int NEPI = Epi::NVM;
    typedef typename AccT<I8>::T acc_t;
    acc_t acc[2][2][4][2];
#pragma unroll
    for (int a = 0; a < 2; ++a)
#pragma unroll
        for (int b = 0; b < 2; ++b)
#pragma unroll
            for (int m = 0; m < 4; ++m)
#pragma unroll
                for (int n = 0; n < 2; ++n) acc[a][b][m][n] = acc_t{};
    bf16x8 At[4][2], B0[2][2], B1[2][2];
    unsigned curA[2][2], nxtA[2][2];
    PG8_MKA(curA, 0, cur);
    PG8_SCALES(cur, 0);
    const char* cA = GATHER ? (const char*)Abase : (const char*)Abase + (size_t)cur.row0 * RB; const char* cB = cur.B;
    PG8_STAGE(PG8_SB(0, 0), cB, voffB); PG8_STAGE(PG8_SB(0, 1), cB + hstep, voffB); PG8_STAGE(PG8_SA(0, 0), cA, curA[0]); PG8_STAGE(PG8_SA(0, 1), cA, curA[1]);
    if (wr == 1) PG8_BAR;
    PG8_WAIT_V(2); PG8_BAR;
    PG8_STAGE(PG8_SB(1, 0), cB + kstep, voffB); PG8_STAGE(PG8_SA(1, 0), cA + kstep, curA[0]); PG8_STAGE(PG8_SB(1, 1), cB + hstep + kstep, voffB);
    PG8_WAIT_V(6); PG8_BAR;
    for (;;) {
        const bool has_next = S.next(ui + 1, nxt);
        const char* nA = has_next ? (GATHER ? (const char*)Abase : (const char*)Abase + (size_t)nxt.row0 * RB) : cA; const char* nB = has_next ? nxt.B : cB;
        if constexpr (GATHER) { if (has_next) { PG8_MKA(nxtA, ui + 1, nxt); } else {
#pragma unroll
            for (int h = 0; h < 2; ++h)
#pragma unroll
                for (int i = 0; i < 2; ++i) nxtA[h][i] = curA[h][i]; } }
#pragma unroll 1
        for (int t = 0; t < nt; t += 2) {
            const bool last = (t == nt - 2);
            const char* a1 = cA + (size_t)(t + 1) * kstep;
            const char* a2 = last ? nA : cA + (size_t)(t + 2) * kstep; const char* b2 = last ? nB : cB + (size_t)(t + 2) * kstep;
            const char* a3 = a2 + kstep; const char* b3 = b2 + kstep;
            unsigned s0[2], s1[2];
#pragma unroll
            for (int i = 0; i < 2; ++i) { if constexpr (GATHER) { s0[i] = last ? nxtA[0][i] : curA[0][i]; s1[i] = last ? nxtA[1][i] : curA[1][i]; } else { s0[i] = curA[0][i]; s1[i] = curA[1][i]; } }
            const bool relax = (t == 0) && (ui > 0);
            PG8_LDB(B0, 0, 0); PG8_LDB(B1, 0, 1); PG8_SCHED; PG8_LDA(At, 0, 0); PG8_STAGE(PG8_SA(1, 1), a1, curA[1]);
            if (relax) { if constexpr (NEPI == 16) PG8_WAIT_V(24); else PG8_WAIT_V(16); } else PG8_WAIT_V(8);
            PG8_WAIT_L(0); PG8_BAR; PG8_MMA(0, 0, At, B0); PG8_MMA(0, 1, At, B1); PG8_BAR; PG8_SCHED;
            PG8_LDA(At, 0, 1); PG8_STAGE(PG8_SB(0, 0), b2, voffB); PG8_STAGE(PG8_SB(0, 1), b2 + hstep, voffB); PG8_STAGE(PG8_SA(0, 0), a2, s0);
            if (relax) { if constexpr (NEPI == 16) PG8_WAIT_V(24); else PG8_WAIT_V(16); } else PG8_WAIT_V(8);
            PG8_WAIT_L(0); PG8_BAR; PG8_MMA(1, 0, At, B0); PG8_MMA(1, 1, At, B1); PG8_BAR; PG8_SCHED;
            PG8_LDB(B0, 1, 0); PG8_LDB(B1, 1, 1); PG8_SCHED; PG8_LDA(At, 1, 0); PG8_STAGE(PG8_SA(0, 1), a2, s1);
            PG8_WAIT_V(8); PG8_WAIT_L(0); PG8_BAR; PG8_MMA(0, 0, At, B0); PG8_MMA(0, 1, At, B1); PG8_BAR; PG8_SCHED;
            PG8_LDA(At, 1, 1); PG8_STAGE(PG8_SB(1, 0), b3, voffB); PG8_STAGE(PG8_SB(1, 1), b3 + hstep, voffB); PG8_STAGE(PG8_SA(1, 0), a3, s0);
            PG8_WAIT_V(8); PG8_WAIT_L(0); PG8_BAR; PG8_MMA(1, 0, At, B0); PG8_MMA(1, 1, At, B1); PG8_BAR; PG8_SCHED;
        }
        if (wr == 0) PG8_BAR;
        E(acc, cur, ui, wr, wc, fr, fq, sclb + (ui & 1) * 512);
        if (!has_next) break;
#pragma unroll
        for (int a = 0; a < 2; ++a)
#pragma unroll
            for (int b = 0; b < 2; ++b)
#pragma unroll
                for (int m = 0; m < 4; ++m)
#pragma unroll
                    for (int n = 0; n < 2; ++n) acc[a][b][m][n] = acc_t{};
        cur = nxt; cA = nA; cB = nB; ++ui;
        PG8_SCALES(cur, ui);
        if constexpr (GATHER) {
#pragma unroll
            for (int h = 0; h < 2; ++h)
#pragma unroll
                for (int i = 0; i < 2; ++i) curA[h][i] = nxtA[h][i]; }
        if (wr == 1) PG8_BAR;
    }
    PG8_WAIT_V(0);
    PG8_BAR;
#undef PG8_SA
#undef PG8_SB
#undef PG8_STAGE
#undef PG8_LDA
#undef PG8_LDB
#undef PG8_MMA
#undef PG8_WAIT_V
#undef PG8_WAIT_L
#undef PG8_BAR
#undef PG8_SCHED
#undef PG8_MKA
#undef PG8_SCALES
}
}

namespace att {
constexpr int DV = 128, NW = 8, QBLK = 32, KVBLK = 64;
constexpr float THR = 8.f;
#define SBAR() __builtin_amdgcn_sched_barrier(0)
__device__ __forceinline__ int crow(int r, int hi) { return (r & 3) + 8 * (r >> 2) + 4 * hi; }
template <int DQK> struct Cfg {
    static constexpr int NQ = DQK / 16, SHM_K = KVBLK * DQK * 2, KCH = DQK / 64;
    static constexpr int RB0 = DQK >= 128 ? 256 : 128;
    static constexpr int KCH0 = DQK >= 128 ? 2 : 1, KCH1 = DQK == 192 ? 1 : 0, REG1 = KVBLK * RB0;
    static constexpr float SCALE = DQK == 64 ? 0.125f : (DQK == 128 ? 0.088388347648318440f : 0.072168783648703220f);
};
constexpr int SHM_V = KVBLK * DV * 2;

template <int DQK> __device__ __forceinline__ void partialSM(f32x16& p0, f32x16& p1, float& m_reg, float& mn, float& alpha) {
    constexpr float SCALE = Cfg<DQK>::SCALE, C = SCALE * 1.4426950408889634f;
    float pmax = p0[0];
#pragma unroll
    for (int r = 1; r < 16; ++r) pmax = fmaxf(pmax, p0[r]);
#pragma unroll
    for (int r = 0; r < 16; ++r) pmax = fmaxf(pmax, p1[r]);
    { auto rr = __builtin_amdgcn_permlane32_swap(__float_as_uint(pmax), __float_as_uint(pmax), false, false);
      pmax = fmaxf(__uint_as_float(rr[0]), __uint_as_float(rr[1])); }
    if (__builtin_expect(__all(pmax - m_reg <= THR / SCALE), 1)) { mn = m_reg; alpha = 1.f; }
    else { mn = fmaxf(m_reg, pmax); alpha = __builtin_amdgcn_exp2f((m_reg - mn) * C); m_reg = mn; }
    const float mnC = -mn * C;
#pragma unroll
    for (int r = 0; r < 16; ++r) p0[r] = fmaf(p0[r], C, mnC);
#pragma unroll
    for (int r = 0; r < 16; ++r) p1[r] = fmaf(p1[r], C, mnC);
#pragma unroll
    for (int r = 0; r < 16; ++r) p0[r] = __builtin_amdgcn_exp2f(p0[r]);
}
__device__ __forceinline__ void finishSM(f32x16& p0, f32x16& p1, float alpha, float& l_reg, bf16x8& pa0, bf16x8& pa1, bf16x8& pa2, bf16x8& pa3) {
#pragma unroll
    for (int r = 0; r < 16; ++r) p1[r] = __builtin_amdgcn_exp2f(p1[r]);
    float ps = 0;
#pragma unroll
    for (int r = 0; r < 16; ++r) ps += p0[r];
#pragma unroll
    for (int r = 0; r < 16; ++r) ps += p1[r];
    { auto rr = __builtin_amdgcn_permlane32_swap(__float_as_uint(ps), __float_as_uint(ps), false, false);
      ps = __uint_as_float(rr[0]) + __uint_as_float(rr[1]); }
    l_reg = l_reg * alpha + ps;
#define PK4(P, BASE, OUT) do { unsigned a0 = cvt_pk_bf16(P[BASE + 0], P[BASE + 1]), a1 = cvt_pk_bf16(P[BASE + 2], P[BASE + 3]);   \
    unsigned b0 = cvt_pk_bf16(P[BASE + 4], P[BASE + 5]), b1 = cvt_pk_bf16(P[BASE + 6], P[BASE + 7]);                              \
    auto r0 = __builtin_amdgcn_permlane32_swap(a0, b0, false, false); auto r1 = __builtin_amdgcn_permlane32_swap(a1, b1, false, false); \
    u32x4 w = {r0[0], r1[0], r0[1], r1[1]}; OUT = *reinterpret_cast<bf16x8*>(&w); } while (0)
    PK4(p0, 0, pa0); PK4(p0, 8, pa1); PK4(p1, 0, pa2); PK4(p1, 8, pa3);
#undef PK4
}
template <int DQK> __device__ __forceinline__ void qkt(f32x16& p0, f32x16& p1, const char* Ks, const bf16x8* qr, const char* qx, int r32, int hi) {
    p0 = f32x16{}; p1 = f32x16{};
    constexpr int RB0 = Cfg<DQK>::RB0;
#pragma unroll
    for (int d0 = 0; d0 < Cfg<DQK>::NQ; ++d0) {
        bf16x8 b0, b1, q;
        if (d0 < 8) { const int cb = (d0 * 16 + hi * 8) * 2;
            const int sw = (RB0 == 256 ? (r32 & 15) : ((r32 >> 1) & 7)) << 4;
            b0 = *reinterpret_cast<const bf16x8*>(Ks + r32 * RB0 + (cb ^ sw));
            b1 = *reinterpret_cast<const bf16x8*>(Ks + (32 + r32) * RB0 + (cb ^ sw));
            q = qr[d0 < 8 ? d0 : 0];
        } else { const int cb = ((d0 - 8) * 16 + hi * 8) * 2;
            const int sw = ((r32 >> 1) & 7) << 4;
            b0 = *reinterpret_cast<const bf16x8*>(Ks + Cfg<DQK>::REG1 + r32 * 128 + (cb ^ sw));
            b1 = *reinterpret_cast<const bf16x8*>(Ks + Cfg<DQK>::REG1 + (32 + r32) * 128 + (cb ^ sw));
            q = *reinterpret_cast<const bf16x8*>(qx + (d0 - 8) * 1024);
        }
        p0 = __builtin_amdgcn_mfma_f32_32x32x16_bf16(b0, q, p0, 0, 0, 0);
        p1 = __builtin_amdgcn_mfma_f32_32x32x16_bf16(b1, q, p1, 0, 0, 0); }
}
__device__ __forceinline__ int v_rd_base(int lane) { return ((lane & 3) << 3) | (((lane >> 2) & 3) << 6) | (((lane >> 4) & 1) << 5) | (((lane >> 5) & 1) << 8); }
constexpr int v_rd_off(int d0, int ks, int half) { return d0 * 512 + ks * 4096 + half * 2048; }
template <int OFF> __device__ __forceinline__ s16x4 tr_read(int vb) {
    s16x4 r; asm volatile("ds_read_b64_tr_b16 %0, %1 offset:%2" : "=&v"(r) : "v"(vb), "i"(OFF) : "memory"); return r;
}
template <int D0> __device__ __forceinline__ void pv_one(f32x16& od, int vb, bf16x8 pa0, bf16x8 pa1, bf16x8 pa2, bf16x8 pa3) {
    const s16x4 l0 = tr_read<v_rd_off(D0, 0, 0)>(vb), h0 = tr_read<v_rd_off(D0, 0, 1)>(vb), l1 = tr_read<v_rd_off(D0, 1, 0)>(vb), h1 = tr_read<v_rd_off(D0, 1, 1)>(vb);
    const s16x4 l2 = tr_read<v_rd_off(D0, 2, 0)>(vb), h2 = tr_read<v_rd_off(D0, 2, 1)>(vb), l3 = tr_read<v_rd_off(D0, 3, 0)>(vb), h3 = tr_read<v_rd_off(D0, 3, 1)>(vb);
    asm volatile("s_waitcnt lgkmcnt(0)" ::: "memory"); SBAR();
#define PK(L, H) (bf16x8){L[0], L[1], L[2], L[3], H[0], H[1], H[2], H[3]}
    od = __builtin_amdgcn_mfma_f32_32x32x16_bf16(pa0, PK(l0, h0), od, 0, 0, 0);
    od = __builtin_amdgcn_mfma_f32_32x32x16_bf16(pa1, PK(l1, h1), od, 0, 0, 0);
    od = __builtin_amdgcn_mfma_f32_32x32x16_bf16(pa2, PK(l2, h2), od, 0, 0, 0);
    od = __builtin_amdgcn_mfma_f32_32x32x16_bf16(pa3, PK(l3, h3), od, 0, 0, 0);
#undef PK
}
__device__ __forceinline__ void pv_d0(f32x16* o, int vb, bf16x8 pa0, bf16x8 pa1, bf16x8 pa2, bf16x8 pa3) {
    pv_one<0>(o[0], vb, pa0, pa1, pa2, pa3); pv_one<1>(o[1], vb, pa0, pa1, pa2, pa3); pv_one<2>(o[2], vb, pa0, pa1, pa2, pa3); pv_one<3>(o[3], vb, pa0, pa1, pa2, pa3);
}

template <int DQK, bool PIPE, bool QROPE>
__device__ __forceinline__ void attn_unit(const bf16_t* __restrict__ Qb, int ldq, const bf16_t* __restrict__ K0, int ldk0, const bf16_t* __restrict__ K1, int ldk1,
                                          const bf16_t* __restrict__ Vh, int ldv, bf16_t* __restrict__ Ob, int ldo, int nkeys, int qpos0, const f32x2* ropeR, const f32x2* ropeC,
                                          char* lds, LAS unsigned char* ldsl, const int tid) {
    using C = Cfg<DQK>; constexpr int NQ = C::NQ, SHM_K = C::SHM_K, NB = PIPE ? 3 : 2, KCH0 = C::KCH0, KCH1 = C::KCH1;
    const int wid = __builtin_amdgcn_readfirstlane(tid >> 6), lane = tid & 63, r32 = lane & 31, hi = lane >> 5;
    char* V_lds = lds; char* K_lds = lds + NB * SHM_V;
    float* ws = (float*)(lds + NB * SHM_V + NB * SHM_K) + wid * 64; float* li_l = ws; float* al_l = ws + 32;
    float m_reg = -1e30f, l_reg = 0; f32x16 o[4] = {}; constexpr int NQR = NQ < 8 ? NQ : 8; bf16x8 qr[NQR];
    char* qx = lds + NB * SHM_V + NB * SHM_K + 2048 + wid * 4096 + lane * 16;
    const bf16_t* Qw = Qb + (long)(wid * QBLK + r32) * ldq + hi * 8;
#pragma unroll
    for (int d0 = 0; d0 < NQR; ++d0) qr[d0] = *reinterpret_cast<const bf16x8*>(Qw + d0 * 16);
    if constexpr (QROPE) {
        static_assert(DQK == 192, "QROPE: MLA layout");
        const int pos = qpos0 + wid * QBLK + r32, gr = pos >> 6, gc = pos & 63;
#pragma unroll
        for (int blk = 0; blk < 2; ++blk) { const f32x2* tb = (blk == 0 ? ropeR + gr * 16 : ropeC + gc * 16) + hi * 8;
            bf16x8 x1 = *reinterpret_cast<const bf16x8*>(Qw + (8 + 2 * blk) * 16), x2 = *reinterpret_cast<const bf16x8*>(Qw + (9 + 2 * blk) * 16);
#pragma unroll
            for (int i = 0; i < 8; ++i) { const f32x2 cs = tb[i]; const float a = bf2f((unsigned short)x1[i]), b = bf2f((unsigned short)x2[i]);
                x1[i] = (short)f2bf(a * cs.x - b * cs.y); x2[i] = (short)f2bf(b * cs.x + a * cs.y); }
            *reinterpret_cast<bf16x8*>(qx + (2 * blk) * 1024) = x1; *reinterpret_cast<bf16x8*>(qx + (2 * blk + 1) * 1024) = x2; }
    } else { static_assert(NQ <= 8, "fragments beyond 8 need the LDS path"); }
    unsigned voffv[2], koff[KCH0 + (KCH1 ? 1 : 0)];
#pragma unroll
    for (int i = 0; i < 2; ++i) { const int st = 4 * wid + 2 * i + (lane >> 5), kk = (st >> 2) * 8 + ((lane & 31) >> 2), k = (kk & ~0xC) | ((kk & 4) << 1) | ((kk & 8) >> 1), c = (st & 3) * 32 + (lane & 3) * 8;
        voffv[i] = (unsigned)(k * ldv + c) * 2u; }
#pragma unroll
    for (int i = 0; i < KCH0; ++i) { const int sgm = KCH0 * wid + i; int row, q; if (C::RB0 == 256) { row = 4 * sgm + (lane >> 4); q = lane & 15; } else { row = 8 * sgm + (lane >> 3); q = lane & 7; }
        koff[i] = (unsigned)(row * ldk0 + (q ^ (C::RB0 == 256 ? (row & 15) : ((row >> 1) & 7))) * 8) * 2u; }
    if constexpr (KCH1) { const int row = 8 * wid + (lane >> 3), q = lane & 7; koff[KCH0] = (unsigned)(row * ldk1 + (q ^ ((row >> 1) & 7)) * 8) * 2u; }
    const int vb0 = (int)(uintptr_t)V_lds + v_rd_base(lane);
    LAS unsigned char* Vl = ldsl; LAS unsigned char* Kl = ldsl + NB * SHM_V;
#define GLDS(gp, lp) __builtin_amdgcn_global_load_lds((const unsigned*)(gp), (LAS unsigned*)(lp), 16, 0, 0)
#define DMA(k0, b) do { const char* _vb = (const char*)(Vh + (long)(k0) * ldv); const char* _kb0 = (const char*)(K0 + (long)(k0) * ldk0); \
    _Pragma("unroll") for (int _i = 0; _i < 2; ++_i) GLDS(_vb + voffv[_i], Vl + (b) * SHM_V + (2 * wid + _i) * 1024); \
    _Pragma("unroll") for (int _i = 0; _i < KCH0; ++_i) GLDS(_kb0 + koff[_i], Kl + (b) * SHM_K + (KCH0 * wid + _i) * 1024); \
    if constexpr (KCH1) { const char* _kb1 = (const char*)(K1 + (long)(k0) * ldk1); GLDS(_kb1 + koff[KCH0], Kl + (b) * SHM_K + C::REG1 + wid * 1024); } } while (0)
#define VM0() asm volatile("s_waitcnt vmcnt(0)" ::: "memory")
#define RESC(a) do { if (__any((a) < 1.f)) { if (hi == 0) al_l[r32] = (a); asm volatile("s_waitcnt lgkmcnt(0)" ::: "memory"); \
    _Pragma("unroll") for (int d = 0; d < 4; ++d) _Pragma("unroll") for (int r = 0; r < 16; ++r) o[d][r] *= al_l[crow(r, hi)]; } } while (0)
    bf16x8 pa0, pa1, pa2, pa3; const int NT = nkeys / KVBLK;
    if constexpr (PIPE) {
        f32x16 pA0, pA1, pB0, pB1; float mnA, mnB, alA, alB;
        int bc = 1, bp = 0, bn = 2;
        DMA(0, 0); DMA(KVBLK, 1); VM0(); __syncthreads();
        qkt<DQK>(pA0, pA1, K_lds, qr, qx, r32, hi); partialSM<DQK>(pA0, pA1, m_reg, mnA, alA);
#define STEP(PC0, PC1, mnC, alC, PP0, PP1, alP, j) do { \
        if ((j) + 1 < NT) DMA(((j) + 1) * KVBLK, bn); \
        SBAR(); qkt<DQK>(PC0, PC1, K_lds + bc * SHM_K, qr, qx, r32, hi); \
        finishSM(PP0, PP1, alP, l_reg, pa0, pa1, pa2, pa3); SBAR(); \
        pv_d0(o, vb0 + bp * SHM_V, pa0, pa1, pa2, pa3); partialSM<DQK>(PC0, PC1, m_reg, mnC, alC); \
        RESC(alC); VM0(); __syncthreads(); \
        { const int _t = bp; bp = bc; bc = bn; bn = _t; } } while (0)
        int j = 1;
        for (; j + 1 < NT; j += 2) { STEP(pB0, pB1, mnB, alB, pA0, pA1, alA, j); STEP(pA0, pA1, mnA, alA, pB0, pB1, alB, j + 1); }
        STEP(pB0, pB1, mnB, alB, pA0, pA1, alA, j);
#undef STEP
        finishSM(pB0, pB1, alB, l_reg, pa0, pa1, pa2, pa3); SBAR();
        pv_d0(o, vb0 + bp * SHM_V, pa0, pa1, pa2, pa3);
    } else {
        f32x16 p0, p1; float mn, al;
        DMA(0, 0); VM0(); __syncthreads();
        for (int j = 0; j < NT; ++j) {
            const int bs = j & 1;
            if (j + 1 < NT) DMA((j + 1) * KVBLK, bs ^ 1);
            SBAR(); qkt<DQK>(p0, p1, K_lds + bs * SHM_K, qr, qx, r32, hi); partialSM<DQK>(p0, p1, m_reg, mn, al);
            RESC(al);
            finishSM(p0, p1, al, l_reg, pa0, pa1, pa2, pa3); SBAR();
            pv_d0(o, vb0 + bs * SHM_V, pa0, pa1, pa2, pa3);
            VM0(); __syncthreads();
        }
    }
    if (hi == 0) li_l[r32] = l_reg; asm volatile("s_waitcnt lgkmcnt(0)" ::: "memory");
    float rli[16];
#pragma unroll
    for (int r = 0; r < 16; ++r) rli[r] = __builtin_amdgcn_rcpf(li_l[crow(r, hi)]);
    bf16_t* Ow = Ob + (long)(wid * QBLK) * ldo;
#pragma unroll
    for (int r = 0; r < 16; ++r) { const int orow = crow(r, hi);
#pragma unroll
        for (int d0 = 0; d0 < 4; ++d0) Ow[(long)orow * ldo + d0 * 32 + r32] = (bf16_t)f2bf(o[d0][r] * rli[r]); }
    asm volatile("s_waitcnt vmcnt(0)" ::: "memory");
    __syncthreads();
#undef GLDS
#undef DMA
#undef VM0
#undef RESC
}
}

struct Args { const float* in[28]; float* out; unsigned char* ws; int ph_lo, ph_hi; };
typedef const __attribute__((address_space(4))) Args* KArgs;
struct Frame {
    LAS unsigned char* lds; char* ldsg;
    unsigned* ctl; unsigned char* ws; KArgs ka;
    int tid, lane, wave, vcu, G, gw, NGW;
};
#define PHASE_BEGIN(F) __syncthreads(); Frame P = (F); { int _l; asm volatile("v_mbcnt_lo_u32_b32 %0, -1, 0\n\tv_mbcnt_hi_u32_b32 %0, -1, %0" : "=v"(_l)); long _z = 0; asm volatile("" : "+s"(_z)); unsigned char* _w = (F).ka->ws + _z; P.ws = _w; P.ctl = (unsigned*)_w;     \
    P.lane = _l; P.tid = P.wave * 64 + _l; P.gw = P.vcu * 8 + P.wave; }
enum { I_X = 0, I_C, I_CTX, I_CCTX, I_ADAW, I_ADAB, I_LNMG, I_LNMB, I_LNFG, I_LNFB, I_ABWIN, I_ABWOUT, I_DLAM, I_SUBLN, I_QNG, I_KNG,
       I_MDOWN, I_MQNG, I_MUQ, I_MKVNG, I_MUKV, I_MWO, I_RW, I_RB, I_EWIN, I_EWOUT, I_SWIN, I_SWOUT };

__device__ __forceinline__ int tok_row(int layer, int t) { return layer ? (t >> 11) * RPB + CTXL + (t & 2047) : t; }

__constant__ float INV128[32] = { 1.f, 0.749894202f, 0.562341332f, 0.421696514f, 0.316227764f, 0.237137392f, 0.177827939f, 0.133352146f, 0.100000001f, 0.0749894157f, 0.0562341288f, 0.0421696492f,
    0.0316227786f, 0.0237137359f, 0.0177827943f, 0.0133352149f, 0.00999999978f, 0.00749894232f, 0.00562341325f, 0.00421696482f, 0.00316227786f, 0.00237137382f, 0.00177827943f, 0.00133352145f,
    0.00100000005f, 0.000749894185f, 0.000562341302f, 0.000421696546f, 0.000316227786f, 0.000237137385f, 0.00017782794f, 0.00013335215f };

__device__ __forceinline__ f32x2 sincos_d(double a) {
    const double twopi = 6.283185307179586476925287;
    const double k = __builtin_rint(a / twopi); const double r = a - k * twopi, r2 = r * r;
    double ts = r, tc = 1.0, ss = r, cc = 1.0;
#pragma unroll 1
    for (int n = 1; n <= 15; ++n) { tc *= -r2 / (double)((2 * n - 1) * (2 * n)); cc += tc; ts *= -r2 / (double)((2 * n) * (2 * n + 1)); ss += ts; }
    return (f32x2){(float)cc, (float)ss};
}

__device__ __forceinline__ int fresh_lane() { int l; asm volatile("v_mbcnt_lo_u32_b32 %0, -1, 0\n\tv_mbcnt_hi_u32_b32 %0, -1, %0" : "=v"(l)); return l; }
__device__ __forceinline__ int fresh_tid(const Frame& F) { return F.wave * 64 + fresh_lane(); }
__device__ __forceinline__ void transpose_item(const float* W, int K, int N, bf16_t* WT, int k0, int n0, int drow0, LAS float* scr, int lane) {
#pragma unroll 8
    for (int i = 0; i < 32; ++i) { const int kk = 2 * i + (lane >> 5); scr[kk * 33 + (lane & 31)] = W[(size_t)(k0 + kk) * N + n0 + (lane & 31)]; }
    asm volatile("s_waitcnt lgkmcnt(0)" ::: "memory");
    const int c = lane & 7;
#pragma unroll
    for (int j = 0; j < 4; ++j) { const int n = (lane >> 3) + 8 * j; const LAS float* s = scr + (8 * c) * 33 + n;
        u32x4 o; o.x = pk2(s[0 * 33], s[1 * 33]); o.y = pk2(s[2 * 33], s[3 * 33]); o.z = pk2(s[4 * 33], s[5 * 33]); o.w = pk2(s[6 * 33], s[7 * 33]);
        *(u32x4*)(WT + (size_t)(drow0 + n) * K + k0 + 8 * c) = o; }
    asm volatile("s_waitcnt lgkmcnt(0)" ::: "memory");
}
struct QItem { const float* W; int N, n0, drow; signed char* Q; float* SW; };
template <int KW, int NC, class Dec>
__device__ __forceinline__ void quant_loop(Frame& F, int nitems, const Dec& dec, int first) {
    LAS unsigned short* scr = (LAS unsigned short*)(F.lds + F.wave * 16384);
    LAS float* PM = (LAS float*)(F.lds + 131072);
    constexpr int K = 8 * KW, CH = KW / 16, LPR = NC / 4, RPI = 64 / LPR, NL = KW / RPI;
    static_assert(KW * NC * 2 <= 16384 && (NC == 32 || NC == 64), "quant_loop tile");
    const int k0 = F.wave * KW, rg = F.lane / LPR, c4 = (F.lane % LPR) * 4;
    f32x4 regs[NL]; QItem cur, nxt;
    int it = first; if (it >= nitems) return;
    dec(it, cur);
#pragma unroll
    for (int i = 0; i < NL; ++i) regs[i] = __builtin_nontemporal_load((const f32x4*)(cur.W + (size_t)(k0 + RPI * i + rg) * cur.N + cur.n0 + c4));
    for (;;) {
        f32x4 am = {0.f, 0.f, 0.f, 0.f};
#pragma unroll
        for (int i = 0; i < NL; ++i) { const f32x4 w = regs[i]; am[0] = fmaxf(am[0], fabsf(w[0])); am[1] = fmaxf(am[1], fabsf(w[1])); am[2] = fmaxf(am[2], fabsf(w[2])); am[3] = fmaxf(am[3], fabsf(w[3]));
            const int sw = (((RPI * i) >> 4) & 15) << 1;
            const unsigned lo = cvt_pk_bf16(w[0], w[1]), hi = cvt_pk_bf16(w[2], w[3]);
            *(LAS u32x2*)(scr + (RPI * i + rg) * NC + (c4 ^ (sw & 28))) = (sw & 2) ? (u32x2){hi, lo} : (u32x2){lo, hi}; }
#pragma unroll
        for (int q = 0; q < 4; ++q) { float v = am[q];
#pragma unroll
            for (int o = LPR; o < 64; o <<= 1) v = fmaxf(v, __shfl_xor(v, o));
            am[q] = v; }
        if (F.lane < LPR) *(LAS f32x4*)(PM + F.wave * NC + c4) = am;
        __syncthreads();
        if (F.tid < NC) { float m = 0.f;
#pragma unroll
            for (int w = 0; w < 8; ++w) m = fmaxf(m, PM[w * NC + F.tid]);
            PM[512 + F.tid] = m > 0.f ? 127.0f / m : 0.f; cur.SW[cur.drow + F.tid] = m * (1.0f / 127.0f); }
        __syncthreads();
        const int itn = it + F.G; const bool has_next = itn < nitems;
        if (has_next) { dec(itn, nxt);
#pragma unroll
            for (int i = 0; i < NL; ++i) regs[i] = __builtin_nontemporal_load((const f32x4*)(nxt.W + (size_t)(k0 + RPI * i + rg) * nxt.N + nxt.n0 + c4)); }
#pragma unroll 1
        for (int pass = 0; pass < NC * CH / 64; ++pass) { const int cidx = pass * 64 + F.lane, n = cidx / CH, kb = (cidx % CH) * 16; const float inv = PM[512 + n]; u32x4 o;
#pragma unroll
            for (int d = 0; d < 4; ++d) { float x[4];
#pragma unroll
                for (int e = 0; e < 4; ++e) x[e] = bf2f(scr[(kb + d * 4 + e) * NC + (n ^ (((kb >> 4) & 15) << 1))]);
                o[d] = q8x4(x[0], x[1], x[2], x[3], inv); }
            *(u32x4*)(cur.Q + (size_t)(cur.drow + n) * K + k0 + kb) = o; }
        __syncthreads();
        if (!has_next) break;
        it = itn; cur = nxt;
    }
}
struct DecDense256 { KArgs ka; unsigned char* ws;
    static constexpr int NITEMS = 144 + 64 + 34 + 64;
    __device__ __forceinline__ void operator()(int it, QItem& p) const { float* SWD = (float*)(ws + WS_SWD); int r = it;
        if (r < 144) { p.W = ka->in[I_ABWIN]; p.N = ABW; p.Q = (signed char*)(ws + WS_W_IN); p.SW = SWD + SWD_IN; }
        else if ((r -= 144) < 64) { p.W = ka->in[I_ABWOUT]; p.N = 2048; p.Q = (signed char*)(ws + WS_W_OUT); p.SW = SWD + SWD_OUT; }
        else if ((r -= 64) < 34) { p.W = ka->in[I_MDOWN]; p.N = 1088; p.Q = (signed char*)(ws + WS_W_DOWN); p.SW = SWD + SWD_DOWN; }
        else { r -= 34; p.W = ka->in[I_MWO]; p.N = 2048; p.Q = (signed char*)(ws + WS_W_O); p.SW = SWD + SWD_O; }
        p.n0 = r * 32; p.drow = p.n0; }
};
struct DecDense64 { KArgs ka; unsigned char* ws;
    static constexpr int NITEMS = 48 + 64;
    __device__ __forceinline__ void operator()(int it, QItem& p) const { float* SWD = (float*)(ws + WS_SWD); int r = it;
        if (r < 48) { p.W = ka->in[I_MUQ]; p.N = UQ_N; p.Q = (signed char*)(ws + WS_W_UQ); p.SW = SWD + SWD_UQ; }
        else { r -= 48; p.W = ka->in[I_MUKV]; p.N = UKV_N; p.Q = (signed char*)(ws + WS_W_UKV); p.SW = SWD + SWD_UKV; }
        p.n0 = r * 64; p.drow = p.n0; }
};
struct DecExpIn { KArgs ka; unsigned char* ws; int layer;
    static constexpr int NITEMS = 65 * 32;
    __device__ __forceinline__ void operator()(int it, QItem& p) const { const int e = it >> 5, m = layer * 65 + e; p.n0 = (it & 31) * 32; p.N = 1024;
        p.W = (e < 64) ? ka->in[I_EWIN] + ((size_t)layer * 64 + e) * 2048 * 1024 : ka->in[I_SWIN] + (size_t)layer * 2048 * 1024;
        p.drow = (p.n0 < 512) ? ((p.n0 >> 7) * 256 + (p.n0 & 127)) : (((p.n0 - 512) >> 7) * 256 + 128 + ((p.n0 - 512) & 127));
        p.Q = (signed char*)(ws + WS_EXP_IN + (size_t)m * EXP_IN_BYTES); p.SW = (float*)(ws + WS_SW) + (size_t)m * 1024; }
};
struct DecExpOut { KArgs ka; unsigned char* ws; int layer;
    static constexpr int NITEMS = 65 * 32;
    __device__ __forceinline__ void operator()(int it, QItem& p) const { const int e = it >> 5, m = layer * 65 + e; p.n0 = (it & 31) * 64; p.N = 2048;
        p.W = (e < 64) ? ka->in[I_EWOUT] + ((size_t)layer * 64 + e) * 512 * 2048 : ka->in[I_SWOUT] + (size_t)layer * 512 * 2048;
        p.Q = (signed char*)(ws + WS_EXP_OUT + (size_t)m * EXP_OUT_BYTES); p.SW = (float*)(ws + WS_SW2) + (size_t)m * 2048; p.drow = p.n0; }
};
__device__ __forceinline__ void side_quant_experts(Frame& F, int layer);
__device__ __forceinline__ void transpose_matrix(Frame& F, const float* W, int K, int N, bf16_t* WT, int mode, int& cursor) {
    LAS float* scr = (LAS float*)(F.lds + F.wave * 16384);
    const int nblk = N / 32, nitems = (K / 64) * nblk;
    int it = (F.gw - cursor) % F.NGW; if (it < 0) it += F.NGW;
    for (; it < nitems; it += F.NGW) { const int kb = it / nblk, nb = it % nblk, n0 = nb * 32;
        int drow = n0; if (mode == 1) drow = (n0 < 512) ? ((n0 >> 7) * 256 + (n0 & 127)) : (((n0 - 512) >> 7) * 256 + 128 + ((n0 - 512) & 127));
        transpose_item(W, K, N, WT, kb * 64, n0, drow, scr, F.lane); }
    cursor = (cursor + nitems) % F.NGW;
}

__device__ __forceinline__ void p0_prologue(Frame& F) {
    {
        LAS float* act = (LAS float*)F.lds;
        LAS float* part = (LAS float*)(F.lds + 9 * 2048 * 4);
        for (int i = F.tid; i < 9 * 2048; i += 512) { const int m = i >> 11, k = i & 2047; const float v = (m < 8) ? F.ka->in[I_C][m * 2048 + k] : F.ka->in[I_CCTX][k]; act[i] = v / (1.0f + __expf(-v)); }
        __syncthreads();
        float* MOD = (float*)(F.ws + WS_MOD);
        const int l16 = F.lane & 15, kg = (F.tid >> 4);
        for (int item = F.vcu; item < 2 * 192; item += F.G) {
            const int layer = item / 192, n0 = (item % 192) * 64;
            const float* W = F.ka->in[I_ADAW] + (size_t)layer * 2048 * 12288 + n0 + l16 * 4;
            f32x4 acc[9];
#pragma unroll
            for (int m = 0; m < 9; ++m) acc[m] = (f32x4){0.f, 0.f, 0.f, 0.f};
#pragma unroll 4
            for (int j = 0; j < 64; ++j) { const int k = kg + 32 * j; const f32x4 w = *(const f32x4*)(W + (size_t)k * 12288);
#pragma unroll
                for (int m = 0; m < 9; ++m) acc[m] += w * act[m * 2048 + k]; }
#pragma unroll
            for (int m = 0; m < 9; ++m)
#pragma unroll
                for (int q = 0; q < 4; ++q) { float v = acc[m][q]; v += __shfl_xor(v, 16); v += __shfl_xor(v, 32); acc[m][q] = v; }
            if (F.lane < 16) {
#pragma unroll
                for (int m = 0; m < 9; ++m) *(LAS f32x4*)(part + (F.wave * 9 + m) * 64 + l16 * 4) = acc[m]; }
            __syncthreads();
            for (int i = F.tid; i < 9 * 64; i += 512) { const int m = i >> 6, n = i & 63; float s = 0.f;
#pragma unroll
                for (int w = 0; w < 8; ++w) s += part[(w * 9 + m) * 64 + n];
                MOD[((size_t)layer * 9 + m) * 12288 + n0 + n] = s + F.ka->in[I_ADAB][layer * 12288 + n0 + n]; }
            __syncthreads();
        }
    }
    {
        f32x2* tab = (f32x2*)(F.ws + WS_TAB);
        for (int i = F.gw * 64 + F.lane; i < 512 + 1024 + 1024 + 2048; i += F.NGW * 64) {
            int pos, f; double inv; f32x2* dst;
            if (i < 512) { pos = i >> 4; f = i & 15; inv = (double)INV128[2 * f]; dst = tab + TAB64R / 8 + i; }
            else if (i < 1536) { const int j = i - 512; pos = j >> 4; f = j & 15; inv = (double)INV128[2 * f]; dst = tab + TAB64C / 8 + j; }
            else if (i < 2560) { const int j = i - 1536; pos = j >> 5; f = j & 31; inv = (double)INV128[f]; dst = tab + TAB128R / 8 + j; }
            else { const int j = i - 2560; pos = j >> 5; f = j & 31; inv = (double)INV128[f]; dst = tab + TAB128C / 8 + j; }
            *dst = sincos_d((double)(float)((float)pos * (float)inv));
        }
        u32x4* z = (u32x4*)(F.ws + WS_W_DOWN + (size_t)1088 * D);
        for (int i = F.gw * 64 + F.lane; i < (DOWN_N - 1088) * D / 16; i += F.NGW * 64) z[i] = (u32x4){0u, 0u, 0u, 0u};
        for (int i = F.gw * 64 + F.lane; i < DOWN_N - 1088; i += F.NGW * 64) ((float*)(F.ws + WS_SWD))[SWD_DOWN + 1088 + i] = 0.f;
    }
    {
        { DecDense256 d{F.ka, F.ws}; quant_loop<256, 32>(F, DecDense256::NITEMS, d, F.vcu); }
        __syncthreads();
        { DecDense64 d{F.ka, F.ws}; quant_loop<64, 64>(F, DecDense64::NITEMS, d, F.vcu); }
        __syncthreads();
        int cursor = 0;
        for (int l = 0; l < 2; ++l) transpose_matrix(F, F.ka->in[I_RW] + (size_t)l * 2048 * 64, 2048, 64, (bf16_t*)(F.ws + WS_ROUTER + (size_t)l * 64 * 2048 * 2), 0, cursor);
    }
}

__device__ __forceinline__ void side_quant_experts(Frame& F, int layer) {
    __syncthreads();
    const unsigned* qw = (const unsigned*)(F.ws + WS_CTL) + CW_QW + layer * 32;
    const int q0 = min((int)__hip_atomic_load(qw, RLX_AGENT), DecExpIn::NITEMS), q1 = min((int)__hip_atomic_load(qw + 16, RLX_AGENT), DecExpOut::NITEMS);
    { DecExpIn d{F.ka, F.ws, layer}; quant_loop<256, 32>(F, DecExpIn::NITEMS, d, q0 + (int)blockIdx.x); }
    __syncthreads();
    { DecExpOut d{F.ka, F.ws, layer}; quant_loop<64, 64>(F, DecExpOut::NITEMS, d, q1 + (int)blockIdx.x); }
    __syncthreads();
}
__device__ __forceinline__ void tail_quant(Frame& F, int layer, int n_in, int n_out) {
    unsigned* qw = (unsigned*)(F.ws + WS_CTL) + CW_QW + layer * 32;
    LAS int* slot = (LAS int*)(F.lds + QSLOT_OFF);
#pragma unroll 1
    for (int n = 0; n < n_in; ++n) {
        __syncthreads();
        if (F.tid == 0) *slot = (int)__hip_atomic_fetch_add(qw, 1u, RLX_AGENT);
        __syncthreads();
        const int it = *slot;
        if (it < DecExpIn::NITEMS) { DecExpIn d{F.ka, F.ws, layer}; quant_loop<256, 32>(F, it + 1, d, it); }
    }
#pragma unroll 1
    for (int n = 0; n < n_out; ++n) {
        __syncthreads();
        if (F.tid == 0) *slot = (int)__hip_atomic_fetch_add(qw + 16, 1u, RLX_AGENT);
        __syncthreads();
        const int it = *slot;
        if (it < DecExpOut::NITEMS) { DecExpOut d{F.ka, F.ws, layer}; quant_loop<64, 64>(F, it + 1, d, it); }
    }
    __syncthreads();
}
__device__ __forceinline__ bool is_tail_wg(int nunits, int G, int c) { const int mx = (nunits + G - 1) / G, mine = c < nunits ? (nunits - c + G - 1) / G : 0; return mine < mx; }
__device__ __forceinline__ const float* x_src(Frame& F, int layer, int r) {
    if (layer) return (const float*)(F.ws + WS_X) + (size_t)r * D;
    const int b = r / RPB, i = r - b * RPB;
    return (i < CTXL) ? F.ka->in[I_CTX] + ((size_t)b * CTXL + i) * D : F.ka->in[I_X] + ((size_t)b * SEQ + (i - CTXL)) * D;
}
__device__ __forceinline__ const float* mod_row(Frame& F, int layer, int r) { const int b = r / RPB, i = r - b * RPB; return (const float*)(F.ws + WS_MOD) + ((size_t)layer * 9 + ((i < CTXL) ? 8 : b)) * 12288; }

__device__ __forceinline__ void ld8f(const float* p, float (&v)[8]) { const f32x4 a = *(const f32x4*)p, b = *(const f32x4*)(p + 4); v[0] = a[0]; v[1] = a[1]; v[2] = a[2]; v[3] = a[3]; v[4] = b[0]; v[5] = b[1]; v[6] = b[2]; v[7] = b[3]; }
__device__ __forceinline__ void ld8f_nt(const float* p, float (&v)[8]) { const f32x4 a = __builtin_nontemporal_load((const f32x4*)p), b = __builtin_nontemporal_load((const f32x4*)(p + 4)); v[0] = a[0]; v[1] = a[1]; v[2] = a[2]; v[3] = a[3]; v[4] = b[0]; v[5] = b[1]; v[6] = b[2]; v[7] = b[3]; }
__device__ __forceinline__ void ld8l(const LAS float* p, float (&v)[8]) { const f32x4 a = *(const LAS f32x4*)p, b = *(const LAS f32x4*)(p + 4); v[0] = a[0]; v[1] = a[1]; v[2] = a[2]; v[3] = a[3]; v[4] = b[0]; v[5] = b[1]; v[6] = b[2]; v[7] = b[3]; }
__device__ __forceinline__ void st8f(float* p, const float (&v)[8]) { *(f32x4*)p = (f32x4){v[0], v[1], v[2], v[3]}; *(f32x4*)(p + 4) = (f32x4){v[4], v[5], v[6], v[7]}; }
__device__ __forceinline__ void unpk8(const u32x4 w, float (&v)[8]) {
#pragma unroll
    for (int e = 0; e < 4; ++e) { v[2 * e] = bflo(w[e]); v[2 * e + 1] = bfhi(w[e]); } }
__device__ __forceinline__ void unfp8(const u32x2 w, float (&v)[8]) {
#pragma unroll
    for (int d = 0; d < 2; ++d) { const f32x2 a = __builtin_amdgcn_cvt_pk_f32_fp8((int)w[d], false), b = __builtin_amdgcn_cvt_pk_f32_fp8((int)w[d], true); v[4 * d] = a.x; v[4 * d + 1] = a.y; v[4 * d + 2] = b.x; v[4 * d + 3] = b.y; } }
__device__ __forceinline__ u32x4 pk8(const float (&v)[8]) { u32x4 w;
#pragma unroll
    for (int e = 0; e < 4; ++e) w[e] = pk2(v[2 * e], v[2 * e + 1]);
    return w; }

__device__ __forceinline__ void quant_row_store(const float (&v)[4][8], signed char* dst, float* scale, int lane) {
    float am = 0.f;
#pragma unroll
    for (int j = 0; j < 4; ++j)
#pragma unroll
        for (int e = 0; e < 8; ++e) am = fmaxf(am, fabsf(v[j][e]));
#pragma unroll
    for (int o = 1; o < 64; o <<= 1) am = fmaxf(am, __shfl_xor(am, o));
    const float inv = am > 0.f ? 127.0f / am : 0.f;
    if (lane == 0) *scale = am * (1.0f / 127.0f);
#pragma unroll
    for (int j = 0; j < 4; ++j) { u32x2 w;
#pragma unroll
        for (int d = 0; d < 2; ++d) w[d] = q8x4(v[j][d * 4], v[j][d * 4 + 1], v[j][d * 4 + 2], v[j][d * 4 + 3], inv);
        *(u32x2*)(dst + 512 * j + 8 * lane) = w; }
}
__device__ __forceinline__ void quant_row512_store(const float (&v)[8], signed char* dst, float* scale, int lane) {
    float am = 0.f;
#pragma unroll
    for (int e = 0; e < 8; ++e) am = fmaxf(am, fabsf(v[e]));
#pragma unroll
    for (int o = 1; o < 64; o <<= 1) am = fmaxf(am, __shfl_xor(am, o));
    const float inv = am > 0.f ? 127.0f / am : 0.f;
    if (lane == 0) *scale = am * (1.0f / 127.0f);
    u32x2 w;
#pragma unroll
    for (int d = 0; d < 2; ++d) w[d] = q8x4(v[d * 4], v[d * 4 + 1], v[d * 4 + 2], v[d * 4 + 3], inv);
    *(u32x2*)(dst + 8 * lane) = w;
}

template <int R> __device__ __forceinline__ void p1_rows(Frame& F, int t0, int i) {
    const LAS float* PA = (const LAS float*)F.lds;
    float x[R][4][8]; int var[R];
#pragma unroll
    for (int q = 0; q < R; ++q) { const int r = t0 + i + 8 * q; const float* xs = x_src(F, 0, r); var[q] = ((r % RPB) < CTXL) ? 2 : 0;
#pragma unroll
        for (int j = 0; j < 4; ++j) ld8f_nt(xs + 512 * j + 8 * F.lane, x[q][j]); }
#pragma unroll
    for (int q = 0; q < R; ++q) { const int r = t0 + i + 8 * q;
#pragma unroll
        for (int j = 0; j < 4; ++j) { const int c = 512 * j + 8 * F.lane; float sh[8], sc[8]; ld8l(PA + var[q] * 2048 + c, sh); ld8l(PA + (var[q] + 1) * 2048 + c, sc);
#pragma unroll
            for (int e = 0; e < 8; ++e) x[q][j][e] = x[q][j][e] * (1.0f + sc[e]) + sh[e]; }
        quant_row_store(x[q], (signed char*)(F.ws + WS_H8) + (size_t)r * D, (float*)(F.ws + WS_SA) + r, F.lane); }
}
__device__ __forceinline__ void p1_modulate(Frame& F) {
    LAS float* PA = (LAS float*)F.lds;
    constexpr int BR = 72, nblk = T_ALL / BR;
    const float* MOD = (const float*)(F.ws + WS_MOD);
    for (int blk = F.vcu; blk < nblk; blk += F.G) {
        const int t0 = blk * BR, b = t0 / RPB;
        __syncthreads();
        { const int c = F.tid * 4; const float* mb = MOD + (size_t)b * 12288; const float* mc = MOD + (size_t)8 * 12288;
          *(LAS f32x4*)(PA + c) = *(const f32x4*)(mb + c); *(LAS f32x4*)(PA + 2048 + c) = *(const f32x4*)(mb + 2048 + c);
          *(LAS f32x4*)(PA + 4096 + c) = *(const f32x4*)(mc + c); *(LAS f32x4*)(PA + 6144 + c) = *(const f32x4*)(mc + 2048 + c); }
        __syncthreads();
        for (int i = F.wave; i < BR; i += 16) { if (i + 8 < BR) p1_rows<2>(F, t0, i); else p1_rows<1>(F, t0, i); }
    }
}

__device__ __forceinline__ void p_post_ab(Frame& F) {
    bf16_t* P = (bf16_t*)(F.ws + WS_PROJ);
    const f32x2* t64r = (const f32x2*)(F.ws + WS_TAB + TAB64R); const f32x2* t64c = (const f32x2*)(F.ws + WS_TAB + TAB64C);
    const f32x2* t128r = (const f32x2*)(F.ws + WS_TAB + TAB128R); const f32x2* t128c = (const f32x2*)(F.ws + WS_TAB + TAB128C);
    const float* qg = F.ka->in[I_QNG]; const float* kg = F.ka->in[I_KNG];
    for (int r = F.gw; r < T_ALL; r += F.NGW) {
        const int b = r / RPB, i = r - b * RPB; const bool lat = i >= CTXL; const int pos = i - CTXL, gr = pos >> 6, gc = pos & 63;
        bf16_t* row = P + (size_t)r * ABW;
        if (lat) {
            bf16_t* blk = row + F.lane * 32; const f32x2* tb = (F.lane & 1) ? t64c + gc * 16 : t64r + gr * 16;
            u32x4 w[4];
#pragma unroll
            for (int q = 0; q < 4; ++q) w[q] = *(const u32x4*)(blk + 8 * q);
#pragma unroll
            for (int q = 0; q < 2; ++q)
#pragma unroll
                for (int e = 0; e < 4; ++e) { const unsigned a = w[q][e], bq = w[q + 2][e]; const f32x2 c0 = tb[q * 8 + e * 2], c1 = tb[q * 8 + e * 2 + 1];
                    const float a0 = bflo(a), a1 = bfhi(a), b0 = bflo(bq), b1 = bfhi(bq);
                    w[q][e] = pk2(a0 * c0.x - b0 * c0.y, a1 * c1.x - b1 * c1.y); w[q + 2][e] = pk2(b0 * c0.x + a0 * c0.y, b1 * c1.x + a1 * c1.y); }
#pragma unroll
            for (int q = 0; q < 4; ++q) *(u32x4*)(blk + 8 * q) = w[q];
        }
#pragma unroll
        for (int pass = 0; pass < 2; ++pass) {
            const int head = pass * 8 + (F.lane >> 3), s = F.lane & 7; const bool act = head < 10;
            bf16_t* hp = row + (head < 8 ? QB_OFF + head * 128 : KB_OFF + (head - 8) * 128); const float* g = head < 8 ? qg : kg;
            float v[4][4]; float ss = 0.f;
            if (act) {
#pragma unroll
                for (int q = 0; q < 4; ++q) { const int c = (q >> 1) * 64 + (q & 1) * 32 + s * 4; const u32x2 w = *(const u32x2*)(hp + c);
                    v[q][0] = bflo(w.x); v[q][1] = bfhi(w.x); v[q][2] = bflo(w.y); v[q][3] = bfhi(w.y);
#pragma unroll
                    for (int e = 0; e < 4; ++e) ss += v[q][e] * v[q][e]; }
            }
            ss += __shfl_xor(ss, 1); ss += __shfl_xor(ss, 2); ss += __shfl_xor(ss, 4);
            if (act) {
                const float rs = 1.0f / sqrtf(ss * (1.0f / 128.0f) + 1e-6f);
#pragma unroll
                for (int q = 0; q < 4; ++q) { const int c = (q >> 1) * 64 + (q & 1) * 32 + s * 4;
#pragma unroll
                    for (int e = 0; e < 4; ++e) v[q][e] = v[q][e] * rs * g[c + e]; }
                if (lat) {
#pragma unroll
                    for (int half = 0; half < 2; ++half) { const f32x2* tb = (half ? t128c + gc * 32 : t128r + gr * 32) + s * 4;
#pragma unroll
                        for (int e = 0; e < 4; ++e) { const f32x2 cs = tb[e]; const float a = v[half * 2][e], bq = v[half * 2 + 1][e];
                            v[half * 2][e] = a * cs.x - bq * cs.y; v[half * 2 + 1][e] = bq * cs.x + a * cs.y; } }
                }
#pragma unroll
                for (int q = 0; q < 4; ++q) { const int c = (q >> 1) * 64 + (q & 1) * 32 + s * 4; u32x2 w; w.x = pk2(v[q][0], v[q][1]); w.y = pk2(v[q][2], v[q][3]); *(u32x2*)(hp + c) = w; }
            }
        }
    }
}

__device__ __forceinline__ void attn_ab_unit(Frame& F, int k) {
    const bf16_t* P = (const bf16_t*)(F.ws + WS_PROJ); bf16_t* MG = (bf16_t*)(F.ws + WS_MERGED); bf16_t* OA = (bf16_t*)(F.ws + WS_OA);
    if (k < 3) {
        const int u = (k < 2) ? F.vcu + k * F.G : 512 + F.vcu; if (k == 2 ? F.vcu >= 64 : u >= 512) return;
        int b, h, q0, nk;
        if (u < 512) { const int grp = u >> 5, w = u & 31; b = grp >> 1; h = (grp & 1) * 4 + (w >> 3); q0 = CTXL + (w & 7) * 256; nk = RPB; }
        else { const int v = u - 512; b = v >> 3; h = v & 7; q0 = 0; nk = CTXL; }
        const size_t kr = (size_t)b * RPB, qr = kr + q0; const int kvh = h >> 2;
        att::attn_unit<128, true, false>(P + qr * ABW + QB_OFF + h * 128, ABW, P + kr * ABW + KB_OFF + kvh * 128, ABW, nullptr, 0, P + kr * ABW + VB_OFF + kvh * 128, ABW,
                                         MG + qr * D + 1024 + h * 128, D, nk, 0, nullptr, nullptr, F.ldsg, F.lds, fresh_tid(F));
    } else {
        const int j = k - 3, u = (j < 4) ? F.vcu + j * F.G : 1024 + F.vcu; if (j == 4 ? F.vcu >= 128 : u >= 1024) return;
        int b, vh, q0, nk;
        if (u < 1024) { const int grp = u >> 4, w = u & 15; b = grp >> 3; vh = (grp & 7) * 2 + (w >> 3); q0 = CTXL + (w & 7) * 256; nk = RPB; }
        else { const int v = u - 1024; b = v >> 4; vh = v & 15; q0 = 0; nk = CTXL; }
        const size_t kr = (size_t)b * RPB, qr = kr + q0;
        att::attn_unit<64, true, false>(P + qr * ABW + QA_OFF + vh * 64, ABW, P + kr * ABW + KA_OFF + vh * 64, ABW, nullptr, 0, P + kr * ABW + VA_OFF + (vh >> 1) * 128, ABW,
                                        OA + qr * D + vh * 128, D, nk, 0, nullptr, nullptr, F.ldsg, F.lds, fresh_tid(F));
    }
}
__device__ __forceinline__ void p_attn_ab(Frame& F) {
    const int sk6 = min((int)blockIdx.x / 43, 5), side_k = (sk6 < 1) ? 1 : (sk6 < 2 ? 2 : sk6 + 2);
#pragma unroll 1
    for (int k = 0; k < side_k; ++k) attn_ab_unit(F, k);
    side_quant_experts(F, 0);
#pragma unroll 1
    for (int k = side_k; k < 8; ++k) attn_ab_unit(F, k);
}

__device__ __forceinline__ void p_diff_combine(Frame& F) {
    const bf16_t* OA = (const bf16_t*)(F.ws + WS_OA); const bf16_t* MG = (const bf16_t*)(F.ws + WS_MERGED);
    signed char* MG8 = (signed char*)(F.ws + WS_MG8); float* SMG = (float*)(F.ws + WS_SMG);
    const float* lp = F.ka->in[I_DLAM]; const float* sg = F.ka->in[I_SUBLN];
    const float d1 = wave_sum(lp[F.lane] * lp[64 + F.lane]), d2 = wave_sum(lp[128 + F.lane] * lp[192 + F.lane]);
    const float lam = __expf(d1) - __expf(d2) + LAM_INIT0;
    const int h = F.lane >> 3, s = F.lane & 7;
    float g[16];
#pragma unroll
    for (int e = 0; e < 16; ++e) g[e] = sg[s * 16 + e] * (1.0f - LAM_INIT0);
    for (int r = F.gw; r < T_ALL; r += F.NGW) {
        const bf16_t* o1 = OA + (size_t)r * D + (2 * h) * 128 + s * 16; const bf16_t* o2 = o1 + 128; const bf16_t* ob = MG + (size_t)r * D + 1024 + h * 128 + s * 16;
        float v[16], vb[16]; float ss = 0.f;
#pragma unroll
        for (int q = 0; q < 2; ++q) { const u32x4 a = *(const u32x4*)(o1 + 8 * q), bq = *(const u32x4*)(o2 + 8 * q), cq = *(const u32x4*)(ob + 8 * q);
#pragma unroll
            for (int e = 0; e < 4; ++e) { v[q * 8 + 2 * e] = bflo(a[e]) - lam * bflo(bq[e]); v[q * 8 + 2 * e + 1] = bfhi(a[e]) - lam * bfhi(bq[e]); vb[q * 8 + 2 * e] = bflo(cq[e]); vb[q * 8 + 2 * e + 1] = bfhi(cq[e]); } }
#pragma unroll
        for (int e = 0; e < 16; ++e) ss += v[e] * v[e];
        ss += __shfl_xor(ss, 1); ss += __shfl_xor(ss, 2); ss += __shfl_xor(ss, 4);
        const float rs = 1.0f / sqrtf(ss * (1.0f / 128.0f) + 1e-5f);
        float am = 0.f;
#pragma unroll
        for (int e = 0; e < 16; ++e) { v[e] = v[e] * rs * g[e]; am = fmaxf(am, fmaxf(fabsf(v[e]), fabsf(vb[e]))); }
#pragma unroll
        for (int o = 1; o < 64; o <<= 1) am = fmaxf(am, __shfl_xor(am, o));
        const float inv = am > 0.f ? 127.0f / am : 0.f;
        if (F.lane == 0) SMG[r] = am * (1.0f / 127.0f);
        u32x4 wa, wb;
#pragma unroll
        for (int d = 0; d < 4; ++d) { wa[d] = q8x4(v[d * 4], v[d * 4 + 1], v[d * 4 + 2], v[d * 4 + 3], inv); wb[d] = q8x4(vb[d * 4], vb[d * 4 + 1], vb[d * 4 + 2], vb[d * 4 + 3], inv); }
        *(u32x4*)(MG8 + (size_t)r * D + h * 128 + s * 16) = wa; *(u32x4*)(MG8 + (size_t)r * D + 1024 + h * 128 + s * 16) = wb;
    }
}

__device__ __forceinline__ void p_quant_merged(Frame& F) {
    const bf16_t* MG = (const bf16_t*)(F.ws + WS_MERGED);
    for (int t = F.gw; t < T_LAT; t += F.NGW) { const int r = tok_row(1, t); float v[4][8];
#pragma unroll
        for (int j = 0; j < 4; ++j) unpk8(*(const u32x4*)(MG + (size_t)r * D + 512 * j + 8 * F.lane), v[j]);
        quant_row_store(v, (signed char*)(F.ws + WS_MG8) + (size_t)r * D, (float*)(F.ws + WS_SMG) + r, F.lane); }
}

__device__ __forceinline__ void p_post_down(Frame& F) {
    const bf16_t* DN = (const bf16_t*)(F.ws + WS_DOWN); bf16_t* KPE = (bf16_t*)(F.ws + WS_KPE);
    const f32x2* t64r = (const f32x2*)(F.ws + WS_TAB + TAB64R); const f32x2* t64c = (const f32x2*)(F.ws + WS_TAB + TAB64C);
    const float* qg = F.ka->in[I_MQNG]; const float* kvg = F.ka->in[I_MKVNG];
    for (int r = F.gw; r < T_ALL; r += F.NGW) {
        const int b = r / RPB, i = r - b * RPB; const bool lat = i >= CTXL; const int pos = i - CTXL, gr = pos >> 6, gc = pos & 63;
        const bf16_t* row = DN + (size_t)r * DOWN_N;
#pragma unroll
        for (int which = 0; which < 2; ++which) {
            const u32x4 w = *(const u32x4*)(row + which * 512 + F.lane * 8); float v[8];
#pragma unroll
            for (int e = 0; e < 4; ++e) { v[2 * e] = bflo(w[e]); v[2 * e + 1] = bfhi(w[e]); }
            float ss = 0.f;
#pragma unroll
            for (int e = 0; e < 8; ++e) ss += v[e] * v[e];
            ss = wave_sum(ss); const float rs = 1.0f / sqrtf(ss * (1.0f / 512.0f) + 1e-6f); const float* g = (which ? kvg : qg) + F.lane * 8;
#pragma unroll
            for (int e = 0; e < 8; ++e) v[e] = v[e] * rs * g[e];
            quant_row512_store(v, (signed char*)(F.ws + (which ? WS_CKVN : WS_CQN)) + (size_t)r * 512, (float*)(F.ws + (which ? WS_SCKV : WS_SCQ)) + r, F.lane);
        }
        if (F.lane < 32) {
            const int blk = F.lane >> 4, f = F.lane & 15; const float a = bf2f(row[1024 + blk * 32 + f]), bq = bf2f(row[1024 + blk * 32 + 16 + f]);
            float oa = a, ob = bq;
            if (lat) { const f32x2 cs = blk ? t64c[gc * 16 + f] : t64r[gr * 16 + f]; oa = a * cs.x - bq * cs.y; ob = bq * cs.x + a * cs.y; }
            KPE[(size_t)r * 64 + blk * 32 + f] = (bf16_t)f2bf(oa); KPE[(size_t)r * 64 + blk * 32 + 16 + f] = (bf16_t)f2bf(ob);
        }
    }
}

__device__ __forceinline__ void attn_mla_unit(Frame& F, int u) {
    const bf16_t* QM = (const bf16_t*)(F.ws + WS_QM); const bf16_t* KVM = (const bf16_t*)(F.ws + WS_KVM); const bf16_t* KPE = (const bf16_t*)(F.ws + WS_KPE); bf16_t* MG = (bf16_t*)(F.ws + WS_MERGED);
    const f32x2* t64r = (const f32x2*)(F.ws + WS_TAB + TAB64R); const f32x2* t64c = (const f32x2*)(F.ws + WS_TAB + TAB64C);
    const int grp = u >> 3, b = grp >> 4, h = grp & 15, qb = u & 7; const size_t kr = (size_t)b * RPB, qr = kr + CTXL + qb * 256;
    att::attn_unit<192, true, true>(QM + qr * UQ_N + h * 192, UQ_N, KVM + kr * UKV_N + h * 256, UKV_N, KPE + kr * 64, 64, KVM + kr * UKV_N + h * 256 + 128, UKV_N,
                                    MG + qr * D + h * 128, D, RPB, qb * 256, t64r, t64c, F.ldsg, F.lds, fresh_tid(F));
}
__device__ __forceinline__ void p_attn_mla(Frame& F) {
    const int side_n = min((int)blockIdx.x / 64, 3) + 1; int u = F.vcu, n = 0;
#pragma unroll 1
    for (; u < 1024 && n < side_n; u += F.G, ++n) attn_mla_unit(F, u);
    side_quant_experts(F, 1);
#pragma unroll 1
    for (; u < 1024; u += F.G) attn_mla_unit(F, u);
}

template <int R> __device__ __forceinline__ void ln1_rows(Frame& F, int layer, int t0, int i) {
    const LAS float* PA = (const LAS float*)F.lds;
    const unsigned char* Y1 = (const unsigned char*)(F.ws + WS_Y1); bf16_t* XB = (bf16_t*)(F.ws + WS_X); bf16_t* H = (bf16_t*)(F.ws + WS_H);
    float v[R][4][8]; u32x2 yw[R][4]; int var[R], rr[R];
#pragma unroll
    for (int q = 0; q < R; ++q) { const int r = tok_row(layer, t0 + i + 8 * q); rr[q] = r; const float* xs = x_src(F, 0, r); var[q] = (layer == 0 && (r % RPB) < CTXL) ? 3 : 0;
#pragma unroll
        for (int j = 0; j < 4; ++j) { if (layer == 0) ld8f_nt(xs + 512 * j + 8 * F.lane, v[q][j]); else unpk8(*(const u32x4*)(XB + (size_t)r * D + 512 * j + 8 * F.lane), v[q][j]); yw[q][j] = __builtin_nontemporal_load((const u32x2*)(Y1 + (size_t)r * D + 512 * j + 8 * F.lane)); } }
#pragma unroll
    for (int q = 0; q < R; ++q) {
        float s = 0.f;
#pragma unroll
        for (int j = 0; j < 4; ++j) { const int c = 512 * j + 8 * F.lane; float g1[8], y[8]; ld8l(PA + (2 + var[q]) * 2048 + c, g1); unfp8(yw[q][j], y);
#pragma unroll
            for (int e = 0; e < 8; ++e) { v[q][j][e] = v[q][j][e] * ALPHA + g1[e] * y[e]; s += v[q][j][e]; } }
        const float mean = wave_sum(s) * (1.0f / D); float s2 = 0.f;
#pragma unroll
        for (int j = 0; j < 4; ++j)
#pragma unroll
            for (int e = 0; e < 8; ++e) { v[q][j][e] -= mean; s2 += v[q][j][e] * v[q][j][e]; }
        const float rstd = 1.0f / sqrtf(wave_sum(s2) * (1.0f / D) + 1e-5f);
#pragma unroll
        for (int j = 0; j < 4; ++j) { const int c = 512 * j + 8 * F.lane; float a[8], bq[8], xo[8], h[8];
            ld8l(PA + c, a); ld8l(PA + 2048 + c, bq);
#pragma unroll
            for (int e = 0; e < 8; ++e) xo[e] = v[q][j][e] * rstd * a[e] + bq[e];
            *(u32x4*)(XB + (size_t)rr[q] * D + c) = pk8(xo);
            ld8l(PA + (3 + var[q]) * 2048 + c, a); ld8l(PA + (4 + var[q]) * 2048 + c, bq);
#pragma unroll
            for (int e = 0; e < 8; ++e) { h[e] = v[q][j][e] * rstd * a[e] + bq[e]; v[q][j][e] = h[e]; }
            *(u32x4*)(H + (size_t)rr[q] * D + c) = pk8(h); }
        quant_row_store(v[q], (signed char*)(F.ws + WS_H8) + (size_t)rr[q] * D, (float*)(F.ws + WS_SA) + rr[q], F.lane);
    }
}
__device__ __forceinline__ void p_ln1(Frame& F, int layer) {
    LAS float* PA = (LAS float*)F.lds;
    const int NT = layer ? T_LAT : T_ALL, BR = layer ? 64 : 72, nblk = NT / BR, rpb = layer ? SEQ : RPB;
    const float* lg = F.ka->in[I_LNMG] + layer * D; const float* lb = F.ka->in[I_LNMB] + layer * D; const float* MOD = (const float*)(F.ws + WS_MOD) + (size_t)layer * 9 * 12288;
    for (int blk = F.vcu; blk < nblk; blk += F.G) {
        const int t0 = blk * BR, b = t0 / rpb;
        __syncthreads();
        { const int c = F.tid * 4; const f32x4 g = *(const f32x4*)(lg + c), bb = *(const f32x4*)(lb + c);
          *(LAS f32x4*)(PA + c) = g; *(LAS f32x4*)(PA + 2048 + c) = bb;
#pragma unroll
          for (int vv = 0; vv < 2; ++vv) { const float* m = MOD + (size_t)(vv ? 8 : b) * 12288; const f32x4 g1 = *(const f32x4*)(m + 2 * 2048 + c), sh2 = *(const f32x4*)(m + 3 * 2048 + c), sc2 = *(const f32x4*)(m + 4 * 2048 + c);
              *(LAS f32x4*)(PA + (2 + 3 * vv) * 2048 + c) = g1; *(LAS f32x4*)(PA + (3 + 3 * vv) * 2048 + c) = g * (1.0f + sc2); *(LAS f32x4*)(PA + (4 + 3 * vv) * 2048 + c) = bb * (1.0f + sc2) + sh2; } }
        __syncthreads();
        for (int i = F.wave; i < BR; i += 16) { if (i + 8 < BR) ln1_rows<2>(F, layer, t0, i); else ln1_rows<1>(F, layer, t0, i); }
    }
}

__device__ __forceinline__ void p_router(Frame& F, int layer) {
    const int NT = layer ? T_LAT : T_ALL, ngroups = NT / 32;
    const bf16_t* H = (const bf16_t*)(F.ws + WS_H); const bf16_t* RT = (const bf16_t*)(F.ws + WS_ROUTER + (size_t)layer * 64 * 2048 * 2);
    const float* rb = F.ka->in[I_RB] + layer * 64;
    int* LIST = (int*)(F.ws + WS_LIST); int* TS = (int*)(F.ws + WS_TOKSLOT); float* GATE = (float*)(F.ws + WS_GATE);
    unsigned* CNT = F.ctl + CW_CNT + layer * 64 * 16;
    LAS float* part = (LAS float*)F.lds;
    LAS float* SC = (LAS float*)(F.lds + 65536);
    LAS float* BS = (LAS float*)(F.lds + 65536 + 8448);
    LAS int* hist = (LAS int*)(F.lds + 65536 + 2 * 8448);
    LAS int* base = hist + 64;
    LAS int* SEL = base + 64;
    const int r32 = F.lane & 31, hi = F.lane >> 5;
    if (F.tid < 64) hist[F.tid] = 0;
    __syncthreads();
    int gi = 0;
    for (int g = F.vcu; g < ngroups; g += F.G, ++gi) {
        const int t0 = g * 32;
        {
            const bf16_t* ap = H + (size_t)tok_row(layer, t0 + r32) * D + F.wave * 256 + hi * 8;
            const bf16_t* b0p = RT + (size_t)r32 * D + F.wave * 256 + hi * 8; const bf16_t* b1p = b0p + (size_t)32 * D;
            f32x16 a0 = {}, a1 = {};
#pragma unroll
            for (int k = 0; k < 16; ++k) { const bf16x8 a = *(const bf16x8*)(ap + k * 16), w0 = *(const bf16x8*)(b0p + k * 16), w1 = *(const bf16x8*)(b1p + k * 16);
                a0 = __builtin_amdgcn_mfma_f32_32x32x16_bf16(a, w0, a0, 0, 0, 0); a1 = __builtin_amdgcn_mfma_f32_32x32x16_bf16(a, w1, a1, 0, 0, 0); }
#pragma unroll
            for (int r = 0; r < 16; ++r) { const int row = att::crow(r, hi); part[(F.wave * 32 + row) * 64 + r32] = a0[r]; part[(F.wave * 32 + row) * 64 + 32 + r32] = a1[r]; }
        }
        __syncthreads();
        for (int i = F.tid; i < 2048; i += 512) { float s = 0.f;
#pragma unroll
            for (int w = 0; w < 8; ++w) s += part[w * 2048 + i];
            const float sg = 1.0f / (1.0f + __expf(-s)); const int tk = i >> 6, e = i & 63; SC[tk * 65 + e] = sg; BS[tk * 65 + e] = sg + rb[e]; }
        __syncthreads();
        if (F.tid < 32) {
            const LAS float* bs = BS + F.tid * 65; const LAS float* sc = SC + F.tid * 65;
            float bv[64];
#pragma unroll
            for (int e = 0; e < 64; ++e) bv[e] = bs[e];
            float gs[8];
#pragma unroll
            for (int gq = 0; gq < 8; ++gq) { float m1 = -INFINITY, m2 = -INFINITY;
#pragma unroll
                for (int j = 0; j < 8; ++j) { const float v = bv[gq * 8 + j]; const float lo = fminf(v, m1); m1 = fmaxf(v, m1); m2 = fmaxf(m2, lo); }
                gs[gq] = m1 + m2; }
            unsigned gmask = 0u;
#pragma unroll
            for (int it = 0; it < 4; ++it) { float best = -INFINITY; int bi = 0;
#pragma unroll
                for (int gq = 0; gq < 8; ++gq) { const bool ok = !((gmask >> gq) & 1u) && gs[gq] > best; best = ok ? gs[gq] : best; bi = ok ? gq : bi; }
                gmask |= 1u << bi; }
#pragma unroll
            for (int e = 0; e < 64; ++e) bv[e] = ((gmask >> (e >> 3)) & 1u) ? bv[e] : -INFINITY;
            int sel[8]; float gv[8]; float gsum = 0.f;
#pragma unroll
            for (int k = 0; k < 8; ++k) { float best = -INFINITY; int be = 0;
#pragma unroll
                for (int e = 0; e < 64; ++e) { const bool ok = bv[e] > best; best = ok ? bv[e] : best; be = ok ? e : be; }
#pragma unroll
                for (int e = 0; e < 64; ++e) bv[e] = (e == be) ? -INFINITY : bv[e];
                sel[k] = be; gv[k] = sc[be]; gsum += gv[k]; }
            const int r = tok_row(layer, t0 + F.tid); const float inv = 2.5f / gsum;
#pragma unroll
            for (int k = 0; k < 8; ++k) { const int lp = atomicAdd((int*)(hist + sel[k]), 1); SEL[((gi & 3) * 32 + F.tid) * 8 + k] = (sel[k] << 16) | lp; GATE[(size_t)r * 8 + k] = gv[k] * inv; }
        }
        __syncthreads();
    }
    if (F.tid < 64) base[F.tid] = (int)__hip_atomic_fetch_add(CNT + F.tid * 16, (unsigned)hist[F.tid], RLX_AGENT);
    __syncthreads();
    gi = 0;
    for (int g = F.vcu; g < ngroups; g += F.G, ++gi) {
        if (F.tid < 256) { const int tk = F.tid >> 3, k = F.tid & 7; const int v = SEL[((gi & 3) * 32 + tk) * 8 + k], e = v >> 16, pos = base[e] + (v & 0xffff); const int r = tok_row(layer, g * 32 + tk);
            LIST[(size_t)e * LIST_CAP + pos] = r; TS[(size_t)r * 8 + k] = (e << 16) | pos; }
    }
    __syncthreads();
}

__device__ __forceinline__ int moe_tables(Frame& F, int layer) {
    LAS int* MISC = (LAS int*)(F.lds + MISC_OFF); LAS int* TT = (LAS int*)(F.lds + TTAB_OFF);
    const int NT = layer ? T_LAT : T_ALL;
    __syncthreads();
    if (F.wave == 0) {
        const unsigned* CNT = F.ctl + CW_CNT + layer * 64 * 16;
        const int c = (int)__hip_atomic_load(CNT + F.lane * 16, RLX_AGENT); const int nt = (c + 255) >> 8;
        int inc = nt;
#pragma unroll
        for (int o = 1; o < 64; o <<= 1) { const int v = __shfl_up(inc, o); if (F.lane >= o) inc += v; }
        const int start = inc - nt; MISC[F.lane] = start; MISC[80 + F.lane] = c;
        if (F.lane == 63) { MISC[64] = inc; MISC[65] = inc + NT / 256; }
    }
    __syncthreads();
    const int s64 = MISC[64], total = MISC[65];
    for (int tile = F.tid; tile < total; tile += 512) {
        int lo = 0, hi = 64;
#pragma unroll
        for (int it = 0; it < 7; ++it) { const int mid = (lo + hi + 1) >> 1; const bool ok = MISC[mid] <= tile; lo = ok ? mid : lo; hi = ok ? hi : mid - 1; }
        TT[tile] = (lo << 16) | (tile - MISC[lo]); }
    (void)s64;
    __syncthreads();
    return total;
}

__device__ __forceinline__ void p_moe_gemm1(Frame& F, int layer) {
    const int total = moe_tables(F, layer);
    LAS int* MISC = (LAS int*)(F.lds + MISC_OFF); LAS int* TT = (LAS int*)(F.lds + TTAB_OFF); LAS int* IDX = (LAS int*)(F.lds + IDXC_OFF);
    const int* LIST = (const int*)(F.ws + WS_LIST);
    typedef pg8::SchedMoe<4, EXP_IN_BYTES, (size_t)256 * D> Sch; Sch S; S.ntiles = total; S.G = F.G; S.vcu = F.vcu; S.ttab = TT; S.Bt = (const char*)(F.ws + WS_EXP_IN + (size_t)layer * 65 * EXP_IN_BYTES);
    {
        pg8::Unit u; const int fallback = tok_row(layer, 0);
        for (int i = 0; i < IDXC_UNITS && S.next(i, u); ++i) {
            if (F.tid < 256) { const int tile = u.row0 >> 8, tv = TT[tile], e = tv >> 16, p = (tv & 0xffff) * 256 + F.tid;
                int src; if (e < 64) src = (p < MISC[80 + e]) ? LIST[(size_t)e * LIST_CAP + p] : fallback; else src = tok_row(layer, p);
                IDX[i * 256 + F.tid] = src; }
        }
        __syncthreads();
    }
    pg8::EpiSwigluI8 E{(unsigned char*)(F.ws + WS_HMID), FDIM, (const float*)(F.ws + WS_SA), (const float*)(F.ws + WS_SW) + (size_t)layer * 65 * 1024, IDX};
    pg8::gemm_phase<pg8::EpiSwigluI8, Sch, true, true>(F.lds, (const void*)(F.ws + WS_H8), D, S, E, IDX, fresh_tid(F));
    if (layer == 0 && is_tail_wg(total * 4, F.G, F.vcu)) tail_quant(F, 1, 1, 1);
}
__device__ __forceinline__ void p_quant_hmid(Frame& F, int layer) {
    const int total = moe_tables(F, layer), nrows = total * 256;
    const unsigned char* HM = (const unsigned char*)(F.ws + WS_HMID); signed char* HM8 = (signed char*)(F.ws + WS_HM8); float* SHM = (float*)(F.ws + WS_SHM);
    for (int r0 = F.gw * 4; r0 < nrows; r0 += F.NGW * 4) {
        u32x2 w[4];
#pragma unroll
        for (int q = 0; q < 4; ++q) w[q] = *(const u32x2*)(HM + (size_t)(r0 + q) * FDIM + 8 * F.lane);
#pragma unroll
        for (int q = 0; q < 4; ++q) { float v[8]; unfp8(w[q], v); quant_row512_store(v, HM8 + (size_t)(r0 + q) * FDIM, SHM + r0 + q, F.lane); }
    }
}
__device__ __forceinline__ void p_moe_gemm2(Frame& F, int layer) {
    const int total = moe_tables(F, layer);
    LAS int* TT = (LAS int*)(F.lds + TTAB_OFF);
    typedef pg8::SchedMoe<8, EXP_OUT_BYTES, (size_t)256 * FDIM> Sch; Sch S; S.ntiles = total; S.G = F.G; S.vcu = F.vcu; S.ttab = TT; S.Bt = (const char*)(F.ws + WS_EXP_OUT + (size_t)layer * 65 * EXP_OUT_BYTES);
    pg8::EpiI8Fp8<2048> E{(unsigned char*)(F.ws + WS_Y2P), D, (const float*)(F.ws + WS_SHM), (const float*)(F.ws + WS_SW2) + (size_t)layer * 65 * 2048};
    pg8::gemm_phase<pg8::EpiI8Fp8<2048>, Sch, false, true>(F.lds, (const void*)(F.ws + WS_HM8), FDIM, S, E, nullptr, fresh_tid(F));
}

__device__ __forceinline__ void p_combine_ln2(Frame& F, int layer) {
    (void)moe_tables(F, layer);
    LAS int* MISC = (LAS int*)(F.lds + MISC_OFF); LAS float* PA = (LAS float*)F.lds;
    const int NT = layer ? T_LAT : T_ALL, BR = layer ? 64 : 72, nblk = NT / BR, rpb = layer ? SEQ : RPB;
    const unsigned char* Y2 = (const unsigned char*)(F.ws + WS_Y2P);     const int* TS = (const int*)(F.ws + WS_TOKSLOT); const float* GATE = (const float*)(F.ws + WS_GATE);
    bf16_t* XB = (bf16_t*)(F.ws + WS_X); float* OUT = F.ka->out;
    const int sh0 = MISC[64] * 256;
    for (int blk = F.vcu; blk < nblk; blk += F.G) {
        const int t0 = blk * BR, b = t0 / rpb;
        __syncthreads();
        { int z = 0; asm volatile("" : "+s"(z));
          const float* lg = F.ka->in[I_LNFG + z] + layer * D; const float* lb = F.ka->in[I_LNFB + z] + layer * D; const float* MOD = (const float*)(F.ka->ws + WS_MOD) + z;
          const int c = fresh_tid(F) * 4; const f32x4 g = *(const f32x4*)(lg + c), bb = *(const f32x4*)(lb + c);
          *(LAS f32x4*)(PA + c) = g; *(LAS f32x4*)(PA + 2048 + c) = bb;
#pragma unroll
          for (int vv = 0; vv < 2; ++vv) { const float* m = MOD + ((size_t)layer * 9 + (vv ? 8 : b)) * 12288; const float* m1 = MOD + ((size_t)9 + (vv ? 8 : b)) * 12288;
              const f32x4 g2 = *(const f32x4*)(m + 5 * 2048 + c), sh1 = *(const f32x4*)(m1 + c), sc1 = *(const f32x4*)(m1 + 2048 + c);
              *(LAS f32x4*)(PA + (2 + 3 * vv) * 2048 + c) = g2; *(LAS f32x4*)(PA + (3 + 3 * vv) * 2048 + c) = g * (1.0f + sc1); *(LAS f32x4*)(PA + (4 + 3 * vv) * 2048 + c) = bb * (1.0f + sc1) + sh1; } }
        __syncthreads();
        int r = tok_row(layer, t0 + F.wave); int tsv = 0; float gtv = 0.f;
        { const int l0 = fresh_lane(); if (l0 < 8) { tsv = TS[(size_t)r * 8 + l0]; gtv = GATE[(size_t)r * 8 + l0]; } }
        for (int i = F.wave; i < BR; i += 8) {
            const int t = t0 + i, var = (layer == 0 && (r % RPB) < CTXL) ? 3 : 0;
            const int ln = fresh_lane();
            float xv[4][8]; float y[4][8]; const int tsc = tsv; const int gtc = __builtin_bit_cast(int, gtv);
#define YROW(k) (Y2 + (size_t)(__builtin_amdgcn_readfirstlane(MISC[__builtin_amdgcn_readlane(tsc, (k)) >> 16]) * 256 + (__builtin_amdgcn_readlane(tsc, (k)) & 0xffff)) * D)
#define GK(k) __builtin_bit_cast(float, __builtin_amdgcn_readlane(gtc, (k)))
            const int rcur = r;
            {
                u32x2 yw[5][4];
#pragma unroll
                for (int k = 0; k < 4; ++k)
#pragma unroll
                    for (int j = 0; j < 4; ++j) yw[k][j] = __builtin_nontemporal_load((const u32x2*)(YROW(k) + 8 * ln + 512 * j));
                { const unsigned char* yr = Y2 + (size_t)(sh0 + t) * D + 8 * ln;
#pragma unroll
                  for (int j = 0; j < 4; ++j) yw[4][j] = __builtin_nontemporal_load((const u32x2*)(yr + 512 * j)); }
                if (i + 8 < BR) { r = tok_row(layer, t + 8); if (ln < 8) { tsv = TS[(size_t)r * 8 + ln]; gtv = GATE[(size_t)r * 8 + ln]; } }
#pragma unroll
                for (int j = 0; j < 4; ++j) { float tmp[8]; unfp8(yw[4][j], y[j]);
#pragma unroll
                    for (int k = 0; k < 4; ++k) { unfp8(yw[k][j], tmp);
#pragma unroll
                        for (int e = 0; e < 8; ++e) y[j][e] += GK(k) * tmp[e]; } }
            }
            asm volatile("" ::: "memory");
            {
                u32x2 yw[4][4];
#pragma unroll
                for (int k = 0; k < 4; ++k)
#pragma unroll
                    for (int j = 0; j < 4; ++j) yw[k][j] = __builtin_nontemporal_load((const u32x2*)(YROW(4 + k) + 8 * ln + 512 * j));
#pragma unroll
                for (int j = 0; j < 4; ++j) unpk8(*(const u32x4*)(XB + (size_t)rcur * D + 512 * j + 8 * ln), xv[j]);
#pragma unroll
                for (int j = 0; j < 4; ++j) { float tmp[8];
#pragma unroll
                    for (int k = 0; k < 4; ++k) { unfp8(yw[k][j], tmp);
#pragma unroll
                        for (int e = 0; e < 8; ++e) y[j][e] += GK(4 + k) * tmp[e]; } }
            }
#undef YROW
#undef GK
            float s = 0.f;
#pragma unroll
            for (int j = 0; j < 4; ++j) { const int c = 512 * j + 8 * ln; float g2[8];
                ld8l(PA + (2 + var) * 2048 + c, g2);
#pragma unroll
                for (int e = 0; e < 8; ++e) { xv[j][e] = xv[j][e] * ALPHA + g2[e] * y[j][e]; s += xv[j][e]; } }
            const float mean = wave_sum(s) * (1.0f / D); float s2 = 0.f;
#pragma unroll
            for (int j = 0; j < 4; ++j)
#pragma unroll
                for (int e = 0; e < 8; ++e) { xv[j][e] -= mean; s2 += xv[j][e] * xv[j][e]; }
            const float rstd = 1.0f / sqrtf(wave_sum(s2) * (1.0f / D) + 1e-5f);
#pragma unroll
            for (int j = 0; j < 4; ++j) { const int c = 512 * j + 8 * ln; float a[8], bq[8], xo[8];
                ld8l(PA + c, a); ld8l(PA + 2048 + c, bq);
#pragma unroll
                for (int e = 0; e < 8; ++e) xo[e] = xv[j][e] * rstd * a[e] + bq[e];
                if (layer == 0) { *(u32x4*)(XB + (size_t)rcur * D + c) = pk8(xo); ld8l(PA + (3 + var) * 2048 + c, a); ld8l(PA + (4 + var) * 2048 + c, bq);
#pragma unroll
                    for (int e = 0; e < 8; ++e) xv[j][e] = xv[j][e] * rstd * a[e] + bq[e]; }
                else st8f(OUT + (size_t)t * D + c, xo); }
            if (layer == 0) quant_row_store(xv, (signed char*)(F.ws + WS_H8) + (size_t)rcur * D, (float*)(F.ws + WS_SA) + rcur, ln);
        }
    }
}

__device__ __forceinline__ void p_dense(Frame& F, const bf16_t* A, const bf16_t* Bt, int K, int nM, int nN, int latmap, bf16_t* O, int ldc) {
    pg8::SchedDense S; S.init(nM, nN, F.G, (int)blockIdx.x, latmap, Bt, K);
    pg8::EpiBf16 E{O, ldc};
    pg8::gemm_phase<pg8::EpiBf16, pg8::SchedDense, false>(F.lds, A, K, S, E, nullptr, F.tid);
}
__device__ __forceinline__ void p_dense_i8_fp8(Frame& F, const void* A, const float* SA, const void* Bt, const float* SW, int K, int nM, int nN, int latmap, unsigned char* O, int ldc) {
    pg8::SchedDense S; S.init(nM, nN, F.G, (int)blockIdx.x, latmap, (const bf16_t*)Bt, K); S.tstepB = (size_t)256 * K;
    pg8::EpiI8Fp8<0> E{O, ldc, SA, SW};
    pg8::gemm_phase<pg8::EpiI8Fp8<0>, pg8::SchedDense, false, true>(F.lds, A, K, S, E, nullptr, fresh_tid(F));
}
__device__ __forceinline__ void p_dense_i8(Frame& F, const void* A, const float* SA, const void* Bt, const float* SW, int K, int nM, int nN, int latmap, bf16_t* O, int ldc) {
    pg8::SchedDense S; S.init(nM, nN, F.G, (int)blockIdx.x, latmap, (const bf16_t*)Bt, K); S.tstepB = (size_t)256 * K;
    pg8::EpiI8Bf16<0> E{O, ldc, SA, SW};
    pg8::gemm_phase<pg8::EpiI8Bf16<0>, pg8::SchedDense, false, true>(F.lds, A, K, S, E, nullptr, fresh_tid(F));
}

constexpr int N_PHASES = 26;

__global__ void __launch_bounds__(512, 2) mk_fwd(Args args) {
    extern __shared__ __attribute__((aligned(16))) unsigned char lds_raw[];
    Frame F;
    F.lds = (LAS unsigned char*)lds_raw; F.ldsg = (char*)lds_raw;
    F.tid = threadIdx.x; F.lane = F.tid & 63; F.wave = __builtin_amdgcn_readfirstlane(F.tid >> 6);
    F.G = gridDim.x; { const int bx = blockIdx.x; F.vcu = (F.G % 8 == 0) ? (bx % 8) * (F.G / 8) + bx / 8 : bx; }
    F.gw = F.vcu * 8 + F.wave; F.NGW = F.G * 8;
    F.ka = (KArgs)__builtin_amdgcn_kernarg_segment_ptr();
    F.ws = F.ka->ws; F.ctl = (unsigned*)F.ws;
    const int lo = args.ph_lo, hi = args.ph_hi;
    volatile LAS unsigned* bw = (volatile LAS unsigned*)(F.lds + BARW_OFF);
    if (F.tid < 4) bw[F.tid] = 0u;
    __syncthreads();
    XcdBarrier bar; bar.bar = F.ctl + CW_BAR; bar.x = 0; bar.st = bw;
    if (hi - lo > 1) bar = xcd_barrier_post(F.ctl + CW_BAR, bw);
#ifndef MK_ONLY
#define MK_ONLY -1
#endif
#ifndef MK_REPMASK
#define MK_REPMASK 0u
#endif
#define IN(k) ((MK_ONLY < 0 || MK_ONLY == (k)) && lo <= (k) && (k) < hi)
#define NREP(k) ((int)(((unsigned)MK_REPMASK >> (k)) & 1u) + 1)
#define SEAM(k) do { if (lo <= (k) && (k) + 1 < hi) xcd_barrier(bar); } while (0)

    if (IN(0)) for (int rep = 0; rep < NREP(0); ++rep) { PHASE_BEGIN(F); p0_prologue(P); } SEAM(0);
    if (IN(1)) for (int rep = 0; rep < NREP(1); ++rep) { PHASE_BEGIN(F); p1_modulate(P); } SEAM(1);
#if defined(MK_UNROLL_LAYERS)
#pragma unroll
#else
#pragma unroll 1
#endif
    for (int layer = 0; layer < 2; ++layer) {
        const int pb = 2 + 12 * layer;
        if (IN(pb + 0)) for (int rep = 0; rep < NREP(pb + 0); ++rep) { PHASE_BEGIN(F);
            p_dense_i8(P, P.ws + WS_H8, (const float*)(P.ws + WS_SA), P.ws + (layer == 0 ? WS_W_IN : WS_W_DOWN), (const float*)(P.ws + WS_SWD) + (layer == 0 ? SWD_IN : SWD_DOWN), D, T_ALL / 256, layer == 0 ? ABW / 256 : DOWN_N / 256, 0,
                       (bf16_t*)(P.ws + (layer == 0 ? WS_PROJ : WS_DOWN)), layer == 0 ? ABW : DOWN_N);
            if (is_tail_wg((T_ALL / 256) * (layer == 0 ? ABW / 256 : DOWN_N / 256), P.G, (int)blockIdx.x)) tail_quant(P, layer, 1, layer == 0 ? 1 : 2);
        } SEAM(pb + 0);
        if (IN(pb + 1)) for (int rep = 0; rep < NREP(pb + 1); ++rep) { PHASE_BEGIN(F); if (layer == 0) p_post_ab(P); else p_post_down(P); } SEAM(pb + 1);
        if (IN(pb + 2)) for (int rep = 0; rep < NREP(pb + 2); ++rep) { PHASE_BEGIN(F);
            if (layer == 0) p_attn_ab(P);
            else {
#pragma unroll 1
                for (int w = 0; w < 2; ++w) {
                    p_dense_i8(P, P.ws + (w == 0 ? WS_CQN : WS_CKVN), (const float*)(P.ws + (w == 0 ? WS_SCQ : WS_SCKV)), P.ws + (w == 0 ? WS_W_UQ : WS_W_UKV), (const float*)(P.ws + WS_SWD) + (w == 0 ? SWD_UQ : SWD_UKV), 512,
                               w == 0 ? T_LAT / 256 : T_ALL / 256, w == 0 ? UQ_N / 256 : UKV_N / 256, w == 0 ? 1 : 0, (bf16_t*)(P.ws + (w == 0 ? WS_QM : WS_KVM)), w == 0 ? UQ_N : UKV_N); }
            }
        } SEAM(pb + 2);
        if (IN(pb + 3)) for (int rep = 0; rep < NREP(pb + 3); ++rep) { PHASE_BEGIN(F); if (layer == 0) p_diff_combine(P); else p_attn_mla(P); } SEAM(pb + 3);
        if (layer == 1) { if (IN(pb + 4)) for (int rep = 0; rep < NREP(pb + 4); ++rep) { PHASE_BEGIN(F); p_quant_merged(P); } SEAM(pb + 4); }
        if (IN(pb + 5)) for (int rep = 0; rep < NREP(pb + 5); ++rep) { PHASE_BEGIN(F);
            p_dense_i8_fp8(P, P.ws + WS_MG8, (const float*)(P.ws + WS_SMG), P.ws + (layer == 0 ? WS_W_OUT : WS_W_O), (const float*)(P.ws + WS_SWD) + (layer == 0 ? SWD_OUT : SWD_O), D, layer == 0 ? T_ALL / 256 : T_LAT / 256, D / 256, layer,
                           (unsigned char*)(P.ws + WS_Y1), D);
            if (layer == 0 && is_tail_wg((T_ALL / 256) * (D / 256), P.G, (int)blockIdx.x)) tail_quant(P, 1, 1, 1);
        } SEAM(pb + 5);
        if (IN(pb + 6)) for (int rep = 0; rep < NREP(pb + 6); ++rep) { PHASE_BEGIN(F); p_ln1(P, layer); } SEAM(pb + 6);
        if (IN(pb + 7)) for (int rep = 0; rep < NREP(pb + 7); ++rep) { PHASE_BEGIN(F); p_router(P, layer); } SEAM(pb + 7);
        if (IN(pb + 8)) for (int rep = 0; rep < NREP(pb + 8); ++rep) { PHASE_BEGIN(F); p_moe_gemm1(P, layer); } SEAM(pb + 8);
        if (IN(pb + 9)) for (int rep = 0; rep < NREP(pb + 9); ++rep) { PHASE_BEGIN(F); p_quant_hmid(P, layer); } SEAM(pb + 9);
        if (IN(pb + 10)) for (int rep = 0; rep < NREP(pb + 10); ++rep) { PHASE_BEGIN(F); p_moe_gemm2(P, layer); } SEAM(pb + 10);
        if (IN(pb + 11)) for (int rep = 0; rep < NREP(pb + 11); ++rep) { PHASE_BEGIN(F); p_combine_ln2(P, layer); } SEAM(pb + 11);
    }
#undef IN
#undef SEAM
}

extern "C" void kernel_launch(void* const* d_in, const int* in_sizes, int n_in, void* d_out, int out_size, void* d_ws, size_t ws_size, hipStream_t stream) {
    static int grid = 0;
    if (grid == 0) {
        if (n_in != 28 || out_size != T_LAT * D || ws_size < WS_END) { fprintf(stderr, "kernel_launch: expected 28 inputs, out %d, ws >= %zu; got n_in %d out %d ws %zu\n", T_LAT * D, (size_t)WS_END, n_in, out_size, ws_size); grid = -1; return; }
        int dev = 0, cus = 0, per_cu = 0;
        if (hipGetDevice(&dev) != hipSuccess || hipDeviceGetAttribute(&cus, hipDeviceAttributeMultiprocessorCount, dev) != hipSuccess) { fprintf(stderr, "kernel_launch: device query failed\n"); grid = -1; return; }
        if (hipFuncSetAttribute((const void*)mk_fwd, hipFuncAttributeMaxDynamicSharedMemorySize, LDS_BYTES) != hipSuccess) { fprintf(stderr, "kernel_launch: hipFuncSetAttribute failed\n"); grid = -1; return; }
        if (hipOccupancyMaxActiveBlocksPerMultiprocessor(&per_cu, (const void*)mk_fwd, 512, LDS_BYTES) != hipSuccess || per_cu < 1) fprintf(stderr, "kernel_launch: occupancy query reports %d\n", per_cu);
        (void)hipGetLastError();
        grid = cus;
        if (grid != 256) fprintf(stderr, "kernel_launch: note: %d CUs (tuned for 256)\n", grid);
    }
    if (grid < 0) return;
    if (hipMemsetAsync((char*)d_ws + WS_CTL, 0, CTL_BYTES, stream) != hipSuccess) { fprintf(stderr, "kernel_launch: memset failed\n"); return; }
    Args a{};
    for (int i = 0; i < 28; ++i) a.in[i] = (const float*)d_in[i];
    a.out = (float*)d_out; a.ws = (unsigned char*)d_ws;
#if MK_ONE_LAUNCH
    a.ph_lo = 0; a.ph_hi = N_PHASES;
    hipLaunchKernelGGL(mk_fwd, dim3(grid), dim3(512), LDS_BYTES, stream, a);
#else
    for (int p = 0; p < N_PHASES; ++p) { a.ph_lo = p; a.ph_hi = p + 1; hipLaunchKernelGGL(mk_fwd, dim3(grid), dim3(512), LDS_BYTES, stream, a); }
#endif
    const hipError_t le = hipPeekAtLastError();
    if (le != hipSuccess) fprintf(stderr, "kernel_launch: launch failed: %s\n", hipGetErrorName(le));
}
```

```cpp
#include <hip/hip_runtime.h>
#include <cstdio>
#include <cstdint>

#ifndef MK_ONE_LAUNCH
#define MK_ONE_LAUNCH 1
#endif

#define LAS __attribute__((address_space(3)))
typedef unsigned short bf16_t;
typedef short bf16x8 __attribute__((ext_vector_type(8)));
typedef short s16x4 __attribute__((ext_vector_type(4)));
typedef float f32x4 __attribute__((ext_vector_type(4)));
typedef float f32x2 __attribute__((ext_vector_type(2)));
typedef float f32x16 __attribute__((ext_vector_type(16)));
typedef unsigned u32x4 __attribute__((ext_vector_type(4)));
typedef unsigned u32x2 __attribute__((ext_vector_type(2)));
typedef int i32x4 __attribute__((ext_vector_type(4)));

constexpr int D = 2048, NB = 8, SEQ = 2048, CTXL = 256, RPB = SEQ + CTXL  ;
constexpr int T_ALL = NB * RPB  , T_LAT = NB * SEQ  ;
constexpr int NEXP = 64, FDIM = 512, TOPK = 8;
constexpr int ABW = 4608, QA_OFF = 0, KA_OFF = 1024, VA_OFF = 2048, QB_OFF = 3072, KB_OFF = 4096, VB_OFF = 4352;
constexpr int DOWN_N = 1280  , UQ_N = 3072, UKV_N = 4096;
constexpr float ALPHA = 1.41421356237f;
constexpr float LAM_INIT0 = 0.2f;
constexpr int LIST_CAP = T_ALL;
constexpr int MAX_TILES = 712;

constexpr size_t al4k(size_t x) { return (x + 4095) & ~(size_t)4095; }
constexpr size_t WS_CTL = 0, CTL_BYTES = 1u << 20;
constexpr size_t WS_TAB = WS_CTL + CTL_BYTES;
constexpr size_t WS_MOD = WS_TAB + (1u << 16);
constexpr size_t WS_W_IN = WS_MOD + (1u << 20);
constexpr size_t WS_W_OUT = WS_W_IN + al4k((size_t)ABW * D * 2);
constexpr size_t WS_W_DOWN = WS_W_OUT + al4k((size_t)D * D * 2);
constexpr size_t WS_W_UQ = WS_W_DOWN + al4k((size_t)DOWN_N * D * 2);
constexpr size_t WS_W_UKV = WS_W_UQ + al4k((size_t)UQ_N * 512 * 2);
constexpr size_t WS_W_O = WS_W_UKV + al4k((size_t)UKV_N * 512 * 2);
constexpr size_t WS_ROUTER = WS_W_O + al4k((size_t)D * D * 2);
constexpr size_t EXP_IN_BYTES = (size_t)1024 * D  , EXP_OUT_BYTES = (size_t)D * FDIM  ;
constexpr size_t WS_EXP_IN = WS_ROUTER + al4k((size_t)2 * 64 * D * 2);
constexpr size_t WS_EXP_OUT = WS_EXP_IN + (size_t)2 * 65 * EXP_IN_BYTES;
constexpr size_t WS_X = WS_EXP_OUT + (size_t)2 * 65 * EXP_OUT_BYTES;
constexpr size_t WS_H = WS_X + (size_t)T_ALL * D * 4;
constexpr size_t WS_PROJ = WS_H + (size_t)T_ALL * D * 2;
constexpr size_t WS_OA = WS_PROJ + (size_t)T_ALL * ABW * 2;
constexpr size_t WS_MERGED = WS_OA + (size_t)T_ALL * D * 2;
constexpr size_t WS_Y1 = WS_MERGED + (size_t)T_ALL * D * 2;
constexpr size_t P_MAX = (size_t)MAX_TILES * 256;
constexpr size_t WS_HMID = WS_Y1 + (size_t)T_ALL * D * 2;
constexpr size_t WS_Y2P = WS_HMID + P_MAX * FDIM * 2;
constexpr size_t WS_LIST = WS_Y2P + P_MAX * D * 2;
constexpr size_t WS_TOKSLOT = WS_LIST + (size_t)64 * LIST_CAP * 4;
constexpr size_t WS_GATE = WS_TOKSLOT + (size_t)T_ALL * 8 * 4;
constexpr size_t WS_DOWN = WS_GATE + (size_t)T_ALL * 8 * 4;
constexpr size_t WS_CQN = WS_DOWN + (size_t)T_ALL * DOWN_N * 2;
constexpr size_t WS_CKVN = WS_CQN + (size_t)T_ALL * 512 * 2;
constexpr size_t WS_KPE = WS_CKVN + (size_t)T_ALL * 512 * 2;
constexpr size_t WS_QM = WS_KPE + (size_t)T_ALL * 64 * 2;
constexpr size_t WS_KVM = WS_QM + (size_t)T_ALL * UQ_N * 2;
constexpr size_t WS_SW = WS_KVM + (size_t)T_ALL * UKV_N * 2;
constexpr size_t WS_H8 = WS_SW + al4k((size_t)2 * 65 * 1024 * 4);
constexpr size_t WS_SA = WS_H8 + (size_t)T_ALL * D;
constexpr size_t WS_SWD = WS_SA + al4k((size_t)T_ALL * 4);
constexpr int SWD_IN = 0, SWD_OUT = 4608, SWD_DOWN = 6656, SWD_UQ = 7936, SWD_UKV = 11008, SWD_O = 15104, SWD_N = 17152;
constexpr size_t WS_SW2 = WS_SWD + al4k((size_t)SWD_N * 4);
constexpr size_t WS_SCQ = WS_SW2 + al4k((size_t)2 * 65 * 2048 * 4);
constexpr size_t WS_SCKV = WS_SCQ + al4k((size_t)T_ALL * 4);
constexpr size_t WS_SMG = WS_SCKV + al4k((size_t)T_ALL * 4);
constexpr size_t WS_SHM = WS_SMG + al4k((size_t)T_ALL * 4);
constexpr size_t WS_HM8 = WS_SHM + al4k(P_MAX * 4);
constexpr size_t WS_MG8 = WS_HM8 + P_MAX * FDIM;
constexpr size_t WS_END = WS_MG8 + (size_t)T_ALL * D;
constexpr size_t TAB64R = 0, TAB64C = 4096, TAB128R = 12288, TAB128C = 20480;
constexpr int CW_BAR = 4096, CW_CNT = 16384;
constexpr int CW_QW = 20480;
constexpr int QSLOT_OFF = 163776;

constexpr int RING_BYTES = 131072;
constexpr int IDXC_OFF = 131072, IDXC_UNITS = 16;
constexpr int TTAB_OFF = IDXC_OFF + IDXC_UNITS * 1024;
constexpr int MISC_OFF = TTAB_OFF + 4096;
constexpr int LDS_BYTES = 163840;
constexpr int BARW_OFF = LDS_BYTES - 16;
constexpr int SCL_OFF = MISC_OFF + 2048;

#define RLX_AGENT __ATOMIC_RELAXED, __HIP_MEMORY_SCOPE_AGENT
__device__ __forceinline__ unsigned f2bf(float f) { unsigned u = __builtin_bit_cast(unsigned, f); return (u + 0x7fffu + ((u >> 16) & 1u)) >> 16; }
__device__ __forceinline__ unsigned pk2(float lo, float hi) { return f2bf(lo) | (f2bf(hi) << 16); }
__device__ __forceinline__ float bf2f(unsigned short b) { return __builtin_bit_cast(float, ((unsigned)b) << 16); }
__device__ __forceinline__ float bflo(unsigned w) { return __builtin_bit_cast(float, w << 16); }
__device__ __forceinline__ float bfhi(unsigned w) { return __builtin_bit_cast(float, w & 0xffff0000u); }
__device__ __forceinline__ unsigned cvt_pk_bf16(float lo, float hi) { unsigned r; asm volatile("v_cvt_pk_bf16_f32 %0, %1, %2" : "=v"(r) : "v"(lo), "v"(hi)); return r; }
__device__ __forceinline__ unsigned q8x4(float a, float b, float c, float d, float inv) {
    unsigned w = 0;
    w = __builtin_amdgcn_cvt_pk_u8_f32(__builtin_rintf(fmaf(a, inv, 128.0f)), 0, w); w = __builtin_amdgcn_cvt_pk_u8_f32(__builtin_rintf(fmaf(b, inv, 128.0f)), 1, w);
    w = __builtin_amdgcn_cvt_pk_u8_f32(__builtin_rintf(fmaf(c, inv, 128.0f)), 2, w); w = __builtin_amdgcn_cvt_pk_u8_f32(__builtin_rintf(fmaf(d, inv, 128.0f)), 3, w);
    return w ^ 0x80808080u;
}
__device__ __forceinline__ float wave_sum(float v) {
#pragma unroll
    for (int o = 1; o < 64; o <<= 1) v += __shfl_xor(v, o);
    return v;
}

#define XB_TMO      128
#define XB_XCNT(j)  (256  + 64 * (j))
#define XB_XSUB(j)  (1280 + 64 * (j))
#define XB_XGEN(j)  (2304 + 64 * (j))
#define XB_TOP      3328
#define XB_TOPGEN   3392
#define XCD_BAR_WORDS 3456
#define XB_SPIN_CAP (1u << 18)
__device__ __forceinline__ unsigned xb_ld(unsigned* p)              { return __hip_atomic_load(p, __ATOMIC_RELAXED, __HIP_MEMORY_SCOPE_AGENT); }
__device__ __forceinline__ unsigned xb_add(unsigned* p, unsigned v) { return __hip_atomic_fetch_add(p, v, __ATOMIC_RELAXED, __HIP_MEMORY_SCOPE_AGENT); }
__device__ __forceinline__ unsigned xb_xcc_id() { return (unsigned)__builtin_amdgcn_s_getreg((3 << 11) | 20) & 0xFu; }
#define XB_SPIN(cond, bar) do { unsigned _sp = 0; while (cond) { __builtin_amdgcn_s_sleep(1); \
    if ((++_sp & 255u) == 0u) { if (xb_ld(&(bar)[XB_TMO])) break; if (_sp > XB_SPIN_CAP) { atomicAdd(&(bar)[XB_TMO], 1u); break; } } } } while (0)
struct XcdBarrier { unsigned* bar; unsigned x; volatile LAS unsigned* st; };
__device__ __forceinline__ XcdBarrier xcd_barrier_post(unsigned* bar, volatile LAS unsigned* st) {
    XcdBarrier b; b.bar = bar; b.x = xb_xcc_id(); b.st = st;
    if (threadIdx.x == 0) (void)xb_add(&bar[XB_XCNT(b.x)], 1u);
    return b;
}
__device__ __forceinline__ void xcd_barrier_complete(unsigned* bar, unsigned x, unsigned& nloc, unsigned& nx) {
    const unsigned G = gridDim.x * gridDim.y * gridDim.z;
    unsigned sum, cnt, mine, sp = 0u;
    for (;;) {
        sum = 0u; cnt = 0u; mine = 0u;
#pragma unroll
        for (unsigned j = 0; j < 16; ++j) { const unsigned c = xb_ld(&bar[XB_XCNT(j)]); sum += c; cnt += (c > 0u) ? 1u : 0u; mine = (j == x) ? c : mine; }
        if (sum == G) break;
        __builtin_amdgcn_s_sleep(1);
        if ((++sp & 255u) == 0u) { if (xb_ld(&bar[XB_TMO])) break; if (sp > XB_SPIN_CAP) { atomicAdd(&bar[XB_TMO], 1u); break; } }
    }
    nloc = mine > 0u ? mine : 1u; nx = cnt > 0u ? cnt : 1u;
}
__device__ __forceinline__ void xcd_barrier(const XcdBarrier& b) {
    asm volatile("s_waitcnt vmcnt(0)" ::: "memory");
    __syncthreads();
    if (threadIdx.x == 0) {
        unsigned* bar = b.bar;
        __builtin_amdgcn_s_waitcnt(0);
        unsigned nloc = b.st[0], nx = b.st[1];
        if (nloc == 0u) { xcd_barrier_complete(bar, b.x, nloc, nx); b.st[0] = nloc; b.st[1] = nx; }
        const unsigned old = xb_add(&bar[XB_XSUB(b.x)], 1u);
        const unsigned gen = old / nloc;
        if (old + 1u == (gen + 1u) * nloc) {
            __builtin_amdgcn_fence(__ATOMIC_RELEASE, "agent");
            asm volatile("s_waitcnt vmcnt(0)" ::: "memory");
            const unsigned og = xb_add(&bar[XB_TOP], 1u);
            const unsigned tg = og / nx;
            if (og + 1u == (tg + 1u) * nx) xb_add(&bar[XB_TOPGEN], 1u);
            else XB_SPIN(xb_ld(&bar[XB_TOPGEN]) == tg, bar);
            __builtin_amdgcn_fence(__ATOMIC_ACQUIRE, "agent");
            xb_add(&bar[XB_XGEN(b.x)], 1u);
            asm volatile("s_waitcnt vmcnt(0)" ::: "memory");
        } else {
            XB_SPIN(xb_ld(&bar[XB_XGEN(b.x)]) == gen, bar);
            __builtin_amdgcn_fence(__ATOMIC_ACQUIRE, "agent");
            asm volatile("s_waitcnt vmcnt(0)" ::: "memory");
        }
    }
    __syncthreads();
}

namespace pg8 {
constexpr int BM = 256, BK = 64, HALF = 128, HTB = HALF * BK * 2, STAGE_BYTES = 8 * HTB;
__device__ __forceinline__ int lds_byte(int r, int c) { const int st = (r >> 4) * 2 + (c >> 5), rr = r & 15, cc = c & 31, ob = rr * 64 + cc * 2; return st * 1024 + (ob ^ (((ob >> 9) & 1) << 5)); }
__device__ __forceinline__ void stage_rc(int b, int& R, int& C) { const int st = b / 1024, sb = b % 1024, swz = sb ^ (((sb >> 9) & 1) << 5); R = (st >> 1) * 16 + swz / 64; C = (st & 1) * 32 + (swz % 64) / 2; }
__device__ __forceinline__ int perm32(int rho) { const int n = rho >> 4, i = rho & 15; return 8 * (i >> 2) + 4 * n + (i & 3); }

struct Unit { int row0; int pn; int e; const char* B; };

struct SchedDense {
    int nM, nN, nwg, G, c, latmap; const char* Bt; size_t tstepB;
    __device__ __forceinline__ void init(int nM_, int nN_, int G_, int c_, int latmap_, const bf16_t* Bt_, int K) { nM = nM_; nN = nN_; nwg = nM * nN; G = G_; c = c_; latmap = latmap_; Bt = (const char*)Bt_; tstepB = (size_t)BM * K * 2; }
    __device__ __forceinline__ bool next(int i, Unit& u) const {
        const long L = (long)i * G + c; if (L >= nwg) return false;
        int wgid = (int)L; { const int q = nwg / 8, r = nwg % 8, xcd = wgid % 8, off = wgid / 8; wgid = (xcd < r ? xcd * (q + 1) : r * (q + 1) + (xcd - r) * q) + off; }
        const int nig = 8 * nN, gid = wgid / nig, fm = gid * 8, gsz = (nM - fm) < 8 ? (nM - fm) : 8;
        int pm = fm + ((wgid % nig) % gsz); u.pn = (wgid % nig) / gsz;
        if (latmap) pm = (pm >> 3) * 9 + 1 + (pm & 7);
        u.row0 = pm * BM; u.e = 0; u.B = Bt + (size_t)u.pn * tstepB; return true;
    }
};
template <int NN, size_t GSTRIDE, size_t TSTEPB> struct SchedMoe {
    int ntiles, G, vcu; const LAS int* ttab; const char* Bt;
    __device__ __forceinline__ bool next(int i, Unit& u) const {
        const int L = i * G + vcu; if (L >= ntiles * NN) return false;
        const int tile = L / NN; u.pn = L - tile * NN; const int e = ttab[tile] >> 16;
        u.row0 = tile * BM; u.e = e; u.B = Bt + (size_t)e * GSTRIDE + (size_t)u.pn * TSTEPB; return true;
    }
};
struct EpiBf16 {
    static constexpr bool PERM = true; static constexpr int NVM = 16;
    bf16_t* O; int ldc;
    __device__ __forceinline__ const float* sa_src(const Unit& u, int ui, int r) const { return (const float*)O; }
    __device__ __forceinline__ const float* sw_src(const Unit& u, int c) const { return (const float*)O; }
    __device__ __forceinline__ void operator()(const f32x4 (&acc)[2][2][4][2], const Unit& u, int ui, int wr, int wc, int fr, int fq, const LAS float* scl) const {
        const int row0 = u.row0 + wr * 64 + fr, col0 = u.pn * BM + wc * 32 + 8 * fq;
#pragma unroll
        for (int ai = 0; ai < 2; ++ai)
#pragma unroll
            for (int m = 0; m < 4; ++m) { bf16_t* rowp = O + (size_t)(row0 + ai * HALF + m * 16) * ldc + col0;
#pragma unroll
                for (int bj = 0; bj < 2; ++bj) { const f32x4 v0 = acc[ai][bj][m][0], v1 = acc[ai][bj][m][1];
                    u32x4 w; w.x = cvt_pk_bf16(v0[0], v0[1]); w.y = cvt_pk_bf16(v0[2], v0[3]); w.z = cvt_pk_bf16(v1[0], v1[1]); w.w = cvt_pk_bf16(v1[2], v1[3]);
                    *(u32x4*)(rowp + bj * HALF) = w; } }
    }
};
__device__ __forceinline__ float silu_mul(float g, float u) { return g * __builtin_amdgcn_rcpf(1.0f + __builtin_amdgcn_exp2f(-1.4426950408889634f * g)) * u; }
template <int SWG> struct EpiI8Bf16 {
    static constexpr bool PERM = true; static constexpr int NVM = 16;
    bf16_t* O; int ldc; const float* SA; const float* SW;
    __device__ __forceinline__ const float* sa_src(const Unit& u, int ui, int r) const { return SA + u.row0 + r; }
    __device__ __forceinline__ const float* sw_src(const Unit& u, int c) const { return SW + (size_t)u.e * SWG + u.pn * BM + c; }
    __device__ __forceinline__ void operator()(const i32x4 (&acc)[2][2][4][2], const Unit& u, int ui, int wr, int wc, int fr, int fq, const LAS float* scl) const {
        const int lrow = wr * 64 + fr, row0 = u.row0 + lrow, col0 = u.pn * BM + wc * 32 + 8 * fq;
#pragma unroll
        for (int bj = 0; bj < 2; ++bj) { const f32x4 w0 = *(const LAS f32x4*)(scl + 256 + bj * HALF + wc * 32 + 8 * fq), w1 = *(const LAS f32x4*)(scl + 256 + bj * HALF + wc * 32 + 8 * fq + 4);
#pragma unroll
            for (int ai = 0; ai < 2; ++ai)
#pragma unroll
                for (int m = 0; m < 4; ++m) { const int r = row0 + ai * HALF + m * 16; bf16_t* rowp = O + (size_t)r * ldc + col0 + bj * HALF; const float sa = scl[lrow + ai * HALF + m * 16];
                    const i32x4 v0 = acc[ai][bj][m][0], v1 = acc[ai][bj][m][1]; const f32x4 s0 = w0 * sa, s1 = w1 * sa;
                    const f32x4 f0 = __builtin_convertvector(v0, f32x4) * s0, f1 = __builtin_convertvector(v1, f32x4) * s1;
                    u32x4 w; w.x = cvt_pk_bf16(f0[0], f0[1]); w.y = cvt_pk_bf16(f0[2], f0[3]); w.z = cvt_pk_bf16(f1[0], f1[1]); w.w = cvt_pk_bf16(f1[2], f1[3]);
                    *(u32x4*)rowp = w; } }
    }
};
template <int SWG, bool SA1 = false> struct EpiI8Fp8 {
    static constexpr bool PERM = true; static constexpr int NVM = 16;
    unsigned char* O; int ldc; const float* SA; const float* SW;
    __device__ __forceinline__ const float* sa_src(const Unit& u, int ui, int r) const { return SA1 ? SW : SA + u.row0 + r; }
    __device__ __forceinline__ const float* sw_src(const Unit& u, int c) const { return SW + (size_t)u.e * SWG + u.pn * BM + c; }
    template <class AV> __device__ __forceinline__ void operator()(const AV (&acc)[2][2][4][2], const Unit& u, int ui, int wr, int wc, int fr, int fq, const LAS float* scl) const {
        const int lrow = wr * 64 + fr, row0 = u.row0 + lrow, col0 = u.pn * BM + wc * 32 + 8 * fq;
#pragma unroll
        for (int bj = 0; bj < 2; ++bj) { const f32x4 w0 = *(const LAS f32x4*)(scl + 256 + bj * HALF + wc * 32 + 8 * fq), w1 = *(const LAS f32x4*)(scl + 256 + bj * HALF + wc * 32 + 8 * fq + 4);
#pragma unroll
            for (int ai = 0; ai < 2; ++ai)
#pragma unroll
                for (int m = 0; m < 4; ++m) { const int r = row0 + ai * HALF + m * 16; unsigned char* rowp = O + (size_t)r * ldc + col0 + bj * HALF; const float sa = SA1 ? 1.0f : scl[lrow + ai * HALF + m * 16];
                    const AV v0 = acc[ai][bj][m][0], v1 = acc[ai][bj][m][1]; const f32x4 s0 = w0 * sa, s1 = w1 * sa;
                    const f32x4 f0 = __builtin_convertvector(v0, f32x4) * s0, f1 = __builtin_convertvector(v1, f32x4) * s1;
                    int lo = 0, hi = 0;
                    lo = __builtin_amdgcn_cvt_pk_fp8_f32(f0[0], f0[1], lo, false); lo = __builtin_amdgcn_cvt_pk_fp8_f32(f0[2], f0[3], lo, true);
                    hi = __builtin_amdgcn_cvt_pk_fp8_f32(f1[0], f1[1], hi, false); hi = __builtin_amdgcn_cvt_pk_fp8_f32(f1[2], f1[3], hi, true);
                    *(u32x2*)rowp = (u32x2){(unsigned)lo, (unsigned)hi}; } }
    }
};
struct EpiSwigluI8 {
    static constexpr bool PERM = true; static constexpr int NVM = 8;
    unsigned char* O; int ldc; const float* SA; const float* SW; const LAS int* idxc;
    __device__ __forceinline__ const float* sa_src(const Unit& u, int ui, int r) const { return SA + idxc[(ui & (IDXC_UNITS - 1)) * 256 + r]; }
    __device__ __forceinline__ const float* sw_src(const Unit& u, int c) const { return SW + (size_t)u.e * 1024 + u.pn * BM + c; }
    __device__ __forceinline__ void operator()(const i32x4 (&acc)[2][2][4][2], const Unit& u, int ui, int wr, int wc, int fr, int fq, const LAS float* scl) const {
        const int lrow = wr * 64 + fr, row0 = u.row0 + lrow, col0 = u.pn * HALF + wc * 32 + 8 * fq;
        const LAS float* sw = scl + 256 + wc * 32 + 8 * fq;
        const f32x4 wg0 = *(const LAS f32x4*)sw, wg1 = *(const LAS f32x4*)(sw + 4), wu0 = *(const LAS f32x4*)(sw + HALF), wu1 = *(const LAS f32x4*)(sw + HALF + 4);
#pragma unroll
        for (int ai = 0; ai < 2; ++ai)
#pragma unroll
            for (int m = 0; m < 4; ++m) { unsigned char* rowp = O + (size_t)(row0 + ai * HALF + m * 16) * ldc + col0;
                const float sa = scl[lrow + ai * HALF + m * 16];
                const i32x4 g0 = acc[ai][0][m][0], g1 = acc[ai][0][m][1], u0 = acc[ai][1][m][0], u1 = acc[ai][1][m][1];
                float o[8];
#pragma unroll
                for (int j = 0; j < 4; ++j) { o[j] = silu_mul((float)g0[j] * (sa * wg0[j]), (float)u0[j] * (sa * wu0[j])); o[4 + j] = silu_mul((float)g1[j] * (sa * wg1[j]), (float)u1[j] * (sa * wu1[j])); }
                int lo = 0, hi = 0;
                lo = __builtin_amdgcn_cvt_pk_fp8_f32(o[0], o[1], lo, false); lo = __builtin_amdgcn_cvt_pk_fp8_f32(o[2], o[3], lo, true);
                hi = __builtin_amdgcn_cvt_pk_fp8_f32(o[4], o[5], hi, false); hi = __builtin_amdgcn_cvt_pk_fp8_f32(o[6], o[7], hi, true);
                *(u32x2*)rowp = (u32x2){(unsigned)lo, (unsigned)hi}; }
    }
};

template <int I8> struct AccT { typedef f32x4 T; };
template <> struct AccT<1> { typedef i32x4 T; };
__device__ __forceinline__ f32x4 mma16(bf16x8 b, bf16x8 a, f32x4 c) { return __builtin_amdgcn_mfma_f32_16x16x32_bf16(b, a, c, 0, 0, 0); }
__device__ __forceinline__ i32x4 mma16(bf16x8 b, bf16x8 a, i32x4 c) { return __builtin_amdgcn_mfma_i32_16x16x64_i8(__builtin_bit_cast(i32x4, b), __builtin_bit_cast(i32x4, a), c, 0, 0, 0); }
typedef int i32x8 __attribute__((ext_vector_type(8)));
__device__ __forceinline__ f32x4 mma_f8(bf16x8 b0, bf16x8 b1, bf16x8 a0, bf16x8 a1, f32x4 c) {
    const i32x8 bb = __builtin_shufflevector(__builtin_bit_cast(i32x4, b0), __builtin_bit_cast(i32x4, b1), 0, 1, 2, 3, 4, 5, 6, 7);
    const i32x8 aa = __builtin_shufflevector(__builtin_bit_cast(i32x4, a0), __builtin_bit_cast(i32x4, a1), 0, 1, 2, 3, 4, 5, 6, 7);
    return __builtin_amdgcn_mfma_scale_f32_16x16x128_f8f6f4(bb, aa, c, 0, 0, 0, 0, 0, 0);
}
template <class Epi, class Sched, bool GATHER, int I8 = 0>
__device__ __forceinline__ void gemm_phase(LAS unsigned char* lds, const void* Abase, const int K, const Sched& S, const Epi& E, const LAS int* idxc, const int tid) {
    const int wid = __builtin_amdgcn_readfirstlane(tid >> 6), lane = tid & 63, wr = wid >> 2, wc = wid & 3, fr = lane & 15, fq = lane >> 4;
    const int RB = I8 ? K : K * 2, nt = RB / 128;
    int Ri[2], Ci[2]; unsigned voffB[2];
#pragma unroll
    for (int i = 0; i < 2; ++i) { int R, C; stage_rc(tid * 16 + i * 8192, R, C); Ri[i] = R; Ci[i] = C; const int Rb = Epi::PERM ? ((R & ~31) + perm32(R & 31)) : R; voffB[i] = (unsigned)(Rb * RB + C * 2); }
    const size_t kstep = 128;
    const size_t hstep = (size_t)HALF * RB;
    const unsigned ldsw = (unsigned)wid * 1024u;
    const int aoff = lds_byte(wr * 64 + fr, fq * 8), boff = lds_byte(wc * 32 + fr, fq * 8);
#define PG8_SA(b, h) (((b) * 2 + (h)) * HTB)
#define PG8_SB(b, h) ((4 + (b) * 2 + (h)) * HTB)
#define PG8_STAGE(bufoff, gbase, voff) do { _Pragma("unroll") for (int _i = 0; _i < 2; ++_i) \
        __builtin_amdgcn_global_load_lds((const unsigned*)((const char*)(gbase) + (voff)[_i]), (LAS unsigned*)(lds + (bufoff) + ldsw + _i * 8192), 16, 0, 0); } while (0)
#define PG8_LDA(dst, b, h) do { _Pragma("unroll") for (int m = 0; m < 4; ++m) _Pragma("unroll") for (int k = 0; k < 2; ++k) dst[m][k] = *(const LAS bf16x8*)(lds + PG8_SA(b, h) + aoff + m * 2048 + k * 1024); } while (0)
#define PG8_LDB(dst, b, h) do { _Pragma("unroll") for (int n = 0; n < 2; ++n) _Pragma("unroll") for (int k = 0; k < 2; ++k) dst[n][k] = *(const LAS bf16x8*)(lds + PG8_SB(b, h) + boff + n * 2048 + k * 1024); } while (0)
#define PG8_MMA(ai, bj, At, Bt) do { __builtin_amdgcn_s_setprio(1); _Pragma("unroll") for (int m = 0; m < 4; ++m) _Pragma("unroll") for (int n = 0; n < 2; ++n) { \
        if constexpr (I8 == 2) acc[ai][bj][m][n] = mma_f8(Bt[n][0], Bt[n][1], At[m][0], At[m][1], acc[ai][bj][m][n]); \
        else { _Pragma("unroll") for (int k = 0; k < 2; ++k) acc[ai][bj][m][n] = mma16(Bt[n][k], At[m][k], acc[ai][bj][m][n]); } } __builtin_amdgcn_s_setprio(0); } while (0)
#define PG8_WAIT_V(n) asm volatile("s_waitcnt vmcnt(" #n ")" ::: "memory")
#define PG8_WAIT_L(n) asm volatile("s_waitcnt lgkmcnt(" #n ")" ::: "memory")
#define PG8_BAR __builtin_amdgcn_s_barrier()
#define PG8_SCHED __builtin_amdgcn_sched_barrier(0)
#define PG8_MKA(dst, ui, u_) do { _Pragma("unroll") for (int _h = 0; _h < 2; ++_h) _Pragma("unroll") for (int _i = 0; _i < 2; ++_i) { \
        if constexpr (GATHER) dst[_h][_i] = (unsigned)idxc[((ui) & (IDXC_UNITS - 1)) * 256 + _h * HALF + Ri[_i]] * (unsigned)RB + (unsigned)(Ci[_i] * 2); \
        else dst[_h][_i] = (unsigned)((_h * HALF + Ri[_i]) * RB + Ci[_i] * 2); } } while (0)
    Unit cur, nxt; int ui = 0;
    if (!S.next(0, cur)) return;
    LAS float* const sclb = (LAS float*)(lds + SCL_OFF);
#define PG8_SCALES(u_, ui_) do { const float* _src = (wid < 4) ? E.sa_src(u_, ui_, wid * 64 + lane) : E.sw_src(u_, (wid - 4) * 64 + lane); \
        __builtin_amdgcn_global_load_lds((const unsigned*)_src, (LAS unsigned*)(sclb + ((ui_) & 1) * 512 + wid * 64), 4, 0, 0); } while (0)
    constexpr int NEPI = Epi::NVM;
    typedef typename AccT<I8>::T acc_t;
    acc_t acc[2][2][4][2];
#pragma unroll
    for (int a = 0; a < 2; ++a)
#pragma unroll
        for (int b = 0; b < 2; ++b)
#pragma unroll
            for (int m = 0; m < 4; ++m)
#pragma unroll
                for (int n = 0; n < 2; ++n) acc[a][b][m][n] = acc_t{};
    bf16x8 At[4][2], B0[2][2], B1[2][2];
    unsigned curA[2][2], nxtA[2][2];
    PG8_MKA(curA, 0, cur);
    PG8_SCALES(cur, 0);
    const char* cA = GATHER ? (const char*)Abase : (const char*)Abase + (size_t)cur.row0 * RB; const char* cB = cur.B;
    PG8_STAGE(PG8_SB(0, 0), cB, voffB); PG8_STAGE(PG8_SB(0, 1), cB + hstep, voffB); PG8_STAGE(PG8_SA(0, 0), cA, curA[0]); PG8_STAGE(PG8_SA(0, 1), cA, curA[1]);
    if (wr == 1) PG8_BAR;
    PG8_WAIT_V(2); PG8_BAR;
    PG8_STAGE(PG8_SB(1, 0), cB + kstep, voffB); PG8_STAGE(PG8_SA(1, 0), cA + kstep, curA[0]); PG8_STAGE(PG8_SB(1, 1), cB + hstep + kstep, voffB);
    PG8_WAIT_V(6); PG8_BAR;
    for (;;) {
        const bool has_next = S.next(ui + 1, nxt);
        const char* nA = has_next ? (GATHER ? (const char*)Abase : (const char*)Abase + (size_t)nxt.row0 * RB) : cA; const char* nB = has_next ? nxt.B : cB;
        if constexpr (GATHER) { if (has_next) { PG8_MKA(nxtA, ui + 1, nxt); } else {
#pragma unroll
            for (int h = 0; h < 2; ++h)
#pragma unroll
                for (int i = 0; i < 2; ++i) nxtA[h][i] = curA[h][i]; } }
#pragma unroll 1
        for (int t = 0; t < nt; t += 2) {
            const bool last = (t == nt - 2);
            const char* a1 = cA + (size_t)(t + 1) * kstep;
            const char* a2 = last ? nA : cA + (size_t)(t + 2) * kstep; const char* b2 = last ? nB : cB + (size_t)(t + 2) * kstep;
            const char* a3 = a2 + kstep; const char* b3 = b2 + kstep;
            unsigned s0[2], s1[2];
#pragma unroll
            for (int i = 0; i < 2; ++i) { if constexpr (GATHER) { s0[i] = last ? nxtA[0][i] : curA[0][i]; s1[i] = last ? nxtA[1][i] : curA[1][i]; } else { s0[i] = curA[0][i]; s1[i] = curA[1][i]; } }
            const bool relax = (t == 0) && (ui > 0);
            PG8_LDB(B0, 0, 0); PG8_LDB(B1, 0, 1); PG8_SCHED; PG8_LDA(At, 0, 0); PG8_STAGE(PG8_SA(1, 1), a1, curA[1]);
            if (relax) { if constexpr (NEPI == 16) PG8_WAIT_V(24); else PG8_WAIT_V(16); } else PG8_WAIT_V(8);
            PG8_WAIT_L(0); PG8_BAR; PG8_MMA(0, 0, At, B0); PG8_MMA(0, 1, At, B1); PG8_BAR; PG8_SCHED;
            PG8_LDA(At, 0, 1); PG8_STAGE(PG8_SB(0, 0), b2, voffB); PG8_STAGE(PG8_SB(0, 1), b2 + hstep, voffB); PG8_STAGE(PG8_SA(0, 0), a2, s0);
            if (relax) { if constexpr (NEPI == 16) PG8_WAIT_V(24); else PG8_WAIT_V(16); } else PG8_WAIT_V(8);
            PG8_WAIT_L(0); PG8_BAR; PG8_MMA(1, 0, At, B0); PG8_MMA(1, 1, At, B1); PG8_BAR; PG8_SCHED;
            PG8_LDB(B0, 1, 0); PG8_LDB(B1, 1, 1); PG8_SCHED; PG8_LDA(At, 1, 0); PG8_STAGE(PG8_SA(0, 1), a2, s1);
            PG8_WAIT_V(8); PG8_WAIT_L(0); PG8_BAR; PG8_MMA(0, 0, At, B0); PG8_MMA(0, 1, At, B1); PG8_BAR; PG8_SCHED;
            PG8_LDA(At, 1, 1); PG8_STAGE(PG8_SB(1, 0), b3, voffB); PG8_STAGE(PG8_SB(1, 1), b3 + hstep, voffB); PG8_STAGE(PG8_SA(1, 0), a3, s0);
            PG8_WAIT_V(8); PG8_WAIT_L(0); PG8_BAR; PG8_MMA(1, 0, At, B0); PG8_MMA(1, 1, At, B1); PG8_BAR; PG8_SCHED;
        }
        if (wr == 0) PG8_BAR;
        E(acc, cur, ui, wr, wc, fr, fq, sclb + (ui & 1) * 512);
        if (!has_next) break;
#pragma unroll
        for (int a = 0; a < 2; ++a)
#pragma unroll
            for (int b = 0; b < 2; ++b)
#pragma unroll
                for (int m = 0; m < 4; ++m)
#pragma unroll
                    for (int n = 0; n < 2; ++n) acc[a][b][m][n] = acc_t{};
        cur = nxt; cA = nA; cB = nB; ++ui;
        PG8_SCALES(cur, ui);
        if constexpr (GATHER) {
#pragma unroll
            for (int h = 0; h < 2; ++h)
#pragma unroll
                for (int i = 0; i < 2; ++i) curA[h][i] = nxtA[h][i]; }
        if (wr == 1) PG8_BAR;
    }
    PG8_WAIT_V(0);
    PG8_BAR;
#undef PG8_SA
#undef PG8_SB
#undef PG8_STAGE
#undef PG8_LDA
#undef PG8_LDB
#undef PG8_MMA
#undef PG8_WAIT_V
#undef PG8_WAIT_L
#undef PG8_BAR
#undef PG8_SCHED
#undef PG8_MKA
#undef PG8_SCALES
}
}

namespace att {
constexpr int DV = 128, NW = 8, QBLK = 32, KVBLK = 64;
constexpr float THR = 8.f;
#define SBAR() __builtin_amdgcn_sched_barrier(0)
__device__ __forceinline__ int crow(int r, int hi) { return (r & 3) + 8 * (r >> 2) + 4 * hi; }
template <int DQK> struct Cfg {
    static constexpr int NQ = DQK / 16, SHM_K = KVBLK * DQK * 2, KCH = DQK / 64;
    static constexpr int RB0 = DQK >= 128 ? 256 : 128;
    static constexpr int KCH0 = DQK >= 128 ? 2 : 1, KCH1 = DQK == 192 ? 1 : 0, REG1 = KVBLK * RB0;
    static constexpr float SCALE = DQK == 64 ? 0.125f : (DQK == 128 ? 0.088388347648318440f : 0.072168783648703220f);
};
constexpr int SHM_V = KVBLK * DV * 2;

template <int DQK> __device__ __forceinline__ void partialSM(f32x16& p0, f32x16& p1, float& m_reg, float& mn, float& alpha) {
    constexpr float SCALE = Cfg<DQK>::SCALE, C = SCALE * 1.4426950408889634f;
    float pmax = p0[0];
#pragma unroll
    for (int r = 1; r < 16; ++r) pmax = fmaxf(pmax, p0[r]);
#pragma unroll
    for (int r = 0; r < 16; ++r) pmax = fmaxf(pmax, p1[r]);
    { auto rr = __builtin_amdgcn_permlane32_swap(__float_as_uint(pmax), __float_as_uint(pmax), false, false);
      pmax = fmaxf(__uint_as_float(rr[0]), __uint_as_float(rr[1])); }
    if (__builtin_expect(__all(pmax - m_reg <= THR / SCALE), 1)) { mn = m_reg; alpha = 1.f; }
    else { mn = fmaxf(m_reg, pmax); alpha = __builtin_amdgcn_exp2f((m_reg - mn) * C); m_reg = mn; }
    const float mnC = -mn * C;
#pragma unroll
    for (int r = 0; r < 16; ++r) p0[r] = fmaf(p0[r], C, mnC);
#pragma unroll
    for (int r = 0; r < 16; ++r) p1[r] = fmaf(p1[r], C, mnC);
#pragma unroll
    for (int r = 0; r < 16; ++r) p0[r] = __builtin_amdgcn_exp2f(p0[r]);
}
__device__ __forceinline__ void finishSM(f32x16& p0, f32x16& p1, float alpha, float& l_reg, bf16x8& pa0, bf16x8& pa1, bf16x8& pa2, bf16x8& pa3) {
#pragma unroll
    for (int r = 0; r < 16; ++r) p1[r] = __builtin_amdgcn_exp2f(p1[r]);
    float ps = 0;
#pragma unroll
    for (int r = 0; r < 16; ++r) ps += p0[r];
#pragma unroll
    for (int r = 0; r < 16; ++r) ps += p1[r];
    { auto rr = __builtin_amdgcn_permlane32_swap(__float_as_uint(ps), __float_as_uint(ps), false, false);
      ps = __uint_as_float(rr[0]) + __uint_as_float(rr[1]); }
    l_reg = l_reg * alpha + ps;
#define PK4(P, BASE, OUT) do { unsigned a0 = cvt_pk_bf16(P[BASE + 0], P[BASE + 1]), a1 = cvt_pk_bf16(P[BASE + 2], P[BASE + 3]);   \
    unsigned b0 = cvt_pk_bf16(P[BASE + 4], P[BASE + 5]), b1 = cvt_pk_bf16(P[BASE + 6], P[BASE + 7]);                              \
    auto r0 = __builtin_amdgcn_permlane32_swap(a0, b0, false, false); auto r1 = __builtin_amdgcn_permlane32_swap(a1, b1, false, false); \
    u32x4 w = {r0[0], r1[0], r0[1], r1[1]}; OUT = *reinterpret_cast<bf16x8*>(&w); } while (0)
    PK4(p0, 0, pa0); PK4(p0, 8, pa1); PK4(p1, 0, pa2); PK4(p1, 8, pa3);
#undef PK4
}
template <int DQK> __device__ __forceinline__ void qkt(f32x16& p0, f32x16& p1, const char* Ks, const bf16x8* qr, const char* qx, int r32, int hi) {
    p0 = f32x16{}; p1 = f32x16{};
    constexpr int RB0 = Cfg<DQK>::RB0;
#pragma unroll
    for (int d0 = 0; d0 < Cfg<DQK>::NQ; ++d0) {
        bf16x8 b0, b1, q;
        if (d0 < 8) { const int cb = (d0 * 16 + hi * 8) * 2;
            const int sw = (RB0 == 256 ? (r32 & 15) : ((r32 >> 1) & 7)) << 4;
            b0 = *reinterpret_cast<const bf16x8*>(Ks + r32 * RB0 + (cb ^ sw));
            b1 = *reinterpret_cast<const bf16x8*>(Ks + (32 + r32) * RB0 + (cb ^ sw));
            q = qr[d0 < 8 ? d0 : 0];
        } else { const int cb = ((d0 - 8) * 16 + hi * 8) * 2;
            const int sw = ((r32 >> 1) & 7) << 4;
            b0 = *reinterpret_cast<const bf16x8*>(Ks + Cfg<DQK>::REG1 + r32 * 128 + (cb ^ sw));
            b1 = *reinterpret_cast<const bf16x8*>(Ks + Cfg<DQK>::REG1 + (32 + r32) * 128 + (cb ^ sw));
            q = *reinterpret_cast<const bf16x8*>(qx + (d0 - 8) * 1024);
        }
        p0 = __builtin_amdgcn_mfma_f32_32x32x16_bf16(b0, q, p0, 0, 0, 0);
        p1 = __builtin_amdgcn_mfma_f32_32x32x16_bf16(b1, q, p1, 0, 0, 0); }
}
__device__ __forceinline__ int v_rd_base(int lane) { return ((lane & 3) << 3) | (((lane >> 2) & 3) << 6) | (((lane >> 4) & 1) << 5) | (((lane >> 5) & 1) << 8); }
constexpr int v_rd_off(int d0, int ks, int half) { return d0 * 512 + ks * 4096 + half * 2048; }
template <int OFF> __device__ __forceinline__ s16x4 tr_read(int vb) {
    s16x4 r; asm volatile("ds_read_b64_tr_b16 %0, %1 offset:%2" : "=&v"(r) : "v"(vb), "i"(OFF) : "memory"); return r;
}
template <int D0> __device__ __forceinline__ void pv_one(f32x16& od, int vb, bf16x8 pa0, bf16x8 pa1, bf16x8 pa2, bf16x8 pa3) {
    const s16x4 l0 = tr_read<v_rd_off(D0, 0, 0)>(vb), h0 = tr_read<v_rd_off(D0, 0, 1)>(vb), l1 = tr_read<v_rd_off(D0, 1, 0)>(vb), h1 = tr_read<v_rd_off(D0, 1, 1)>(vb);
    const s16x4 l2 = tr_read<v_rd_off(D0, 2, 0)>(vb), h2 = tr_read<v_rd_off(D0, 2, 1)>(vb), l3 = tr_read<v_rd_off(D0, 3, 0)>(vb), h3 = tr_read<v_rd_off(D0, 3, 1)>(vb);
    asm volatile("s_waitcnt lgkmcnt(0)" ::: "memory"); SBAR();
#define PK(L, H) (bf16x8){L[0], L[1], L[2], L[3], H[0], H[1], H[2], H[3]}
    od = __builtin_amdgcn_mfma_f32_32x32x16_bf16(pa0, PK(l0, h0), od, 0, 0, 0);
    od = __builtin_amdgcn_mfma_f32_32x32x16_bf16(pa1, PK(l1, h1), od, 0, 0, 0);
    od = __builtin_amdgcn_mfma_f32_32x32x16_bf16(pa2, PK(l2, h2), od, 0, 0, 0);
    od = __builtin_amdgcn_mfma_f32_32x32x16_bf16(pa3, PK(l3, h3), od, 0, 0, 0);
#undef PK
}
__device__ __forceinline__ void pv_d0(f32x16* o, int vb, bf16x8 pa0, bf16x8 pa1, bf16x8 pa2, bf16x8 pa3) {
    pv_one<0>(o[0], vb, pa0, pa1, pa2, pa3); pv_one<1>(o[1], vb, pa0, pa1, pa2, pa3); pv_one<2>(o[2], vb, pa0, pa1, pa2, pa3); pv_one<3>(o[3], vb, pa0, pa1, pa2, pa3);
}

template <int DQK, bool PIPE, bool QROPE, bool O8 = false>
__device__ __forceinline__ void attn_unit(const bf16_t* __restrict__ Qb, int ldq, const bf16_t* __restrict__ K0, int ldk0, const bf16_t* __restrict__ K1, int ldk1,
                                          const bf16_t* __restrict__ Vh, int ldv, bf16_t* __restrict__ Ob, int ldo, int nkeys, int qpos0, const f32x2* ropeR, const f32x2* ropeC,
                                          char* lds, LAS unsigned char* ldsl, const int tid) {
    using C = Cfg<DQK>; constexpr int NQ = C::NQ, SHM_K = C::SHM_K, NB = PIPE ? 3 : 2, KCH0 = C::KCH0, KCH1 = C::KCH1;
    const int wid = __builtin_amdgcn_readfirstlane(tid >> 6), lane = tid & 63, r32 = lane & 31, hi = lane >> 5;
    char* V_lds = lds; char* K_lds = lds + NB * SHM_V;
    float* ws = (float*)(lds + NB * SHM_V + NB * SHM_K) + wid * 64; float* li_l = ws; float* al_l = ws + 32;
    float m_reg = -1e30f, l_reg = 0; f32x16 o[4] = {}; constexpr int NQR = NQ < 8 ? NQ : 8; bf16x8 qr[NQR];
    char* qx = lds + NB * SHM_V + NB * SHM_K + 2048 + wid * 4096 + lane * 16;
    const bf16_t* Qw = Qb + (long)(wid * QBLK + r32) * ldq + hi * 8;
#pragma unroll
    for (int d0 = 0; d0 < NQR; ++d0) qr[d0] = *reinterpret_cast<const bf16x8*>(Qw + d0 * 16);
    if constexpr (QROPE) {
        static_assert(DQK == 192, "QROPE: MLA layout");
        const int pos = qpos0 + wid * QBLK + r32, gr = pos >> 6, gc = pos & 63;
#pragma unroll
        for (int blk = 0; blk < 2; ++blk) { const f32x2* tb = (blk == 0 ? ropeR + gr * 16 : ropeC + gc * 16) + hi * 8;
            bf16x8 x1 = *reinterpret_cast<const bf16x8*>(Qw + (8 + 2 * blk) * 16), x2 = *reinterpret_cast<const bf16x8*>(Qw + (9 + 2 * blk) * 16);
#pragma unroll
            for (int i = 0; i < 8; ++i) { const f32x2 cs = tb[i]; const float a = bf2f((unsigned short)x1[i]), b = bf2f((unsigned short)x2[i]);
                x1[i] = (short)f2bf(a * cs.x - b * cs.y); x2[i] = (short)f2bf(b * cs.x + a * cs.y); }
            *reinterpret_cast<bf16x8*>(qx + (2 * blk) * 1024) = x1; *reinterpret_cast<bf16x8*>(qx + (2 * blk + 1) * 1024) = x2; }
    } else { static_assert(NQ <= 8, "fragments beyond 8 need the LDS path"); }
    unsigned voffv[2], koff[KCH0 + (KCH1 ? 1 : 0)];
#pragma unroll
    for (int i = 0; i < 2; ++i) { const int st = 4 * wid + 2 * i + (lane >> 5), kk = (st >> 2) * 8 + ((lane & 31) >> 2), k = (kk & ~0xC) | ((kk & 4) << 1) | ((kk & 8) >> 1), c = (st & 3) * 32 + (lane & 3) * 8;
        voffv[i] = (unsigned)(k * ldv + c) * 2u; }
#pragma unroll
    for (int i = 0; i < KCH0; ++i) { const int sgm = KCH0 * wid + i; int row, q; if (C::RB0 == 256) { row = 4 * sgm + (lane >> 4); q = lane & 15; } else { row = 8 * sgm + (lane >> 3); q = lane & 7; }
        koff[i] = (unsigned)(row * ldk0 + (q ^ (C::RB0 == 256 ? (row & 15) : ((row >> 1) & 7))) * 8) * 2u; }
    if constexpr (KCH1) { const int row = 8 * wid + (lane >> 3), q = lane & 7; koff[KCH0] = (unsigned)(row * ldk1 + (q ^ ((row >> 1) & 7)) * 8) * 2u; }
    const int vb0 = (int)(uintptr_t)V_lds + v_rd_base(lane);
    LAS unsigned char* Vl = ldsl; LAS unsigned char* Kl = ldsl + NB * SHM_V;
#define GLDS(gp, lp) __builtin_amdgcn_global_load_lds((const unsigned*)(gp), (LAS unsigned*)(lp), 16, 0, 0)
#define DMA(k0, b) do { const char* _vb = (const char*)(Vh + (long)(k0) * ldv); const char* _kb0 = (const char*)(K0 + (long)(k0) * ldk0); \
    _Pragma("unroll") for (int _i = 0; _i < 2; ++_i) GLDS(_vb + voffv[_i], Vl + (b) * SHM_V + (2 * wid + _i) * 1024); \
    _Pragma("unroll") for (int _i = 0; _i < KCH0; ++_i) GLDS(_kb0 + koff[_i], Kl + (b) * SHM_K + (KCH0 * wid + _i) * 1024); \
    if constexpr (KCH1) { const char* _kb1 = (const char*)(K1 + (long)(k0) * ldk1); GLDS(_kb1 + koff[KCH0], Kl + (b) * SHM_K + C::REG1 + wid * 1024); } } while (0)
#define VM0() asm volatile("s_waitcnt vmcnt(0)" ::: "memory")
#define RESC(a) do { if (__any((a) < 1.f)) { if (hi == 0) al_l[r32] = (a); asm volatile("s_waitcnt lgkmcnt(0)" ::: "memory"); \
    _Pragma("unroll") for (int d = 0; d < 4; ++d) _Pragma("unroll") for (int r = 0; r < 16; ++r) o[d][r] *= al_l[crow(r, hi)]; } } while (0)
    bf16x8 pa0, pa1, pa2, pa3; const int NT = nkeys / KVBLK;
    if constexpr (PIPE) {
        f32x16 pA0, pA1, pB0, pB1; float mnA, mnB, alA, alB;
        int bc = 1, bp = 0, bn = 2;
        DMA(0, 0); DMA(KVBLK, 1); VM0(); __syncthreads();
        qkt<DQK>(pA0, pA1, K_lds, qr, qx, r32, hi); partialSM<DQK>(pA0, pA1, m_reg, mnA, alA);
#define STEP(PC0, PC1, mnC, alC, PP0, PP1, alP, j) do { \
        if ((j) + 1 < NT) DMA(((j) + 1) * KVBLK, bn); \
        SBAR(); qkt<DQK>(PC0, PC1, K_lds + bc * SHM_K, qr, qx, r32, hi); \
        finishSM(PP0, PP1, alP, l_reg, pa0, pa1, pa2, pa3); SBAR(); \
        pv_d0(o, vb0 + bp * SHM_V, pa0, pa1, pa2, pa3); partialSM<DQK>(PC0, PC1, m_reg, mnC, alC); \
        RESC(alC); VM0(); __syncthreads(); \
        { const int _t = bp; bp = bc; bc = bn; bn = _t; } } while (0)
        int j = 1;
        for (; j + 1 < NT; j += 2) { STEP(pB0, pB1, mnB, alB, pA0, pA1, alA, j); STEP(pA0, pA1, mnA, alA, pB0, pB1, alB, j + 1); }
        STEP(pB0, pB1, mnB, alB, pA0, pA1, alA, j);
#undef STEP
        finishSM(pB0, pB1, alB, l_reg, pa0, pa1, pa2, pa3); SBAR();
        pv_d0(o, vb0 + bp * SHM_V, pa0, pa1, pa2, pa3);
    } else {
        f32x16 p0, p1; float mn, al;
        DMA(0, 0); VM0(); __syncthreads();
        for (int j = 0; j < NT; ++j) {
            const int bs = j & 1;
            if (j + 1 < NT) DMA((j + 1) * KVBLK, bs ^ 1);
            SBAR(); qkt<DQK>(p0, p1, K_lds + bs * SHM_K, qr, qx, r32, hi); partialSM<DQK>(p0, p1, m_reg, mn, al);
            RESC(al);
            finishSM(p0, p1, al, l_reg, pa0, pa1, pa2, pa3); SBAR();
            pv_d0(o, vb0 + bs * SHM_V, pa0, pa1, pa2, pa3);
            VM0(); __syncthreads();
        }
    }
    if (hi == 0) li_l[r32] = l_reg; asm volatile("s_waitcnt lgkmcnt(0)" ::: "memory");
    float rli[16];
#pragma unroll
    for (int r = 0; r < 16; ++r) rli[r] = __builtin_amdgcn_rcpf(li_l[crow(r, hi)]);
    if constexpr (O8) { unsigned char* Ow = (unsigned char*)Ob + (long)(wid * QBLK) * ldo;
#pragma unroll
        for (int r = 0; r < 16; ++r) { const int orow = crow(r, hi);
#pragma unroll
            for (int d0 = 0; d0 < 4; ++d0) Ow[(long)orow * ldo + d0 * 32 + r32] = (unsigned char)__builtin_amdgcn_cvt_pk_fp8_f32(o[d0][r] * rli[r], 0.0f, 0, false); } }
    else { bf16_t* Ow = Ob + (long)(wid * QBLK) * ldo;
#pragma unroll
    for (int r = 0; r < 16; ++r) { const int orow = crow(r, hi);
#pragma unroll
        for (int d0 = 0; d0 < 4; ++d0) Ow[(long)orow * ldo + d0 * 32 + r32] = (bf16_t)f2bf(o[d0][r] * rli[r]); } }
    asm volatile("s_waitcnt vmcnt(0)" ::: "memory");
    __syncthreads();
#undef GLDS
#undef DMA
#undef VM0
#undef RESC
}
}

struct Args { const float* in[28]; float* out; unsigned char* ws; int ph_lo, ph_hi; };
typedef const __attribute__((address_space(4))) Args* KArgs;
struct Frame {
    LAS unsigned char* lds; char* ldsg;
    unsigned* ctl; unsigned char* ws; KArgs ka;
    int tid, lane, wave, vcu, G, gw, NGW;
};
#define PHASE_BEGIN(F) __syncthreads(); Frame P = (F); { int _l; asm volatile("v_mbcnt_lo_u32_b32 %0, -1, 0\n\tv_mbcnt_hi_u32_b32 %0, -1, %0" : "=v"(_l)); long _z = 0; asm volatile("" : "+s"(_z)); unsigned char* _w = (F).ka->ws + _z; P.ws = _w; P.ctl = (unsigned*)_w;     \
    P.lane = _l; P.tid = P.wave * 64 + _l; P.gw = P.vcu * 8 + P.wave; }
enum { I_X = 0, I_C, I_CTX, I_CCTX, I_ADAW, I_ADAB, I_LNMG, I_LNMB, I_LNFG, I_LNFB, I_ABWIN, I_ABWOUT, I_DLAM, I_SUBLN, I_QNG, I_KNG,
       I_MDOWN, I_MQNG, I_MUQ, I_MKVNG, I_MUKV, I_MWO, I_RW, I_RB, I_EWIN, I_EWOUT, I_SWIN, I_SWOUT };

__device__ __forceinline__ int tok_row(int layer, int t) { return layer ? (t >> 11) * RPB + CTXL + (t & 2047) : t; }

__constant__ float INV128[32] = { 1.f, 0.749894202f, 0.562341332f, 0.421696514f, 0.316227764f, 0.237137392f, 0.177827939f, 0.133352146f, 0.100000001f, 0.0749894157f, 0.0562341288f, 0.0421696492f,
    0.0316227786f, 0.0237137359f, 0.0177827943f, 0.0133352149f, 0.00999999978f, 0.00749894232f, 0.00562341325f, 0.00421696482f, 0.00316227786f, 0.00237137382f, 0.00177827943f, 0.00133352145f,
    0.00100000005f, 0.000749894185f, 0.000562341302f, 0.000421696546f, 0.000316227786f, 0.000237137385f, 0.00017782794f, 0.00013335215f };

__device__ __forceinline__ f32x2 sincos_d(double a) {
    const double twopi = 6.283185307179586476925287;
    const double k = __builtin_rint(a / twopi); const double r = a - k * twopi, r2 = r * r;
    double ts = r, tc = 1.0, ss = r, cc = 1.0;
#pragma unroll 1
    for (int n = 1; n <= 15; ++n) { tc *= -r2 / (double)((2 * n - 1) * (2 * n)); cc += tc; ts *= -r2 / (double)((2 * n) * (2 * n + 1)); ss += ts; }
    return (f32x2){(float)cc, (float)ss};
}

__device__ __forceinline__ int fresh_lane() { int l; asm volatile("v_mbcnt_lo_u32_b32 %0, -1, 0\n\tv_mbcnt_hi_u32_b32 %0, -1, %0" : "=v"(l)); return l; }
__device__ __forceinline__ int fresh_tid(const Frame& F) { return F.wave * 64 + fresh_lane(); }
__device__ __forceinline__ void transpose_item(const float* W, int K, int N, bf16_t* WT, int k0, int n0, int drow0, LAS float* scr, int lane) {
#pragma unroll 8
    for (int i = 0; i < 32; ++i) { const int kk = 2 * i + (lane >> 5); scr[kk * 33 + (lane & 31)] = W[(size_t)(k0 + kk) * N + n0 + (lane & 31)]; }
    asm volatile("s_waitcnt lgkmcnt(0)" ::: "memory");
    const int c = lane & 7;
#pragma unroll
    for (int j = 0; j < 4; ++j) { const int n = (lane >> 3) + 8 * j; const LAS float* s = scr + (8 * c) * 33 + n;
        u32x4 o; o.x = pk2(s[0 * 33], s[1 * 33]); o.y = pk2(s[2 * 33], s[3 * 33]); o.z = pk2(s[4 * 33], s[5 * 33]); o.w = pk2(s[6 * 33], s[7 * 33]);
        *(u32x4*)(WT + (size_t)(drow0 + n) * K + k0 + 8 * c) = o; }
    asm volatile("s_waitcnt lgkmcnt(0)" ::: "memory");
}
struct QItem { const float* W; int N, n0, drow; signed char* Q; float* SW; };
template <int KW, int NC, class Dec, bool F8 = false>
__device__ __forceinline__ void quant_loop(Frame& F, int nitems, const Dec& dec, int first) {
    LAS unsigned short* scr = (LAS unsigned short*)(F.lds + F.wave * 16384);
    LAS float* PM = (LAS float*)(F.lds + 131072);
    constexpr int K = 8 * KW, CH = KW / 16, LPR = NC / 4, RPI = 64 / LPR, NL = KW / RPI;
    static_assert(KW * NC * 2 <= 16384 && (NC == 32 || NC == 64), "quant_loop tile");
    const int k0 = F.wave * KW, rg = F.lane / LPR, c4 = (F.lane % LPR) * 4;
    f32x4 regs[NL]; QItem cur, nxt;
    int it = first; if (it >= nitems) return;
    dec(it, cur);
#pragma unroll
    for (int i = 0; i < NL; ++i) regs[i] = __builtin_nontemporal_load((const f32x4*)(cur.W + (size_t)(k0 + RPI * i + rg) * cur.N + cur.n0 + c4));
    for (;;) {
        f32x4 am = {0.f, 0.f, 0.f, 0.f};
#pragma unroll
        for (int i = 0; i < NL; ++i) { const f32x4 w = regs[i]; am[0] = fmaxf(am[0], fabsf(w[0])); am[1] = fmaxf(am[1], fabsf(w[1])); am[2] = fmaxf(am[2], fabsf(w[2])); am[3] = fmaxf(am[3], fabsf(w[3]));
            const int sw = (((RPI * i) >> 4) & 15) << 1;
            const unsigned lo = cvt_pk_bf16(w[0], w[1]), hi = cvt_pk_bf16(w[2], w[3]);
            *(LAS u32x2*)(scr + (RPI * i + rg) * NC + (c4 ^ (sw & 28))) = (sw & 2) ? (u32x2){hi, lo} : (u32x2){lo, hi}; }
#pragma unroll
        for (int q = 0; q < 4; ++q) { float v = am[q];
#pragma unroll
            for (int o = LPR; o < 64; o <<= 1) v = fmaxf(v, __shfl_xor(v, o));
            am[q] = v; }
        if (F.lane < LPR) *(LAS f32x4*)(PM + F.wave * NC + c4) = am;
        __syncthreads();
        if (F.tid < NC) { float m = 0.f;
#pragma unroll
            for (int w = 0; w < 8; ++w) m = fmaxf(m, PM[w * NC + F.tid]);
            PM[512 + F.tid] = m > 0.f ? (F8 ? 448.0f : 127.0f) / m : 0.f; cur.SW[cur.drow + F.tid] = m * (1.0f / (F8 ? 448.0f : 127.0f)); }
        __syncthreads();
        const int itn = it + F.G; const bool has_next = itn < nitems;
        if (has_next) { dec(itn, nxt);
#pragma unroll
            for (int i = 0; i < NL; ++i) regs[i] = __builtin_nontemporal_load((const f32x4*)(nxt.W + (size_t)(k0 + RPI * i + rg) * nxt.N + nxt.n0 + c4)); }
#pragma unroll 1
        for (int pass = 0; pass < NC * CH / 64; ++pass) { const int cidx = pass * 64 + F.lane, n = cidx / CH, kb = (cidx % CH) * 16; const float inv = PM[512 + n]; u32x4 o;
#pragma unroll
            for (int d = 0; d < 4; ++d) { float x[4];
#pragma unroll
                for (int e = 0; e < 4; ++e) x[e] = bf2f(scr[(kb + d * 4 + e) * NC + (n ^ (((kb >> 4) & 15) << 1))]);
                if constexpr (F8) { int w = 0; w = __builtin_amdgcn_cvt_pk_fp8_f32(x[0] * inv, x[1] * inv, w, false); w = __builtin_amdgcn_cvt_pk_fp8_f32(x[2] * inv, x[3] * inv, w, true); o[d] = (unsigned)w; }
                else o[d] = q8x4(x[0], x[1], x[2], x[3], inv); }
            *(u32x4*)(cur.Q + (size_t)(cur.drow + n) * K + k0 + kb) = o; }
        __syncthreads();
        if (!has_next) break;
        it = itn; cur = nxt;
    }
}
struct DecDense256 { KArgs ka; unsigned char* ws;
    static constexpr int NITEMS = 144 + 64 + 34 + 64;
    __device__ __forceinline__ void operator()(int it, QItem& p) const { float* SWD = (float*)(ws + WS_SWD); int r = it;
        if (r < 144) { p.W = ka->in[I_ABWIN]; p.N = ABW; p.Q = (signed char*)(ws + WS_W_IN); p.SW = SWD + SWD_IN; }
        else if ((r -= 144) < 64) { p.W = ka->in[I_ABWOUT]; p.N = 2048; p.Q = (signed char*)(ws + WS_W_OUT); p.SW = SWD + SWD_OUT; }
        else if ((r -= 64) < 34) { p.W = ka->in[I_MDOWN]; p.N = 1088; p.Q = (signed char*)(ws + WS_W_DOWN); p.SW = SWD + SWD_DOWN; }
        else { r -= 34; p.W = ka->in[I_MWO]; p.N = 2048; p.Q = (signed char*)(ws + WS_W_O); p.SW = SWD + SWD_O; }
        p.n0 = r * 32; p.drow = p.n0; }
};
struct DecDense64 { KArgs ka; unsigned char* ws;
    static constexpr int NITEMS = 48 + 64;
    __device__ __forceinline__ void operator()(int it, QItem& p) const { float* SWD = (float*)(ws + WS_SWD); int r = it;
        if (r < 48) { p.W = ka->in[I_MUQ]; p.N = UQ_N; p.Q = (signed char*)(ws + WS_W_UQ); p.SW = SWD + SWD_UQ; }
        else { r -= 48; p.W = ka->in[I_MUKV]; p.N = UKV_N; p.Q = (signed char*)(ws + WS_W_UKV); p.SW = SWD + SWD_UKV; }
        p.n0 = r * 64; p.drow = p.n0; }
};
struct DecExpIn { KArgs ka; unsigned char* ws; int layer;
    static constexpr int NITEMS = 65 * 32;
    __device__ __forceinline__ void operator()(int it, QItem& p) const { const int e = it >> 5, m = layer * 65 + e; p.n0 = (it & 31) * 32; p.N = 1024;
        p.W = (e < 64) ? ka->in[I_EWIN] + ((size_t)layer * 64 + e) * 2048 * 1024 : ka->in[I_SWIN] + (size_t)layer * 2048 * 1024;
        p.drow = (p.n0 < 512) ? ((p.n0 >> 7) * 256 + (p.n0 & 127)) : (((p.n0 - 512) >> 7) * 256 + 128 + ((p.n0 - 512) & 127));
        p.Q = (signed char*)(ws + WS_EXP_IN + (size_t)m * EXP_IN_BYTES); p.SW = (float*)(ws + WS_SW) + (size_t)m * 1024; }
};
struct DecExpOut { KArgs ka; unsigned char* ws; int layer;
    static constexpr int NITEMS = 65 * 32;
    __device__ __forceinline__ void operator()(int it, QItem& p) const { const int e = it >> 5, m = layer * 65 + e; p.n0 = (it & 31) * 64; p.N = 2048;
        p.W = (e < 64) ? ka->in[I_EWOUT] + ((size_t)layer * 64 + e) * 512 * 2048 : ka->in[I_SWOUT] + (size_t)layer * 512 * 2048;
        p.Q = (signed char*)(ws + WS_EXP_OUT + (size_t)m * EXP_OUT_BYTES); p.SW = (float*)(ws + WS_SW2) + (size_t)m * 2048; p.drow = p.n0; }
};
__device__ __forceinline__ void side_quant_experts(Frame& F, int layer);
__device__ __forceinline__ void transpose_matrix(Frame& F, const float* W, int K, int N, bf16_t* WT, int mode, int& cursor) {
    LAS float* scr = (LAS float*)(F.lds + F.wave * 16384);
    const int nblk = N / 32, nitems = (K / 64) * nblk;
    int it = (F.gw - cursor) % F.NGW; if (it < 0) it += F.NGW;
    for (; it < nitems; it += F.NGW) { const int kb = it / nblk, nb = it % nblk, n0 = nb * 32;
        int drow = n0; if (mode == 1) drow = (n0 < 512) ? ((n0 >> 7) * 256 + (n0 & 127)) : (((n0 - 512) >> 7) * 256 + 128 + ((n0 - 512) & 127));
        transpose_item(W, K, N, WT, kb * 64, n0, drow, scr, F.lane); }
    cursor = (cursor + nitems) % F.NGW;
}

__device__ __forceinline__ void p0_prologue(Frame& F) {
    {
        LAS float* act = (LAS float*)F.lds;
        LAS float* part = (LAS float*)(F.lds + 9 * 2048 * 4);
        for (int i = F.tid; i < 9 * 2048; i += 512) { const int m = i >> 11, k = i & 2047; const float v = (m < 8) ? F.ka->in[I_C][m * 2048 + k] : F.ka->in[I_CCTX][k]; act[i] = v / (1.0f + __expf(-v)); }
        __syncthreads();
        float* MOD = (float*)(F.ws + WS_MOD);
        const int l16 = F.lane & 15, kg = (F.tid >> 4);
        for (int item = F.vcu; item < 2 * 192; item += F.G) {
            const int layer = item / 192, n0 = (item % 192) * 64;
            const float* W = F.ka->in[I_ADAW] + (size_t)layer * 2048 * 12288 + n0 + l16 * 4;
            f32x4 acc[9];
#pragma unroll
            for (int m = 0; m < 9; ++m) acc[m] = (f32x4){0.f, 0.f, 0.f, 0.f};
#pragma unroll 4
            for (int j = 0; j < 64; ++j) { const int k = kg + 32 * j; const f32x4 w = *(const f32x4*)(W + (size_t)k * 12288);
#pragma unroll
                for (int m = 0; m < 9; ++m) acc[m] += w * act[m * 2048 + k]; }
#pragma unroll
            for (int m = 0; m < 9; ++m)
#pragma unroll
                for (int q = 0; q < 4; ++q) { float v = acc[m][q]; v += __shfl_xor(v, 16); v += __shfl_xor(v, 32); acc[m][q] = v; }
            if (F.lane < 16) {
#pragma unroll
                for (int m = 0; m < 9; ++m) *(LAS f32x4*)(part + (F.wave * 9 + m) * 64 + l16 * 4) = acc[m]; }
            __syncthreads();
            for (int i = F.tid; i < 9 * 64; i += 512) { const int m = i >> 6, n = i & 63; float s = 0.f;
#pragma unroll
                for (int w = 0; w < 8; ++w) s += part[(w * 9 + m) * 64 + n];
                MOD[((size_t)layer * 9 + m) * 12288 + n0 + n] = s + F.ka->in[I_ADAB][layer * 12288 + n0 + n]; }
            __syncthreads();
        }
    }
    {
        f32x2* tab = (f32x2*)(F.ws + WS_TAB);
        for (int i = F.gw * 64 + F.lane; i < 512 + 1024 + 1024 + 2048; i += F.NGW * 64) {
            int pos, f; double inv; f32x2* dst;
            if (i < 512) { pos = i >> 4; f = i & 15; inv = (double)INV128[2 * f]; dst = tab + TAB64R / 8 + i; }
            else if (i < 1536) { const int j = i - 512; pos = j >> 4; f = j & 15; inv = (double)INV128[2 * f]; dst = tab + TAB64C / 8 + j; }
            else if (i < 2560) { const int j = i - 1536; pos = j >> 5; f = j & 31; inv = (double)INV128[f]; dst = tab + TAB128R / 8 + j; }
            else { const int j = i - 2560; pos = j >> 5; f = j & 31; inv = (double)INV128[f]; dst = tab + TAB128C / 8 + j; }
            *dst = sincos_d((double)(float)((float)pos * (float)inv));
        }
        u32x4* z = (u32x4*)(F.ws + WS_W_DOWN + (size_t)1088 * D);
        for (int i = F.gw * 64 + F.lane; i < (DOWN_N - 1088) * D / 16; i += F.NGW * 64) z[i] = (u32x4){0u, 0u, 0u, 0u};
        for (int i = F.gw * 64 + F.lane; i < DOWN_N - 1088; i += F.NGW * 64) ((float*)(F.ws + WS_SWD))[SWD_DOWN + 1088 + i] = 0.f;
    }
    {
        { DecDense256 d{F.ka, F.ws}; quant_loop<256, 32>(F, DecDense256::NITEMS - 64, d, F.vcu); __syncthreads();
          quant_loop<256, 32, DecDense256, true>(F, DecDense256::NITEMS, d, DecDense256::NITEMS - 64 + F.vcu); }
        __syncthreads();
        { DecDense64 d{F.ka, F.ws}; quant_loop<64, 64>(F, DecDense64::NITEMS, d, F.vcu); }
        __syncthreads();
        int cursor = 0;
        for (int l = 0; l < 2; ++l) transpose_matrix(F, F.ka->in[I_RW] + (size_t)l * 2048 * 64, 2048, 64, (bf16_t*)(F.ws + WS_ROUTER + (size_t)l * 64 * 2048 * 2), 0, cursor);
    }
}

__device__ __forceinline__ void side_quant_experts(Frame& F, int layer) {
    __syncthreads();
    const unsigned* qw = (const unsigned*)(F.ws + WS_CTL) + CW_QW + layer * 32;
    const int q0 = min((int)__hip_atomic_load(qw, RLX_AGENT), DecExpIn::NITEMS), q1 = min((int)__hip_atomic_load(qw + 16, RLX_AGENT), DecExpOut::NITEMS);
    { DecExpIn d{F.ka, F.ws, layer}; quant_loop<256, 32>(F, DecExpIn::NITEMS, d, q0 + (int)blockIdx.x); }
    __syncthreads();
    { DecExpOut d{F.ka, F.ws, layer}; quant_loop<64, 64, DecExpOut, true>(F, DecExpOut::NITEMS, d, q1 + (int)blockIdx.x); }
    __syncthreads();
}
__device__ __forceinline__ void tail_quant(Frame& F, int layer, int n_in, int n_out) {
    unsigned* qw = (unsigned*)(F.ws + WS_CTL) + CW_QW + layer * 32;
    LAS int* slot = (LAS int*)(F.lds + QSLOT_OFF);
#pragma unroll 1
    for (int n = 0; n < n_in; ++n) {
        __syncthreads();
        if (F.tid == 0) *slot = (int)__hip_atomic_fetch_add(qw, 1u, RLX_AGENT);
        __syncthreads();
        const int it = *slot;
        if (it < DecExpIn::NITEMS) { DecExpIn d{F.ka, F.ws, layer}; quant_loop<256, 32>(F, it + 1, d, it); }
    }
#pragma unroll 1
    for (int n = 0; n < n_out; ++n) {
        __syncthreads();
        if (F.tid == 0) *slot = (int)__hip_atomic_fetch_add(qw + 16, 1u, RLX_AGENT);
        __syncthreads();
        const int it = *slot;
        if (it < DecExpOut::NITEMS) { DecExpOut d{F.ka, F.ws, layer}; quant_loop<64, 64, DecExpOut, true>(F, it + 1, d, it); }
    }
    __syncthreads();
}
__device__ __forceinline__ bool is_tail_wg(int nunits, int G, int c) { const int mx = (nunits + G - 1) / G, mine = c < nunits ? (nunits - c + G - 1) / G : 0; return mine < mx; }
__device__ __forceinline__ const float* x_src(Frame& F, int layer, int r) {
    if (layer) return (const float*)(F.ws + WS_X) + (size_t)r * D;
    const int b = r / RPB, i = r - b * RPB;
    return (i < CTXL) ? F.ka->in[I_CTX] + ((size_t)b * CTXL + i) * D : F.ka->in[I_X] + ((size_t)b * SEQ + (i - CTXL)) * D;
}
__device__ __forceinline__ const float* mod_row(Frame& F, int layer, int r) { const int b = r / RPB, i = r - b * RPB; return (const float*)(F.ws + WS_MOD) + ((size_t)layer * 9 + ((i < CTXL) ? 8 : b)) * 12288; }

__device__ __forceinline__ void ld8f(const float* p, float (&v)[8]) { const f32x4 a = *(const f32x4*)p, b = *(const f32x4*)(p + 4); v[0] = a[0]; v[1] = a[1]; v[2] = a[2]; v[3] = a[3]; v[4] = b[0]; v[5] = b[1]; v[6] = b[2]; v[7] = b[3]; }
__device__ __forceinline__ void ld8f_nt(const float* p, float (&v)[8]) { const f32x4 a = __builtin_nontemporal_load((const f32x4*)p), b = __builtin_nontemporal_load((const f32x4*)(p + 4)); v[0] = a[0]; v[1] = a[1]; v[2] = a[2]; v[3] = a[3]; v[4] = b[0]; v[5] = b[1]; v[6] = b[2]; v[7] = b[3]; }
__device__ __forceinline__ void ld8l(const LAS float* p, float (&v)[8]) { const f32x4 a = *(const LAS f32x4*)p, b = *(const LAS f32x4*)(p + 4); v[0] = a[0]; v[1] = a[1]; v[2] = a[2]; v[3] = a[3]; v[4] = b[0]; v[5] = b[1]; v[6] = b[2]; v[7] = b[3]; }
__device__ __forceinline__ void st8f(float* p, const float (&v)[8]) { *(f32x4*)p = (f32x4){v[0], v[1], v[2], v[3]}; *(f32x4*)(p + 4) = (f32x4){v[4], v[5], v[6], v[7]}; }
__device__ __forceinline__ void unpk8(const u32x4 w, float (&v)[8]) {
#pragma unroll
    for (int e = 0; e < 4; ++e) { v[2 * e] = bflo(w[e]); v[2 * e + 1] = bfhi(w[e]); } }
__device__ __forceinline__ void unfp8(const u32x2 w, float (&v)[8]) {
#pragma unroll
    for (int d = 0; d < 2; ++d) { const f32x2 a = __builtin_amdgcn_cvt_pk_f32_fp8((int)w[d], false), b = __builtin_amdgcn_cvt_pk_f32_fp8((int)w[d], true); v[4 * d] = a.x; v[4 * d + 1] = a.y; v[4 * d + 2] = b.x; v[4 * d + 3] = b.y; } }
__device__ __forceinline__ u32x4 pk8(const float (&v)[8]) { u32x4 w;
#pragma unroll
    for (int e = 0; e < 4; ++e) w[e] = pk2(v[2 * e], v[2 * e + 1]);
    return w; }

__device__ __forceinline__ void quant_row_store(const float (&v)[4][8], signed char* dst, float* scale, int lane) {
    float am = 0.f;
#pragma unroll
    for (int j = 0; j < 4; ++j)
#pragma unroll
        for (int e = 0; e < 8; ++e) am = fmaxf(am, fabsf(v[j][e]));
#pragma unroll
    for (int o = 1; o < 64; o <<= 1) am = fmaxf(am, __shfl_xor(am, o));
    const float inv = am > 0.f ? 127.0f / am : 0.f;
    if (lane == 0) *scale = am * (1.0f / 127.0f);
#pragma unroll
    for (int j = 0; j < 4; ++j) { u32x2 w;
#pragma unroll
        for (int d = 0; d < 2; ++d) w[d] = q8x4(v[j][d * 4], v[j][d * 4 + 1], v[j][d * 4 + 2], v[j][d * 4 + 3], inv);
        *(u32x2*)(dst + 512 * j + 8 * lane) = w; }
}
__device__ __forceinline__ void quant_row512_store(const float (&v)[8], signed char* dst, float* scale, int lane) {
    float am = 0.f;
#pragma unroll
    for (int e = 0; e < 8; ++e) am = fmaxf(am, fabsf(v[e]));
#pragma unroll
    for (int o = 1; o < 64; o <<= 1) am = fmaxf(am, __shfl_xor(am, o));
    const float inv = am > 0.f ? 127.0f / am : 0.f;
    if (lane == 0) *scale = am * (1.0f / 127.0f);
    u32x2 w;
#pragma unroll
    for (int d = 0; d < 2; ++d) w[d] = q8x4(v[d * 4], v[d * 4 + 1], v[d * 4 + 2], v[d * 4 + 3], inv);
    *(u32x2*)(dst + 8 * lane) = w;
}

template <int R> __device__ __forceinline__ void p1_rows(Frame& F, int t0, int i) {
    const LAS float* PA = (const LAS float*)F.lds;
    float x[R][4][8]; int var[R];
#pragma unroll
    for (int q = 0; q < R; ++q) { const int r = t0 + i + 8 * q; const float* xs = x_src(F, 0, r); var[q] = ((r % RPB) < CTXL) ? 2 : 0;
#pragma unroll
        for (int j = 0; j < 4; ++j) ld8f_nt(xs + 512 * j + 8 * F.lane, x[q][j]); }
#pragma unroll
    for (int q = 0; q < R; ++q) { const int r = t0 + i + 8 * q;
#pragma unroll
        for (int j = 0; j < 4; ++j) { const int c = 512 * j + 8 * F.lane; float sh[8], sc[8]; ld8l(PA + var[q] * 2048 + c, sh); ld8l(PA + (var[q] + 1) * 2048 + c, sc);
#pragma unroll
            for (int e = 0; e < 8; ++e) x[q][j][e] = x[q][j][e] * (1.0f + sc[e]) + sh[e]; }
        quant_row_store(x[q], (signed char*)(F.ws + WS_H8) + (size_t)r * D, (float*)(F.ws + WS_SA) + r, F.lane); }
}
__device__ __forceinline__ void p1_modulate(Frame& F) {
    LAS float* PA = (LAS float*)F.lds;
    constexpr int BR = 72, nblk = T_ALL / BR;
    const float* MOD = (const float*)(F.ws + WS_MOD);
    for (int blk = F.vcu; blk < nblk; blk += F.G) {
        const int t0 = blk * BR, b = t0 / RPB;
        __syncthreads();
        { const int c = F.tid * 4; const float* mb = MOD + (size_t)b * 12288; const float* mc = MOD + (size_t)8 * 12288;
          *(LAS f32x4*)(PA + c) = *(const f32x4*)(mb + c); *(LAS f32x4*)(PA + 2048 + c) = *(const f32x4*)(mb + 2048 + c);
          *(LAS f32x4*)(PA + 4096 + c) = *(const f32x4*)(mc + c); *(LAS f32x4*)(PA + 6144 + c) = *(const f32x4*)(mc + 2048 + c); }
        __syncthreads();
        for (int i = F.wave; i < BR; i += 16) { if (i + 8 < BR) p1_rows<2>(F, t0, i); else p1_rows<1>(F, t0, i); }
    }
}

__device__ __forceinline__ void p_post_ab(Frame& F) {
    bf16_t* P = (bf16_t*)(F.ws + WS_PROJ);
    const f32x2* t64r = (const f32x2*)(F.ws + WS_TAB + TAB64R); const f32x2* t64c = (const f32x2*)(F.ws + WS_TAB + TAB64C);
    const f32x2* t128r = (const f32x2*)(F.ws + WS_TAB + TAB128R); const f32x2* t128c = (const f32x2*)(F.ws + WS_TAB + TAB128C);
    const float* qg = F.ka->in[I_QNG]; const float* kg = F.ka->in[I_KNG];
    for (int r = F.gw; r < T_ALL; r += F.NGW) {
        const int b = r / RPB, i = r - b * RPB; const bool lat = i >= CTXL; const int pos = i - CTXL, gr = pos >> 6, gc = pos & 63;
        bf16_t* row = P + (size_t)r * ABW;
        if (lat) {
            bf16_t* blk = row + F.lane * 32; const f32x2* tb = (F.lane & 1) ? t64c + gc * 16 : t64r + gr * 16;
            u32x4 w[4];
#pragma unroll
            for (int q = 0; q < 4; ++q) w[q] = *(const u32x4*)(blk + 8 * q);
#pragma unroll
            for (int q = 0; q < 2; ++q)
#pragma unroll
                for (int e = 0; e < 4; ++e) { const unsigned a = w[q][e], bq = w[q + 2][e]; const f32x2 c0 = tb[q * 8 + e * 2], c1 = tb[q * 8 + e * 2 + 1];
                    const float a0 = bflo(a), a1 = bfhi(a), b0 = bflo(bq), b1 = bfhi(bq);
                    w[q][e] = pk2(a0 * c0.x - b0 * c0.y, a1 * c1.x - b1 * c1.y); w[q + 2][e] = pk2(b0 * c0.x + a0 * c0.y, b1 * c1.x + a1 * c1.y); }
#pragma unroll
            for (int q = 0; q < 4; ++q) *(u32x4*)(blk + 8 * q) = w[q];
        }
#pragma unroll
        for (int pass = 0; pass < 2; ++pass) {
            const int head = pass * 8 + (F.lane >> 3), s = F.lane & 7; const bool act = head < 10;
            bf16_t* hp = row + (head < 8 ? QB_OFF + head * 128 : KB_OFF + (head - 8) * 128); const float* g = head < 8 ? qg : kg;
            float v[4][4]; float ss = 0.f;
            if (act) {
#pragma unroll
                for (int q = 0; q < 4; ++q) { const int c = (q >> 1) * 64 + (q & 1) * 32 + s * 4; const u32x2 w = *(const u32x2*)(hp + c);
                    v[q][0] = bflo(w.x); v[q][1] = bfhi(w.x); v[q][2] = bflo(w.y); v[q][3] = bfhi(w.y);
#pragma unroll
                    for (int e = 0; e < 4; ++e) ss += v[q][e] * v[q][e]; }
            }
            ss += __shfl_xor(ss, 1); ss += __shfl_xor(ss, 2); ss += __shfl_xor(ss, 4);
            if (act) {
                const float rs = 1.0f / sqrtf(ss * (1.0f / 128.0f) + 1e-6f);
#pragma unroll
                for (int q = 0; q < 4; ++q) { const int c = (q >> 1) * 64 + (q & 1) * 32 + s * 4;
#pragma unroll
                    for (int e = 0; e < 4; ++e) v[q][e] = v[q][e] * rs * g[c + e]; }
                if (lat) {
#pragma unroll
                    for (int half = 0; half < 2; ++half) { const f32x2* tb = (half ? t128c + gc * 32 : t128r + gr * 32) + s * 4;
#pragma unroll
                        for (int e = 0; e < 4; ++e) { const f32x2 cs = tb[e]; const float a = v[half * 2][e], bq = v[half * 2 + 1][e];
                            v[half * 2][e] = a * cs.x - bq * cs.y; v[half * 2 + 1][e] = bq * cs.x + a * cs.y; } }
                }
#pragma unroll
                for (int q = 0; q < 4; ++q) { const int c = (q >> 1) * 64 + (q & 1) * 32 + s * 4; u32x2 w; w.x = pk2(v[q][0], v[q][1]); w.y = pk2(v[q][2], v[q][3]); *(u32x2*)(hp + c) = w; }
            }
        }
    }
}

__device__ __forceinline__ void attn_ab_unit(Frame& F, int k) {
    const bf16_t* P = (const bf16_t*)(F.ws + WS_PROJ); bf16_t* MG = (bf16_t*)(F.ws + WS_MERGED); bf16_t* OA = (bf16_t*)(F.ws + WS_OA);
    if (k < 3) {
        const int u = (k < 2) ? F.vcu + k * F.G : 512 + F.vcu; if (k == 2 ? F.vcu >= 64 : u >= 512) return;
        int b, h, q0, nk;
        if (u < 512) { const int grp = u >> 5, w = u & 31; b = grp >> 1; h = (grp & 1) * 4 + (w >> 3); q0 = CTXL + (w & 7) * 256; nk = RPB; }
        else { const int v = u - 512; b = v >> 3; h = v & 7; q0 = 0; nk = CTXL; }
        const size_t kr = (size_t)b * RPB, qr = kr + q0; const int kvh = h >> 2;
        att::attn_unit<128, true, false>(P + qr * ABW + QB_OFF + h * 128, ABW, P + kr * ABW + KB_OFF + kvh * 128, ABW, nullptr, 0, P + kr * ABW + VB_OFF + kvh * 128, ABW,
                                         MG + qr * D + 1024 + h * 128, D, nk, 0, nullptr, nullptr, F.ldsg, F.lds, fresh_tid(F));
    } else {
        const int j = k - 3, u = (j < 4) ? F.vcu + j * F.G : 1024 + F.vcu; if (j == 4 ? F.vcu >= 128 : u >= 1024) return;
        int b, vh, q0, nk;
        if (u < 1024) { const int grp = u >> 4, w = u & 15; b = grp >> 3; vh = (grp & 7) * 2 + (w >> 3); q0 = CTXL + (w & 7) * 256; nk = RPB; }
        else { const int v = u - 1024; b = v >> 4; vh = v & 15; q0 = 0; nk = CTXL; }
        const size_t kr = (size_t)b * RPB, qr = kr + q0;
        att::attn_unit<64, true, false>(P + qr * ABW + QA_OFF + vh * 64, ABW, P + kr * ABW + KA_OFF + vh * 64, ABW, nullptr, 0, P + kr * ABW + VA_OFF + (vh >> 1) * 128, ABW,
                                        OA + qr * D + vh * 128, D, nk, 0, nullptr, nullptr, F.ldsg, F.lds, fresh_tid(F));
    }
}
__device__ __forceinline__ void p_attn_ab(Frame& F) {
    const int sk6 = min((int)blockIdx.x / 43, 5), side_k = (sk6 < 1) ? 1 : (sk6 < 2 ? 2 : sk6 + 2);
#pragma unroll 1
    for (int k = 0; k < side_k; ++k) attn_ab_unit(F, k);
    side_quant_experts(F, 0);
#pragma unroll 1
    for (int k = side_k; k < 8; ++k) attn_ab_unit(F, k);
}

__device__ __forceinline__ void p_diff_combine(Frame& F) {
    const bf16_t* OA = (const bf16_t*)(F.ws + WS_OA); const bf16_t* MG = (const bf16_t*)(F.ws + WS_MERGED);
    signed char* MG8 = (signed char*)(F.ws + WS_MG8); float* SMG = (float*)(F.ws + WS_SMG);
    const float* lp = F.ka->in[I_DLAM]; const float* sg = F.ka->in[I_SUBLN];
    const float d1 = wave_sum(lp[F.lane] * lp[64 + F.lane]), d2 = wave_sum(lp[128 + F.lane] * lp[192 + F.lane]);
    const float lam = __expf(d1) - __expf(d2) + LAM_INIT0;
    const int h = F.lane >> 3, s = F.lane & 7;
    float g[16];
#pragma unroll
    for (int e = 0; e < 16; ++e) g[e] = sg[s * 16 + e] * (1.0f - LAM_INIT0);
    for (int r = F.gw; r < T_ALL; r += F.NGW) {
        const bf16_t* o1 = OA + (size_t)r * D + (2 * h) * 128 + s * 16; const bf16_t* o2 = o1 + 128; const bf16_t* ob = MG + (size_t)r * D + 1024 + h * 128 + s * 16;
        float v[16], vb[16]; float ss = 0.f;
#pragma unroll
        for (int q = 0; q < 2; ++q) { const u32x4 a = *(const u32x4*)(o1 + 8 * q), bq = *(const u32x4*)(o2 + 8 * q), cq = *(const u32x4*)(ob + 8 * q);
#pragma unroll
            for (int e = 0; e < 4; ++e) { v[q * 8 + 2 * e] = bflo(a[e]) - lam * bflo(bq[e]); v[q * 8 + 2 * e + 1] = bfhi(a[e]) - lam * bfhi(bq[e]); vb[q * 8 + 2 * e] = bflo(cq[e]); vb[q * 8 + 2 * e + 1] = bfhi(cq[e]); } }
#pragma unroll
        for (int e = 0; e < 16; ++e) ss += v[e] * v[e];
        ss += __shfl_xor(ss, 1); ss += __shfl_xor(ss, 2); ss += __shfl_xor(ss, 4);
        const float rs = 1.0f / sqrtf(ss * (1.0f / 128.0f) + 1e-5f);
        float am = 0.f;
#pragma unroll
        for (int e = 0; e < 16; ++e) { v[e] = v[e] * rs * g[e]; am = fmaxf(am, fmaxf(fabsf(v[e]), fabsf(vb[e]))); }
#pragma unroll
        for (int o = 1; o < 64; o <<= 1) am = fmaxf(am, __shfl_xor(am, o));
        const float inv = am > 0.f ? 127.0f / am : 0.f;
        if (F.lane == 0) SMG[r] = am * (1.0f / 127.0f);
        u32x4 wa, wb;
#pragma unroll
        for (int d = 0; d < 4; ++d) { wa[d] = q8x4(v[d * 4], v[d * 4 + 1], v[d * 4 + 2], v[d * 4 + 3], inv); wb[d] = q8x4(vb[d * 4], vb[d * 4 + 1], vb[d * 4 + 2], vb[d * 4 + 3], inv); }
        *(u32x4*)(MG8 + (size_t)r * D + h * 128 + s * 16) = wa; *(u32x4*)(MG8 + (size_t)r * D + 1024 + h * 128 + s * 16) = wb;
    }
}

__device__ __forceinline__ void p_quant_merged(Frame& F) {
    const bf16_t* MG = (const bf16_t*)(F.ws + WS_MERGED);
    for (int t = F.gw; t < T_LAT; t += F.NGW) { const int r = tok_row(1, t); float v[4][8];
#pragma unroll
        for (int j = 0; j < 4; ++j) unpk8(*(const u32x4*)(MG + (size_t)r * D + 512 * j + 8 * F.lane), v[j]);
        quant_row_store(v, (signed char*)(F.ws + WS_MG8) + (size_t)r * D, (float*)(F.ws + WS_SMG) + r, F.lane); }
}

__device__ __forceinline__ void p_post_down(Frame& F) {
    const bf16_t* DN = (const bf16_t*)(F.ws + WS_DOWN); bf16_t* KPE = (bf16_t*)(F.ws + WS_KPE);
    const f32x2* t64r = (const f32x2*)(F.ws + WS_TAB + TAB64R); const f32x2* t64c = (const f32x2*)(F.ws + WS_TAB + TAB64C);
    const float* qg = F.ka->in[I_MQNG]; const float* kvg = F.ka->in[I_MKVNG];
    for (int r = F.gw; r < T_ALL; r += F.NGW) {
        const int b = r / RPB, i = r - b * RPB; const bool lat = i >= CTXL; const int pos = i - CTXL, gr = pos >> 6, gc = pos & 63;
        const bf16_t* row = DN + (size_t)r * DOWN_N;
#pragma unroll
        for (int which = 0; which < 2; ++which) {
            const u32x4 w = *(const u32x4*)(row + which * 512 + F.lane * 8); float v[8];
#pragma unroll
            for (int e = 0; e < 4; ++e) { v[2 * e] = bflo(w[e]); v[2 * e + 1] = bfhi(w[e]); }
            float ss = 0.f;
#pragma unroll
            for (int e = 0; e < 8; ++e) ss += v[e] * v[e];
            ss = wave_sum(ss); const float rs = 1.0f / sqrtf(ss * (1.0f / 512.0f) + 1e-6f); const float* g = (which ? kvg : qg) + F.lane * 8;
#pragma unroll
            for (int e = 0; e < 8; ++e) v[e] = v[e] * rs * g[e];
            quant_row512_store(v, (signed char*)(F.ws + (which ? WS_CKVN : WS_CQN)) + (size_t)r * 512, (float*)(F.ws + (which ? WS_SCKV : WS_SCQ)) + r, F.lane);
        }
        if (F.lane < 32) {
            const int blk = F.lane >> 4, f = F.lane & 15; const float a = bf2f(row[1024 + blk * 32 + f]), bq = bf2f(row[1024 + blk * 32 + 16 + f]);
            float oa = a, ob = bq;
            if (lat) { const f32x2 cs = blk ? t64c[gc * 16 + f] : t64r[gr * 16 + f]; oa = a * cs.x - bq * cs.y; ob = bq * cs.x + a * cs.y; }
            KPE[(size_t)r * 64 + blk * 32 + f] = (bf16_t)f2bf(oa); KPE[(size_t)r * 64 + blk * 32 + 16 + f] = (bf16_t)f2bf(ob);
        }
    }
}

__device__ __forceinline__ void attn_mla_unit(Frame& F, int u) {
    const bf16_t* QM = (const bf16_t*)(F.ws + WS_QM); const bf16_t* KVM = (const bf16_t*)(F.ws + WS_KVM); const bf16_t* KPE = (const bf16_t*)(F.ws + WS_KPE);
    const f32x2* t64r = (const f32x2*)(F.ws + WS_TAB + TAB64R); const f32x2* t64c = (const f32x2*)(F.ws + WS_TAB + TAB64C);
    const int grp = u >> 3, b = grp >> 4, h = grp & 15, qb = u & 7; const size_t kr = (size_t)b * RPB, qr = kr + CTXL + qb * 256;
    att::attn_unit<192, true, true, true>(QM + qr * UQ_N + h * 192, UQ_N, KVM + kr * UKV_N + h * 256, UKV_N, KPE + kr * 64, 64, KVM + kr * UKV_N + h * 256 + 128, UKV_N,
                                    (bf16_t*)(F.ws + WS_MG8 + qr * D + h * 128), D, RPB, qb * 256, t64r, t64c, F.ldsg, F.lds, fresh_tid(F));
}
__device__ __forceinline__ void p_attn_mla(Frame& F) {
    const int side_n = min((int)blockIdx.x / 64, 3) + 1; int u = F.vcu, n = 0;
#pragma unroll 1
    for (; u < 1024 && n < side_n; u += F.G, ++n) attn_mla_unit(F, u);
    side_quant_experts(F, 1);
#pragma unroll 1
    for (; u < 1024; u += F.G) attn_mla_unit(F, u);
}

template <int R> __device__ __forceinline__ void ln1_rows(Frame& F, int layer, int t0, int i) {
    const LAS float* PA = (const LAS float*)F.lds;
    const unsigned char* Y1 = (const unsigned char*)(F.ws + WS_Y1); bf16_t* XB = (bf16_t*)(F.ws + WS_X); bf16_t* H = (bf16_t*)(F.ws + WS_H);
    float v[R][4][8]; u32x2 yw[R][4]; int var[R], rr[R];
#pragma unroll
    for (int q = 0; q < R; ++q) { const int r = tok_row(layer, t0 + i + 8 * q); rr[q] = r; const float* xs = x_src(F, 0, r); var[q] = (layer == 0 && (r % RPB) < CTXL) ? 3 : 0;
#pragma unroll
        for (int j = 0; j < 4; ++j) { if (layer == 0) ld8f_nt(xs + 512 * j + 8 * F.lane, v[q][j]); else unpk8(*(const u32x4*)(XB + (size_t)r * D + 512 * j + 8 * F.lane), v[q][j]); yw[q][j] = __builtin_nontemporal_load((const u32x2*)(Y1 + (size_t)r * D + 512 * j + 8 * F.lane)); } }
#pragma unroll
    for (int q = 0; q < R; ++q) {
        float s = 0.f;
#pragma unroll
        for (int j = 0; j < 4; ++j) { const int c = 512 * j + 8 * F.lane; float g1[8], y[8]; ld8l(PA + (2 + var[q]) * 2048 + c, g1); unfp8(yw[q][j], y);
#pragma unroll
            for (int e = 0; e < 8; ++e) { v[q][j][e] = v[q][j][e] * ALPHA + g1[e] * y[e]; s += v[q][j][e]; } }
        const float mean = wave_sum(s) * (1.0f / D); float s2 = 0.f;
#pragma unroll
        for (int j = 0; j < 4; ++j)
#pragma unroll
            for (int e = 0; e < 8; ++e) { v[q][j][e] -= mean; s2 += v[q][j][e] * v[q][j][e]; }
        const float rstd = 1.0f / sqrtf(wave_sum(s2) * (1.0f / D) + 1e-5f);
#pragma unroll
        for (int j = 0; j < 4; ++j) { const int c = 512 * j + 8 * F.lane; float a[8], bq[8], xo[8], h[8];
            ld8l(PA + c, a); ld8l(PA + 2048 + c, bq);
#pragma unroll
            for (int e = 0; e < 8; ++e) xo[e] = v[q][j][e] * rstd * a[e] + bq[e];
            *(u32x4*)(XB + (size_t)rr[q] * D + c) = pk8(xo);
            ld8l(PA + (3 + var[q]) * 2048 + c, a); ld8l(PA + (4 + var[q]) * 2048 + c, bq);
#pragma unroll
            for (int e = 0; e < 8; ++e) { h[e] = v[q][j][e] * rstd * a[e] + bq[e]; v[q][j][e] = h[e]; }
            *(u32x4*)(H + (size_t)rr[q] * D + c) = pk8(h); }
        quant_row_store(v[q], (signed char*)(F.ws + WS_H8) + (size_t)rr[q] * D, (float*)(F.ws + WS_SA) + rr[q], F.lane);
    }
}
__device__ __forceinline__ void p_ln1(Frame& F, int layer) {
    LAS float* PA = (LAS float*)F.lds;
    const int NT = layer ? T_LAT : T_ALL, BR = layer ? 64 : 72, nblk = NT / BR, rpb = layer ? SEQ : RPB;
    const float* lg = F.ka->in[I_LNMG] + layer * D; const float* lb = F.ka->in[I_LNMB] + layer * D; const float* MOD = (const float*)(F.ws + WS_MOD) + (size_t)layer * 9 * 12288;
    for (int blk = F.vcu; blk < nblk; blk += F.G) {
        const int t0 = blk * BR, b = t0 / rpb;
        __syncthreads();
        { const int c = F.tid * 4; const f32x4 g = *(const f32x4*)(lg + c), bb = *(const f32x4*)(lb + c);
          *(LAS f32x4*)(PA + c) = g; *(LAS f32x4*)(PA + 2048 + c) = bb;
#pragma unroll
          for (int vv = 0; vv < 2; ++vv) { const float* m = MOD + (size_t)(vv ? 8 : b) * 12288; const f32x4 g1 = *(const f32x4*)(m + 2 * 2048 + c), sh2 = *(const f32x4*)(m + 3 * 2048 + c), sc2 = *(const f32x4*)(m + 4 * 2048 + c);
              *(LAS f32x4*)(PA + (2 + 3 * vv) * 2048 + c) = g1; *(LAS f32x4*)(PA + (3 + 3 * vv) * 2048 + c) = g * (1.0f + sc2); *(LAS f32x4*)(PA + (4 + 3 * vv) * 2048 + c) = bb * (1.0f + sc2) + sh2; } }
        __syncthreads();
        for (int i = F.wave; i < BR; i += 16) { if (i + 8 < BR) ln1_rows<2>(F, layer, t0, i); else ln1_rows<1>(F, layer, t0, i); }
    }
}

__device__ __forceinline__ void p_router(Frame& F, int layer) {
    const int NT = layer ? T_LAT : T_ALL, ngroups = NT / 32;
    const bf16_t* H = (const bf16_t*)(F.ws + WS_H); const bf16_t* RT = (const bf16_t*)(F.ws + WS_ROUTER + (size_t)layer * 64 * 2048 * 2);
    const float* rb = F.ka->in[I_RB] + layer * 64;
    int* LIST = (int*)(F.ws + WS_LIST); int* TS = (int*)(F.ws + WS_TOKSLOT); float* GATE = (float*)(F.ws + WS_GATE);
    unsigned* CNT = F.ctl + CW_CNT + layer * 64 * 16;
    LAS float* part = (LAS float*)F.lds;
    LAS float* SC = (LAS float*)(F.lds + 65536);
    LAS float* BS = (LAS float*)(F.lds + 65536 + 8448);
    LAS int* hist = (LAS int*)(F.lds + 65536 + 2 * 8448);
    LAS int* base = hist + 64;
    LAS int* SEL = base + 64;
    const int r32 = F.lane & 31, hi = F.lane >> 5;
    if (F.tid < 64) hist[F.tid] = 0;
    __syncthreads();
    int gi = 0;
    for (int g = F.vcu; g < ngroups; g += F.G, ++gi) {
        const int t0 = g * 32;
        {
            const bf16_t* ap = H + (size_t)tok_row(layer, t0 + r32) * D + F.wave * 256 + hi * 8;
            const bf16_t* b0p = RT + (size_t)r32 * D + F.wave * 256 + hi * 8; const bf16_t* b1p = b0p + (size_t)32 * D;
            f32x16 a0 = {}, a1 = {};
#pragma unroll
            for (int k = 0; k < 16; ++k) { const bf16x8 a = *(const bf16x8*)(ap + k * 16), w0 = *(const bf16x8*)(b0p + k * 16), w1 = *(const bf16x8*)(b1p + k * 16);
                a0 = __builtin_amdgcn_mfma_f32_32x32x16_bf16(a, w0, a0, 0, 0, 0); a1 = __builtin_amdgcn_mfma_f32_32x32x16_bf16(a, w1, a1, 0, 0, 0); }
#pragma unroll
            for (int r = 0; r < 16; ++r) { const int row = att::crow(r, hi); part[(F.wave * 32 + row) * 64 + r32] = a0[r]; part[(F.wave * 32 + row) * 64 + 32 + r32] = a1[r]; }
        }
        __syncthreads();
        for (int i = F.tid; i < 2048; i += 512) { float s = 0.f;
#pragma unroll
            for (int w = 0; w < 8; ++w) s += part[w * 2048 + i];
            const float sg = 1.0f / (1.0f + __expf(-s)); const int tk = i >> 6, e = i & 63; SC[tk * 65 + e] = sg; BS[tk * 65 + e] = sg + rb[e]; }
        __syncthreads();
        if (F.tid < 32) {
            const LAS float* bs = BS + F.tid * 65; const LAS float* sc = SC + F.tid * 65;
            float bv[64];
#pragma unroll
            for (int e = 0; e < 64; ++e) bv[e] = bs[e];
            float gs[8];
#pragma unroll
            for (int gq = 0; gq < 8; ++gq) { float m1 = -INFINITY, m2 = -INFINITY;
#pragma unroll
                for (int j = 0; j < 8; ++j) { const float v = bv[gq * 8 + j]; const float lo = fminf(v, m1); m1 = fmaxf(v, m1); m2 = fmaxf(m2, lo); }
                gs[gq] = m1 + m2; }
            unsigned gmask = 0u;
#pragma unroll
            for (int it = 0; it < 4; ++it) { float best = -INFINITY; int bi = 0;
#pragma unroll
                for (int gq = 0; gq < 8; ++gq) { const bool ok = !((gmask >> gq) & 1u) && gs[gq] > best; best = ok ? gs[gq] : best; bi = ok ? gq : bi; }
                gmask |= 1u << bi; }
#pragma unroll
            for (int e = 0; e < 64; ++e) bv[e] = ((gmask >> (e >> 3)) & 1u) ? bv[e] : -INFINITY;
            int sel[8]; float gv[8]; float gsum = 0.f;
#pragma unroll
            for (int k = 0; k < 8; ++k) { float best = -INFINITY; int be = 0;
#pragma unroll
                for (int e = 0; e < 64; ++e) { const bool ok = bv[e] > best; best = ok ? bv[e] : best; be = ok ? e : be; }
#pragma unroll
                for (int e = 0; e < 64; ++e) bv[e] = (e == be) ? -INFINITY : bv[e];
                sel[k] = be; gv[k] = sc[be]; gsum += gv[k]; }
            const int r = tok_row(layer, t0 + F.tid); const float inv = 2.5f / gsum;
#pragma unroll
            for (int k = 0; k < 8; ++k) { const int lp = atomicAdd((int*)(hist + sel[k]), 1); SEL[((gi & 3) * 32 + F.tid) * 8 + k] = (sel[k] << 16) | lp; GATE[(size_t)r * 8 + k] = gv[k] * inv; }
        }
        __syncthreads();
    }
    if (F.tid < 64) base[F.tid] = (int)__hip_atomic_fetch_add(CNT + F.tid * 16, (unsigned)hist[F.tid], RLX_AGENT);
    __syncthreads();
    gi = 0;
    for (int g = F.vcu; g < ngroups; g += F.G, ++gi) {
        if (F.tid < 256) { const int tk = F.tid >> 3, k = F.tid & 7; const int v = SEL[((gi & 3) * 32 + tk) * 8 + k], e = v >> 16, pos = base[e] + (v & 0xffff); const int r = tok_row(layer, g * 32 + tk);
            LIST[(size_t)e * LIST_CAP + pos] = r; TS[(size_t)r * 8 + k] = (e << 16) | pos; }
    }
    __syncthreads();
}

__device__ __forceinline__ int moe_tables(Frame& F, int layer) {
    LAS int* MISC = (LAS int*)(F.lds + MISC_OFF); LAS int* TT = (LAS int*)(F.lds + TTAB_OFF);
    const int NT = layer ? T_LAT : T_ALL;
    __syncthreads();
    if (F.wave == 0) {
        const unsigned* CNT = F.ctl + CW_CNT + layer * 64 * 16;
        const int c = (int)__hip_atomic_load(CNT + F.lane * 16, RLX_AGENT); const int nt = (c + 255) >> 8;
        int inc = nt;
#pragma unroll
        for (int o = 1; o < 64; o <<= 1) { const int v = __shfl_up(inc, o); if (F.lane >= o) inc += v; }
        const int start = inc - nt; MISC[F.lane] = start; MISC[80 + F.lane] = c;
        if (F.lane == 63) { MISC[64] = inc; MISC[65] = inc + NT / 256; }
    }
    __syncthreads();
    const int s64 = MISC[64], total = MISC[65];
    for (int tile = F.tid; tile < total; tile += 512) {
        int lo = 0, hi = 64;
#pragma unroll
        for (int it = 0; it < 7; ++it) { const int mid = (lo + hi + 1) >> 1; const bool ok = MISC[mid] <= tile; lo = ok ? mid : lo; hi = ok ? hi : mid - 1; }
        TT[tile] = (lo << 16) | (tile - MISC[lo]); }
    (void)s64;
    __syncthreads();
    return total;
}

__device__ __forceinline__ void p_moe_gemm1(Frame& F, int layer) {
    const int total = moe_tables(F, layer);
    LAS int* MISC = (LAS int*)(F.lds + MISC_OFF); LAS int* TT = (LAS int*)(F.lds + TTAB_OFF); LAS int* IDX = (LAS int*)(F.lds + IDXC_OFF);
    const int* LIST = (const int*)(F.ws + WS_LIST);
    typedef pg8::SchedMoe<4, EXP_IN_BYTES, (size_t)256 * D> Sch; Sch S; S.ntiles = total; S.G = F.G; S.vcu = F.vcu; S.ttab = TT; S.Bt = (const char*)(F.ws + WS_EXP_IN + (size_t)layer * 65 * EXP_IN_BYTES);
    {
        pg8::Unit u; const int fallback = tok_row(layer, 0);
        for (int i = 0; i < IDXC_UNITS && S.next(i, u); ++i) {
            if (F.tid < 256) { const int tile = u.row0 >> 8, tv = TT[tile], e = tv >> 16, p = (tv & 0xffff) * 256 + F.tid;
                int src; if (e < 64) src = (p < MISC[80 + e]) ? LIST[(size_t)e * LIST_CAP + p] : fallback; else src = tok_row(layer, p);
                IDX[i * 256 + F.tid] = src; }
        }
        __syncthreads();
    }
    pg8::EpiSwigluI8 E{(unsigned char*)(F.ws + WS_HMID), FDIM, (const float*)(F.ws + WS_SA), (const float*)(F.ws + WS_SW) + (size_t)layer * 65 * 1024, IDX};
    pg8::gemm_phase<pg8::EpiSwigluI8, Sch, true, 1>(F.lds, (const void*)(F.ws + WS_H8), D, S, E, IDX, fresh_tid(F));
    if (layer == 0 && is_tail_wg(total * 4, F.G, F.vcu)) tail_quant(F, 1, 1, 1);
}
__device__ __forceinline__ void p_quant_hmid(Frame& F, int layer) {
    const int total = moe_tables(F, layer), nrows = total * 256;
    const unsigned char* HM = (const unsigned char*)(F.ws + WS_HMID); signed char* HM8 = (signed char*)(F.ws + WS_HM8); float* SHM = (float*)(F.ws + WS_SHM);
    for (int r0 = F.gw * 4; r0 < nrows; r0 += F.NGW * 4) {
        u32x2 w[4];
#pragma unroll
        for (int q = 0; q < 4; ++q) w[q] = *(const u32x2*)(HM + (size_t)(r0 + q) * FDIM + 8 * F.lane);
#pragma unroll
        for (int q = 0; q < 4; ++q) { float v[8]; unfp8(w[q], v); quant_row512_store(v, HM8 + (size_t)(r0 + q) * FDIM, SHM + r0 + q, F.lane); }
    }
}
__device__ __forceinline__ void p_moe_gemm2(Frame& F, int layer) {
    const int total = moe_tables(F, layer);
    LAS int* TT = (LAS int*)(F.lds + TTAB_OFF);
    typedef pg8::SchedMoe<8, EXP_OUT_BYTES, (size_t)256 * FDIM> Sch; Sch S; S.ntiles = total; S.G = F.G; S.vcu = F.vcu; S.ttab = TT; S.Bt = (const char*)(F.ws + WS_EXP_OUT + (size_t)layer * 65 * EXP_OUT_BYTES);
    pg8::EpiI8Fp8<2048, true> E{(unsigned char*)(F.ws + WS_Y2P), D, (const float*)(F.ws + WS_SW2), (const float*)(F.ws + WS_SW2) + (size_t)layer * 65 * 2048};
    pg8::gemm_phase<pg8::EpiI8Fp8<2048, true>, Sch, false, 2>(F.lds, (const void*)(F.ws + WS_HMID), FDIM, S, E, nullptr, fresh_tid(F));
}

__device__ __forceinline__ void p_combine_ln2(Frame& F, int layer) {
    (void)moe_tables(F, layer);
    LAS int* MISC = (LAS int*)(F.lds + MISC_OFF); LAS float* PA = (LAS float*)F.lds;
    const int NT = layer ? T_LAT : T_ALL, BR = layer ? 64 : 72, nblk = NT / BR, rpb = layer ? SEQ : RPB;
    const unsigned char* Y2 = (const unsigned char*)(F.ws + WS_Y2P);     const int* TS = (const int*)(F.ws + WS_TOKSLOT); const float* GATE = (const float*)(F.ws + WS_GATE);
    bf16_t* XB = (bf16_t*)(F.ws + WS_X); float* OUT = F.ka->out;
    const int sh0 = MISC[64] * 256;
    for (int blk = F.vcu; blk < nblk; blk += F.G) {
        const int t0 = blk * BR, b = t0 / rpb;
        __syncthreads();
        { int z = 0; asm volatile("" : "+s"(z));
          const float* lg = F.ka->in[I_LNFG + z] + layer * D; const float* lb = F.ka->in[I_LNFB + z] + layer * D; const float* MOD = (const float*)(F.ka->ws + WS_MOD) + z;
          const int c = fresh_tid(F) * 4; const f32x4 g = *(const f32x4*)(lg + c), bb = *(const f32x4*)(lb + c);
          *(LAS f32x4*)(PA + c) = g; *(LAS f32x4*)(PA + 2048 + c) = bb;
#pragma unroll
          for (int vv = 0; vv < 2; ++vv) { const float* m = MOD + ((size_t)layer * 9 + (vv ? 8 : b)) * 12288; const float* m1 = MOD + ((size_t)9 + (vv ? 8 : b)) * 12288;
              const f32x4 g2 = *(const f32x4*)(m + 5 * 2048 + c), sh1 = *(const f32x4*)(m1 + c), sc1 = *(const f32x4*)(m1 + 2048 + c);
              *(LAS f32x4*)(PA + (2 + 3 * vv) * 2048 + c) = g2; *(LAS f32x4*)(PA + (3 + 3 * vv) * 2048 + c) = g * (1.0f + sc1); *(LAS f32x4*)(PA + (4 + 3 * vv) * 2048 + c) = bb * (1.0f + sc1) + sh1; } }
        __syncthreads();
        int r = tok_row(layer, t0 + F.wave); int tsv = 0; float gtv = 0.f;
        { const int l0 = fresh_lane(); if (l0 < 8) { tsv = TS[(size_t)r * 8 + l0]; gtv = GATE[(size_t)r * 8 + l0]; } }
        for (int i = F.wave; i < BR; i += 8) {
            const int t = t0 + i, var = (layer == 0 && (r % RPB) < CTXL) ? 3 : 0;
            const int ln = fresh_lane();
            float xv[4][8]; float y[4][8]; const int tsc = tsv; const int gtc = __builtin_bit_cast(int, gtv);
#define YROW(k) (Y2 + (size_t)(__builtin_amdgcn_readfirstlane(MISC[__builtin_amdgcn_readlane(tsc, (k)) >> 16]) * 256 + (__builtin_amdgcn_readlane(tsc, (k)) & 0xffff)) * D)
#define GK(k) __builtin_bit_cast(float, __builtin_amdgcn_readlane(gtc, (k)))
            const int rcur = r;
            {
                u32x2 yw[5][4];
#pragma unroll
                for (int k = 0; k < 4; ++k)
#pragma unroll
                    for (int j = 0; j < 4; ++j) yw[k][j] = __builtin_nontemporal_load((const u32x2*)(YROW(k) + 8 * ln + 512 * j));
                { const unsigned char* yr = Y2 + (size_t)(sh0 + t) * D + 8 * ln;
#pragma unroll
                  for (int j = 0; j < 4; ++j) yw[4][j] = __builtin_nontemporal_load((const u32x2*)(yr + 512 * j)); }
                if (i + 8 < BR) { r = tok_row(layer, t + 8); if (ln < 8) { tsv = TS[(size_t)r * 8 + ln]; gtv = GATE[(size_t)r * 8 + ln]; } }
#pragma unroll
                for (int j = 0; j < 4; ++j) { float tmp[8]; unfp8(yw[4][j], y[j]);
#pragma unroll
                    for (int k = 0; k < 4; ++k) { unfp8(yw[k][j], tmp);
#pragma unroll
                        for (int e = 0; e < 8; ++e) y[j][e] += GK(k) * tmp[e]; } }
            }
            asm volatile("" ::: "memory");
            {
                u32x2 yw[4][4];
#pragma unroll
                for (int k = 0; k < 4; ++k)
#pragma unroll
                    for (int j = 0; j < 4; ++j) yw[k][j] = __builtin_nontemporal_load((const u32x2*)(YROW(4 + k) + 8 * ln + 512 * j));
#pragma unroll
                for (int j = 0; j < 4; ++j) unpk8(*(const u32x4*)(XB + (size_t)rcur * D + 512 * j + 8 * ln), xv[j]);
#pragma unroll
                for (int j = 0; j < 4; ++j) { float tmp[8];
#pragma unroll
                    for (int k = 0; k < 4; ++k) { unfp8(yw[k][j], tmp);
#pragma unroll
                        for (int e = 0; e < 8; ++e) y[j][e] += GK(4 + k) * tmp[e]; } }
            }
#undef YROW
#undef GK
            float s = 0.f;
#pragma unroll
            for (int j = 0; j < 4; ++j) { const int c = 512 * j + 8 * ln; float g2[8];
                ld8l(PA + (2 + var) * 2048 + c, g2);
#pragma unroll
                for (int e = 0; e < 8; ++e) { xv[j][e] = xv[j][e] * ALPHA + g2[e] * y[j][e]; s += xv[j][e]; } }
            const float mean = wave_sum(s) * (1.0f / D); float s2 = 0.f;
#pragma unroll
            for (int j = 0; j < 4; ++j)
#pragma unroll
                for (int e = 0; e < 8; ++e) { xv[j][e] -= mean; s2 += xv[j][e] * xv[j][e]; }
            const float rstd = 1.0f / sqrtf(wave_sum(s2) * (1.0f / D) + 1e-5f);
#pragma unroll
            for (int j = 0; j < 4; ++j) { const int c = 512 * j + 8 * ln; float a[8], bq[8], xo[8];
                ld8l(PA + c, a); ld8l(PA + 2048 + c, bq);
#pragma unroll
                for (int e = 0; e < 8; ++e) xo[e] = xv[j][e] * rstd * a[e] + bq[e];
                if (layer == 0) { *(u32x4*)(XB + (size_t)rcur * D + c) = pk8(xo); ld8l(PA + (3 + var) * 2048 + c, a); ld8l(PA + (4 + var) * 2048 + c, bq);
#pragma unroll
                    for (int e = 0; e < 8; ++e) xv[j][e] = xv[j][e] * rstd * a[e] + bq[e]; }
                else st8f(OUT + (size_t)t * D + c, xo); }
            if (layer == 0) quant_row_store(xv, (signed char*)(F.ws + WS_H8) + (size_t)rcur * D, (float*)(F.ws + WS_SA) + rcur, ln);
        }
    }
}

__device__ __forceinline__ void p_dense(Frame& F, const bf16_t* A, const bf16_t* Bt, int K, int nM, int nN, int latmap, bf16_t* O, int ldc) {
    pg8::SchedDense S; S.init(nM, nN, F.G, (int)blockIdx.x, latmap, Bt, K);
    pg8::EpiBf16 E{O, ldc};
    pg8::gemm_phase<pg8::EpiBf16, pg8::SchedDense, false>(F.lds, A, K, S, E, nullptr, F.tid);
}
__device__ __forceinline__ void p_dense_i8_fp8(Frame& F, const void* A, const float* SA, const void* Bt, const float* SW, int K, int nM, int nN, int latmap, unsigned char* O, int ldc) {
    pg8::SchedDense S; S.init(nM, nN, F.G, (int)blockIdx.x, latmap, (const bf16_t*)Bt, K); S.tstepB = (size_t)256 * K;
    pg8::EpiI8Fp8<0> E{O, ldc, SA, SW};
    pg8::gemm_phase<pg8::EpiI8Fp8<0>, pg8::SchedDense, false, 1>(F.lds, A, K, S, E, nullptr, fresh_tid(F));
}
__device__ __forceinline__ void p_dense_f8_fp8(Frame& F, const void* A, const void* Bt, const float* SW, int K, int nM, int nN, int latmap, unsigned char* O, int ldc) {
    pg8::SchedDense S; S.init(nM, nN, F.G, (int)blockIdx.x, latmap, (const bf16_t*)Bt, K); S.tstepB = (size_t)256 * K;
    pg8::EpiI8Fp8<0, true> E{O, ldc, SW, SW};
    pg8::gemm_phase<pg8::EpiI8Fp8<0, true>, pg8::SchedDense, false, 2>(F.lds, A, K, S, E, nullptr, fresh_tid(F));
}
__device__ __forceinline__ void p_dense_i8(Frame& F, const void* A, const float* SA, const void* Bt, const float* SW, int K, int nM, int nN, int latmap, bf16_t* O, int ldc) {
    pg8::SchedDense S; S.init(nM, nN, F.G, (int)blockIdx.x, latmap, (const bf16_t*)Bt, K); S.tstepB = (size_t)256 * K;
    pg8::EpiI8Bf16<0> E{O, ldc, SA, SW};
    pg8::gemm_phase<pg8::EpiI8Bf16<0>, pg8::SchedDense, false, 1>(F.lds, A, K, S, E, nullptr, fresh_tid(F));
}

constexpr int N_PHASES = 26;

__global__ void __launch_bounds__(512, 2) mk_fwd(Args args) {
    extern __shared__ __attribute__((aligned(16))) unsigned char lds_raw[];
    Frame F;
    F.lds = (LAS unsigned char*)lds_raw; F.ldsg = (char*)lds_raw;
    F.tid = threadIdx.x; F.lane = F.tid & 63; F.wave = __builtin_amdgcn_readfirstlane(F.tid >> 6);
    F.G = gridDim.x; { const int bx = blockIdx.x; F.vcu = (F.G % 8 == 0) ? (bx % 8) * (F.G / 8) + bx / 8 : bx; }
    F.gw = F.vcu * 8 + F.wave; F.NGW = F.G * 8;
    F.ka = (KArgs)__builtin_amdgcn_kernarg_segment_ptr();
    F.ws = F.ka->ws; F.ctl = (unsigned*)F.ws;
    const int lo = args.ph_lo, hi = args.ph_hi;
    volatile LAS unsigned* bw = (volatile LAS unsigned*)(F.lds + BARW_OFF);
    if (F.tid < 4) bw[F.tid] = 0u;
    __syncthreads();
    XcdBarrier bar; bar.bar = F.ctl + CW_BAR; bar.x = 0; bar.st = bw;
    if (hi - lo > 1) bar = xcd_barrier_post(F.ctl + CW_BAR, bw);
#ifndef MK_ONLY
#define MK_ONLY -1
#endif
#ifndef MK_REPMASK
#define MK_REPMASK 0u
#endif
#define IN(k) ((MK_ONLY < 0 || MK_ONLY == (k)) && lo <= (k) && (k) < hi)
#define NREP(k) ((int)(((unsigned)MK_REPMASK >> (k)) & 1u) + 1)
#define SEAM(k) do { if (lo <= (k) && (k) + 1 < hi) xcd_barrier(bar); } while (0)

    if (IN(0)) for (int rep = 0; rep < NREP(0); ++rep) { PHASE_BEGIN(F); p0_prologue(P); } SEAM(0);
    if (IN(1)) for (int rep = 0; rep < NREP(1); ++rep) { PHASE_BEGIN(F); p1_modulate(P); } SEAM(1);
#if defined(MK_UNROLL_LAYERS)
#pragma unroll
#else
#pragma unroll 1
#endif
    for (int layer = 0; layer < 2; ++layer) {
        const int pb = 2 + 12 * layer;
        if (IN(pb + 0)) for (int rep = 0; rep < NREP(pb + 0); ++rep) { PHASE_BEGIN(F);
            p_dense_i8(P, P.ws + WS_H8, (const float*)(P.ws + WS_SA), P.ws + (layer == 0 ? WS_W_IN : WS_W_DOWN), (const float*)(P.ws + WS_SWD) + (layer == 0 ? SWD_IN : SWD_DOWN), D, T_ALL / 256, layer == 0 ? ABW / 256 : DOWN_N / 256, 0,
                       (bf16_t*)(P.ws + (layer == 0 ? WS_PROJ : WS_DOWN)), layer == 0 ? ABW : DOWN_N);
            if (is_tail_wg((T_ALL / 256) * (layer == 0 ? ABW / 256 : DOWN_N / 256), P.G, (int)blockIdx.x)) tail_quant(P, layer, 1, layer == 0 ? 1 : 2);
        } SEAM(pb + 0);
        if (IN(pb + 1)) for (int rep = 0; rep < NREP(pb + 1); ++rep) { PHASE_BEGIN(F); if (layer == 0) p_post_ab(P); else p_post_down(P); } SEAM(pb + 1);
        if (IN(pb + 2)) for (int rep = 0; rep < NREP(pb + 2); ++rep) { PHASE_BEGIN(F);
            if (layer == 0) p_attn_ab(P);
            else {
#pragma unroll 1
                for (int w = 0; w < 2; ++w) {
                    p_dense_i8(P, P.ws + (w == 0 ? WS_CQN : WS_CKVN), (const float*)(P.ws + (w == 0 ? WS_SCQ : WS_SCKV)), P.ws + (w == 0 ? WS_W_UQ : WS_W_UKV), (const float*)(P.ws + WS_SWD) + (w == 0 ? SWD_UQ : SWD_UKV), 512,
                               w == 0 ? T_LAT / 256 : T_ALL / 256, w == 0 ? UQ_N / 256 : UKV_N / 256, w == 0 ? 1 : 0, (bf16_t*)(P.ws + (w == 0 ? WS_QM : WS_KVM)), w == 0 ? UQ_N : UKV_N); }
            }
        } SEAM(pb + 2);
        if (IN(pb + 3)) for (int rep = 0; rep < NREP(pb + 3); ++rep) { PHASE_BEGIN(F); if (layer == 0) p_diff_combine(P); else p_attn_mla(P); } SEAM(pb + 3);
        if (IN(pb + 5)) for (int rep = 0; rep < NREP(pb + 5); ++rep) { PHASE_BEGIN(F);
            if (layer == 0) p_dense_i8_fp8(P, P.ws + WS_MG8, (const float*)(P.ws + WS_SMG), P.ws + WS_W_OUT, (const float*)(P.ws + WS_SWD) + SWD_OUT, D, T_ALL / 256, D / 256, 0, (unsigned char*)(P.ws + WS_Y1), D);
            else p_dense_f8_fp8(P, P.ws + WS_MG8, P.ws + WS_W_O, (const float*)(P.ws + WS_SWD) + SWD_O, D, T_LAT / 256, D / 256, 1, (unsigned char*)(P.ws + WS_Y1), D);
            if (layer == 0 && is_tail_wg((T_ALL / 256) * (D / 256), P.G, (int)blockIdx.x)) tail_quant(P, 1, 1, 1);
        } SEAM(pb + 5);
        if (IN(pb + 6)) for (int rep = 0; rep < NREP(pb + 6); ++rep) { PHASE_BEGIN(F); p_ln1(P, layer); } SEAM(pb + 6);
        if (IN(pb + 7)) for (int rep = 0; rep < NREP(pb + 7); ++rep) { PHASE_BEGIN(F); p_router(P, layer); } SEAM(pb + 7);
        if (IN(pb + 8)) for (int rep = 0; rep < NREP(pb + 8); ++rep) { PHASE_BEGIN(F); p_moe_gemm1(P, layer); } SEAM(pb + 8);
        if (IN(pb + 10)) for (int rep = 0; rep < NREP(pb + 10); ++rep) { PHASE_BEGIN(F); p_moe_gemm2(P, layer); } SEAM(pb + 10);
        if (IN(pb + 11)) for (int rep = 0; rep < NREP(pb + 11); ++rep) { PHASE_BEGIN(F); p_combine_ln2(P, layer); } SEAM(pb + 11);
    }
#undef IN
#undef SEAM
}

extern "C" void kernel_launch(void* const* d_in, const int* in_sizes, int n_in, void* d_out, int out_size, void* d_ws, size_t ws_size, hipStream_t stream) {
    static int grid = 0;
    if (grid == 0) {
        if (n_in != 28 || out_size != T_LAT * D || ws_size < WS_END) { fprintf(stderr, "kernel_launch: expected 28 inputs, out %d, ws >= %zu; got n_in %d out %d ws %zu\n", T_LAT * D, (size_t)WS_END, n_in, out_size, ws_size); grid = -1; return; }
        int dev = 0, cus = 0, per_cu = 0;
        if (hipGetDevice(&dev) != hipSuccess || hipDeviceGetAttribute(&cus, hipDeviceAttributeMultiprocessorCount, dev) != hipSuccess) { fprintf(stderr, "kernel_launch: device query failed\n"); grid = -1; return; }
        if (hipFuncSetAttribute((const void*)mk_fwd, hipFuncAttributeMaxDynamicSharedMemorySize, LDS_BYTES) != hipSuccess) { fprintf(stderr, "kernel_launch: hipFuncSetAttribute failed\n"); grid = -1; return; }
        if (hipOccupancyMaxActiveBlocksPerMultiprocessor(&per_cu, (const void*)mk_fwd, 512, LDS_BYTES) != hipSuccess || per_cu < 1) fprintf(stderr, "kernel_launch: occupancy query reports %d\n", per_cu);
        (void)hipGetLastError();
        grid = cus;
        if (grid != 256) fprintf(stderr, "kernel_launch: note: %d CUs (tuned for 256)\n", grid);
    }
    if (grid < 0) return;
    if (hipMemsetAsync((char*)d_ws + WS_CTL, 0, CTL_BYTES, stream) != hipSuccess) { fprintf(stderr, "kernel_launch: memset failed\n"); return; }
    Args a{};
    for (int i = 0; i < 28; ++i) a.in[i] = (const float*)d_in[i];
    a.out = (float*)d_out; a.ws = (unsigned char*)d_ws;
#if MK_ONE_LAUNCH
    a.ph_lo = 0; a.ph_hi = N_PHASES;
    hipLaunchKernelGGL(mk_fwd, dim3(grid), dim3(512), LDS_BYTES, stream, a);
#else
    for (int p = 0; p < N_PHASES; ++p) { a.ph_lo = p; a.ph_hi = p + 1; hipLaunchKernelGGL(mk_fwd, dim3(grid), dim3(512), LDS_BYTES, stream, a); }
#endif
    const hipError_t le = hipPeekAtLastError();
    if (le != hipSuccess) fprintf(stderr, "kernel_launch: launch failed: %s\n", hipGetErrorName(le));
}
```

```cpp
#include <hip/hip_runtime.h>
#include <cstdio>
#include <cstdint>

#ifndef MK_ONE_LAUNCH
#define MK_ONE_LAUNCH 1
#endif

#define LAS __attribute__((address_space(3)))
typedef unsigned short bf16_t;
typedef short bf16x8 __attribute__((ext_vector_type(8)));
typedef short s16x4 __attribute__((ext_vector_type(4)));
typedef float f32x4 __attribute__((ext_vector_type(4)));
typedef float f32x2 __attribute__((ext_vector_type(2)));
typedef float f32x16 __attribute__((ext_vector_type(16)));
typedef unsigned u32x4 __attribute__((ext_vector_type(4)));
typedef unsigned u32x2 __attribute__((ext_vector_type(2)));
typedef int i32x4 __attribute__((ext_vector_type(4)));

constexpr int D = 2048, NB = 8, SEQ = 2048, CTXL = 256, RPB = SEQ + CTXL  ;
constexpr int T_ALL = NB * RPB  , T_LAT = NB * SEQ  ;
constexpr int NEXP = 64, FDIM = 512, TOPK = 8;
constexpr int ABW = 4608, QA_OFF = 0, KA_OFF = 1024, VA_OFF = 2048, QB_OFF = 3072, KB_OFF = 4096, VB_OFF = 4352;
constexpr int DOWN_N = 1280  , UQ_N = 3072, UKV_N = 4096;
constexpr float ALPHA = 1.41421356237f;
constexpr float LAM_INIT0 = 0.2f;
constexpr int LIST_CAP = T_ALL;
constexpr int MAX_TILES = 712;

constexpr size_t al4k(size_t x) { return (x + 4095) & ~(size_t)4095; }
constexpr size_t WS_CTL = 0, CTL_BYTES = 1u << 20;
constexpr size_t WS_TAB = WS_CTL + CTL_BYTES;
constexpr size_t WS_MOD = WS_TAB + (1u << 16);
constexpr size_t WS_W_IN = WS_MOD + (1u << 20);
constexpr size_t WS_W_OUT = WS_W_IN + al4k((size_t)ABW * D * 2);
constexpr size_t WS_W_DOWN = WS_W_OUT + al4k((size_t)D * D * 2);
constexpr size_t WS_W_UQ = WS_W_DOWN + al4k((size_t)DOWN_N * D * 2);
constexpr size_t WS_W_UKV = WS_W_UQ + al4k((size_t)UQ_N * 512 * 2);
constexpr size_t WS_W_O = WS_W_UKV + al4k((size_t)UKV_N * 512 * 2);
constexpr size_t WS_ROUTER = WS_W_O + al4k((size_t)D * D * 2);
constexpr size_t EXP_IN_BYTES = (size_t)1024 * D  , EXP_OUT_BYTES = (size_t)D * FDIM  ;
constexpr size_t WS_EXP_IN = WS_ROUTER + al4k((size_t)2 * 64 * D * 2);
constexpr size_t WS_EXP_OUT = WS_EXP_IN + (size_t)2 * 65 * EXP_IN_BYTES;
constexpr size_t WS_X = WS_EXP_OUT + (size_t)2 * 65 * EXP_OUT_BYTES;
constexpr size_t WS_H = WS_X + (size_t)T_ALL * D * 4;
constexpr size_t WS_PROJ = WS_H + (size_t)T_ALL * D * 2;
constexpr size_t WS_OA = WS_PROJ + (size_t)T_ALL * ABW * 2;
constexpr size_t WS_MERGED = WS_OA + (size_t)T_ALL * D * 2;
constexpr size_t WS_Y1 = WS_MERGED + (size_t)T_ALL * D * 2;
constexpr size_t P_MAX = (size_t)MAX_TILES * 256;
constexpr size_t WS_HMID = WS_Y1 + (size_t)T_ALL * D * 2;
constexpr size_t WS_Y2P = WS_HMID + P_MAX * FDIM * 2;
constexpr size_t WS_LIST = WS_Y2P + P_MAX * D * 2;
constexpr size_t WS_TOKSLOT = WS_LIST + (size_t)64 * LIST_CAP * 4;
constexpr size_t WS_GATE = WS_TOKSLOT + (size_t)T_ALL * 8 * 4;
constexpr size_t WS_DOWN = WS_GATE + (size_t)T_ALL * 8 * 4;
constexpr size_t WS_CQN = WS_DOWN + (size_t)T_ALL * DOWN_N * 2;
constexpr size_t WS_CKVN = WS_CQN + (size_t)T_ALL * 512 * 2;
constexpr size_t WS_KPE = WS_CKVN + (size_t)T_ALL * 512 * 2;
constexpr size_t WS_QM = WS_KPE + (size_t)T_ALL * 64 * 2;
constexpr size_t WS_KVM = WS_QM + (size_t)T_ALL * UQ_N * 2;
constexpr size_t WS_SW = WS_KVM + (size_t)T_ALL * UKV_N * 2;
constexpr size_t WS_H8 = WS_SW + al4k((size_t)2 * 65 * 1024 * 4);
constexpr size_t WS_SA = WS_H8 + (size_t)T_ALL * D;
constexpr size_t WS_SWD = WS_SA + al4k((size_t)T_ALL * 4);
constexpr int SWD_IN = 0, SWD_OUT = 4608, SWD_DOWN = 6656, SWD_UQ = 7936, SWD_UKV = 11008, SWD_O = 15104, SWD_N = 17152;
constexpr size_t WS_SW2 = WS_SWD + al4k((size_t)SWD_N * 4);
constexpr size_t WS_SCQ = WS_SW2 + al4k((size_t)2 * 65 * 2048 * 4);
constexpr size_t WS_SCKV = WS_SCQ + al4k((size_t)T_ALL * 4);
constexpr size_t WS_SMG = WS_SCKV + al4k((size_t)T_ALL * 4);
constexpr size_t WS_SHM = WS_SMG + al4k((size_t)T_ALL * 4);
constexpr size_t WS_HM8 = WS_SHM + al4k(P_MAX * 4);
constexpr size_t WS_MG8 = WS_HM8 + P_MAX * FDIM;
constexpr size_t WS_END = WS_MG8 + (size_t)T_ALL * D;
constexpr size_t TAB64R = 0, TAB64C = 4096, TAB128R = 12288, TAB128C = 20480;
constexpr int CW_BAR = 4096, CW_CNT = 16384;
constexpr int CW_QW = 20480;
constexpr int QSLOT_OFF = 163776;

constexpr int RING_BYTES = 131072;
constexpr int IDXC_OFF = 131072, IDXC_UNITS = 16;
constexpr int TTAB_OFF = IDXC_OFF + IDXC_UNITS * 1024;
constexpr int MISC_OFF = TTAB_OFF + 4096;
constexpr int LDS_BYTES = 163840;
constexpr int BARW_OFF = LDS_BYTES - 16;
constexpr int SCL_OFF = MISC_OFF + 2048;

#define RLX_AGENT __ATOMIC_RELAXED, __HIP_MEMORY_SCOPE_AGENT
__device__ __forceinline__ unsigned f2bf(float f) { unsigned u = __builtin_bit_cast(unsigned, f); return (u + 0x7fffu + ((u >> 16) & 1u)) >> 16; }
__device__ __forceinline__ unsigned pk2(float lo, float hi) { return f2bf(lo) | (f2bf(hi) << 16); }
__device__ __forceinline__ float bf2f(unsigned short b) { return __builtin_bit_cast(float, ((unsigned)b) << 16); }
__device__ __forceinline__ float bflo(unsigned w) { return __builtin_bit_cast(float, w << 16); }
__device__ __forceinline__ float bfhi(unsigned w) { return __builtin_bit_cast(float, w & 0xffff0000u); }
__device__ __forceinline__ unsigned cvt_pk_bf16(float lo, float hi) { unsigned r; asm volatile("v_cvt_pk_bf16_f32 %0, %1, %2" : "=v"(r) : "v"(lo), "v"(hi)); return r; }
__device__ __forceinline__ unsigned q8x4(float a, float b, float c, float d, float inv) {
    unsigned w = 0;
    w = __builtin_amdgcn_cvt_pk_u8_f32(__builtin_rintf(fmaf(a, inv, 128.0f)), 0, w); w = __builtin_amdgcn_cvt_pk_u8_f32(__builtin_rintf(fmaf(b, inv, 128.0f)), 1, w);
    w = __builtin_amdgcn_cvt_pk_u8_f32(__builtin_rintf(fmaf(c, inv, 128.0f)), 2, w); w = __builtin_amdgcn_cvt_pk_u8_f32(__builtin_rintf(fmaf(d, inv, 128.0f)), 3, w);
    return w ^ 0x80808080u;
}
__device__ __forceinline__ float wave_sum(float v) {
#pragma unroll
    for (int o = 1; o < 64; o <<= 1) v += __shfl_xor(v, o);
    return v;
}

#define XB_TMO      128
#define XB_XCNT(j)  (256  + 64 * (j))
#define XB_XSUB(j)  (1280 + 64 * (j))
#define XB_XGEN(j)  (2304 + 64 * (j))
#define XB_TOP      3328
#define XB_TOPGEN   3392
#define XCD_BAR_WORDS 3456
#define XB_SPIN_CAP (1u << 18)
__device__ __forceinline__ unsigned xb_ld(unsigned* p)              { return __hip_atomic_load(p, __ATOMIC_RELAXED, __HIP_MEMORY_SCOPE_AGENT); }
__device__ __forceinline__ unsigned xb_add(unsigned* p, unsigned v) { return __hip_atomic_fetch_add(p, v, __ATOMIC_RELAXED, __HIP_MEMORY_SCOPE_AGENT); }
__device__ __forceinline__ unsigned xb_xcc_id() { return (unsigned)__builtin_amdgcn_s_getreg((3 << 11) | 20) & 0xFu; }
#define XB_SPIN(cond, bar) do { unsigned _sp = 0; while (cond) { __builtin_amdgcn_s_sleep(1); \
    if ((++_sp & 255u) == 0u) { if (xb_ld(&(bar)[XB_TMO])) break; if (_sp > XB_SPIN_CAP) { atomicAdd(&(bar)[XB_TMO], 1u); break; } } } } while (0)
struct XcdBarrier { unsigned* bar; unsigned x; volatile LAS unsigned* st; };
__device__ __forceinline__ XcdBarrier xcd_barrier_post(unsigned* bar, volatile LAS unsigned* st) {
    XcdBarrier b; b.bar = bar; b.x = xb_xcc_id(); b.st = st;
    if (threadIdx.x == 0) (void)xb_add(&bar[XB_XCNT(b.x)], 1u);
    return b;
}
__device__ __forceinline__ void xcd_barrier_complete(unsigned* bar, unsigned x, unsigned& nloc, unsigned& nx) {
    const unsigned G = gridDim.x * gridDim.y * gridDim.z;
    unsigned sum, cnt, mine, sp = 0u;
    for (;;) {
        sum = 0u; cnt = 0u; mine = 0u;
#pragma unroll
        for (unsigned j = 0; j < 16; ++j) { const unsigned c = xb_ld(&bar[XB_XCNT(j)]); sum += c; cnt += (c > 0u) ? 1u : 0u; mine = (j == x) ? c : mine; }
        if (sum == G) break;
        __builtin_amdgcn_s_sleep(1);
        if ((++sp & 255u) == 0u) { if (xb_ld(&bar[XB_TMO])) break; if (sp > XB_SPIN_CAP) { atomicAdd(&bar[XB_TMO], 1u); break; } }
    }
    nloc = mine > 0u ? mine : 1u; nx = cnt > 0u ? cnt : 1u;
}
__device__ __forceinline__ void xcd_barrier(const XcdBarrier& b) {
    asm volatile("s_waitcnt vmcnt(0)" ::: "memory");
    __syncthreads();
    if (threadIdx.x == 0) {
        unsigned* bar = b.bar;
        __builtin_amdgcn_s_waitcnt(0);
        unsigned nloc = b.st[0], nx = b.st[1];
        if (nloc == 0u) { xcd_barrier_complete(bar, b.x, nloc, nx); b.st[0] = nloc; b.st[1] = nx; }
        const unsigned old = xb_add(&bar[XB_XSUB(b.x)], 1u);
        const unsigned gen = old / nloc;
        if (old + 1u == (gen + 1u) * nloc) {
            __builtin_amdgcn_fence(__ATOMIC_RELEASE, "agent");
            asm volatile("s_waitcnt vmcnt(0)" ::: "memory");
            const unsigned og = xb_add(&bar[XB_TOP], 1u);
            const unsigned tg = og / nx;
            if (og + 1u == (tg + 1u) * nx) xb_add(&bar[XB_TOPGEN], 1u);
            else XB_SPIN(xb_ld(&bar[XB_TOPGEN]) == tg, bar);
            __builtin_amdgcn_fence(__ATOMIC_ACQUIRE, "agent");
            xb_add(&bar[XB_XGEN(b.x)], 1u);
            asm volatile("s_waitcnt vmcnt(0)" ::: "memory");
        } else {
            XB_SPIN(xb_ld(&bar[XB_XGEN(b.x)]) == gen, bar);
            __builtin_amdgcn_fence(__ATOMIC_ACQUIRE, "agent");
            asm volatile("s_waitcnt vmcnt(0)" ::: "memory");
        }
    }
    __syncthreads();
}

namespace pg8 {
constexpr int BM = 256, BK = 64, HALF = 128, HTB = HALF * BK * 2, STAGE_BYTES = 8 * HTB;
__device__ __forceinline__ int lds_byte(int r, int c) { const int st = (r >> 4) * 2 + (c >> 5), rr = r & 15, cc = c & 31, ob = rr * 64 + cc * 2; return st * 1024 + (ob ^ (((ob >> 9) & 1) << 5)); }
__device__ __forceinline__ void stage_rc(int b, int& R, int& C) { const int st = b / 1024, sb = b % 1024, swz = sb ^ (((sb >> 9) & 1) << 5); R = (st >> 1) * 16 + swz / 64; C = (st & 1) * 32 + (swz % 64) / 2; }
__device__ __forceinline__ int perm32(int rho) { const int n = rho >> 4, i = rho & 15; return 8 * (i >> 2) + 4 * n + (i & 3); }

struct Unit { int row0; int pn; int e; const char* B; };

struct SchedDense {
    int nM, nN, nwg, G, c, latmap; const char* Bt; size_t tstepB;
    __device__ __forceinline__ void init(int nM_, int nN_, int G_, int c_, int latmap_, const bf16_t* Bt_, int K) { nM = nM_; nN = nN_; nwg = nM * nN; G = G_; c = c_; latmap = latmap_; Bt = (const char*)Bt_; tstepB = (size_t)BM * K * 2; }
    __device__ __forceinline__ bool next(int i, Unit& u) const {
        const long L = (long)i * G + c; if (L >= nwg) return false;
        int wgid = (int)L; { const int q = nwg / 8, r = nwg % 8, xcd = wgid % 8, off = wgid / 8; wgid = (xcd < r ? xcd * (q + 1) : r * (q + 1) + (xcd - r) * q) + off; }
        const int nig = 8 * nN, gid = wgid / nig, fm = gid * 8, gsz = (nM - fm) < 8 ? (nM - fm) : 8;
        int pm = fm + ((wgid % nig) % gsz); u.pn = (wgid % nig) / gsz;
        if (latmap) pm = (pm >> 3) * 9 + 1 + (pm & 7);
        u.row0 = pm * BM; u.e = 0; u.B = Bt + (size_t)u.pn * tstepB; return true;
    }
};
template <int NN, size_t GSTRIDE, size_t TSTEPB> struct SchedMoe {
    int ntiles, G, vcu; const LAS int* ttab; const char* Bt;
    __device__ __forceinline__ bool next(int i, Unit& u) const {
        const int L = i * G + vcu; if (L >= ntiles * NN) return false;
        const int tile = L / NN; u.pn = L - tile * NN; const int e = ttab[tile] >> 16;
        u.row0 = tile * BM; u.e = e; u.B = Bt + (size_t)e * GSTRIDE + (size_t)u.pn * TSTEPB; return true;
    }
};
struct EpiBf16 {
    static constexpr bool PERM = true; static constexpr int NVM = 16;
    bf16_t* O; int ldc;
    __device__ __forceinline__ const float* sa_src(const Unit& u, int ui, int r) const { return (const float*)O; }
    __device__ __forceinline__ const float* sw_src(const Unit& u, int c) const { return (const float*)O; }
    __device__ __forceinline__ void operator()(const f32x4 (&acc)[2][2][4][2], const Unit& u, int ui, int wr, int wc, int fr, int fq, const LAS float* scl) const {
        const int row0 = u.row0 + wr * 64 + fr, col0 = u.pn * BM + wc * 32 + 8 * fq;
#pragma unroll
        for (int ai = 0; ai < 2; ++ai)
#pragma unroll
            for (int m = 0; m < 4; ++m) { bf16_t* rowp = O + (size_t)(row0 + ai * HALF + m * 16) * ldc + col0;
#pragma unroll
                for (int bj = 0; bj < 2; ++bj) { const f32x4 v0 = acc[ai][bj][m][0], v1 = acc[ai][bj][m][1];
                    u32x4 w; w.x = cvt_pk_bf16(v0[0], v0[1]); w.y = cvt_pk_bf16(v0[2], v0[3]); w.z = cvt_pk_bf16(v1[0], v1[1]); w.w = cvt_pk_bf16(v1[2], v1[3]);
                    *(u32x4*)(rowp + bj * HALF) = w; } }
    }
};
__device__ __forceinline__ float silu_mul(float g, float u) { return g * __builtin_amdgcn_rcpf(1.0f + __builtin_amdgcn_exp2f(-1.4426950408889634f * g)) * u; }
template <int SWG> struct EpiI8Bf16 {
    static constexpr bool PERM = true; static constexpr int NVM = 16;
    bf16_t* O; int ldc; const float* SA; const float* SW;
    __device__ __forceinline__ const float* sa_src(const Unit& u, int ui, int r) const { return SA + u.row0 + r; }
    __device__ __forceinline__ const float* sw_src(const Unit& u, int c) const { return SW + (size_t)u.e * SWG + u.pn * BM + c; }
    __device__ __forceinline__ void operator()(const i32x4 (&acc)[2][2][4][2], const Unit& u, int ui, int wr, int wc, int fr, int fq, const LAS float* scl) const {
        const int lrow = wr * 64 + fr, row0 = u.row0 + lrow, col0 = u.pn * BM + wc * 32 + 8 * fq;
#pragma unroll
        for (int bj = 0; bj < 2; ++bj) { const f32x4 w0 = *(const LAS f32x4*)(scl + 256 + bj * HALF + wc * 32 + 8 * fq), w1 = *(const LAS f32x4*)(scl + 256 + bj * HALF + wc * 32 + 8 * fq + 4);
#pragma unroll
            for (int ai = 0; ai < 2; ++ai)
#pragma unroll
                for (int m = 0; m < 4; ++m) { const int r = row0 + ai * HALF + m * 16; bf16_t* rowp = O + (size_t)r * ldc + col0 + bj * HALF; const float sa = scl[lrow + ai * HALF + m * 16];
                    const i32x4 v0 = acc[ai][bj][m][0], v1 = acc[ai][bj][m][1]; const f32x4 s0 = w0 * sa, s1 = w1 * sa;
                    const f32x4 f0 = __builtin_convertvector(v0, f32x4) * s0, f1 = __builtin_convertvector(v1, f32x4) * s1;
                    u32x4 w; w.x = cvt_pk_bf16(f0[0], f0[1]); w.y = cvt_pk_bf16(f0[2], f0[3]); w.z = cvt_pk_bf16(f1[0], f1[1]); w.w = cvt_pk_bf16(f1[2], f1[3]);
                    *(u32x4*)rowp = w; } }
    }
};
template <int SWG, bool SA1 = false> struct EpiI8Fp8 {
    static constexpr bool PERM = true; static constexpr int NVM = 16;
    unsigned char* O; int ldc; const float* SA; const float* SW;
    __device__ __forceinline__ const float* sa_src(const Unit& u, int ui, int r) const { return SA1 ? SW : SA + u.row0 + r; }
    __device__ __forceinline__ const float* sw_src(const Unit& u, int c) const { return SW + (size_t)u.e * SWG + u.pn * BM + c; }
    template <class AV> __device__ __forceinline__ void operator()(const AV (&acc)[2][2][4][2], const Unit& u, int ui, int wr, int wc, int fr, int fq, const LAS float* scl) const {
        const int lrow = wr * 64 + fr, row0 = u.row0 + lrow, col0 = u.pn * BM + wc * 32 + 8 * fq;
#pragma unroll
        for (int bj = 0; bj < 2; ++bj) { const f32x4 w0 = *(const LAS f32x4*)(scl + 256 + bj * HALF + wc * 32 + 8 * fq), w1 = *(const LAS f32x4*)(scl + 256 + bj * HALF + wc * 32 + 8 * fq + 4);
#pragma unroll
            for (int ai = 0; ai < 2; ++ai)
#pragma unroll
                for (int m = 0; m < 4; ++m) { const int r = row0 + ai * HALF + m * 16; unsigned char* rowp = O + (size_t)r * ldc + col0 + bj * HALF; const float sa = SA1 ? 1.0f : scl[lrow + ai * HALF + m * 16];
                    const AV v0 = acc[ai][bj][m][0], v1 = acc[ai][bj][m][1]; const f32x4 s0 = w0 * sa, s1 = w1 * sa;
                    const f32x4 f0 = __builtin_convertvector(v0, f32x4) * s0, f1 = __builtin_convertvector(v1, f32x4) * s1;
                    int lo = 0, hi = 0;
                    lo = __builtin_amdgcn_cvt_pk_fp8_f32(f0[0], f0[1], lo, false); lo = __builtin_amdgcn_cvt_pk_fp8_f32(f0[2], f0[3], lo, true);
                    hi = __builtin_amdgcn_cvt_pk_fp8_f32(f1[0], f1[1], hi, false); hi = __builtin_amdgcn_cvt_pk_fp8_f32(f1[2], f1[3], hi, true);
                    *(u32x2*)rowp = (u32x2){(unsigned)lo, (unsigned)hi}; } }
    }
};
struct EpiSwigluI8 {
    static constexpr bool PERM = true; static constexpr int NVM = 8;
    unsigned char* O; int ldc; const float* SA; const float* SW; const LAS int* idxc;
    __device__ __forceinline__ const float* sa_src(const Unit& u, int ui, int r) const { return SA + idxc[(ui & (IDXC_UNITS - 1)) * 256 + r]; }
    __device__ __forceinline__ const float* sw_src(const Unit& u, int c) const { return SW + (size_t)u.e * 1024 + u.pn * BM + c; }
    __device__ __forceinline__ void operator()(const i32x4 (&acc)[2][2][4][2], const Unit& u, int ui, int wr, int wc, int fr, int fq, const LAS float* scl) const {
        const int lrow = wr * 64 + fr, row0 = u.row0 + lrow, col0 = u.pn * HALF + wc * 32 + 8 * fq;
        const LAS float* sw = scl + 256 + wc * 32 + 8 * fq;
        const f32x4 wg0 = *(const LAS f32x4*)sw, wg1 = *(const LAS f32x4*)(sw + 4), wu0 = *(const LAS f32x4*)(sw + HALF), wu1 = *(const LAS f32x4*)(sw + HALF + 4);
#pragma unroll
        for (int ai = 0; ai < 2; ++ai)
#pragma unroll
            for (int m = 0; m < 4; ++m) { unsigned char* rowp = O + (size_t)(row0 + ai * HALF + m * 16) * ldc + col0;
                const float sa = scl[lrow + ai * HALF + m * 16];
                const i32x4 g0 = acc[ai][0][m][0], g1 = acc[ai][0][m][1], u0 = acc[ai][1][m][0], u1 = acc[ai][1][m][1];
                float o[8];
#pragma unroll
                for (int j = 0; j < 4; ++j) { o[j] = silu_mul((float)g0[j] * (sa * wg0[j]), (float)u0[j] * (sa * wu0[j])); o[4 + j] = silu_mul((float)g1[j] * (sa * wg1[j]), (float)u1[j] * (sa * wu1[j])); }
                int lo = 0, hi = 0;
                lo = __builtin_amdgcn_cvt_pk_fp8_f32(o[0], o[1], lo, false); lo = __builtin_amdgcn_cvt_pk_fp8_f32(o[2], o[3], lo, true);
                hi = __builtin_amdgcn_cvt_pk_fp8_f32(o[4], o[5], hi, false); hi = __builtin_amdgcn_cvt_pk_fp8_f32(o[6], o[7], hi, true);
                *(u32x2*)rowp = (u32x2){(unsigned)lo, (unsigned)hi}; }
    }
};

template <int I8> struct AccT { typedef f32x4 T; };
template <> struct AccT<1> { typedef i32x4 T; };
__device__ __forceinline__ f32x4 mma16(bf16x8 b, bf16x8 a, f32x4 c) { return __builtin_amdgcn_mfma_f32_16x16x32_bf16(b, a, c, 0, 0, 0); }
__device__ __forceinline__ i32x4 mma16(bf16x8 b, bf16x8 a, i32x4 c) { return __builtin_amdgcn_mfma_i32_16x16x64_i8(__builtin_bit_cast(i32x4, b), __builtin_bit_cast(i32x4, a), c, 0, 0, 0); }
typedef int i32x8 __attribute__((ext_vector_type(8)));
__device__ __forceinline__ f32x4 mma_f8(bf16x8 b0, bf16x8 b1, bf16x8 a0, bf16x8 a1, f32x4 c) {
    const i32x8 bb = __builtin_shufflevector(__builtin_bit_cast(i32x4, b0), __builtin_bit_cast(i32x4, b1), 0, 1, 2, 3, 4, 5, 6, 7);
    const i32x8 aa = __builtin_shufflevector(__builtin_bit_cast(i32x4, a0), __builtin_bit_cast(i32x4, a1), 0, 1, 2, 3, 4, 5, 6, 7);
    return __builtin_amdgcn_mfma_scale_f32_16x16x128_f8f6f4(bb, aa, c, 0, 0, 0, 0, 0, 0);
}
template <class Epi, class Sched, bool GATHER, int I8 = 0>
__device__ __forceinline__ void gemm_phase(LAS unsigned char* lds, const void* Abase, const int K, const Sched& S, const Epi& E, const LAS int* idxc, const int tid) {
    const int wid = __builtin_amdgcn_readfirstlane(tid >> 6), lane = tid & 63, wr = wid >> 2, wc = wid & 3, fr = lane & 15, fq = lane >> 4;
    const int RB = I8 ? K : K * 2, nt = RB / 128;
    int Ri[2], Ci[2]; unsigned voffB[2];
#pragma unroll
    for (int i = 0; i < 2; ++i) { int R, C; stage_rc(tid * 16 + i * 8192, R, C); Ri[i] = R; Ci[i] = C; const int Rb = Epi::PERM ? ((R & ~31) + perm32(R & 31)) : R; voffB[i] = (unsigned)(Rb * RB + C * 2); }
    const size_t kstep = 128;
    const size_t hstep = (size_t)HALF * RB;
    const unsigned ldsw = (unsigned)wid * 1024u;
    const int aoff = lds_byte(wr * 64 + fr, fq * 8), boff = lds_byte(wc * 32 + fr, fq * 8);
#define PG8_SA(b, h) (((b) * 2 + (h)) * HTB)
#define PG8_SB(b, h) ((4 + (b) * 2 + (h)) * HTB)
#define PG8_STAGE(bufoff, gbase, voff) do { _Pragma("unroll") for (int _i = 0; _i < 2; ++_i) \
        __builtin_amdgcn_global_load_lds((const unsigned*)((const char*)(gbase) + (voff)[_i]), (LAS unsigned*)(lds + (bufoff) + ldsw + _i * 8192), 16, 0, 0); } while (0)
#define PG8_LDA(dst, b, h) do { _Pragma("unroll") for (int m = 0; m < 4; ++m) _Pragma("unroll") for (int k = 0; k < 2; ++k) dst[m][k] = *(const LAS bf16x8*)(lds + PG8_SA(b, h) + aoff + m * 2048 + k * 1024); } while (0)
#define PG8_LDB(dst, b, h) do { _Pragma("unroll") for (int n = 0; n < 2; ++n) _Pragma("unroll") for (int k = 0; k < 2; ++k) dst[n][k] = *(const LAS bf16x8*)(lds + PG8_SB(b, h) + boff + n * 2048 + k * 1024); } while (0)
#define PG8_MMA(ai, bj, At, Bt) do { __builtin_amdgcn_s_setprio(1); _Pragma("unroll") for (int m = 0; m < 4; ++m) _Pragma("unroll") for (int n = 0; n < 2; ++n) { \
        if constexpr (I8 == 2) acc[ai][bj][m][n] = mma_f8(Bt[n][0], Bt[n][1], At[m][0], At[m][1], acc[ai][bj][m][n]); \
        else { _Pragma("unroll") for (int k = 0; k < 2; ++k) acc[ai][bj][m][n] = mma16(Bt[n][k], At[m][k], acc[ai][bj][m][n]); } } __builtin_amdgcn_s_setprio(0); } while (0)
#define PG8_WAIT_V(n) asm volatile("s_waitcnt vmcnt(" #n ")" ::: "memory")
#define PG8_WAIT_L(n) asm volatile("s_waitcnt lgkmcnt(" #n ")" ::: "memory")
#define PG8_BAR __builtin_amdgcn_s_barrier()
#define PG8_SCHED __builtin_amdgcn_sched_barrier(0)
#define PG8_MKA(dst, ui, u_) do { _Pragma("unroll") for (int _h = 0; _h < 2; ++_h) _Pragma("unroll") for (int _i = 0; _i < 2; ++_i) { \
        if constexpr (GATHER) dst[_h][_i] = (unsigned)idxc[((ui) & (IDXC_UNITS - 1)) * 256 + _h * HALF + Ri[_i]] * (unsigned)RB + (unsigned)(Ci[_i] * 2); \
        else dst[_h][_i] = (unsigned)((_h * HALF + Ri[_i]) * RB + Ci[_i] * 2); } } while (0)
    Unit cur, nxt; int ui = 0;
    if (!S.next(0, cur)) return;
    LAS float* const sclb = (LAS float*)(lds + SCL_OFF);
#define PG8_SCALES(u_, ui_) do { const float* _src = (wid < 4) ? E.sa_src(u_, ui_, wid * 64 + lane) : E.sw_src(u_, (wid - 4) * 64 + lane); \
        __builtin_amdgcn_global_load_lds((const unsigned*)_src, (LAS unsigned*)(sclb + ((ui_) & 1) * 512 + wid * 64), 4, 0, 0); } while (0)
    constexpr int NEPI = Epi::NVM;
    typedef typename AccT<I8>::T acc_t;
    acc_t acc[2][2][4][2];
#pragma unroll
    for (int a = 0; a < 2; ++a)
#pragma unroll
        for (int b = 0; b < 2; ++b)
#pragma unroll
            for (int m = 0; m < 4; ++m)
#pragma unroll
                for (int n = 0; n < 2; ++n) acc[a][b][m][n] = acc_t{};
    bf16x8 At[4][2], B0[2][2], B1[2][2];
    unsigned curA[2][2], nxtA[2][2];
    PG8_MKA(curA, 0, cur);
    PG8_SCALES(cur, 0);
    const char* cA = GATHER ? (const char*)Abase : (const char*)Abase + (size_t)cur.row0 * RB; const char* cB = cur.B;
    PG8_STAGE(PG8_SB(0, 0), cB, voffB); PG8_STAGE(PG8_SB(0, 1), cB + hstep, voffB); PG8_STAGE(PG8_SA(0, 0), cA, curA[0]); PG8_STAGE(PG8_SA(0, 1), cA, curA[1]);
    if (wr == 1) PG8_BAR;
    PG8_WAIT_V(2); PG8_BAR;
    PG8_STAGE(PG8_SB(1, 0), cB + kstep, voffB); PG8_STAGE(PG8_SA(1, 0), cA + kstep, curA[0]); PG8_STAGE(PG8_SB(1, 1), cB + hstep + kstep, voffB);
    PG8_WAIT_V(6); PG8_BAR;
    for (;;) {
        const bool has_next = S.next(ui + 1, nxt);
        const char* nA = has_next ? (GATHER ? (const char*)Abase : (const char*)Abase + (size_t)nxt.row0 * RB) : cA; const char* nB = has_next ? nxt.B : cB;
        if constexpr (GATHER) { if (has_next) { PG8_MKA(nxtA, ui + 1, nxt); } else {
#pragma unroll
            for (int h = 0; h < 2; ++h)
#pragma unroll
                for (int i = 0; i < 2; ++i) nxtA[h][i] = curA[h][i]; } }
#pragma unroll 1
        for (int t = 0; t < nt; t += 2) {
            const bool last = (t == nt - 2);
            const char* a1 = cA + (size_t)(t + 1) * kstep;
            const char* a2 = last ? nA : cA + (size_t)(t + 2) * kstep; const char* b2 = last ? nB : cB + (size_t)(t + 2) * kstep;
            const char* a3 = a2 + kstep; const char* b3 = b2 + kstep;
            unsigned s0[2], s1[2];
#pragma unroll
            for (int i = 0; i < 2; ++i) { if constexpr (GATHER) { s0[i] = last ? nxtA[0][i] : curA[0][i]; s1[i] = last ? nxtA[1][i] : curA[1][i]; } else { s0[i] = curA[0][i]; s1[i] = curA[1][i]; } }
            const bool relax = (t == 0) && (ui > 0);
            PG8_LDB(B0, 0, 0); PG8_LDB(B1, 0, 1); PG8_SCHED; PG8_LDA(At, 0, 0); PG8_STAGE(PG8_SA(1, 1), a1, curA[1]);
            if (relax) { if constexpr (NEPI == 16) PG8_WAIT_V(24); else PG8_WAIT_V(16); } else PG8_WAIT_V(8);
            PG8_WAIT_L(0); PG8_BAR; PG8_MMA(0, 0, At, B0); PG8_MMA(0, 1, At, B1); PG8_BAR; PG8_SCHED;
            PG8_LDA(At, 0, 1); PG8_STAGE(PG8_SB(0, 0), b2, voffB); PG8_STAGE(PG8_SB(0, 1), b2 + hstep, voffB); PG8_STAGE(PG8_SA(0, 0), a2, s0);
            if (relax) { if constexpr (NEPI == 16) PG8_WAIT_V(24); else PG8_WAIT_V(16); } else PG8_WAIT_V(8);
            PG8_WAIT_L(0); PG8_BAR; PG8_MMA(1, 0, At, B0); PG8_MMA(1, 1, At, B1); PG8_BAR; PG8_SCHED;
            PG8_LDB(B0, 1, 0); PG8_LDB(B1, 1, 1); PG8_SCHED; PG8_LDA(At, 1, 0); PG8_STAGE(PG8_SA(0, 1), a2, s1);
            PG8_WAIT_V(8); PG8_WAIT_L(0); PG8_BAR; PG8_MMA(0, 0, At, B0); PG8_MMA(0, 1, At, B1); PG8_BAR; PG8_SCHED;
            PG8_LDA(At, 1, 1); PG8_STAGE(PG8_SB(1, 0), b3, voffB); PG8_STAGE(PG8_SB(1, 1), b3 + hstep, voffB); PG8_STAGE(PG8_SA(1, 0), a3, s0);
            PG8_WAIT_V(8); PG8_WAIT_L(0); PG8_BAR; PG8_MMA(1, 0, At, B0); PG8_MMA(1, 1, At, B1); PG8_BAR; PG8_SCHED;
        }
        if (wr == 0) PG8_BAR;
        E(acc, cur, ui, wr, wc, fr, fq, sclb + (ui & 1) * 512);
        if (!has_next) break;
#pragma unroll
        for (int a = 0; a < 2; ++a)
#pragma unroll
            for (int b = 0; b < 2; ++b)
#pragma unroll
                for (int m = 0; m < 4; ++m)
#pragma unroll
                    for (int n = 0; n < 2; ++n) acc[a][b][m][n] = acc_t{};
        cur = nxt; cA = nA; cB = nB; ++ui;
        PG8_SCALES(cur, ui);
        if constexpr (GATHER) {
#pragma unroll
            for (int h = 0; h < 2; ++h)
#pragma unroll
                for (int i = 0; i < 2; ++i) curA[h][i] = nxtA[h][i]; }
        if (wr == 1) PG8_BAR;
    }
    PG8_WAIT_V(0);
    PG8_BAR;
#undef PG8_SA
#undef PG8_SB
#undef PG8_STAGE
#undef PG8_LDA
#undef PG8_LDB
#undef PG8_MMA
#undef PG8_WAIT_V
#undef PG8_WAIT_L
#undef PG8_BAR
#undef PG8_SCHED
#undef PG8_MKA
#undef PG8_SCALES
}
}

namespace att {
constexpr int DV = 128, NW = 8, QBLK = 32, KVBLK = 64;
constexpr float THR = 8.f;
#define SBAR() __builtin_amdgcn_sched_barrier(0)
__device__ __forceinline__ int crow(int r, int hi) { return (r & 3) + 8 * (r >> 2) + 4 * hi; }
template <int DQK> struct Cfg {
    static constexpr int NQ = DQK / 16, SHM_K = KVBLK * DQK * 2, KCH = DQK / 64;
    static constexpr int RB0 = DQK >= 128 ? 256 : 128;
    static constexpr int KCH0 = DQK >= 128 ? 2 : 1, KCH1 = DQK == 192 ? 1 : 0, REG1 = KVBLK * RB0;
    static constexpr float SCALE = DQK == 64 ? 0.125f : (DQK == 128 ? 0.088388347648318440f : 0.072168783648703220f);
};
constexpr int SHM_V = KVBLK * DV * 2;

template <int DQK> __device__ __forceinline__ void partialSM(f32x16& p0, f32x16& p1, float& m_reg, float& mn, float& alpha) {
    constexpr float SCALE = Cfg<DQK>::SCALE, C = SCALE * 1.4426950408889634f;
    float pmax = p0[0];
#pragma unroll
    for (int r = 1; r < 16; ++r) pmax = fmaxf(pmax, p0[r]);
#pragma unroll
    for (int r = 0; r < 16; ++r) pmax = fmaxf(pmax, p1[r]);
    { auto rr = __builtin_amdgcn_permlane32_swap(__float_as_uint(pmax), __float_as_uint(pmax), false, false);
      pmax = fmaxf(__uint_as_float(rr[0]), __uint_as_float(rr[1])); }
    if (__builtin_expect(__all(pmax - m_reg <= THR / SCALE), 1)) { mn = m_reg; alpha = 1.f; }
    else { mn = fmaxf(m_reg, pmax); alpha = __builtin_amdgcn_exp2f((m_reg - mn) * C); m_reg = mn; }
    const float mnC = -mn * C;
#pragma unroll
    for (int r = 0; r < 16; ++r) p0[r] = fmaf(p0[r], C, mnC);
#pragma unroll
    for (int r = 0; r < 16; ++r) p1[r] = fmaf(p1[r], C, mnC);
#pragma unroll
    for (int r = 0; r < 16; ++r) p0[r] = __builtin_amdgcn_exp2f(p0[r]);
}
__device__ __forceinline__ void finishSM(f32x16& p0, f32x16& p1, float alpha, float& l_reg, bf16x8& pa0, bf16x8& pa1, bf16x8& pa2, bf16x8& pa3) {
#pragma unroll
    for (int r = 0; r < 16; ++r) p1[r] = __builtin_amdgcn_exp2f(p1[r]);
    float ps = 0;
#pragma unroll
    for (int r = 0; r < 16; ++r) ps += p0[r];
#pragma unroll
    for (int r = 0; r < 16; ++r) ps += p1[r];
    { auto rr = __builtin_amdgcn_permlane32_swap(__float_as_uint(ps), __float_as_uint(ps), false, false);
      ps = __uint_as_float(rr[0]) + __uint_as_float(rr[1]); }
    l_reg = l_reg * alpha + ps;
#define PK4(P, BASE, OUT) do { unsigned a0 = cvt_pk_bf16(P[BASE + 0], P[BASE + 1]), a1 = cvt_pk_bf16(P[BASE + 2], P[BASE + 3]);   \
    unsigned b0 = cvt_pk_bf16(P[BASE + 4], P[BASE + 5]), b1 = cvt_pk_bf16(P[BASE + 6], P[BASE + 7]);                              \
    auto r0 = __builtin_amdgcn_permlane32_swap(a0, b0, false, false); auto r1 = __builtin_amdgcn_permlane32_swap(a1, b1, false, false); \
    u32x4 w = {r0[0], r1[0], r0[1], r1[1]}; OUT = *reinterpret_cast<bf16x8*>(&w); } while (0)
    PK4(p0, 0, pa0); PK4(p0, 8, pa1); PK4(p1, 0, pa2); PK4(p1, 8, pa3);
#undef PK4
}
template <int DQK> __device__ __forceinline__ void qkt(f32x16& p0, f32x16& p1, const char* Ks, const bf16x8* qr, const char* qx, int r32, int hi) {
    p0 = f32x16{}; p1 = f32x16{};
    constexpr int RB0 = Cfg<DQK>::RB0;
#pragma unroll
    for (int d0 = 0; d0 < Cfg<DQK>::NQ; ++d0) {
        bf16x8 b0, b1, q;
        if (d0 < 8) { const int cb = (d0 * 16 + hi * 8) * 2;
            const int sw = (RB0 == 256 ? (r32 & 15) : ((r32 >> 1) & 7)) << 4;
            b0 = *reinterpret_cast<const bf16x8*>(Ks + r32 * RB0 + (cb ^ sw));
            b1 = *reinterpret_cast<const bf16x8*>(Ks + (32 + r32) * RB0 + (cb ^ sw));
            q = qr[d0 < 8 ? d0 : 0];
        } else { const int cb = ((d0 - 8) * 16 + hi * 8) * 2;
            const int sw = ((r32 >> 1) & 7) << 4;
            b0 = *reinterpret_cast<const bf16x8*>(Ks + Cfg<DQK>::REG1 + r32 * 128 + (cb ^ sw));
            b1 = *reinterpret_cast<const bf16x8*>(Ks + Cfg<DQK>::REG1 + (32 + r32) * 128 + (cb ^ sw));
            q = *reinterpret_cast<const bf16x8*>(qx + (d0 - 8) * 1024);
        }
        p0 = __builtin_amdgcn_mfma_f32_32x32x16_bf16(b0, q, p0, 0, 0, 0);
        p1 = __builtin_amdgcn_mfma_f32_32x32x16_bf16(b1, q, p1, 0, 0, 0); }
}
__device__ __forceinline__ int v_rd_base(int lane) { return ((lane & 3) << 3) | (((lane >> 2) & 3) << 6) | (((lane >> 4) & 1) << 5) | (((lane >> 5) & 1) << 8); }
constexpr int v_rd_off(int d0, int ks, int half) { return d0 * 512 + ks * 4096 + half * 2048; }
template <int OFF> __device__ __forceinline__ s16x4 tr_read(int vb) {
    s16x4 r; asm volatile("ds_read_b64_tr_b16 %0, %1 offset:%2" : "=&v"(r) : "v"(vb), "i"(OFF) : "memory"); return r;
}
template <int D0> __device__ __forceinline__ void pv_one(f32x16& od, int vb, bf16x8 pa0, bf16x8 pa1, bf16x8 pa2, bf16x8 pa3) {
    const s16x4 l0 = tr_read<v_rd_off(D0, 0, 0)>(vb), h0 = tr_read<v_rd_off(D0, 0, 1)>(vb), l1 = tr_read<v_rd_off(D0, 1, 0)>(vb), h1 = tr_read<v_rd_off(D0, 1, 1)>(vb);
    const s16x4 l2 = tr_read<v_rd_off(D0, 2, 0)>(vb), h2 = tr_read<v_rd_off(D0, 2, 1)>(vb), l3 = tr_read<v_rd_off(D0, 3, 0)>(vb), h3 = tr_read<v_rd_off(D0, 3, 1)>(vb);
    asm volatile("s_waitcnt lgkmcnt(0)" ::: "memory"); SBAR();
#define PK(L, H) (bf16x8){L[0], L[1], L[2], L[3], H[0], H[1], H[2], H[3]}
    od = __builtin_amdgcn_mfma_f32_32x32x16_bf16(pa0, PK(l0, h0), od, 0, 0, 0);
    od = __builtin_amdgcn_mfma_f32_32x32x16_bf16(pa1, PK(l1, h1), od, 0, 0, 0);
    od = __builtin_amdgcn_mfma_f32_32x32x16_bf16(pa2, PK(l2, h2), od, 0, 0, 0);
    od = __builtin_amdgcn_mfma_f32_32x32x16_bf16(pa3, PK(l3, h3), od, 0, 0, 0);
#undef PK
}
__device__ __forceinline__ void pv_d0(f32x16* o, int vb, bf16x8 pa0, bf16x8 pa1, bf16x8 pa2, bf16x8 pa3) {
    pv_one<0>(o[0], vb, pa0, pa1, pa2, pa3); pv_one<1>(o[1], vb, pa0, pa1, pa2, pa3); pv_one<2>(o[2], vb, pa0, pa1, pa2, pa3); pv_one<3>(o[3], vb, pa0, pa1, pa2, pa3);
}

template <int DQK, bool PIPE, bool QROPE, bool O8 = false>
__device__ __forceinline__ void attn_unit(const bf16_t* __restrict__ Qb, int ldq, const bf16_t* __restrict__ K0, int ldk0, const bf16_t* __restrict__ K1, int ldk1,
                                          const bf16_t* __restrict__ Vh, int ldv, bf16_t* __restrict__ Ob, int ldo, int nkeys, int qpos0, const f32x2* ropeR, const f32x2* ropeC,
                                          char* lds, LAS unsigned char* ldsl, const int tid) {
    using C = Cfg<DQK>; constexpr int NQ = C::NQ, SHM_K = C::SHM_K, NB = PIPE ? 3 : 2, KCH0 = C::KCH0, KCH1 = C::KCH1;
    const int wid = __builtin_amdgcn_readfirstlane(tid >> 6), lane = tid & 63, r32 = lane & 31, hi = lane >> 5;
    char* V_lds = lds; char* K_lds = lds + NB * SHM_V;
    float* ws = (float*)(lds + NB * SHM_V + NB * SHM_K) + wid * 64; float* li_l = ws; float* al_l = ws + 32;
    float m_reg = -1e30f, l_reg = 0; f32x16 o[4] = {}; constexpr int NQR = NQ < 8 ? NQ : 8; bf16x8 qr[NQR];
    char* qx = lds + NB * SHM_V + NB * SHM_K + 2048 + wid * 4096 + lane * 16;
    const bf16_t* Qw = Qb + (long)(wid * QBLK + r32) * ldq + hi * 8;
#pragma unroll
    for (int d0 = 0; d0 < NQR; ++d0) qr[d0] = *reinterpret_cast<const bf16x8*>(Qw + d0 * 16);
    if constexpr (QROPE) {
        static_assert(DQK == 192, "QROPE: MLA layout");
        const int pos = qpos0 + wid * QBLK + r32, gr = pos >> 6, gc = pos & 63;
#pragma unroll
        for (int blk = 0; blk < 2; ++blk) { const f32x2* tb = (blk == 0 ? ropeR + gr * 16 : ropeC + gc * 16) + hi * 8;
            bf16x8 x1 = *reinterpret_cast<const bf16x8*>(Qw + (8 + 2 * blk) * 16), x2 = *reinterpret_cast<const bf16x8*>(Qw + (9 + 2 * blk) * 16);
#pragma unroll
            for (int i = 0; i < 8; ++i) { const f32x2 cs = tb[i]; const float a = bf2f((unsigned short)x1[i]), b = bf2f((unsigned short)x2[i]);
                x1[i] = (short)f2bf(a * cs.x - b * cs.y); x2[i] = (short)f2bf(b * cs.x + a * cs.y); }
            *reinterpret_cast<bf16x8*>(qx + (2 * blk) * 1024) = x1; *reinterpret_cast<bf16x8*>(qx + (2 * blk + 1) * 1024) = x2; }
    } else { static_assert(NQ <= 8, "fragments beyond 8 need the LDS path"); }
    unsigned voffv[2], koff[KCH0 + (KCH1 ? 1 : 0)];
#pragma unroll
    for (int i = 0; i < 2; ++i) { const int st = 4 * wid + 2 * i + (lane >> 5), kk = (st >> 2) * 8 + ((lane & 31) >> 2), k = (kk & ~0xC) | ((kk & 4) << 1) | ((kk & 8) >> 1), c = (st & 3) * 32 + (lane & 3) * 8;
        voffv[i] = (unsigned)(k * ldv + c) * 2u; }
#pragma unroll
    for (int i = 0; i < KCH0; ++i) { const int sgm = KCH0 * wid + i; int row, q; if (C::RB0 == 256) { row = 4 * sgm + (lane >> 4); q = lane & 15; } else { row = 8 * sgm + (lane >> 3); q = lane & 7; }
        koff[i] = (unsigned)(row * ldk0 + (q ^ (C::RB0 == 256 ? (row & 15) : ((row >> 1) & 7))) * 8) * 2u; }
    if constexpr (KCH1) { const int row = 8 * wid + (lane >> 3), q = lane & 7; koff[KCH0] = (unsigned)(row * ldk1 + (q ^ ((row >> 1) & 7)) * 8) * 2u; }
    const int vb0 = (int)(uintptr_t)V_lds + v_rd_base(lane);
    LAS unsigned char* Vl = ldsl; LAS unsigned char* Kl = ldsl + NB * SHM_V;
#define GLDS(gp, lp) __builtin_amdgcn_global_load_lds((const unsigned*)(gp), (LAS unsigned*)(lp), 16, 0, 0)
#define DMA(k0, b) do { const char* _vb = (const char*)(Vh + (long)(k0) * ldv); const char* _kb0 = (const char*)(K0 + (long)(k0) * ldk0); \
    _Pragma("unroll") for (int _i = 0; _i < 2; ++_i) GLDS(_vb + voffv[_i], Vl + (b) * SHM_V + (2 * wid + _i) * 1024); \
    _Pragma("unroll") for (int _i = 0; _i < KCH0; ++_i) GLDS(_kb0 + koff[_i], Kl + (b) * SHM_K + (KCH0 * wid + _i) * 1024); \
    if constexpr (KCH1) { const char* _kb1 = (const char*)(K1 + (long)(k0) * ldk1); GLDS(_kb1 + koff[KCH0], Kl + (b) * SHM_K + C::REG1 + wid * 1024); } } while (0)
#define VM0() asm volatile("s_waitcnt vmcnt(0)" ::: "memory")
#define RESC(a) do { if (__any((a) < 1.f)) { if (hi == 0) al_l[r32] = (a); asm volatile("s_waitcnt lgkmcnt(0)" ::: "memory"); \
    _Pragma("unroll") for (int d = 0; d < 4; ++d) _Pragma("unroll") for (int r = 0; r < 16; ++r) o[d][r] *= al_l[crow(r, hi)]; } } while (0)
    bf16x8 pa0, pa1, pa2, pa3; const int NT = nkeys / KVBLK;
    if constexpr (PIPE) {
        f32x16 pA0, pA1, pB0, pB1; float mnA, mnB, alA, alB;
        int bc = 1, bp = 0, bn = 2;
        DMA(0, 0); DMA(KVBLK, 1); VM0(); __syncthreads();
        qkt<DQK>(pA0, pA1, K_lds, qr, qx, r32, hi); partialSM<DQK>(pA0, pA1, m_reg, mnA, alA);
#define STEP(PC0, PC1, mnC, alC, PP0, PP1, alP, j) do { \
        if ((j) + 1 < NT) DMA(((j) + 1) * KVBLK, bn); \
        SBAR(); qkt<DQK>(PC0, PC1, K_lds + bc * SHM_K, qr, qx, r32, hi); \
        finishSM(PP0, PP1, alP, l_reg, pa0, pa1, pa2, pa3); SBAR(); \
        pv_d0(o, vb0 + bp * SHM_V, pa0, pa1, pa2, pa3); partialSM<DQK>(PC0, PC1, m_reg, mnC, alC); \
        RESC(alC); VM0(); __syncthreads(); \
        { const int _t = bp; bp = bc; bc = bn; bn = _t; } } while (0)
        int j = 1;
        for (; j + 1 < NT; j += 2) { STEP(pB0, pB1, mnB, alB, pA0, pA1, alA, j); STEP(pA0, pA1, mnA, alA, pB0, pB1, alB, j + 1); }
        STEP(pB0, pB1, mnB, alB, pA0, pA1, alA, j);
#undef STEP
        finishSM(pB0, pB1, alB, l_reg, pa0, pa1, pa2, pa3); SBAR();
        pv_d0(o, vb0 + bp * SHM_V, pa0, pa1, pa2, pa3);
    } else {
        f32x16 p0, p1; float mn, al;
        DMA(0, 0); VM0(); __syncthreads();
        for (int j = 0; j < NT; ++j) {
            const int bs = j & 1;
            if (j + 1 < NT) DMA((j + 1) * KVBLK, bs ^ 1);
            SBAR(); qkt<DQK>(p0, p1, K_lds + bs * SHM_K, qr, qx, r32, hi); partialSM<DQK>(p0, p1, m_reg, mn, al);
            RESC(al);
            finishSM(p0, p1, al, l_reg, pa0, pa1, pa2, pa3); SBAR();
            pv_d0(o, vb0 + bs * SHM_V, pa0, pa1, pa2, pa3);
            VM0(); __syncthreads();
        }
    }
    if (hi == 0) li_l[r32] = l_reg; asm volatile("s_waitcnt lgkmcnt(0)" ::: "memory");
    float rli[16];
#pragma unroll
    for (int r = 0; r < 16; ++r) rli[r] = __builtin_amdgcn_rcpf(li_l[crow(r, hi)]);
    if constexpr (O8) { unsigned char* Ow = (unsigned char*)Ob + (long)(wid * QBLK) * ldo;
#pragma unroll
        for (int r = 0; r < 16; ++r) { const int orow = crow(r, hi);
#pragma unroll
            for (int d0 = 0; d0 < 4; ++d0) Ow[(long)orow * ldo + d0 * 32 + r32] = (unsigned char)__builtin_amdgcn_cvt_pk_fp8_f32(o[d0][r] * rli[r], 0.0f, 0, false); } }
    else { bf16_t* Ow = Ob + (long)(wid * QBLK) * ldo;
#pragma unroll
    for (int r = 0; r < 16; ++r) { const int orow = crow(r, hi);
#pragma unroll
        for (int d0 = 0; d0 < 4; ++d0) Ow[(long)orow * ldo + d0 * 32 + r32] = (bf16_t)f2bf(o[d0][r] * rli[r]); } }
    asm volatile("s_waitcnt vmcnt(0)" ::: "memory");
    __syncthreads();
#undef GLDS
#undef DMA
#undef VM0
#undef RESC
}
}

struct Args { const float* in[28]; float* out; unsigned char* ws; int ph_lo, ph_hi; };
typedef const __attribute__((address_space(4))) Args* KArgs;
struct Frame {
    LAS unsigned char* lds; char* ldsg;
    unsigned* ctl; unsigned char* ws; KArgs ka;
    int tid, lane, wave, vcu, G, gw, NGW;
};
#define PHASE_BEGIN(F) __syncthreads(); Frame P = (F); { int _l; asm volatile("v_mbcnt_lo_u32_b32 %0, -1, 0\n\tv_mbcnt_hi_u32_b32 %0, -1, %0" : "=v"(_l)); long _z = 0; asm volatile("" : "+s"(_z)); unsigned char* _w = (F).ka->ws + _z; P.ws = _w; P.ctl = (unsigned*)_w;     \
    P.lane = _l; P.tid = P.wave * 64 + _l; P.gw = P.vcu * 8 + P.wave; }
enum { I_X = 0, I_C, I_CTX, I_CCTX, I_ADAW, I_ADAB, I_LNMG, I_LNMB, I_LNFG, I_LNFB, I_ABWIN, I_ABWOUT, I_DLAM, I_SUBLN, I_QNG, I_KNG,
       I_MDOWN, I_MQNG, I_MUQ, I_MKVNG, I_MUKV, I_MWO, I_RW, I_RB, I_EWIN, I_EWOUT, I_SWIN, I_SWOUT };

__device__ __forceinline__ int tok_row(int layer, int t) { return layer ? (t >> 11) * RPB + CTXL + (t & 2047) : t; }

__constant__ float INV128[32] = { 1.f, 0.749894202f, 0.562341332f, 0.421696514f, 0.316227764f, 0.237137392f, 0.177827939f, 0.133352146f, 0.100000001f, 0.0749894157f, 0.0562341288f, 0.0421696492f,
    0.0316227786f, 0.0237137359f, 0.0177827943f, 0.0133352149f, 0.00999999978f, 0.00749894232f, 0.00562341325f, 0.00421696482f, 0.00316227786f, 0.00237137382f, 0.00177827943f, 0.00133352145f,
    0.00100000005f, 0.000749894185f, 0.000562341302f, 0.000421696546f, 0.000316227786f, 0.000237137385f, 0.00017782794f, 0.00013335215f };

__device__ __forceinline__ f32x2 sincos_d(double a) {
    const double twopi = 6.283185307179586476925287;
    const double k = __builtin_rint(a / twopi); const double r = a - k * twopi, r2 = r * r;
    double ts = r, tc = 1.0, ss = r, cc = 1.0;
#pragma unroll 1
    for (int n = 1; n <= 15; ++n) { tc *= -r2 / (double)((2 * n - 1) * (2 * n)); cc += tc; ts *= -r2 / (double)((2 * n) * (2 * n + 1)); ss += ts; }
    return (f32x2){(float)cc, (float)ss};
}

__device__ __forceinline__ int fresh_lane() { int l; asm volatile("v_mbcnt_lo_u32_b32 %0, -1, 0\n\tv_mbcnt_hi_u32_b32 %0, -1, %0" : "=v"(l)); return l; }
__device__ __forceinline__ int fresh_tid(const Frame& F) { return F.wave * 64 + fresh_lane(); }
__device__ __forceinline__ void transpose_item(const float* W, int K, int N, bf16_t* WT, int k0, int n0, int drow0, LAS float* scr, int lane) {
#pragma unroll 8
    for (int i = 0; i < 32; ++i) { const int kk = 2 * i + (lane >> 5); scr[kk * 33 + (lane & 31)] = W[(size_t)(k0 + kk) * N + n0 + (lane & 31)]; }
    asm volatile("s_waitcnt lgkmcnt(0)" ::: "memory");
    const int c = lane & 7;
#pragma unroll
    for (int j = 0; j < 4; ++j) { const int n = (lane >> 3) + 8 * j; const LAS float* s = scr + (8 * c) * 33 + n;
        u32x4 o; o.x = pk2(s[0 * 33], s[1 * 33]); o.y = pk2(s[2 * 33], s[3 * 33]); o.z = pk2(s[4 * 33], s[5 * 33]); o.w = pk2(s[6 * 33], s[7 * 33]);
        *(u32x4*)(WT + (size_t)(drow0 + n) * K + k0 + 8 * c) = o; }
    asm volatile("s_waitcnt lgkmcnt(0)" ::: "memory");
}
struct QItem { const float* W; int N, n0, drow; signed char* Q; float* SW; };
template <int KW, int NC, class Dec, bool F8 = false>
__device__ __forceinline__ void quant_loop(Frame& F, int nitems, const Dec& dec, int first) {
    LAS unsigned short* scr = (LAS unsigned short*)(F.lds + F.wave * 16384);
    LAS float* PM = (LAS float*)(F.lds + 131072);
    constexpr int K = 8 * KW, CH = KW / 16, LPR = NC / 4, RPI = 64 / LPR, NL = KW / RPI;
    static_assert(KW * NC * 2 <= 16384 && (NC == 32 || NC == 64), "quant_loop tile");
    const int k0 = F.wave * KW, rg = F.lane / LPR, c4 = (F.lane % LPR) * 4;
    f32x4 regs[NL]; QItem cur, nxt;
    int it = first; if (it >= nitems) return;
    dec(it, cur);
#pragma unroll
    for (int i = 0; i < NL; ++i) regs[i] = __builtin_nontemporal_load((const f32x4*)(cur.W + (size_t)(k0 + RPI * i + rg) * cur.N + cur.n0 + c4));
    for (;;) {
        f32x4 am = {0.f, 0.f, 0.f, 0.f};
#pragma unroll
        for (int i = 0; i < NL; ++i) { const f32x4 w = regs[i]; am[0] = fmaxf(am[0], fabsf(w[0])); am[1] = fmaxf(am[1], fabsf(w[1])); am[2] = fmaxf(am[2], fabsf(w[2])); am[3] = fmaxf(am[3], fabsf(w[3]));
            const int sw = (((RPI * i) >> 4) & 15) << 1;
            const unsigned lo = cvt_pk_bf16(w[0], w[1]), hi = cvt_pk_bf16(w[2], w[3]);
            *(LAS u32x2*)(scr + (RPI * i + rg) * NC + (c4 ^ (sw & 28))) = (sw & 2) ? (u32x2){hi, lo} : (u32x2){lo, hi}; }
#pragma unroll
        for (int q = 0; q < 4; ++q) { float v = am[q];
#pragma unroll
            for (int o = LPR; o < 64; o <<= 1) v = fmaxf(v, __shfl_xor(v, o));
            am[q] = v; }
        if (F.lane < LPR) *(LAS f32x4*)(PM + F.wave * NC + c4) = am;
        __syncthreads();
        if (F.tid < NC) { float m = 0.f;
#pragma unroll
            for (int w = 0; w < 8; ++w) m = fmaxf(m, PM[w * NC + F.tid]);
            PM[512 + F.tid] = m > 0.f ? (F8 ? 448.0f : 127.0f) / m : 0.f; cur.SW[cur.drow + F.tid] = m * (1.0f / (F8 ? 448.0f : 127.0f)); }
        __syncthreads();
        const int itn = it + F.G; const bool has_next = itn < nitems;
        if (has_next) { dec(itn, nxt);
#pragma unroll
            for (int i = 0; i < NL; ++i) regs[i] = __builtin_nontemporal_load((const f32x4*)(nxt.W + (size_t)(k0 + RPI * i + rg) * nxt.N + nxt.n0 + c4)); }
#pragma unroll 1
        for (int pass = 0; pass < NC * CH / 64; ++pass) { const int cidx = pass * 64 + F.lane, n = cidx / CH, kb = (cidx % CH) * 16; const float inv = PM[512 + n]; u32x4 o;
#pragma unroll
            for (int d = 0; d < 4; ++d) { float x[4];
#pragma unroll
                for (int e = 0; e < 4; ++e) x[e] = bf2f(scr[(kb + d * 4 + e) * NC + (n ^ (((kb >> 4) & 15) << 1))]);
                if constexpr (F8) { int w = 0; w = __builtin_amdgcn_cvt_pk_fp8_f32(x[0] * inv, x[1] * inv, w, false); w = __builtin_amdgcn_cvt_pk_fp8_f32(x[2] * inv, x[3] * inv, w, true); o[d] = (unsigned)w; }
                else o[d] = q8x4(x[0], x[1], x[2], x[3], inv); }
            *(u32x4*)(cur.Q + (size_t)(cur.drow + n) * K + k0 + kb) = o; }
        __syncthreads();
        if (!has_next) break;
        it = itn; cur = nxt;
    }
}
struct DecDense256 { KArgs ka; unsigned char* ws;
    static constexpr int NITEMS = 144 + 64 + 34 + 64;
    __device__ __forceinline__ void operator()(int it, QItem& p) const { float* SWD = (float*)(ws + WS_SWD); int r = it;
        if (r < 144) { p.W = ka->in[I_ABWIN]; p.N = ABW; p.Q = (signed char*)(ws + WS_W_IN); p.SW = SWD + SWD_IN; }
        else if ((r -= 144) < 64) { p.W = ka->in[I_ABWOUT]; p.N = 2048; p.Q = (signed char*)(ws + WS_W_OUT); p.SW = SWD + SWD_OUT; }
        else if ((r -= 64) < 34) { p.W = ka->in[I_MDOWN]; p.N = 1088; p.Q = (signed char*)(ws + WS_W_DOWN); p.SW = SWD + SWD_DOWN; }
        else { r -= 34; p.W = ka->in[I_MWO]; p.N = 2048; p.Q = (signed char*)(ws + WS_W_O); p.SW = SWD + SWD_O; }
        p.n0 = r * 32; p.drow = p.n0; }
};
struct DecDense64 { KArgs ka; unsigned char* ws;
    static constexpr int NITEMS = 48 + 64;
    __device__ __forceinline__ void operator()(int it, QItem& p) const { float* SWD = (float*)(ws + WS_SWD); int r = it;
        if (r < 48) { p.W = ka->in[I_MUQ]; p.N = UQ_N; p.Q = (signed char*)(ws + WS_W_UQ); p.SW = SWD + SWD_UQ; }
        else { r -= 48; p.W = ka->in[I_MUKV]; p.N = UKV_N; p.Q = (signed char*)(ws + WS_W_UKV); p.SW = SWD + SWD_UKV; }
        p.n0 = r * 64; p.drow = p.n0; }
};
struct DecExpIn { KArgs ka; unsigned char* ws; int layer;
    static constexpr int NITEMS = 65 * 32;
    __device__ __forceinline__ void operator()(int it, QItem& p) const { const int e = it >> 5, m = layer * 65 + e; p.n0 = (it & 31) * 32; p.N = 1024;
        p.W = (e < 64) ? ka->in[I_EWIN] + ((size_t)layer * 64 + e) * 2048 * 1024 : ka->in[I_SWIN] + (size_t)layer * 2048 * 1024;
        p.drow = (p.n0 < 512) ? ((p.n0 >> 7) * 256 + (p.n0 & 127)) : (((p.n0 - 512) >> 7) * 256 + 128 + ((p.n0 - 512) & 127));
        p.Q = (signed char*)(ws + WS_EXP_IN + (size_t)m * EXP_IN_BYTES); p.SW = (float*)(ws + WS_SW) + (size_t)m * 1024; }
};
struct DecExpOut { KArgs ka; unsigned char* ws; int layer;
    static constexpr int NITEMS = 65 * 32;
    __device__ __forceinline__ void operator()(int it, QItem& p) const { const int e = it >> 5, m = layer * 65 + e; p.n0 = (it & 31) * 64; p.N = 2048;
        p.W = (e < 64) ? ka->in[I_EWOUT] + ((size_t)layer * 64 + e) * 512 * 2048 : ka->in[I_SWOUT] + (size_t)layer * 512 * 2048;
        p.Q = (signed char*)(ws + WS_EXP_OUT + (size_t)m * EXP_OUT_BYTES); p.SW = (float*)(ws + WS_SW2) + (size_t)m * 2048; p.drow = p.n0; }
};
__device__ __forceinline__ void side_quant_experts(Frame& F, int layer);
__device__ __forceinline__ void transpose_matrix(Frame& F, const float* W, int K, int N, bf16_t* WT, int mode, int& cursor) {
    LAS float* scr = (LAS float*)(F.lds + F.wave * 16384);
    const int nblk = N / 32, nitems = (K / 64) * nblk;
    int it = (F.gw - cursor) % F.NGW; if (it < 0) it += F.NGW;
    for (; it < nitems; it += F.NGW) { const int kb = it / nblk, nb = it % nblk, n0 = nb * 32;
        int drow = n0; if (mode == 1) drow = (n0 < 512) ? ((n0 >> 7) * 256 + (n0 & 127)) : (((n0 - 512) >> 7) * 256 + 128 + ((n0 - 512) & 127));
        transpose_item(W, K, N, WT, kb * 64, n0, drow, scr, F.lane); }
    cursor = (cursor + nitems) % F.NGW;
}

__device__ __forceinline__ void p0_prologue(Frame& F) {
    {
        LAS float* act = (LAS float*)F.lds;
        LAS float* part = (LAS float*)(F.lds + 9 * 2048 * 4);
        for (int i = F.tid; i < 9 * 2048; i += 512) { const int m = i >> 11, k = i & 2047; const float v = (m < 8) ? F.ka->in[I_C][m * 2048 + k] : F.ka->in[I_CCTX][k]; act[i] = v / (1.0f + __expf(-v)); }
        __syncthreads();
        float* MOD = (float*)(F.ws + WS_MOD);
        const int l16 = F.lane & 15, kg = (F.tid >> 4);
        for (int item = F.vcu; item < 2 * 192; item += F.G) {
            const int layer = item / 192, n0 = (item % 192) * 64;
            const float* W = F.ka->in[I_ADAW] + (size_t)layer * 2048 * 12288 + n0 + l16 * 4;
            f32x4 acc[9];
#pragma unroll
            for (int m = 0; m < 9; ++m) acc[m] = (f32x4){0.f, 0.f, 0.f, 0.f};
#pragma unroll 4
            for (int j = 0; j < 64; ++j) { const int k = kg + 32 * j; const f32x4 w = *(const f32x4*)(W + (size_t)k * 12288);
#pragma unroll
                for (int m = 0; m < 9; ++m) acc[m] += w * act[m * 2048 + k]; }
#pragma unroll
            for (int m = 0; m < 9; ++m)
#pragma unroll
                for (int q = 0; q < 4; ++q) { float v = acc[m][q]; v += __shfl_xor(v, 16); v += __shfl_xor(v, 32); acc[m][q] = v; }
            if (F.lane < 16) {
#pragma unroll
                for (int m = 0; m < 9; ++m) *(LAS f32x4*)(part + (F.wave * 9 + m) * 64 + l16 * 4) = acc[m]; }
            __syncthreads();
            for (int i = F.tid; i < 9 * 64; i += 512) { const int m = i >> 6, n = i & 63; float s = 0.f;
#pragma unroll
                for (int w = 0; w < 8; ++w) s += part[(w * 9 + m) * 64 + n];
                MOD[((size_t)layer * 9 + m) * 12288 + n0 + n] = s + F.ka->in[I_ADAB][layer * 12288 + n0 + n]; }
            __syncthreads();
        }
    }
    {
        f32x2* tab = (f32x2*)(F.ws + WS_TAB);
        for (int i = F.gw * 64 + F.lane; i < 512 + 1024 + 1024 + 2048; i += F.NGW * 64) {
            int pos, f; double inv; f32x2* dst;
            if (i < 512) { pos = i >> 4; f = i & 15; inv = (double)INV128[2 * f]; dst = tab + TAB64R / 8 + i; }
            else if (i < 1536) { const int j = i - 512; pos = j >> 4; f = j & 15; inv = (double)INV128[2 * f]; dst = tab + TAB64C / 8 + j; }
            else if (i < 2560) { const int j = i - 1536; pos = j >> 5; f = j & 31; inv = (double)INV128[f]; dst = tab + TAB128R / 8 + j; }
            else { const int j = i - 2560; pos = j >> 5; f = j & 31; inv = (double)INV128[f]; dst = tab + TAB128C / 8 + j; }
            *dst = sincos_d((double)(float)((float)pos * (float)inv));
        }
        u32x4* z = (u32x4*)(F.ws + WS_W_DOWN + (size_t)1088 * D);
        for (int i = F.gw * 64 + F.lane; i < (DOWN_N - 1088) * D / 16; i += F.NGW * 64) z[i] = (u32x4){0u, 0u, 0u, 0u};
        for (int i = F.gw * 64 + F.lane; i < DOWN_N - 1088; i += F.NGW * 64) ((float*)(F.ws + WS_SWD))[SWD_DOWN + 1088 + i] = 0.f;
    }
    {
        { DecDense256 d{F.ka, F.ws}; quant_loop<256, 32>(F, DecDense256::NITEMS - 64, d, F.vcu); __syncthreads();
          quant_loop<256, 32, DecDense256, true>(F, DecDense256::NITEMS, d, DecDense256::NITEMS - 64 + F.vcu); }
        __syncthreads();
        { DecDense64 d{F.ka, F.ws}; quant_loop<64, 64>(F, DecDense64::NITEMS, d, F.vcu); }
        __syncthreads();
        int cursor = 0;
        for (int l = 0; l < 2; ++l) transpose_matrix(F, F.ka->in[I_RW] + (size_t)l * 2048 * 64, 2048, 64, (bf16_t*)(F.ws + WS_ROUTER + (size_t)l * 64 * 2048 * 2), 0, cursor);
    }
}

__device__ __forceinline__ void side_quant_experts(Frame& F, int layer) {
    __syncthreads();
    const unsigned* qw = (const unsigned*)(F.ws + WS_CTL) + CW_QW + layer * 32;
    const int q0 = min((int)__hip_atomic_load(qw, RLX_AGENT), DecExpIn::NITEMS), q1 = min((int)__hip_atomic_load(qw + 16, RLX_AGENT), DecExpOut::NITEMS);
    { DecExpIn d{F.ka, F.ws, layer}; quant_loop<256, 32>(F, DecExpIn::NITEMS, d, q0 + (int)blockIdx.x); }
    __syncthreads();
    { DecExpOut d{F.ka, F.ws, layer}; quant_loop<64, 64, DecExpOut, true>(F, DecExpOut::NITEMS, d, q1 + (int)blockIdx.x); }
    __syncthreads();
}
__device__ __forceinline__ void tail_quant(Frame& F, int layer, int n_in, int n_out) {
    unsigned* qw = (unsigned*)(F.ws + WS_CTL) + CW_QW + layer * 32;
    LAS int* slot = (LAS int*)(F.lds + QSLOT_OFF);
#pragma unroll 1
    for (int n = 0; n < n_in; ++n) {
        __syncthreads();
        if (F.tid == 0) *slot = (int)__hip_atomic_fetch_add(qw, 1u, RLX_AGENT);
        __syncthreads();
        const int it = *slot;
        if (it < DecExpIn::NITEMS) { DecExpIn d{F.ka, F.ws, layer}; quant_loop<256, 32>(F, it + 1, d, it); }
    }
#pragma unroll 1
    for (int n = 0; n < n_out; ++n) {
        __syncthreads();
        if (F.tid == 0) *slot = (int)__hip_atomic_fetch_add(qw + 16, 1u, RLX_AGENT);
        __syncthreads();
        const int it = *slot;
        if (it < DecExpOut::NITEMS) { DecExpOut d{F.ka, F.ws, layer}; quant_loop<64, 64, DecExpOut, true>(F, it + 1, d, it); }
    }
    __syncthreads();
}
__device__ __forceinline__ bool is_tail_wg(int nunits, int G, int c) { const int mx = (nunits + G - 1) / G, mine = c < nunits ? (nunits - c + G - 1) / G : 0; return mine < mx; }
__device__ __forceinline__ const float* x_src(Frame& F, int layer, int r) {
    if (layer) return (const float*)(F.ws + WS_X) + (size_t)r * D;
    const int b = r / RPB, i = r - b * RPB;
    return (i < CTXL) ? F.ka->in[I_CTX] + ((size_t)b * CTXL + i) * D : F.ka->in[I_X] + ((size_t)b * SEQ + (i - CTXL)) * D;
}
__device__ __forceinline__ const float* mod_row(Frame& F, int layer, int r) { const int b = r / RPB, i = r - b * RPB; return (const float*)(F.ws + WS_MOD) + ((size_t)layer * 9 + ((i < CTXL) ? 8 : b)) * 12288; }

__device__ __forceinline__ void ld8f(const float* p, float (&v)[8]) { const f32x4 a = *(const f32x4*)p, b = *(const f32x4*)(p + 4); v[0] = a[0]; v[1] = a[1]; v[2] = a[2]; v[3] = a[3]; v[4] = b[0]; v[5] = b[1]; v[6] = b[2]; v[7] = b[3]; }
__device__ __forceinline__ void ld8f_nt(const float* p, float (&v)[8]) { const f32x4 a = __builtin_nontemporal_load((const f32x4*)p), b = __builtin_nontemporal_load((const f32x4*)(p + 4)); v[0] = a[0]; v[1] = a[1]; v[2] = a[2]; v[3] = a[3]; v[4] = b[0]; v[5] = b[1]; v[6] = b[2]; v[7] = b[3]; }
__device__ __forceinline__ void ld8l(const LAS float* p, float (&v)[8]) { const f32x4 a = *(const LAS f32x4*)p, b = *(const LAS f32x4*)(p + 4); v[0] = a[0]; v[1] = a[1]; v[2] = a[2]; v[3] = a[3]; v[4] = b[0]; v[5] = b[1]; v[6] = b[2]; v[7] = b[3]; }
__device__ __forceinline__ void st8f(float* p, const float (&v)[8]) { *(f32x4*)p = (f32x4){v[0], v[1], v[2], v[3]}; *(f32x4*)(p + 4) = (f32x4){v[4], v[5], v[6], v[7]}; }
__device__ __forceinline__ void unpk8(const u32x4 w, float (&v)[8]) {
#pragma unroll
    for (int e = 0; e < 4; ++e) { v[2 * e] = bflo(w[e]); v[2 * e + 1] = bfhi(w[e]); } }
__device__ __forceinline__ void unfp8(const u32x2 w, float (&v)[8]) {
#pragma unroll
    for (int d = 0; d < 2; ++d) { const f32x2 a = __builtin_amdgcn_cvt_pk_f32_fp8((int)w[d], false), b = __builtin_amdgcn_cvt_pk_f32_fp8((int)w[d], true); v[4 * d] = a.x; v[4 * d + 1] = a.y; v[4 * d + 2] = b.x; v[4 * d + 3] = b.y; } }
__device__ __forceinline__ u32x4 pk8(const float (&v)[8]) { u32x4 w;
#pragma unroll
    for (int e = 0; e < 4; ++e) w[e] = pk2(v[2 * e], v[2 * e + 1]);
    return w; }

__device__ __forceinline__ void quant_row_store(const float (&v)[4][8], signed char* dst, float* scale, int lane) {
    float am = 0.f;
#pragma unroll
    for (int j = 0; j < 4; ++j)
#pragma unroll
        for (int e = 0; e < 8; ++e) am = fmaxf(am, fabsf(v[j][e]));
#pragma unroll
    for (int o = 1; o < 64; o <<= 1) am = fmaxf(am, __shfl_xor(am, o));
    const float inv = am > 0.f ? 127.0f / am : 0.f;
    if (lane == 0) *scale = am * (1.0f / 127.0f);
#pragma unroll
    for (int j = 0; j < 4; ++j) { u32x2 w;
#pragma unroll
        for (int d = 0; d < 2; ++d) w[d] = q8x4(v[j][d * 4], v[j][d * 4 + 1], v[j][d * 4 + 2], v[j][d * 4 + 3], inv);
        *(u32x2*)(dst + 512 * j + 8 * lane) = w; }
}
__device__ __forceinline__ void quant_row512_store(const float (&v)[8], signed char* dst, float* scale, int lane) {
    float am = 0.f;
#pragma unroll
    for (int e = 0; e < 8; ++e) am = fmaxf(am, fabsf(v[e]));
#pragma unroll
    for (int o = 1; o < 64; o <<= 1) am = fmaxf(am, __shfl_xor(am, o));
    const float inv = am > 0.f ? 127.0f / am : 0.f;
    if (lane == 0) *scale = am * (1.0f / 127.0f);
    u32x2 w;
#pragma unroll
    for (int d = 0; d < 2; ++d) w[d] = q8x4(v[d * 4], v[d * 4 + 1], v[d * 4 + 2], v[d * 4 + 3], inv);
    *(u32x2*)(dst + 8 * lane) = w;
}

template <int R> __device__ __forceinline__ void p1_rows(Frame& F, int t0, int i) {
    const LAS float* PA = (const LAS float*)F.lds;
    float x[R][4][8]; int var[R];
#pragma unroll
    for (int q = 0; q < R; ++q) { const int r = t0 + i + 8 * q; const float* xs = x_src(F, 0, r); var[q] = ((r % RPB) < CTXL) ? 2 : 0;
#pragma unroll
        for (int j = 0; j < 4; ++j) ld8f_nt(xs + 512 * j + 8 * F.lane, x[q][j]); }
#pragma unroll
    for (int q = 0; q < R; ++q) { const int r = t0 + i + 8 * q;
#pragma unroll
        for (int j = 0; j < 4; ++j) { const int c = 512 * j + 8 * F.lane; float sh[8], sc[8]; ld8l(PA + var[q] * 2048 + c, sh); ld8l(PA + (var[q] + 1) * 2048 + c, sc);
#pragma unroll
            for (int e = 0; e < 8; ++e) x[q][j][e] = x[q][j][e] * (1.0f + sc[e]) + sh[e]; }
        quant_row_store(x[q], (signed char*)(F.ws + WS_H8) + (size_t)r * D, (float*)(F.ws + WS_SA) + r, F.lane); }
}
__device__ __forceinline__ void p1_modulate(Frame& F) {
    LAS float* PA = (LAS float*)F.lds;
    constexpr int BR = 72, nblk = T_ALL / BR;
    const float* MOD = (const float*)(F.ws + WS_MOD);
    for (int blk = F.vcu; blk < nblk; blk += F.G) {
        const int t0 = blk * BR, b = t0 / RPB;
        __syncthreads();
        { const int c = F.tid * 4; const float* mb = MOD + (size_t)b * 12288; const float* mc = MOD + (size_t)8 * 12288;
          *(LAS f32x4*)(PA + c) = *(const f32x4*)(mb + c); *(LAS f32x4*)(PA + 2048 + c) = *(const f32x4*)(mb + 2048 + c);
          *(LAS f32x4*)(PA + 4096 + c) = *(const f32x4*)(mc + c); *(LAS f32x4*)(PA + 6144 + c) = *(const f32x4*)(mc + 2048 + c); }
        __syncthreads();
        for (int i = F.wave; i < BR; i += 16) { if (i + 8 < BR) p1_rows<2>(F, t0, i); else p1_rows<1>(F, t0, i); }
    }
}

__device__ __forceinline__ void p_post_ab(Frame& F) {
    bf16_t* P = (bf16_t*)(F.ws + WS_PROJ);
    const f32x2* t64r = (const f32x2*)(F.ws + WS_TAB + TAB64R); const f32x2* t64c = (const f32x2*)(F.ws + WS_TAB + TAB64C);
    const f32x2* t128r = (const f32x2*)(F.ws + WS_TAB + TAB128R); const f32x2* t128c = (const f32x2*)(F.ws + WS_TAB + TAB128C);
    const float* qg = F.ka->in[I_QNG]; const float* kg = F.ka->in[I_KNG];
    for (int r = F.gw; r < T_ALL; r += F.NGW) {
        const int b = r / RPB, i = r - b * RPB; const bool lat = i >= CTXL; const int pos = i - CTXL, gr = pos >> 6, gc = pos & 63;
        bf16_t* row = P + (size_t)r * ABW;
        if (lat) {
            bf16_t* blk = row + F.lane * 32; const f32x2* tb = (F.lane & 1) ? t64c + gc * 16 : t64r + gr * 16;
            u32x4 w[4];
#pragma unroll
            for (int q = 0; q < 4; ++q) w[q] = *(const u32x4*)(blk + 8 * q);
#pragma unroll
            for (int q = 0; q < 2; ++q)
#pragma unroll
                for (int e = 0; e < 4; ++e) { const unsigned a = w[q][e], bq = w[q + 2][e]; const f32x2 c0 = tb[q * 8 + e * 2], c1 = tb[q * 8 + e * 2 + 1];
                    const float a0 = bflo(a), a1 = bfhi(a), b0 = bflo(bq), b1 = bfhi(bq);
                    w[q][e] = pk2(a0 * c0.x - b0 * c0.y, a1 * c1.x - b1 * c1.y); w[q + 2][e] = pk2(b0 * c0.x + a0 * c0.y, b1 * c1.x + a1 * c1.y); }
#pragma unroll
            for (int q = 0; q < 4; ++q) *(u32x4*)(blk + 8 * q) = w[q];
        }
#pragma unroll
        for (int pass = 0; pass < 2; ++pass) {
            const int head = pass * 8 + (F.lane >> 3), s = F.lane & 7; const bool act = head < 10;
            bf16_t* hp = row + (head < 8 ? QB_OFF + head * 128 : KB_OFF + (head - 8) * 128); const float* g = head < 8 ? qg : kg;
            float v[4][4]; float ss = 0.f;
            if (act) {
#pragma unroll
                for (int q = 0; q < 4; ++q) { const int c = (q >> 1) * 64 + (q & 1) * 32 + s * 4; const u32x2 w = *(const u32x2*)(hp + c);
                    v[q][0] = bflo(w.x); v[q][1] = bfhi(w.x); v[q][2] = bflo(w.y); v[q][3] = bfhi(w.y);
#pragma unroll
                    for (int e = 0; e < 4; ++e) ss += v[q][e] * v[q][e]; }
            }
            ss += __shfl_xor(ss, 1); ss += __shfl_xor(ss, 2); ss += __shfl_xor(ss, 4);
            if (act) {
                const float rs = 1.0f / sqrtf(ss * (1.0f / 128.0f) + 1e-6f);
#pragma unroll
                for (int q = 0; q < 4; ++q) { const int c = (q >> 1) * 64 + (q & 1) * 32 + s * 4;
#pragma unroll
                    for (int e = 0; e < 4; ++e) v[q][e] = v[q][e] * rs * g[c + e]; }
                if (lat) {
#pragma unroll
                    for (int half = 0; half < 2; ++half) { const f32x2* tb = (half ? t128c + gc * 32 : t128r + gr * 32) + s * 4;
#pragma unroll
                        for (int e = 0; e < 4; ++e) { const f32x2 cs = tb[e]; const float a = v[half * 2][e], bq = v[half * 2 + 1][e];
                            v[half * 2][e] = a * cs.x - bq * cs.y; v[half * 2 + 1][e] = bq * cs.x + a * cs.y; } }
                }
#pragma unroll
                for (int q = 0; q < 4; ++q) { const int c = (q >> 1) * 64 + (q & 1) * 32 + s * 4; u32x2 w; w.x = pk2(v[q][0], v[q][1]); w.y = pk2(v[q][2], v[q][3]); *(u32x2*)(hp + c) = w; }
            }
        }
    }
}

__device__ __forceinline__ void attn_ab_unit(Frame& F, int k) {
    const bf16_t* P = (const bf16_t*)(F.ws + WS_PROJ); bf16_t* MG = (bf16_t*)(F.ws + WS_MERGED); bf16_t* OA = (bf16_t*)(F.ws + WS_OA);
    if (k < 3) {
        const int u = (k < 2) ? F.vcu + k * F.G : 512 + F.vcu; if (k == 2 ? F.vcu >= 64 : u >= 512) return;
        int b, h, q0, nk;
        if (u < 512) { const int grp = u >> 5, w = u & 31; b = grp >> 1; h = (grp & 1) * 4 + (w >> 3); q0 = CTXL + (w & 7) * 256; nk = RPB; }
        else { const int v = u - 512; b = v >> 3; h = v & 7; q0 = 0; nk = CTXL; }
        const size_t kr = (size_t)b * RPB, qr = kr + q0; const int kvh = h >> 2;
        att::attn_unit<128, true, false>(P + qr * ABW + QB_OFF + h * 128, ABW, P + kr * ABW + KB_OFF + kvh * 128, ABW, nullptr, 0, P + kr * ABW + VB_OFF + kvh * 128, ABW,
                                         MG + qr * D + 1024 + h * 128, D, nk, 0, nullptr, nullptr, F.ldsg, F.lds, fresh_tid(F));
    } else {
        const int j = k - 3, u = (j < 4) ? F.vcu + j * F.G : 1024 + F.vcu; if (j == 4 ? F.vcu >= 128 : u >= 1024) return;
        int b, vh, q0, nk;
        if (u < 1024) { const int grp = u >> 4, w = u & 15; b = grp >> 3; vh = (grp & 7) * 2 + (w >> 3); q0 = CTXL + (w & 7) * 256; nk = RPB; }
        else { const int v = u - 1024; b = v >> 4; vh = v & 15; q0 = 0; nk = CTXL; }
        const size_t kr = (size_t)b * RPB, qr = kr + q0;
        att::attn_unit<64, true, false>(P + qr * ABW + QA_OFF + vh * 64, ABW, P + kr * ABW + KA_OFF + vh * 64, ABW, nullptr, 0, P + kr * ABW + VA_OFF + (vh >> 1) * 128, ABW,
                                        OA + qr * D + vh * 128, D, nk, 0, nullptr, nullptr, F.ldsg, F.lds, fresh_tid(F));
    }
}
__device__ __forceinline__ void p_attn_ab(Frame& F) {
    const int sk6 = min((int)blockIdx.x / 43, 5), side_k = (sk6 < 1) ? 1 : (sk6 < 2 ? 2 : sk6 + 2);
#pragma unroll 1
    for (int k = 0; k < side_k; ++k) attn_ab_unit(F, k);
    side_quant_experts(F, 0);
#pragma unroll 1
    for (int k = side_k; k < 8; ++k) attn_ab_unit(F, k);
}

__device__ __forceinline__ void p_diff_combine(Frame& F) {
    const bf16_t* OA = (const bf16_t*)(F.ws + WS_OA); const bf16_t* MG = (const bf16_t*)(F.ws + WS_MERGED);
    signed char* MG8 = (signed char*)(F.ws + WS_MG8); float* SMG = (float*)(F.ws + WS_SMG);
    const float* lp = F.ka->in[I_DLAM]; const float* sg = F.ka->in[I_SUBLN];
    const float d1 = wave_sum(lp[F.lane] * lp[64 + F.lane]), d2 = wave_sum(lp[128 + F.lane] * lp[192 + F.lane]);
    const float lam = __expf(d1) - __expf(d2) + LAM_INIT0;
    const int h = F.lane >> 3, s = F.lane & 7;
    float g[16];
#pragma unroll
    for (int e = 0; e < 16; ++e) g[e] = sg[s * 16 + e] * (1.0f - LAM_INIT0);
    for (int r = F.gw; r < T_ALL; r += F.NGW) {
        const bf16_t* o1 = OA + (size_t)r * D + (2 * h) * 128 + s * 16; const bf16_t* o2 = o1 + 128; const bf16_t* ob = MG + (size_t)r * D + 1024 + h * 128 + s * 16;
        float v[16], vb[16]; float ss = 0.f;
#pragma unroll
        for (int q = 0; q < 2; ++q) { const u32x4 a = *(const u32x4*)(o1 + 8 * q), bq = *(const u32x4*)(o2 + 8 * q), cq = *(const u32x4*)(ob + 8 * q);
#pragma unroll
            for (int e = 0; e < 4; ++e) { v[q * 8 + 2 * e] = bflo(a[e]) - lam * bflo(bq[e]); v[q * 8 + 2 * e + 1] = bfhi(a[e]) - lam * bfhi(bq[e]); vb[q * 8 + 2 * e] = bflo(cq[e]); vb[q * 8 + 2 * e + 1] = bfhi(cq[e]); } }
#pragma unroll
        for (int e = 0; e < 16; ++e) ss += v[e] * v[e];
        ss += __shfl_xor(ss, 1); ss += __shfl_xor(ss, 2); ss += __shfl_xor(ss, 4);
        const float rs = 1.0f / sqrtf(ss * (1.0f / 128.0f) + 1e-5f);
        float am = 0.f;
#pragma unroll
        for (int e = 0; e < 16; ++e) { v[e] = v[e] * rs * g[e]; am = fmaxf(am, fmaxf(fabsf(v[e]), fabsf(vb[e]))); }
#pragma unroll
        for (int o = 1; o < 64; o <<= 1) am = fmaxf(am, __shfl_xor(am, o));
        const float inv = am > 0.f ? 127.0f / am : 0.f;
        if (F.lane == 0) SMG[r] = am * (1.0f / 127.0f);
        u32x4 wa, wb;
#pragma unroll
        for (int d = 0; d < 4; ++d) { wa[d] = q8x4(v[d * 4], v[d * 4 + 1], v[d * 4 + 2], v[d * 4 + 3], inv); wb[d] = q8x4(vb[d * 4], vb[d * 4 + 1], vb[d * 4 + 2], vb[d * 4 + 3], inv); }
        *(u32x4*)(MG8 + (size_t)r * D + h * 128 + s * 16) = wa; *(u32x4*)(MG8 + (size_t)r * D + 1024 + h * 128 + s * 16) = wb;
    }
}

__device__ __forceinline__ void p_post_down(Frame& F) {
    const bf16_t* DN = (const bf16_t*)(F.ws + WS_DOWN); bf16_t* KPE = (bf16_t*)(F.ws + WS_KPE);
    const f32x2* t64r = (const f32x2*)(F.ws + WS_TAB + TAB64R); const f32x2* t64c = (const f32x2*)(F.ws + WS_TAB + TAB64C);
    const float* qg = F.ka->in[I_MQNG]; const float* kvg = F.ka->in[I_MKVNG];
    for (int r = F.gw; r < T_ALL; r += F.NGW) {
        const int b = r / RPB, i = r - b * RPB; const bool lat = i >= CTXL; const int pos = i - CTXL, gr = pos >> 6, gc = pos & 63;
        const bf16_t* row = DN + (size_t)r * DOWN_N;
#pragma unroll
        for (int which = 0; which < 2; ++which) {
            const u32x4 w = *(const u32x4*)(row + which * 512 + F.lane * 8); float v[8];
#pragma unroll
            for (int e = 0; e < 4; ++e) { v[2 * e] = bflo(w[e]); v[2 * e + 1] = bfhi(w[e]); }
            float ss = 0.f;
#pragma unroll
            for (int e = 0; e < 8; ++e) ss += v[e] * v[e];
            ss = wave_sum(ss); const float rs = 1.0f / sqrtf(ss * (1.0f / 512.0f) + 1e-6f); const float* g = (which ? kvg : qg) + F.lane * 8;
#pragma unroll
            for (int e = 0; e < 8; ++e) v[e] = v[e] * rs * g[e];
            quant_row512_store(v, (signed char*)(F.ws + (which ? WS_CKVN : WS_CQN)) + (size_t)r * 512, (float*)(F.ws + (which ? WS_SCKV : WS_SCQ)) + r, F.lane);
        }
        if (F.lane < 32) {
            const int blk = F.lane >> 4, f = F.lane & 15; const float a = bf2f(row[1024 + blk * 32 + f]), bq = bf2f(row[1024 + blk * 32 + 16 + f]);
            float oa = a, ob = bq;
            if (lat) { const f32x2 cs = blk ? t64c[gc * 16 + f] : t64r[gr * 16 + f]; oa = a * cs.x - bq * cs.y; ob = bq * cs.x + a * cs.y; }
            KPE[(size_t)r * 64 + blk * 32 + f] = (bf16_t)f2bf(oa); KPE[(size_t)r * 64 + blk * 32 + 16 + f] = (bf16_t)f2bf(ob);
        }
    }
}

__device__ __forceinline__ void attn_mla_unit(Frame& F, int u) {
    const bf16_t* QM = (const bf16_t*)(F.ws + WS_QM); const bf16_t* KVM = (const bf16_t*)(F.ws + WS_KVM); const bf16_t* KPE = (const bf16_t*)(F.ws + WS_KPE);
    const f32x2* t64r = (const f32x2*)(F.ws + WS_TAB + TAB64R); const f32x2* t64c = (const f32x2*)(F.ws + WS_TAB + TAB64C);
    const int grp = u >> 3, b = grp >> 4, h = grp & 15, qb = u & 7; const size_t kr = (size_t)b * RPB, qr = kr + CTXL + qb * 256;
    att::attn_unit<192, true, true, true>(QM + qr * UQ_N + h * 192, UQ_N, KVM + kr * UKV_N + h * 256, UKV_N, KPE + kr * 64, 64, KVM + kr * UKV_N + h * 256 + 128, UKV_N,
                                    (bf16_t*)(F.ws + WS_MG8 + qr * D + h * 128), D, RPB, qb * 256, t64r, t64c, F.ldsg, F.lds, fresh_tid(F));
}
__device__ __forceinline__ void p_attn_mla(Frame& F) {
    const int side_n = min((int)blockIdx.x / 64, 3) + 1; int u = F.vcu, n = 0;
#pragma unroll 1
    for (; u < 1024 && n < side_n; u += F.G, ++n) attn_mla_unit(F, u);
    side_quant_experts(F, 1);
#pragma unroll 1
    for (; u < 1024; u += F.G) attn_mla_unit(F, u);
}

template <int R> __device__ __forceinline__ void ln1_rows(Frame& F, int layer, int t0, int i) {
    const LAS float* PA = (const LAS float*)F.lds;
    const unsigned char* Y1 = (const unsigned char*)(F.ws + WS_Y1); bf16_t* XB = (bf16_t*)(F.ws + WS_X); bf16_t* H = (bf16_t*)(F.ws + WS_H);
    float v[R][4][8]; u32x2 yw[R][4]; int var[R], rr[R];
#pragma unroll
    for (int q = 0; q < R; ++q) { const int r = tok_row(layer, t0 + i + 8 * q); rr[q] = r; const float* xs = x_src(F, 0, r); var[q] = (layer == 0 && (r % RPB) < CTXL) ? 3 : 0;
#pragma unroll
        for (int j = 0; j < 4; ++j) { if (layer == 0) ld8f_nt(xs + 512 * j + 8 * F.lane, v[q][j]); else unpk8(*(const u32x4*)(XB + (size_t)r * D + 512 * j + 8 * F.lane), v[q][j]); yw[q][j] = __builtin_nontemporal_load((const u32x2*)(Y1 + (size_t)r * D + 512 * j + 8 * F.lane)); } }
#pragma unroll
    for (int q = 0; q < R; ++q) {
        float s = 0.f;
#pragma unroll
        for (int j = 0; j < 4; ++j) { const int c = 512 * j + 8 * F.lane; float g1[8], y[8]; ld8l(PA + (2 + var[q]) * 2048 + c, g1); unfp8(yw[q][j], y);
#pragma unroll
            for (int e = 0; e < 8; ++e) { v[q][j][e] = v[q][j][e] * ALPHA + g1[e] * y[e]; s += v[q][j][e]; } }
        const float mean = wave_sum(s) * (1.0f / D); float s2 = 0.f;
#pragma unroll
        for (int j = 0; j < 4; ++j)
#pragma unroll
            for (int e = 0; e < 8; ++e) { v[q][j][e] -= mean; s2 += v[q][j][e] * v[q][j][e]; }
        const float rstd = 1.0f / sqrtf(wave_sum(s2) * (1.0f / D) + 1e-5f);
#pragma unroll
        for (int j = 0; j < 4; ++j) { const int c = 512 * j + 8 * F.lane; float a[8], bq[8], xo[8], h[8];
            ld8l(PA + c, a); ld8l(PA + 2048 + c, bq);
#pragma unroll
            for (int e = 0; e < 8; ++e) xo[e] = v[q][j][e] * rstd * a[e] + bq[e];
            *(u32x4*)(XB + (size_t)rr[q] * D + c) = pk8(xo);
            ld8l(PA + (3 + var[q]) * 2048 + c, a); ld8l(PA + (4 + var[q]) * 2048 + c, bq);
#pragma unroll
            for (int e = 0; e < 8; ++e) { h[e] = v[q][j][e] * rstd * a[e] + bq[e]; v[q][j][e] = h[e]; }
            *(u32x4*)(H + (size_t)rr[q] * D + c) = pk8(h); }
        quant_row_store(v[q], (signed char*)(F.ws + WS_H8) + (size_t)rr[q] * D, (float*)(F.ws + WS_SA) + rr[q], F.lane);
    }
}
__device__ __forceinline__ void p_ln1(Frame& F, int layer) {
    LAS float* PA = (LAS float*)F.lds;
    const int NT = layer ? T_LAT : T_ALL, BR = layer ? 64 : 72, nblk = NT / BR, rpb = layer ? SEQ : RPB;
    const float* lg = F.ka->in[I_LNMG] + layer * D; const float* lb = F.ka->in[I_LNMB] + layer * D; const float* MOD = (const float*)(F.ws + WS_MOD) + (size_t)layer * 9 * 12288;
    for (int blk = F.vcu; blk < nblk; blk += F.G) {
        const int t0 = blk * BR, b = t0 / rpb;
        __syncthreads();
        { const int c = F.tid * 4; const f32x4 g = *(const f32x4*)(lg + c), bb = *(const f32x4*)(lb + c);
          *(LAS f32x4*)(PA + c) = g; *(LAS f32x4*)(PA + 2048 + c) = bb;
#pragma unroll
          for (int vv = 0; vv < 2; ++vv) { const float* m = MOD + (size_t)(vv ? 8 : b) * 12288; const f32x4 g1 = *(const f32x4*)(m + 2 * 2048 + c), sh2 = *(const f32x4*)(m + 3 * 2048 + c), sc2 = *(const f32x4*)(m + 4 * 2048 + c);
              *(LAS f32x4*)(PA + (2 + 3 * vv) * 2048 + c) = g1; *(LAS f32x4*)(PA + (3 + 3 * vv) * 2048 + c) = g * (1.0f + sc2); *(LAS f32x4*)(PA + (4 + 3 * vv) * 2048 + c) = bb * (1.0f + sc2) + sh2; } }
        __syncthreads();
        for (int i = F.wave; i < BR; i += 16) { if (i + 8 < BR) ln1_rows<2>(F, layer, t0, i); else ln1_rows<1>(F, layer, t0, i); }
    }
}

__device__ __forceinline__ void p_router(Frame& F, int layer) {
    const int NT = layer ? T_LAT : T_ALL, ngroups = NT / 32;
    const bf16_t* H = (const bf16_t*)(F.ws + WS_H); const bf16_t* RT = (const bf16_t*)(F.ws + WS_ROUTER + (size_t)layer * 64 * 2048 * 2);
    const float* rb = F.ka->in[I_RB] + layer * 64;
    int* LIST = (int*)(F.ws + WS_LIST); int* TS = (int*)(F.ws + WS_TOKSLOT); float* GATE = (float*)(F.ws + WS_GATE);
    unsigned* CNT = F.ctl + CW_CNT + layer * 64 * 16;
    LAS float* part = (LAS float*)F.lds;
    LAS float* SC = (LAS float*)(F.lds + 65536);
    LAS float* BS = (LAS float*)(F.lds + 65536 + 8448);
    LAS int* hist = (LAS int*)(F.lds + 65536 + 2 * 8448);
    LAS int* base = hist + 64;
    LAS int* SEL = base + 64;
    const int r32 = F.lane & 31, hi = F.lane >> 5;
    if (F.tid < 64) hist[F.tid] = 0;
    __syncthreads();
    int gi = 0;
    for (int g = F.vcu; g < ngroups; g += F.G, ++gi) {
        const int t0 = g * 32;
        {
            const bf16_t* ap = H + (size_t)tok_row(layer, t0 + r32) * D + F.wave * 256 + hi * 8;
            const bf16_t* b0p = RT + (size_t)r32 * D + F.wave * 256 + hi * 8; const bf16_t* b1p = b0p + (size_t)32 * D;
            f32x16 a0 = {}, a1 = {};
#pragma unroll
            for (int k = 0; k < 16; ++k) { const bf16x8 a = *(const bf16x8*)(ap + k * 16), w0 = *(const bf16x8*)(b0p + k * 16), w1 = *(const bf16x8*)(b1p + k * 16);
                a0 = __builtin_amdgcn_mfma_f32_32x32x16_bf16(a, w0, a0, 0, 0, 0); a1 = __builtin_amdgcn_mfma_f32_32x32x16_bf16(a, w1, a1, 0, 0, 0); }
#pragma unroll
            for (int r = 0; r < 16; ++r) { const int row = att::crow(r, hi); part[(F.wave * 32 + row) * 64 + r32] = a0[r]; part[(F.wave * 32 + row) * 64 + 32 + r32] = a1[r]; }
        }
        __syncthreads();
        for (int i = F.tid; i < 2048; i += 512) { float s = 0.f;
#pragma unroll
            for (int w = 0; w < 8; ++w) s += part[w * 2048 + i];
            const float sg = 1.0f / (1.0f + __expf(-s)); const int tk = i >> 6, e = i & 63; SC[tk * 65 + e] = sg; BS[tk * 65 + e] = sg + rb[e]; }
        __syncthreads();
        if (F.tid < 32) {
            const LAS float* bs = BS + F.tid * 65; const LAS float* sc = SC + F.tid * 65;
            float bv[64];
#pragma unroll
            for (int e = 0; e < 64; ++e) bv[e] = bs[e];
            float gs[8];
#pragma unroll
            for (int gq = 0; gq < 8; ++gq) { float m1 = -INFINITY, m2 = -INFINITY;
#pragma unroll
                for (int j = 0; j < 8; ++j) { const float v = bv[gq * 8 + j]; const float lo = fminf(v, m1); m1 = fmaxf(v, m1); m2 = fmaxf(m2, lo); }
                gs[gq] = m1 + m2; }
            unsigned gmask = 0u;
#pragma unroll
            for (int it = 0; it < 4; ++it) { float best = -INFINITY; int bi = 0;
#pragma unroll
                for (int gq = 0; gq < 8; ++gq) { const bool ok = !((gmask >> gq) & 1u) && gs[gq] > best; best = ok ? gs[gq] : best; bi = ok ? gq : bi; }
                gmask |= 1u << bi; }
#pragma unroll
            for (int e = 0; e < 64; ++e) bv[e] = ((gmask >> (e >> 3)) & 1u) ? bv[e] : -INFINITY;
            int sel[8]; float gv[8]; float gsum = 0.f;
#pragma unroll
            for (int k = 0; k < 8; ++k) { float best = -INFINITY; int be = 0;
#pragma unroll
                for (int e = 0; e < 64; ++e) { const bool ok = bv[e] > best; best = ok ? bv[e] : best; be = ok ? e : be; }
#pragma unroll
                for (int e = 0; e < 64; ++e) bv[e] = (e == be) ? -INFINITY : bv[e];
                sel[k] = be; gv[k] = sc[be]; gsum += gv[k]; }
            const int r = tok_row(layer, t0 + F.tid); const float inv = 2.5f / gsum;
#pragma unroll
            for (int k = 0; k < 8; ++k) { const int lp = atomicAdd((int*)(hist + sel[k]), 1); SEL[((gi & 3) * 32 + F.tid) * 8 + k] = (sel[k] << 16) | lp; GATE[(size_t)r * 8 + k] = gv[k] * inv; }
        }
        __syncthreads();
    }
    if (F.tid < 64) base[F.tid] = (int)__hip_atomic_fetch_add(CNT + F.tid * 16, (unsigned)hist[F.tid], RLX_AGENT);
    __syncthreads();
    gi = 0;
    for (int g = F.vcu; g < ngroups; g += F.G, ++gi) {
        if (F.tid < 256) { const int tk = F.tid >> 3, k = F.tid & 7; const int v = SEL[((gi & 3) * 32 + tk) * 8 + k], e = v >> 16, pos = base[e] + (v & 0xffff); const int r = tok_row(layer, g * 32 + tk);
            LIST[(size_t)e * LIST_CAP + pos] = r; TS[(size_t)r * 8 + k] = (e << 16) | pos; }
    }
    __syncthreads();
}

__device__ __forceinline__ int moe_tables(Frame& F, int layer) {
    LAS int* MISC = (LAS int*)(F.lds + MISC_OFF); LAS int* TT = (LAS int*)(F.lds + TTAB_OFF);
    const int NT = layer ? T_LAT : T_ALL;
    __syncthreads();
    if (F.wave == 0) {
        const unsigned* CNT = F.ctl + CW_CNT + layer * 64 * 16;
        const int c = (int)__hip_atomic_load(CNT + F.lane * 16, RLX_AGENT); const int nt = (c + 255) >> 8;
        int inc = nt;
#pragma unroll
        for (int o = 1; o < 64; o <<= 1) { const int v = __shfl_up(inc, o); if (F.lane >= o) inc += v; }
        const int start = inc - nt; MISC[F.lane] = start; MISC[80 + F.lane] = c;
        if (F.lane == 63) { MISC[64] = inc; MISC[65] = inc + NT / 256; }
    }
    __syncthreads();
    const int s64 = MISC[64], total = MISC[65];
    for (int tile = F.tid; tile < total; tile += 512) {
        int lo = 0, hi = 64;
#pragma unroll
        for (int it = 0; it < 7; ++it) { const int mid = (lo + hi + 1) >> 1; const bool ok = MISC[mid] <= tile; lo = ok ? mid : lo; hi = ok ? hi : mid - 1; }
        TT[tile] = (lo << 16) | (tile - MISC[lo]); }
    (void)s64;
    __syncthreads();
    return total;
}

__device__ __forceinline__ void p_moe_gemm1(Frame& F, int layer) {
    const int total = moe_tables(F, layer);
    LAS int* MISC = (LAS int*)(F.lds + MISC_OFF); LAS int* TT = (LAS int*)(F.lds + TTAB_OFF); LAS int* IDX = (LAS int*)(F.lds + IDXC_OFF);
    const int* LIST = (const int*)(F.ws + WS_LIST);
    typedef pg8::SchedMoe<4, EXP_IN_BYTES, (size_t)256 * D> Sch; Sch S; S.ntiles = total; S.G = F.G; S.vcu = F.vcu; S.ttab = TT; S.Bt = (const char*)(F.ws + WS_EXP_IN + (size_t)layer * 65 * EXP_IN_BYTES);
    {
        pg8::Unit u; const int fallback = tok_row(layer, 0);
        for (int i = 0; i < IDXC_UNITS && S.next(i, u); ++i) {
            if (F.tid < 256) { const int tile = u.row0 >> 8, tv = TT[tile], e = tv >> 16, p = (tv & 0xffff) * 256 + F.tid;
                int src; if (e < 64) src = (p < MISC[80 + e]) ? LIST[(size_t)e * LIST_CAP + p] : fallback; else src = tok_row(layer, p);
                IDX[i * 256 + F.tid] = src; }
        }
        __syncthreads();
    }
    pg8::EpiSwigluI8 E{(unsigned char*)(F.ws + WS_HMID), FDIM, (const float*)(F.ws + WS_SA), (const float*)(F.ws + WS_SW) + (size_t)layer * 65 * 1024, IDX};
    pg8::gemm_phase<pg8::EpiSwigluI8, Sch, true, 1>(F.lds, (const void*)(F.ws + WS_H8), D, S, E, IDX, fresh_tid(F));
    if (layer == 0 && is_tail_wg(total * 4, F.G, F.vcu)) tail_quant(F, 1, 1, 1);
}
__device__ __forceinline__ void p_moe_gemm2(Frame& F, int layer) {
    const int total = moe_tables(F, layer);
    LAS int* TT = (LAS int*)(F.lds + TTAB_OFF);
    typedef pg8::SchedMoe<8, EXP_OUT_BYTES, (size_t)256 * FDIM> Sch; Sch S; S.ntiles = total; S.G = F.G; S.vcu = F.vcu; S.ttab = TT; S.Bt = (const char*)(F.ws + WS_EXP_OUT + (size_t)layer * 65 * EXP_OUT_BYTES);
    pg8::EpiI8Fp8<2048, true> E{(unsigned char*)(F.ws + WS_Y2P), D, (const float*)(F.ws + WS_SW2), (const float*)(F.ws + WS_SW2) + (size_t)layer * 65 * 2048};
    pg8::gemm_phase<pg8::EpiI8Fp8<2048, true>, Sch, false, 2>(F.lds, (const void*)(F.ws + WS_HMID), FDIM, S, E, nullptr, fresh_tid(F));
}

__device__ __forceinline__ void p_combine_ln2(Frame& F, int layer) {
    (void)moe_tables(F, layer);
    LAS int* MISC = (LAS int*)(F.lds + MISC_OFF); LAS float* PA = (LAS float*)F.lds;
    const int NT = layer ? T_LAT : T_ALL, BR = layer ? 64 : 72, nblk = NT / BR, rpb = layer ? SEQ : RPB;
    const unsigned char* Y2 = (const unsigned char*)(F.ws + WS_Y2P);     const int* TS = (const int*)(F.ws + WS_TOKSLOT); const float* GATE = (const float*)(F.ws + WS_GATE);
    bf16_t* XB = (bf16_t*)(F.ws + WS_X); float* OUT = F.ka->out;
    const int sh0 = MISC[64] * 256;
    for (int blk = F.vcu; blk < nblk; blk += F.G) {
        const int t0 = blk * BR, b = t0 / rpb;
        __syncthreads();
        { int z = 0; asm volatile("" : "+s"(z));
          const float* lg = F.ka->in[I_LNFG + z] + layer * D; const float* lb = F.ka->in[I_LNFB + z] + layer * D; const float* MOD = (const float*)(F.ka->ws + WS_MOD) + z;
          const int c = fresh_tid(F) * 4; const f32x4 g = *(const f32x4*)(lg + c), bb = *(const f32x4*)(lb + c);
          *(LAS f32x4*)(PA + c) = g; *(LAS f32x4*)(PA + 2048 + c) = bb;
#pragma unroll
          for (int vv = 0; vv < 2; ++vv) { const float* m = MOD + ((size_t)layer * 9 + (vv ? 8 : b)) * 12288; const float* m1 = MOD + ((size_t)9 + (vv ? 8 : b)) * 12288;
              const f32x4 g2 = *(const f32x4*)(m + 5 * 2048 + c), sh1 = *(const f32x4*)(m1 + c), sc1 = *(const f32x4*)(m1 + 2048 + c);
              *(LAS f32x4*)(PA + (2 + 3 * vv) * 2048 + c) = g2; *(LAS f32x4*)(PA + (3 + 3 * vv) * 2048 + c) = g * (1.0f + sc1); *(LAS f32x4*)(PA + (4 + 3 * vv) * 2048 + c) = bb * (1.0f + sc1) + sh1; } }
        __syncthreads();
        int r = tok_row(layer, t0 + F.wave); int tsv = 0; float gtv = 0.f;
        { const int l0 = fresh_lane(); if (l0 < 8) { tsv = TS[(size_t)r * 8 + l0]; gtv = GATE[(size_t)r * 8 + l0]; } }
        for (int i = F.wave; i < BR; i += 8) {
            const int t = t0 + i, var = (layer == 0 && (r % RPB) < CTXL) ? 3 : 0;
            const int ln = fresh_lane();
            float xv[4][8]; float y[4][8]; const int tsc = tsv; const int gtc = __builtin_bit_cast(int, gtv);
#define YROW(k) (Y2 + (size_t)(__builtin_amdgcn_readfirstlane(MISC[__builtin_amdgcn_readlane(tsc, (k)) >> 16]) * 256 + (__builtin_amdgcn_readlane(tsc, (k)) & 0xffff)) * D)
#define GK(k) __builtin_bit_cast(float, __builtin_amdgcn_readlane(gtc, (k)))
            const int rcur = r;
            {
                u32x2 yw[5][4];
#pragma unroll
                for (int k = 0; k < 4; ++k)
#pragma unroll
                    for (int j = 0; j < 4; ++j) yw[k][j] = __builtin_nontemporal_load((const u32x2*)(YROW(k) + 8 * ln + 512 * j));
                { const unsigned char* yr = Y2 + (size_t)(sh0 + t) * D + 8 * ln;
#pragma unroll
                  for (int j = 0; j < 4; ++j) yw[4][j] = __builtin_nontemporal_load((const u32x2*)(yr + 512 * j)); }
                if (i + 8 < BR) { r = tok_row(layer, t + 8); if (ln < 8) { tsv = TS[(size_t)r * 8 + ln]; gtv = GATE[(size_t)r * 8 + ln]; } }
#pragma unroll
                for (int j = 0; j < 4; ++j) { float tmp[8]; unfp8(yw[4][j], y[j]);
#pragma unroll
                    for (int k = 0; k < 4; ++k) { unfp8(yw[k][j], tmp);
#pragma unroll
                        for (int e = 0; e < 8; ++e) y[j][e] += GK(k) * tmp[e]; } }
            }
            asm volatile("" ::: "memory");
            {
                u32x2 yw[4][4];
#pragma unroll
                for (int k = 0; k < 4; ++k)
#pragma unroll
                    for (int j = 0; j < 4; ++j) yw[k][j] = __builtin_nontemporal_load((const u32x2*)(YROW(4 + k) + 8 * ln + 512 * j));
#pragma unroll
                for (int j = 0; j < 4; ++j) unpk8(*(const u32x4*)(XB + (size_t)rcur * D + 512 * j + 8 * ln), xv[j]);
#pragma unroll
                for (int j = 0; j < 4; ++j) { float tmp[8];
#pragma unroll
                    for (int k = 0; k < 4; ++k) { unfp8(yw[k][j], tmp);
#pragma unroll
                        for (int e = 0; e < 8; ++e) y[j][e] += GK(4 + k) * tmp[e]; } }
            }
#undef YROW
#undef GK
            float s = 0.f;
#pragma unroll
            for (int j = 0; j < 4; ++j) { const int c = 512 * j + 8 * ln; float g2[8];
                ld8l(PA + (2 + var) * 2048 + c, g2);
#pragma unroll
                for (int e = 0; e < 8; ++e) { xv[j][e] = xv[j][e] * ALPHA + g2[e] * y[j][e]; s += xv[j][e]; } }
            const float mean = wave_sum(s) * (1.0f / D); float s2 = 0.f;
#pragma unroll
            for (int j = 0; j < 4; ++j)
#pragma unroll
                for (int e = 0; e < 8; ++e) { xv[j][e] -= mean; s2 += xv[j][e] * xv[j][e]; }
            const float rstd = 1.0f / sqrtf(wave_sum(s2) * (1.0f / D) + 1e-5f);
#pragma unroll
            for (int j = 0; j < 4; ++j) { const int c = 512 * j + 8 * ln; float a[8], bq[8], xo[8];
                ld8l(PA + c, a); ld8l(PA + 2048 + c, bq);
#pragma unroll
                for (int e = 0; e < 8; ++e) xo[e] = xv[j][e] * rstd * a[e] + bq[e];
                if (layer == 0) { *(u32x4*)(XB + (size_t)rcur * D + c) = pk8(xo); ld8l(PA + (3 + var) * 2048 + c, a); ld8l(PA + (4 + var) * 2048 + c, bq);
#pragma unroll
                    for (int e = 0; e < 8; ++e) xv[j][e] = xv[j][e] * rstd * a[e] + bq[e]; }
                else st8f(OUT + (size_t)t * D + c, xo); }
            if (layer == 0) quant_row_store(xv, (signed char*)(F.ws + WS_H8) + (size_t)rcur * D, (float*)(F.ws + WS_SA) + rcur, ln);
        }
    }
}

__device__ __forceinline__ void p_dense(Frame& F, const bf16_t* A, const bf16_t* Bt, int K, int nM, int nN, int latmap, bf16_t* O, int ldc) {
    pg8::SchedDense S; S.init(nM, nN, F.G, (int)blockIdx.x, latmap, Bt, K);
    pg8::EpiBf16 E{O, ldc};
    pg8::gemm_phase<pg8::EpiBf16, pg8::SchedDense, false>(F.lds, A, K, S, E, nullptr, F.tid);
}
__device__ __forceinline__ void p_dense_i8_fp8(Frame& F, const void* A, const float* SA, const void* Bt, const float* SW, int K, int nM, int nN, int latmap, unsigned char* O, int ldc) {
    pg8::SchedDense S; S.init(nM, nN, F.G, (int)blockIdx.x, latmap, (const bf16_t*)Bt, K); S.tstepB = (size_t)256 * K;
    pg8::EpiI8Fp8<0> E{O, ldc, SA, SW};
    pg8::gemm_phase<pg8::EpiI8Fp8<0>, pg8::SchedDense, false, 1>(F.lds, A, K, S, E, nullptr, fresh_tid(F));
}
__device__ __forceinline__ void p_dense_f8_fp8(Frame& F, const void* A, const void* Bt, const float* SW, int K, int nM, int nN, int latmap, unsigned char* O, int ldc) {
    pg8::SchedDense S; S.init(nM, nN, F.G, (int)blockIdx.x, latmap, (const bf16_t*)Bt, K); S.tstepB = (size_t)256 * K;
    pg8::EpiI8Fp8<0, true> E{O, ldc, SW, SW};
    pg8::gemm_phase<pg8::EpiI8Fp8<0, true>, pg8::SchedDense, false, 2>(F.lds, A, K, S, E, nullptr, fresh_tid(F));
}
__device__ __forceinline__ void p_dense_i8(Frame& F, const void* A, const float* SA, const void* Bt, const float* SW, int K, int nM, int nN, int latmap, bf16_t* O, int ldc) {
    pg8::SchedDense S; S.init(nM, nN, F.G, (int)blockIdx.x, latmap, (const bf16_t*)Bt, K); S.tstepB = (size_t)256 * K;
    pg8::EpiI8Bf16<0> E{O, ldc, SA, SW};
    pg8::gemm_phase<pg8::EpiI8Bf16<0>, pg8::SchedDense, false, 1>(F.lds, A, K, S, E, nullptr, fresh_tid(F));
}

constexpr int N_PHASES = 26;

__global__ void __launch_bounds__(512, 2) mk_fwd(Args args) {
    extern __shared__ __attribute__((aligned(16))) unsigned char lds_raw[];
    Frame F;
    F.lds = (LAS unsigned char*)lds_raw; F.ldsg = (char*)lds_raw;
    F.tid = threadIdx.x; F.lane = F.tid & 63; F.wave = __builtin_amdgcn_readfirstlane(F.tid >> 6);
    F.G = gridDim.x; { const int bx = blockIdx.x; F.vcu = (F.G % 8 == 0) ? (bx % 8) * (F.G / 8) + bx / 8 : bx; }
    F.gw = F.vcu * 8 + F.wave; F.NGW = F.G * 8;
    F.ka = (KArgs)__builtin_amdgcn_kernarg_segment_ptr();
    F.ws = F.ka->ws; F.ctl = (unsigned*)F.ws;
    const int lo = args.ph_lo, hi = args.ph_hi;
    volatile LAS unsigned* bw = (volatile LAS unsigned*)(F.lds + BARW_OFF);
    if (F.tid < 4) bw[F.tid] = 0u;
    __syncthreads();
    XcdBarrier bar; bar.bar = F.ctl + CW_BAR; bar.x = 0; bar.st = bw;
    if (hi - lo > 1) bar = xcd_barrier_post(F.ctl + CW_BAR, bw);
#ifndef MK_ONLY
#define MK_ONLY -1
#endif
#ifndef MK_REPMASK
#define MK_REPMASK 0u
#endif
#define IN(k) ((MK_ONLY < 0 || MK_ONLY == (k)) && lo <= (k) && (k) < hi)
#define NREP(k) ((int)(((unsigned)MK_REPMASK >> (k)) & 1u) + 1)
#define SEAM(k) do { if (lo <= (k) && (k) + 1 < hi) xcd_barrier(bar); } while (0)

    if (IN(0)) for (int rep = 0; rep < NREP(0); ++rep) { PHASE_BEGIN(F); p0_prologue(P); } SEAM(0);
    if (IN(1)) for (int rep = 0; rep < NREP(1); ++rep) { PHASE_BEGIN(F); p1_modulate(P); } SEAM(1);
#if defined(MK_UNROLL_LAYERS)
#pragma unroll
#else
#pragma unroll 1
#endif
    for (int layer = 0; layer < 2; ++layer) {
        const int pb = 2 + 12 * layer;
        if (IN(pb + 0)) for (int rep = 0; rep < NREP(pb + 0); ++rep) { PHASE_BEGIN(F);
            p_dense_i8(P, P.ws + WS_H8, (const float*)(P.ws + WS_SA), P.ws + (layer == 0 ? WS_W_IN : WS_W_DOWN), (const float*)(P.ws + WS_SWD) + (layer == 0 ? SWD_IN : SWD_DOWN), D, T_ALL / 256, layer == 0 ? ABW / 256 : DOWN_N / 256, 0,
                       (bf16_t*)(P.ws + (layer == 0 ? WS_PROJ : WS_DOWN)), layer == 0 ? ABW : DOWN_N);
            if (is_tail_wg((T_ALL / 256) * (layer == 0 ? ABW / 256 : DOWN_N / 256), P.G, (int)blockIdx.x)) tail_quant(P, layer, 1, layer == 0 ? 1 : 2);
        } SEAM(pb + 0);
        if (IN(pb + 1)) for (int rep = 0; rep < NREP(pb + 1); ++rep) { PHASE_BEGIN(F); if (layer == 0) p_post_ab(P); else p_post_down(P); } SEAM(pb + 1);
        if (IN(pb + 2)) for (int rep = 0; rep < NREP(pb + 2); ++rep) { PHASE_BEGIN(F);
            if (layer == 0) p_attn_ab(P);
            else {
#pragma unroll 1
                for (int w = 0; w < 2; ++w) {
                    p_dense_i8(P, P.ws + (w == 0 ? WS_CQN : WS_CKVN), (const float*)(P.ws + (w == 0 ? WS_SCQ : WS_SCKV)), P.ws + (w == 0 ? WS_W_UQ : WS_W_UKV), (const float*)(P.ws + WS_SWD) + (w == 0 ? SWD_UQ : SWD_UKV), 512,
                               w == 0 ? T_LAT / 256 : T_ALL / 256, w == 0 ? UQ_N / 256 : UKV_N / 256, w == 0 ? 1 : 0, (bf16_t*)(P.ws + (w == 0 ? WS_QM : WS_KVM)), w == 0 ? UQ_N : UKV_N); }
            }
        } SEAM(pb + 2);
        if (IN(pb + 3)) for (int rep = 0; rep < NREP(pb + 3); ++rep) { PHASE_BEGIN(F); if (layer == 0) p_diff_combine(P); else p_attn_mla(P); } SEAM(pb + 3);
        if (IN(pb + 5)) for (int rep = 0; rep < NREP(pb + 5); ++rep) { PHASE_BEGIN(F);
            if (layer == 0) p_dense_i8_fp8(P, P.ws + WS_MG8, (const float*)(P.ws + WS_SMG), P.ws + WS_W_OUT, (const float*)(P.ws + WS_SWD) + SWD_OUT, D, T_ALL / 256, D / 256, 0, (unsigned char*)(P.ws + WS_Y1), D);
            else p_dense_f8_fp8(P, P.ws + WS_MG8, P.ws + WS_W_O, (const float*)(P.ws + WS_SWD) + SWD_O, D, T_LAT / 256, D / 256, 1, (unsigned char*)(P.ws + WS_Y1), D);
            if (layer == 0 && is_tail_wg((T_ALL / 256) * (D / 256), P.G, (int)blockIdx.x)) tail_quant(P, 1, 1, 1);
        } SEAM(pb + 5);
        if (IN(pb + 6)) for (int rep = 0; rep < NREP(pb + 6); ++rep) { PHASE_BEGIN(F); p_ln1(P, layer); } SEAM(pb + 6);
        if (IN(pb + 7)) for (int rep = 0; rep < NREP(pb + 7); ++rep) { PHASE_BEGIN(F); p_router(P, layer); } SEAM(pb + 7);
        if (IN(pb + 8)) for (int rep = 0; rep < NREP(pb + 8); ++rep) { PHASE_BEGIN(F); p_moe_gemm1(P, layer); } SEAM(pb + 8);
        if (IN(pb + 10)) for (int rep = 0; rep < NREP(pb + 10); ++rep) { PHASE_BEGIN(F); p_moe_gemm2(P, layer); } SEAM(pb + 10);
        if (IN(pb + 11)) for (int rep = 0; rep < NREP(pb + 11); ++rep) { PHASE_BEGIN(F); p_combine_ln2(P, layer); } SEAM(pb + 11);
    }
#undef IN
#undef SEAM
}

extern "C" void kernel_launch(void* const* d_in, const int* in_sizes, int n_in, void* d_out, int out_size, void* d_ws, size_t ws_size, hipStream_t stream) {
    static int grid = 0;
    if (grid == 0) {
        if (n_in != 28 || out_size != T_LAT * D || ws_size < WS_END) { fprintf(stderr, "kernel_launch: expected 28 inputs, out %d, ws >= %zu; got n_in %d out %d ws %zu\n", T_LAT * D, (size_t)WS_END, n_in, out_size, ws_size); grid = -1; return; }
        int dev = 0, cus = 0, per_cu = 0;
        if (hipGetDevice(&dev) != hipSuccess || hipDeviceGetAttribute(&cus, hipDeviceAttributeMultiprocessorCount, dev) != hipSuccess) { fprintf(stderr, "kernel_launch: device query failed\n"); grid = -1; return; }
        if (hipFuncSetAttribute((const void*)mk_fwd, hipFuncAttributeMaxDynamicSharedMemorySize, LDS_BYTES) != hipSuccess) { fprintf(stderr, "kernel_launch: hipFuncSetAttribute failed\n"); grid = -1; return; }
        if (hipOccupancyMaxActiveBlocksPerMultiprocessor(&per_cu, (const void*)mk_fwd, 512, LDS_BYTES) != hipSuccess || per_cu < 1) fprintf(stderr, "kernel_launch: occupancy query reports %d\n", per_cu);
        (void)hipGetLastError();
        grid = cus;
        if (grid != 256) fprintf(stderr, "kernel_launch: note: %d CUs (tuned for 256)\n", grid);
    }
    if (grid < 0) return;
    if (hipMemsetAsync((char*)d_ws + WS_CTL, 0, CTL_BYTES, stream) != hipSuccess) { fprintf(stderr, "kernel_launch: memset failed\n"); return; }
    Args a{};
    for (int i = 0; i < 28; ++i) a.in[i] = (const float*)d_in[i];
    a.out = (float*)d_out; a.ws = (unsigned char*)d_ws;
#if MK_ONE_LAUNCH
    a.ph_lo = 0; a.ph_hi = N_PHASES;
    hipLaunchKernelGGL(mk_fwd, dim3(grid), dim3(512), LDS_BYTES, stream, a);
#else
    for (int p = 0; p < N_PHASES; ++p) { a.ph_lo = p; a.ph_hi = p + 1; hipLaunchKernelGGL(mk_fwd, dim3(grid), dim3(512), LDS_BYTES, stream, a); }
#endif
    const hipError_t le = hipPeekAtLastError();
    if (le != hipSuccess) fprintf(stderr, "kernel_launch: launch failed: %s\n", hipGetErrorName(le));
}
```

```cpp
#include <hip/hip_runtime.h>
#include <cstdio>
#include <cstdint>

#ifndef MK_ONE_LAUNCH
#define MK_ONE_LAUNCH 1
#endif

#define LAS __attribute__((address_space(3)))
typedef unsigned short bf16_t;
typedef short bf16x8 __attribute__((ext_vector_type(8)));
typedef short s16x4 __attribute__((ext_vector_type(4)));
typedef float f32x4 __attribute__((ext_vector_type(4)));
typedef float f32x2 __attribute__((ext_vector_type(2)));
typedef float f32x16 __attribute__((ext_vector_type(16)));
typedef unsigned u32x4 __attribute__((ext_vector_type(4)));
typedef unsigned u32x2 __attribute__((ext_vector_type(2)));
typedef int i32x4 __attribute__((ext_vector_type(4)));

constexpr int D = 2048, NB = 8, SEQ = 2048, CTXL = 256, RPB = SEQ + CTXL  ;
constexpr int T_ALL = NB * RPB  , T_LAT = NB * SEQ  ;
constexpr int NEXP = 64, FDIM = 512, TOPK = 8;
constexpr int ABW = 4608, QA_OFF = 0, KA_OFF = 1024, VA_OFF = 2048, QB_OFF = 3072, KB_OFF = 4096, VB_OFF = 4352;
constexpr int DOWN_N = 1280  , UQ_N = 3072, UKV_N = 4096;
constexpr float ALPHA = 1.41421356237f;
constexpr float LAM_INIT0 = 0.2f;
constexpr int LIST_CAP = T_ALL;
constexpr int MAX_TILES = 712;

constexpr size_t al4k(size_t x) { return (x + 4095) & ~(size_t)4095; }
constexpr size_t WS_CTL = 0, CTL_BYTES = 1u << 20;
constexpr size_t WS_TAB = WS_CTL + CTL_BYTES;
constexpr size_t WS_MOD = WS_TAB + (1u << 16);
constexpr size_t WS_W_IN = WS_MOD + (1u << 20);
constexpr size_t WS_W_OUT = WS_W_IN + al4k((size_t)ABW * D * 2);
constexpr size_t WS_W_DOWN = WS_W_OUT + al4k((size_t)D * D * 2);
constexpr size_t WS_W_UQ = WS_W_DOWN + al4k((size_t)DOWN_N * D * 2);
constexpr size_t WS_W_UKV = WS_W_UQ + al4k((size_t)UQ_N * 512 * 2);
constexpr size_t WS_W_O = WS_W_UKV + al4k((size_t)UKV_N * 512 * 2);
constexpr size_t WS_ROUTER = WS_W_O + al4k((size_t)D * D * 2);
constexpr size_t EXP_IN_BYTES = (size_t)1024 * D  , EXP_OUT_BYTES = (size_t)D * FDIM  ;
constexpr size_t WS_EXP_IN = WS_ROUTER + al4k((size_t)2 * 64 * D * 2);
constexpr size_t WS_EXP_OUT = WS_EXP_IN + (size_t)2 * 65 * EXP_IN_BYTES;
constexpr size_t WS_X = WS_EXP_OUT + (size_t)2 * 65 * EXP_OUT_BYTES;
constexpr size_t WS_H = WS_X + (size_t)T_ALL * D * 4;
constexpr size_t WS_PROJ = WS_H + (size_t)T_ALL * D * 2;
constexpr size_t WS_OA = WS_PROJ + (size_t)T_ALL * ABW * 2;
constexpr size_t WS_MERGED = WS_OA + (size_t)T_ALL * D * 2;
constexpr size_t WS_Y1 = WS_MERGED + (size_t)T_ALL * D * 2;
constexpr size_t P_MAX = (size_t)MAX_TILES * 256;
constexpr size_t WS_HMID = WS_Y1 + (size_t)T_ALL * D * 2;
constexpr size_t WS_Y2P = WS_HMID + P_MAX * FDIM * 2;
constexpr size_t WS_LIST = WS_Y2P + P_MAX * D * 2;
constexpr size_t WS_TOKSLOT = WS_LIST + (size_t)64 * LIST_CAP * 4;
constexpr size_t WS_GATE = WS_TOKSLOT + (size_t)T_ALL * 8 * 4;
constexpr size_t WS_DOWN = WS_GATE + (size_t)T_ALL * 8 * 4;
constexpr size_t WS_CQN = WS_DOWN + (size_t)T_ALL * DOWN_N * 2;
constexpr size_t WS_CKVN = WS_CQN + (size_t)T_ALL * 512 * 2;
constexpr size_t WS_KPE = WS_CKVN + (size_t)T_ALL * 512 * 2;
constexpr size_t WS_QM = WS_KPE + (size_t)T_ALL * 64 * 2;
constexpr size_t WS_KVM = WS_QM + (size_t)T_ALL * UQ_N * 2;
constexpr size_t WS_SW = WS_KVM + (size_t)T_ALL * UKV_N * 2;
constexpr size_t WS_H8 = WS_SW + al4k((size_t)2 * 65 * 1024 * 4);
constexpr size_t WS_SA = WS_H8 + (size_t)T_ALL * D;
constexpr size_t WS_SWD = WS_SA + al4k((size_t)T_ALL * 4);
constexpr int SWD_IN = 0, SWD_OUT = 4608, SWD_DOWN = 6656, SWD_UQ = 7936, SWD_UKV = 11008, SWD_O = 15104, SWD_N = 17152;
constexpr size_t WS_SW2 = WS_SWD + al4k((size_t)SWD_N * 4);
constexpr size_t WS_SCQ = WS_SW2 + al4k((size_t)2 * 65 * 2048 * 4);
constexpr size_t WS_SCKV = WS_SCQ + al4k((size_t)T_ALL * 4);
constexpr size_t WS_SMG = WS_SCKV + al4k((size_t)T_ALL * 4);
constexpr size_t WS_SHM = WS_SMG + al4k((size_t)T_ALL * 4);
constexpr size_t WS_HM8 = WS_SHM + al4k(P_MAX * 4);
constexpr size_t WS_MG8 = WS_HM8 + P_MAX * FDIM;
constexpr size_t WS_END = WS_MG8 + (size_t)T_ALL * D;
constexpr size_t TAB64R = 0, TAB64C = 4096, TAB128R = 12288, TAB128C = 20480;
constexpr int CW_BAR = 4096, CW_CNT = 16384;
constexpr int CW_QW = 20480;
constexpr int QSLOT_OFF = 163776;

constexpr int RING_BYTES = 131072;
constexpr int IDXC_OFF = 131072, IDXC_UNITS = 16;
constexpr int TTAB_OFF = IDXC_OFF + IDXC_UNITS * 1024;
constexpr int MISC_OFF = TTAB_OFF + 4096;
constexpr int LDS_BYTES = 163840;
constexpr int BARW_OFF = LDS_BYTES - 16;
constexpr int SCL_OFF = MISC_OFF + 2048;

#define RLX_AGENT __ATOMIC_RELAXED, __HIP_MEMORY_SCOPE_AGENT
__device__ __forceinline__ unsigned f2bf(float f) { unsigned u = __builtin_bit_cast(unsigned, f); return (u + 0x7fffu + ((u >> 16) & 1u)) >> 16; }
__device__ __forceinline__ unsigned pk2(float lo, float hi) { return f2bf(lo) | (f2bf(hi) << 16); }
__device__ __forceinline__ float bf2f(unsigned short b) { return __builtin_bit_cast(float, ((unsigned)b) << 16); }
__device__ __forceinline__ float bflo(unsigned w) { return __builtin_bit_cast(float, w << 16); }
__device__ __forceinline__ float bfhi(unsigned w) { return __builtin_bit_cast(float, w & 0xffff0000u); }
__device__ __forceinline__ unsigned cvt_pk_bf16(float lo, float hi) { unsigned r; asm volatile("v_cvt_pk_bf16_f32 %0, %1, %2" : "=v"(r) : "v"(lo), "v"(hi)); return r; }
__device__ __forceinline__ unsigned q8x4(float a, float b, float c, float d, float inv) {
    unsigned w = 0;
    w = __builtin_amdgcn_cvt_pk_u8_f32(__builtin_rintf(fmaf(a, inv, 128.0f)), 0, w); w = __builtin_amdgcn_cvt_pk_u8_f32(__builtin_rintf(fmaf(b, inv, 128.0f)), 1, w);
    w = __builtin_amdgcn_cvt_pk_u8_f32(__builtin_rintf(fmaf(c, inv, 128.0f)), 2, w); w = __builtin_amdgcn_cvt_pk_u8_f32(__builtin_rintf(fmaf(d, inv, 128.0f)), 3, w);
    return w ^ 0x80808080u;
}
__device__ __forceinline__ float wave_sum(float v) {
#pragma unroll
    for (int o = 1; o < 64; o <<= 1) v += __shfl_xor(v, o);
    return v;
}

#define XB_TMO      128
#define XB_XCNT(j)  (256  + 64 * (j))
#define XB_XSUB(j)  (1280 + 64 * (j))
#define XB_XGEN(j)  (2304 + 64 * (j))
#define XB_TOP      3328
#define XB_TOPGEN   3392
#define XCD_BAR_WORDS 3456
#define XB_SPIN_CAP (1u << 18)
__device__ __forceinline__ unsigned xb_ld(unsigned* p)              { return __hip_atomic_load(p, __ATOMIC_RELAXED, __HIP_MEMORY_SCOPE_AGENT); }
__device__ __forceinline__ unsigned xb_add(unsigned* p, unsigned v) { return __hip_atomic_fetch_add(p, v, __ATOMIC_RELAXED, __HIP_MEMORY_SCOPE_AGENT); }
__device__ __forceinline__ unsigned xb_xcc_id() { return (unsigned)__builtin_amdgcn_s_getreg((3 << 11) | 20) & 0xFu; }
#define XB_SPIN(cond, bar) do { unsigned _sp = 0; while (cond) { __builtin_amdgcn_s_sleep(1); \
    if ((++_sp & 255u) == 0u) { if (xb_ld(&(bar)[XB_TMO])) break; if (_sp > XB_SPIN_CAP) { atomicAdd(&(bar)[XB_TMO], 1u); break; } } } } while (0)
struct XcdBarrier { unsigned* bar; unsigned x; volatile LAS unsigned* st; };
__device__ __forceinline__ XcdBarrier xcd_barrier_post(unsigned* bar, volatile LAS unsigned* st) {
    XcdBarrier b; b.bar = bar; b.x = xb_xcc_id(); b.st = st;
    if (threadIdx.x == 0) (void)xb_add(&bar[XB_XCNT(b.x)], 1u);
    return b;
}
__device__ __forceinline__ void xcd_barrier_complete(unsigned* bar, unsigned x, unsigned& nloc, unsigned& nx) {
    const unsigned G = gridDim.x * gridDim.y * gridDim.z;
    unsigned sum, cnt, mine, sp = 0u;
    for (;;) {
        sum = 0u; cnt = 0u; mine = 0u;
#pragma unroll
        for (unsigned j = 0; j < 16; ++j) { const unsigned c = xb_ld(&bar[XB_XCNT(j)]); sum += c; cnt += (c > 0u) ? 1u : 0u; mine = (j == x) ? c : mine; }
        if (sum == G) break;
        __builtin_amdgcn_s_sleep(1);
        if ((++sp & 255u) == 0u) { if (xb_ld(&bar[XB_TMO])) break; if (sp > XB_SPIN_CAP) { atomicAdd(&bar[XB_TMO], 1u); break; } }
    }
    nloc = mine > 0u ? mine : 1u; nx = cnt > 0u ? cnt : 1u;
}
__device__ __forceinline__ void xcd_barrier(const XcdBarrier& b) {
    asm volatile("s_waitcnt vmcnt(0)" ::: "memory");
    __syncthreads();
    if (threadIdx.x == 0) {
        unsigned* bar = b.bar;
        __builtin_amdgcn_s_waitcnt(0);
        unsigned nloc = b.st[0], nx = b.st[1];
        if (nloc == 0u) { xcd_barrier_complete(bar, b.x, nloc, nx); b.st[0] = nloc; b.st[1] = nx; }
        const unsigned old = xb_add(&bar[XB_XSUB(b.x)], 1u);
        const unsigned gen = old / nloc;
        if (old + 1u == (gen + 1u) * nloc) {
            __builtin_amdgcn_fence(__ATOMIC_RELEASE, "agent");
            asm volatile("s_waitcnt vmcnt(0)" ::: "memory");
            const unsigned og = xb_add(&bar[XB_TOP], 1u);
            const unsigned tg = og / nx;
            if (og + 1u == (tg + 1u) * nx) xb_add(&bar[XB_TOPGEN], 1u);
            else XB_SPIN(xb_ld(&bar[XB_TOPGEN]) == tg, bar);
            __builtin_amdgcn_fence(__ATOMIC_ACQUIRE, "agent");
            xb_add(&bar[XB_XGEN(b.x)], 1u);
            asm volatile("s_waitcnt vmcnt(0)" ::: "memory");
        } else {
            XB_SPIN(xb_ld(&bar[XB_XGEN(b.x)]) == gen, bar);
            __builtin_amdgcn_fence(__ATOMIC_ACQUIRE, "agent");
            asm volatile("s_waitcnt vmcnt(0)" ::: "memory");
        }
    }
    __syncthreads();
}

namespace pg8 {
constexpr int BM = 256, BK = 64, HALF = 128, HTB = HALF * BK * 2, STAGE_BYTES = 8 * HTB;
__device__ __forceinline__ int lds_byte(int r, int c) { const int st = (r >> 4) * 2 + (c >> 5), rr = r & 15, cc = c & 31, ob = rr * 64 + cc * 2; return st * 1024 + (ob ^ (((ob >> 9) & 1) << 5)); }
__device__ __forceinline__ void stage_rc(int b, int& R, int& C) { const int st = b / 1024, sb = b % 1024, swz = sb ^ (((sb >> 9) & 1) << 5); R = (st >> 1) * 16 + swz / 64; C = (st & 1) * 32 + (swz % 64) / 2; }
__device__ __forceinline__ int perm32(int rho) { const int n = rho >> 4, i = rho & 15; return 8 * (i >> 2) + 4 * n + (i & 3); }

struct Unit { int row0; int pn; int e; const char* B; };

struct SchedDense {
    int nM, nN, nwg, G, c, latmap; const char* Bt; size_t tstepB;
    __device__ __forceinline__ void init(int nM_, int nN_, int G_, int c_, int latmap_, const bf16_t* Bt_, int K) { nM = nM_; nN = nN_; nwg = nM * nN; G = G_; c = c_; latmap = latmap_; Bt = (const char*)Bt_; tstepB = (size_t)BM * K * 2; }
    __device__ __forceinline__ bool next(int i, Unit& u) const {
        const long L = (long)i * G + c; if (L >= nwg) return false;
        int wgid = (int)L; { const int q = nwg / 8, r = nwg % 8, xcd = wgid % 8, off = wgid / 8; wgid = (xcd < r ? xcd * (q + 1) : r * (q + 1) + (xcd - r) * q) + off; }
        const int nig = 8 * nN, gid = wgid / nig, fm = gid * 8, gsz = (nM - fm) < 8 ? (nM - fm) : 8;
        int pm = fm + ((wgid % nig) % gsz); u.pn = (wgid % nig) / gsz;
        if (latmap) pm = (pm >> 3) * 9 + 1 + (pm & 7);
        u.row0 = pm * BM; u.e = 0; u.B = Bt + (size_t)u.pn * tstepB; return true;
    }
};
template <int NN, size_t GSTRIDE, size_t TSTEPB> struct SchedMoe {
    int ntiles, G, vcu; const LAS int* ttab; const char* Bt;
    __device__ __forceinline__ bool next(int i, Unit& u) const {
        const int L = i * G + vcu; if (L >= ntiles * NN) return false;
        const int tile = L / NN; u.pn = L - tile * NN; const int e = ttab[tile] >> 16;
        u.row0 = tile * BM; u.e = e; u.B = Bt + (size_t)e * GSTRIDE + (size_t)u.pn * TSTEPB; return true;
    }
};
struct EpiBf16 {
    static constexpr bool PERM = true; static constexpr int NVM = 16;
    bf16_t* O; int ldc;
    __device__ __forceinline__ const float* sa_src(const Unit& u, int ui, int r) const { return (const float*)O; }
    __device__ __forceinline__ const float* sw_src(const Unit& u, int c) const { return (const float*)O; }
    __device__ __forceinline__ void operator()(const f32x4 (&acc)[2][2][4][2], const Unit& u, int ui, int wr, int wc, int fr, int fq, const LAS float* scl) const {
        const int row0 = u.row0 + wr * 64 + fr, col0 = u.pn * BM + wc * 32 + 8 * fq;
#pragma unroll
        for (int ai = 0; ai < 2; ++ai)
#pragma unroll
            for (int m = 0; m < 4; ++m) { bf16_t* rowp = O + (size_t)(row0 + ai * HALF + m * 16) * ldc + col0;
#pragma unroll
                for (int bj = 0; bj < 2; ++bj) { const f32x4 v0 = acc[ai][bj][m][0], v1 = acc[ai][bj][m][1];
                    u32x4 w; w.x = cvt_pk_bf16(v0[0], v0[1]); w.y = cvt_pk_bf16(v0[2], v0[3]); w.z = cvt_pk_bf16(v1[0], v1[1]); w.w = cvt_pk_bf16(v1[2], v1[3]);
                    *(u32x4*)(rowp + bj * HALF) = w; } }
    }
};
__device__ __forceinline__ float silu_mul(float g, float u) { return g * __builtin_amdgcn_rcpf(1.0f + __builtin_amdgcn_exp2f(-1.4426950408889634f * g)) * u; }
template <int SWG> struct EpiI8Bf16 {
    static constexpr bool PERM = true; static constexpr int NVM = 16;
    bf16_t* O; int ldc; const float* SA; const float* SW;
    __device__ __forceinline__ const float* sa_src(const Unit& u, int ui, int r) const { return SA + u.row0 + r; }
    __device__ __forceinline__ const float* sw_src(const Unit& u, int c) const { return SW + (size_t)u.e * SWG + u.pn * BM + c; }
    __device__ __forceinline__ void operator()(const i32x4 (&acc)[2][2][4][2], const Unit& u, int ui, int wr, int wc, int fr, int fq, const LAS float* scl) const {
        const int lrow = wr * 64 + fr, row0 = u.row0 + lrow, col0 = u.pn * BM + wc * 32 + 8 * fq;
#pragma unroll
        for (int bj = 0; bj < 2; ++bj) { const f32x4 w0 = *(const LAS f32x4*)(scl + 256 + bj * HALF + wc * 32 + 8 * fq), w1 = *(const LAS f32x4*)(scl + 256 + bj * HALF + wc * 32 + 8 * fq + 4);
#pragma unroll
            for (int ai = 0; ai < 2; ++ai)
#pragma unroll
                for (int m = 0; m < 4; ++m) { const int r = row0 + ai * HALF + m * 16; bf16_t* rowp = O + (size_t)r * ldc + col0 + bj * HALF; const float sa = scl[lrow + ai * HALF + m * 16];
                    const i32x4 v0 = acc[ai][bj][m][0], v1 = acc[ai][bj][m][1]; const f32x4 s0 = w0 * sa, s1 = w1 * sa;
                    const f32x4 f0 = __builtin_convertvector(v0, f32x4) * s0, f1 = __builtin_convertvector(v1, f32x4) * s1;
                    u32x4 w; w.x = cvt_pk_bf16(f0[0], f0[1]); w.y = cvt_pk_bf16(f0[2], f0[3]); w.z = cvt_pk_bf16(f1[0], f1[1]); w.w = cvt_pk_bf16(f1[2], f1[3]);
                    *(u32x4*)rowp = w; } }
    }
};
template <int SWG, bool SA1 = false> struct EpiI8Fp8 {
    static constexpr bool PERM = true; static constexpr int NVM = 16;
    unsigned char* O; int ldc; const float* SA; const float* SW;
    __device__ __forceinline__ const float* sa_src(const Unit& u, int ui, int r) const { return SA1 ? SW : SA + u.row0 + r; }
    __device__ __forceinline__ const float* sw_src(const Unit& u, int c) const { return SW + (size_t)u.e * SWG + u.pn * BM + c; }
    template <class AV> __device__ __forceinline__ void operator()(const AV (&acc)[2][2][4][2], const Unit& u, int ui, int wr, int wc, int fr, int fq, const LAS float* scl) const {
        const int lrow = wr * 64 + fr, row0 = u.row0 + lrow, col0 = u.pn * BM + wc * 32 + 8 * fq;
#pragma unroll
        for (int bj = 0; bj < 2; ++bj) { const f32x4 w0 = *(const LAS f32x4*)(scl + 256 + bj * HALF + wc * 32 + 8 * fq), w1 = *(const LAS f32x4*)(scl + 256 + bj * HALF + wc * 32 + 8 * fq + 4);
#pragma unroll
            for (int ai = 0; ai < 2; ++ai)
#pragma unroll
                for (int m = 0; m < 4; ++m) { const int r = row0 + ai * HALF + m * 16; unsigned char* rowp = O + (size_t)r * ldc + col0 + bj * HALF; const float sa = SA1 ? 1.0f : scl[lrow + ai * HALF + m * 16];
                    const AV v0 = acc[ai][bj][m][0], v1 = acc[ai][bj][m][1]; const f32x4 s0 = w0 * sa, s1 = w1 * sa;
                    const f32x4 f0 = __builtin_convertvector(v0, f32x4) * s0, f1 = __builtin_convertvector(v1, f32x4) * s1;
                    int lo = 0, hi = 0;
                    lo = __builtin_amdgcn_cvt_pk_fp8_f32(f0[0], f0[1], lo, false); lo = __builtin_amdgcn_cvt_pk_fp8_f32(f0[2], f0[3], lo, true);
                    hi = __builtin_amdgcn_cvt_pk_fp8_f32(f1[0], f1[1], hi, false); hi = __builtin_amdgcn_cvt_pk_fp8_f32(f1[2], f1[3], hi, true);
                    *(u32x2*)rowp = (u32x2){(unsigned)lo, (unsigned)hi}; } }
    }
};
struct EpiSwigluI8 {
    static constexpr bool PERM = true; static constexpr int NVM = 8;
    unsigned char* O; int ldc; const float* SA; const float* SW; const LAS int* idxc;
    __device__ __forceinline__ const float* sa_src(const Unit& u, int ui, int r) const { return SA + idxc[(ui & (IDXC_UNITS - 1)) * 256 + r]; }
    __device__ __forceinline__ const float* sw_src(const Unit& u, int c) const { return SW + (size_t)u.e * 1024 + u.pn * BM + c; }
    __device__ __forceinline__ void operator()(const i32x4 (&acc)[2][2][4][2], const Unit& u, int ui, int wr, int wc, int fr, int fq, const LAS float* scl) const {
        const int lrow = wr * 64 + fr, row0 = u.row0 + lrow, col0 = u.pn * HALF + wc * 32 + 8 * fq;
        const LAS float* sw = scl + 256 + wc * 32 + 8 * fq;
        const f32x4 wg0 = *(const LAS f32x4*)sw, wg1 = *(const LAS f32x4*)(sw + 4), wu0 = *(const LAS f32x4*)(sw + HALF), wu1 = *(const LAS f32x4*)(sw + HALF + 4);
#pragma unroll
        for (int ai = 0; ai < 2; ++ai)
#pragma unroll
            for (int m = 0; m < 4; ++m) { unsigned char* rowp = O + (size_t)(row0 + ai * HALF + m * 16) * ldc + col0;
                const float sa = scl[lrow + ai * HALF + m * 16];
                const i32x4 g0 = acc[ai][0][m][0], g1 = acc[ai][0][m][1], u0 = acc[ai][1][m][0], u1 = acc[ai][1][m][1];
                float o[8];
#pragma unroll
                for (int j = 0; j < 4; ++j) { o[j] = silu_mul((float)g0[j] * (sa * wg0[j]), (float)u0[j] * (sa * wu0[j])); o[4 + j] = silu_mul((float)g1[j] * (sa * wg1[j]), (float)u1[j] * (sa * wu1[j])); }
                int lo = 0, hi = 0;
                lo = __builtin_amdgcn_cvt_pk_fp8_f32(o[0], o[1], lo, false); lo = __builtin_amdgcn_cvt_pk_fp8_f32(o[2], o[3], lo, true);
                hi = __builtin_amdgcn_cvt_pk_fp8_f32(o[4], o[5], hi, false); hi = __builtin_amdgcn_cvt_pk_fp8_f32(o[6], o[7], hi, true);
                *(u32x2*)rowp = (u32x2){(unsigned)lo, (unsigned)hi}; }
    }
};

template <int I8> struct AccT { typedef f32x4 T; };
template <> struct AccT<1> { typedef i32x4 T; };
__device__ __forceinline__ f32x4 mma16(bf16x8 b, bf16x8 a, f32x4 c) { return __builtin_amdgcn_mfma_f32_16x16x32_bf16(b, a, c, 0, 0, 0); }
__device__ __forceinline__ i32x4 mma16(bf16x8 b, bf16x8 a, i32x4 c) { return __builtin_amdgcn_mfma_i32_16x16x64_i8(__builtin_bit_cast(i32x4, b), __builtin_bit_cast(i32x4, a), c, 0, 0, 0); }
typedef int i32x8 __attribute__((ext_vector_type(8)));
__device__ __forceinline__ f32x4 mma_f8(bf16x8 b0, bf16x8 b1, bf16x8 a0, bf16x8 a1, f32x4 c) {
    const i32x8 bb = __builtin_shufflevector(__builtin_bit_cast(i32x4, b0), __builtin_bit_cast(i32x4, b1), 0, 1, 2, 3, 4, 5, 6, 7);
    const i32x8 aa = __builtin_shufflevector(__builtin_bit_cast(i32x4, a0), __builtin_bit_cast(i32x4, a1), 0, 1, 2, 3, 4, 5, 6, 7);
    return __builtin_amdgcn_mfma_scale_f32_16x16x128_f8f6f4(bb, aa, c, 0, 0, 0, 0, 0, 0);
}
template <class Epi, class Sched, bool GATHER, int I8 = 0>
__device__ __forceinline__ void gemm_phase(LAS unsigned char* lds, const void* Abase, const int K, const Sched& S, const Epi& E, const LAS int* idxc, const int tid) {
    const int wid = __builtin_amdgcn_readfirstlane(tid >> 6), lane = tid & 63, wr = wid >> 2, wc = wid & 3, fr = lane & 15, fq = lane >> 4;
    const int RB = I8 ? K : K * 2, nt = RB / 128;
    int Ri[2], Ci[2]; unsigned voffB[2];
#pragma unroll
    for (int i = 0; i < 2; ++i) { int R, C; stage_rc(tid * 16 + i * 8192, R, C); Ri[i] = R; Ci[i] = C; const int Rb = Epi::PERM ? ((R & ~31) + perm32(R & 31)) : R; voffB[i] = (unsigned)(Rb * RB + C * 2); }
    const size_t kstep = 128;
    const size_t hstep = (size_t)HALF * RB;
    const unsigned ldsw = (unsigned)wid * 1024u;
    const int aoff = lds_byte(wr * 64 + fr, fq * 8), boff = lds_byte(wc * 32 + fr, fq * 8);
#define PG8_SA(b, h) (((b) * 2 + (h)) * HTB)
#define PG8_SB(b, h) ((4 + (b) * 2 + (h)) * HTB)
#define PG8_STAGE(bufoff, gbase, voff) do { _Pragma("unroll") for (int _i = 0; _i < 2; ++_i) \
        __builtin_amdgcn_global_load_lds((const unsigned*)((const char*)(gbase) + (voff)[_i]), (LAS unsigned*)(lds + (bufoff) + ldsw + _i * 8192), 16, 0, 0); } while (0)
#define PG8_LDA(dst, b, h) do { _Pragma("unroll") for (int m = 0; m < 4; ++m) _Pragma("unroll") for (int k = 0; k < 2; ++k) dst[m][k] = *(const LAS bf16x8*)(lds + PG8_SA(b, h) + aoff + m * 2048 + k * 1024); } while (0)
#define PG8_LDB(dst, b, h) do { _Pragma("unroll") for (int n = 0; n < 2; ++n) _Pragma("unroll") for (int k = 0; k < 2; ++k) dst[n][k] = *(const LAS bf16x8*)(lds + PG8_SB(b, h) + boff + n * 2048 + k * 1024); } while (0)
#define PG8_MMA(ai, bj, At, Bt) do { __builtin_amdgcn_s_setprio(1); _Pragma("unroll") for (int m = 0; m < 4; ++m) _Pragma("unroll") for (int n = 0; n < 2; ++n) { \
        if constexpr (I8 == 2) acc[ai][bj][m][n] = mma_f8(Bt[n][0], Bt[n][1], At[m][0], At[m][1], acc[ai][bj][m][n]); \
        else { _Pragma("unroll") for (int k = 0; k < 2; ++k) acc[ai][bj][m][n] = mma16(Bt[n][k], At[m][k], acc[ai][bj][m][n]); } } __builtin_amdgcn_s_setprio(0); } while (0)
#define PG8_WAIT_V(n) asm volatile("s_waitcnt vmcnt(" #n ")" ::: "memory")
#define PG8_WAIT_L(n) asm volatile("s_waitcnt lgkmcnt(" #n ")" ::: "memory")
#define PG8_BAR __builtin_amdgcn_s_barrier()
#define PG8_SCHED __builtin_amdgcn_sched_barrier(0)
#define PG8_MKA(dst, ui, u_) do { _Pragma("unroll") for (int _h = 0; _h < 2; ++_h) _Pragma("unroll") for (int _i = 0; _i < 2; ++_i) { \
        if constexpr (GATHER) dst[_h][_i] = (unsigned)idxc[((ui) & (IDXC_UNITS - 1)) * 256 + _h * HALF + Ri[_i]] * (unsigned)RB + (unsigned)(Ci[_i] * 2); \
        else dst[_h][_i] = (unsigned)((_h * HALF + Ri[_i]) * RB + Ci[_i] * 2); } } while (0)
    Unit cur, nxt; int ui = 0;
    if (!S.next(0, cur)) return;
    LAS float* const sclb = (LAS float*)(lds + SCL_OFF);
#define PG8_SCALES(u_, ui_) do { const float* _src = (wid < 4) ? E.sa_src(u_, ui_, wid * 64 + lane) : E.sw_src(u_, (wid - 4) * 64 + lane); \
        __builtin_amdgcn_global_load_lds((const unsigned*)_src, (LAS unsigned*)(sclb + ((ui_) & 1) * 512 + wid * 64), 4, 0, 0); } while (0)
    constexpr int NEPI = Epi::NVM;
    typedef typename AccT<I8>::T acc_t;
    acc_t acc[2][2][4][2];
#pragma unroll
    for (int a = 0; a < 2; ++a)
#pragma unroll
        for (int b = 0; b < 2; ++b)
#pragma unroll
            for (int m = 0; m < 4; ++m)
#pragma unroll
                for (int n = 0; n < 2; ++n) acc[a][b][m][n] = acc_t{};
    bf16x8 At[4][2], B0[2][2], B1[2][2];
    unsigned curA[2][2], nxtA[2][2];
    PG8_MKA(curA, 0, cur);
    PG8_SCALES(cur, 0);
    const char* cA = GATHER ? (const char*)Abase : (const char*)Abase + (size_t)cur.row0 * RB; const char* cB = cur.B;
    PG8_STAGE(PG8_SB(0, 0), cB, voffB); PG8_STAGE(PG8_SB(0, 1), cB + hstep, voffB); PG8_STAGE(PG8_SA(0, 0), cA, curA[0]); PG8_STAGE(PG8_SA(0, 1), cA, curA[1]);
    if (wr == 1) PG8_BAR;
    PG8_WAIT_V(2); PG8_BAR;
    PG8_STAGE(PG8_SB(1, 0), cB + kstep, voffB); PG8_STAGE(PG8_SA(1, 0), cA + kstep, curA[0]); PG8_STAGE(PG8_SB(1, 1), cB + hstep + kstep, voffB);
    PG8_WAIT_V(6); PG8_BAR;
    for (;;) {
        const bool has_next = S.next(ui + 1, nxt);
        const char* nA = has_next ? (GATHER ? (const char*)Abase : (const char*)Abase + (size_t)nxt.row0 * RB) : cA; const char* nB = has_next ? nxt.B : cB;
        if constexpr (GATHER) { if (has_next) { PG8_MKA(nxtA, ui + 1, nxt); } else {
#pragma unroll
            for (int h = 0; h < 2; ++h)
#pragma unroll
                for (int i = 0; i < 2; ++i) nxtA[h][i] = curA[h][i]; } }
#pragma unroll 1
        for (int t = 0; t < nt; t += 2) {
            const bool last = (t == nt - 2);
            const char* a1 = cA + (size_t)(t + 1) * kstep;
            const char* a2 = last ? nA : cA + (size_t)(t + 2) * kstep; const char* b2 = last ? nB : cB + (size_t)(t + 2) * kstep;
            const char* a3 = a2 + kstep; const char* b3 = b2 + kstep;
            unsigned s0[2], s1[2];
#pragma unroll
            for (int i = 0; i < 2; ++i) { if constexpr (GATHER) { s0[i] = last ? nxtA[0][i] : curA[0][i]; s1[i] = last ? nxtA[1][i] : curA[1][i]; } else { s0[i] = curA[0][i]; s1[i] = curA[1][i]; } }
            const bool relax = (t == 0) && (ui > 0);
            PG8_LDB(B0, 0, 0); PG8_LDB(B1, 0, 1); PG8_SCHED; PG8_LDA(At, 0, 0); PG8_STAGE(PG8_SA(1, 1), a1, curA[1]);
            if (relax) { if constexpr (NEPI == 16) PG8_WAIT_V(24); else PG8_WAIT_V(16); } else PG8_WAIT_V(8);
            PG8_WAIT_L(0); PG8_BAR; PG8_MMA(0, 0, At, B0); PG8_MMA(0, 1, At, B1); PG8_BAR; PG8_SCHED;
            PG8_LDA(At, 0, 1); PG8_STAGE(PG8_SB(0, 0), b2, voffB); PG8_STAGE(PG8_SB(0, 1), b2 + hstep, voffB); PG8_STAGE(PG8_SA(0, 0), a2, s0);
            if (relax) { if constexpr (NEPI == 16) PG8_WAIT_V(24); else PG8_WAIT_V(16); } else PG8_WAIT_V(8);
            PG8_WAIT_L(0); PG8_BAR; PG8_MMA(1, 0, At, B0); PG8_MMA(1, 1, At, B1); PG8_BAR; PG8_SCHED;
            PG8_LDB(B0, 1, 0); PG8_LDB(B1, 1, 1); PG8_SCHED; PG8_LDA(At, 1, 0); PG8_STAGE(PG8_SA(0, 1), a2, s1);
            PG8_WAIT_V(8); PG8_WAIT_L(0); PG8_BAR; PG8_MMA(0, 0, At, B0); PG8_MMA(0, 1, At, B1); PG8_BAR; PG8_SCHED;
            PG8_LDA(At, 1, 1); PG8_STAGE(PG8_SB(1, 0), b3, voffB); PG8_STAGE(PG8_SB(1, 1), b3 + hstep, voffB); PG8_STAGE(PG8_SA(1, 0), a3, s0);
            PG8_WAIT_V(8); PG8_WAIT_L(0); PG8_BAR; PG8_MMA(1, 0, At, B0); PG8_MMA(1, 1, At, B1); PG8_BAR; PG8_SCHED;
        }
        if (wr == 0) PG8_BAR;
        E(acc, cur, ui, wr, wc, fr, fq, sclb + (ui & 1) * 512);
        if (!has_next) break;
#pragma unroll
        for (int a = 0; a < 2; ++a)
#pragma unroll
            for (int b = 0; b < 2; ++b)
#pragma unroll
                for (int m = 0; m < 4; ++m)
#pragma unroll
                    for (int n = 0; n < 2; ++n) acc[a][b][m][n] = acc_t{};
        cur = nxt; cA = nA; cB = nB; ++ui;
        PG8_SCALES(cur, ui);
        if constexpr (GATHER) {
#pragma unroll
            for (int h = 0; h < 2; ++h)
#pragma unroll
                for (int i = 0; i < 2; ++i) curA[h][i] = nxtA[h][i]; }
        if (wr == 1) PG8_BAR;
    }
    PG8_WAIT_V(0);
    PG8_BAR;
#undef PG8_SA
#undef PG8_SB
#undef PG8_STAGE
#undef PG8_LDA
#undef PG8_LDB
#undef PG8_MMA
#undef PG8_WAIT_V
#undef PG8_WAIT_L
#undef PG8_BAR
#undef PG8_SCHED
#undef PG8_MKA
#undef PG8_SCALES
}
}

namespace att {
constexpr int DV = 128, NW = 8, QBLK = 32, KVBLK = 64;
constexpr float THR = 8.f;
#define SBAR() __builtin_amdgcn_sched_barrier(0)
__device__ __forceinline__ int crow(int r, int hi) { return (r & 3) + 8 * (r >> 2) + 4 * hi; }
template <int DQK> struct Cfg {
    static constexpr int NQ = DQK / 16, SHM_K = KVBLK * DQK * 2, KCH = DQK / 64;
    static constexpr int RB0 = DQK >= 128 ? 256 : 128;
    static constexpr int KCH0 = DQK >= 128 ? 2 : 1, KCH1 = DQK == 192 ? 1 : 0, REG1 = KVBLK * RB0;
    static constexpr float SCALE = DQK == 64 ? 0.125f : (DQK == 128 ? 0.088388347648318440f : 0.072168783648703220f);
};
constexpr int SHM_V = KVBLK * DV * 2;

template <int DQK> __device__ __forceinline__ void partialSM(f32x16& p0, f32x16& p1, float& m_reg, float& mn, float& alpha) {
    constexpr float SCALE = Cfg<DQK>::SCALE, C = SCALE * 1.4426950408889634f;
    float pmax = p0[0];
#pragma unroll
    for (int r = 1; r < 16; ++r) pmax = fmaxf(pmax, p0[r]);
#pragma unroll
    for (int r = 0; r < 16; ++r) pmax = fmaxf(pmax, p1[r]);
    { auto rr = __builtin_amdgcn_permlane32_swap(__float_as_uint(pmax), __float_as_uint(pmax), false, false);
      pmax = fmaxf(__uint_as_float(rr[0]), __uint_as_float(rr[1])); }
    if (__builtin_expect(__all(pmax - m_reg <= THR / SCALE), 1)) { mn = m_reg; alpha = 1.f; }
    else { mn = fmaxf(m_reg, pmax); alpha = __builtin_amdgcn_exp2f((m_reg - mn) * C); m_reg = mn; }
    const float mnC = -mn * C;
#pragma unroll
    for (int r = 0; r < 16; ++r) p0[r] = fmaf(p0[r], C, mnC);
#pragma unroll
    for (int r = 0; r < 16; ++r) p1[r] = fmaf(p1[r], C, mnC);
#pragma unroll
    for (int r = 0; r < 16; ++r) p0[r] = __builtin_amdgcn_exp2f(p0[r]);
}
__device__ __forceinline__ void finishSM(f32x16& p0, f32x16& p1, float alpha, float& l_reg, bf16x8& pa0, bf16x8& pa1, bf16x8& pa2, bf16x8& pa3) {
#pragma unroll
    for (int r = 0; r < 16; ++r) p1[r] = __builtin_amdgcn_exp2f(p1[r]);
    float ps = 0;
#pragma unroll
    for (int r = 0; r < 16; ++r) ps += p0[r];
#pragma unroll
    for (int r = 0; r < 16; ++r) ps += p1[r];
    { auto rr = __builtin_amdgcn_permlane32_swap(__float_as_uint(ps), __float_as_uint(ps), false, false);
      ps = __uint_as_float(rr[0]) + __uint_as_float(rr[1]); }
    l_reg = l_reg * alpha + ps;
#define PK4(P, BASE, OUT) do { unsigned a0 = cvt_pk_bf16(P[BASE + 0], P[BASE + 1]), a1 = cvt_pk_bf16(P[BASE + 2], P[BASE + 3]);   \
    unsigned b0 = cvt_pk_bf16(P[BASE + 4], P[BASE + 5]), b1 = cvt_pk_bf16(P[BASE + 6], P[BASE + 7]);                              \
    auto r0 = __builtin_amdgcn_permlane32_swap(a0, b0, false, false); auto r1 = __builtin_amdgcn_permlane32_swap(a1, b1, false, false); \
    u32x4 w = {r0[0], r1[0], r0[1], r1[1]}; OUT = *reinterpret_cast<bf16x8*>(&w); } while (0)
    PK4(p0, 0, pa0); PK4(p0, 8, pa1); PK4(p1, 0, pa2); PK4(p1, 8, pa3);
#undef PK4
}
template <int DQK> __device__ __forceinline__ void qkt(f32x16& p0, f32x16& p1, const char* Ks, const bf16x8* qr, const char* qx, int r32, int hi) {
    p0 = f32x16{}; p1 = f32x16{};
    constexpr int RB0 = Cfg<DQK>::RB0;
#pragma unroll
    for (int d0 = 0; d0 < Cfg<DQK>::NQ; ++d0) {
        bf16x8 b0, b1, q;
        if (d0 < 8) { const int cb = (d0 * 16 + hi * 8) * 2;
            const int sw = (RB0 == 256 ? (r32 & 15) : ((r32 >> 1) & 7)) << 4;
            b0 = *reinterpret_cast<const bf16x8*>(Ks + r32 * RB0 + (cb ^ sw));
            b1 = *reinterpret_cast<const bf16x8*>(Ks + (32 + r32) * RB0 + (cb ^ sw));
            q = qr[d0 < 8 ? d0 : 0];
        } else { const int cb = ((d0 - 8) * 16 + hi * 8) * 2;
            const int sw = ((r32 >> 1) & 7) << 4;
            b0 = *reinterpret_cast<const bf16x8*>(Ks + Cfg<DQK>::REG1 + r32 * 128 + (cb ^ sw));
            b1 = *reinterpret_cast<const bf16x8*>(Ks + Cfg<DQK>::REG1 + (32 + r32) * 128 + (cb ^ sw));
            q = *reinterpret_cast<const bf16x8*>(qx + (d0 - 8) * 1024);
        }
        p0 = __builtin_amdgcn_mfma_f32_32x32x16_bf16(b0, q, p0, 0, 0, 0);
        p1 = __builtin_amdgcn_mfma_f32_32x32x16_bf16(b1, q, p1, 0, 0, 0); }
}
__device__ __forceinline__ int v_rd_base(int lane) { return ((lane & 3) << 3) | (((lane >> 2) & 3) << 6) | (((lane >> 4) & 1) << 5) | (((lane >> 5) & 1) << 8); }
constexpr int v_rd_off(int d0, int ks, int half) { return d0 * 512 + ks * 4096 + half * 2048; }
template <int OFF> __device__ __forceinline__ s16x4 tr_read(int vb) {
    s16x4 r; asm volatile("ds_read_b64_tr_b16 %0, %1 offset:%2" : "=&v"(r) : "v"(vb), "i"(OFF) : "memory"); return r;
}
template <int D0> __device__ __forceinline__ void pv_one(f32x16& od, int vb, bf16x8 pa0, bf16x8 pa1, bf16x8 pa2, bf16x8 pa3) {
    const s16x4 l0 = tr_read<v_rd_off(D0, 0, 0)>(vb), h0 = tr_read<v_rd_off(D0, 0, 1)>(vb), l1 = tr_read<v_rd_off(D0, 1, 0)>(vb), h1 = tr_read<v_rd_off(D0, 1, 1)>(vb);
    const s16x4 l2 = tr_read<v_rd_off(D0, 2, 0)>(vb), h2 = tr_read<v_rd_off(D0, 2, 1)>(vb), l3 = tr_read<v_rd_off(D0, 3, 0)>(vb), h3 = tr_read<v_rd_off(D0, 3, 1)>(vb);
    asm volatile("s_waitcnt lgkmcnt(0)" ::: "memory"); SBAR();
#define PK(L, H) (bf16x8){L[0], L[1], L[2], L[3], H[0], H[1], H[2], H[3]}
    od = __builtin_amdgcn_mfma_f32_32x32x16_bf16(pa0, PK(l0, h0), od, 0, 0, 0);
    od = __builtin_amdgcn_mfma_f32_32x32x16_bf16(pa1, PK(l1, h1), od, 0, 0, 0);
    od = __builtin_amdgcn_mfma_f32_32x32x16_bf16(pa2, PK(l2, h2), od, 0, 0, 0);
    od = __builtin_amdgcn_mfma_f32_32x32x16_bf16(pa3, PK(l3, h3), od, 0, 0, 0);
#undef PK
}
__device__ __forceinline__ void pv_d0(f32x16* o, int vb, bf16x8 pa0, bf16x8 pa1, bf16x8 pa2, bf16x8 pa3) {
    pv_one<0>(o[0], vb, pa0, pa1, pa2, pa3); pv_one<1>(o[1], vb, pa0, pa1, pa2, pa3); pv_one<2>(o[2], vb, pa0, pa1, pa2, pa3); pv_one<3>(o[3], vb, pa0, pa1, pa2, pa3);
}

template <int DQK, bool PIPE, bool QROPE, bool O8 = false>
__device__ __forceinline__ void attn_unit(const bf16_t* __restrict__ Qb, int ldq, const bf16_t* __restrict__ K0, int ldk0, const bf16_t* __restrict__ K1, int ldk1,
                                          const bf16_t* __restrict__ Vh, int ldv, bf16_t* __restrict__ Ob, int ldo, int nkeys, int qpos0, const f32x2* ropeR, const f32x2* ropeC,
                                          char* lds, LAS unsigned char* ldsl, const int tid) {
    using C = Cfg<DQK>; constexpr int NQ = C::NQ, SHM_K = C::SHM_K, NB = PIPE ? 3 : 2, KCH0 = C::KCH0, KCH1 = C::KCH1;
    const int wid = __builtin_amdgcn_readfirstlane(tid >> 6), lane = tid & 63, r32 = lane & 31, hi = lane >> 5;
    char* V_lds = lds; char* K_lds = lds + NB * SHM_V;
    float* ws = (float*)(lds + NB * SHM_V + NB * SHM_K) + wid * 64; float* li_l = ws; float* al_l = ws + 32;
    float m_reg = -1e30f, l_reg = 0; f32x16 o[4] = {}; constexpr int NQR = NQ < 8 ? NQ : 8; bf16x8 qr[NQR];
    char* qx = lds + NB * SHM_V + NB * SHM_K + 2048 + wid * 4096 + lane * 16;
    const bf16_t* Qw = Qb + (long)(wid * QBLK + r32) * ldq + hi * 8;
#pragma unroll
    for (int d0 = 0; d0 < NQR; ++d0) qr[d0] = *reinterpret_cast<const bf16x8*>(Qw + d0 * 16);
    if constexpr (QROPE) {
        static_assert(DQK == 192, "QROPE: MLA layout");
        const int pos = qpos0 + wid * QBLK + r32, gr = pos >> 6, gc = pos & 63;
#pragma unroll
        for (int blk = 0; blk < 2; ++blk) { const f32x2* tb = (blk == 0 ? ropeR + gr * 16 : ropeC + gc * 16) + hi * 8;
            bf16x8 x1 = *reinterpret_cast<const bf16x8*>(Qw + (8 + 2 * blk) * 16), x2 = *reinterpret_cast<const bf16x8*>(Qw + (9 + 2 * blk) * 16);
#pragma unroll
            for (int i = 0; i < 8; ++i) { const f32x2 cs = tb[i]; const float a = bf2f((unsigned short)x1[i]), b = bf2f((unsigned short)x2[i]);
                x1[i] = (short)f2bf(a * cs.x - b * cs.y); x2[i] = (short)f2bf(b * cs.x + a * cs.y); }
            *reinterpret_cast<bf16x8*>(qx + (2 * blk) * 1024) = x1; *reinterpret_cast<bf16x8*>(qx + (2 * blk + 1) * 1024) = x2; }
    } else { static_assert(NQ <= 8, "fragments beyond 8 need the LDS path"); }
    unsigned voffv[2], koff[KCH0 + (KCH1 ? 1 : 0)];
#pragma unroll
    for (int i = 0; i < 2; ++i) { const int st = 4 * wid + 2 * i + (lane >> 5), kk = (st >> 2) * 8 + ((lane & 31) >> 2), k = (kk & ~0xC) | ((kk & 4) << 1) | ((kk & 8) >> 1), c = (st & 3) * 32 + (lane & 3) * 8;
        voffv[i] = (unsigned)(k * ldv + c) * 2u; }
#pragma unroll
    for (int i = 0; i < KCH0; ++i) { const int sgm = KCH0 * wid + i; int row, q; if (C::RB0 == 256) { row = 4 * sgm + (lane >> 4); q = lane & 15; } else { row = 8 * sgm + (lane >> 3); q = lane & 7; }
        koff[i] = (unsigned)(row * ldk0 + (q ^ (C::RB0 == 256 ? (row & 15) : ((row >> 1) & 7))) * 8) * 2u; }
    if constexpr (KCH1) { const int row = 8 * wid + (lane >> 3), q = lane & 7; koff[KCH0] = (unsigned)(row * ldk1 + (q ^ ((row >> 1) & 7)) * 8) * 2u; }
    const int vb0 = (int)(uintptr_t)V_lds + v_rd_base(lane);
    LAS unsigned char* Vl = ldsl; LAS unsigned char* Kl = ldsl + NB * SHM_V;
#define GLDS(gp, lp) __builtin_amdgcn_global_load_lds((const unsigned*)(gp), (LAS unsigned*)(lp), 16, 0, 0)
#define DMA(k0, b) do { const char* _vb = (const char*)(Vh + (long)(k0) * ldv); const char* _kb0 = (const char*)(K0 + (long)(k0) * ldk0); \
    _Pragma("unroll") for (int _i = 0; _i < 2; ++_i) GLDS(_vb + voffv[_i], Vl + (b) * SHM_V + (2 * wid + _i) * 1024); \
    _Pragma("unroll") for (int _i = 0; _i < KCH0; ++_i) GLDS(_kb0 + koff[_i], Kl + (b) * SHM_K + (KCH0 * wid + _i) * 1024); \
    if constexpr (KCH1) { const char* _kb1 = (const char*)(K1 + (long)(k0) * ldk1); GLDS(_kb1 + koff[KCH0], Kl + (b) * SHM_K + C::REG1 + wid * 1024); } } while (0)
#define VM0() asm volatile("s_waitcnt vmcnt(0)" ::: "memory")
#define RESC(a) do { if (__any((a) < 1.f)) { if (hi == 0) al_l[r32] = (a); asm volatile("s_waitcnt lgkmcnt(0)" ::: "memory"); \
    _Pragma("unroll") for (int d = 0; d < 4; ++d) _Pragma("unroll") for (int r = 0; r < 16; ++r) o[d][r] *= al_l[crow(r, hi)]; } } while (0)
    bf16x8 pa0, pa1, pa2, pa3; const int NT = nkeys / KVBLK;
    if constexpr (PIPE) {
        f32x16 pA0, pA1, pB0, pB1; float mnA, mnB, alA, alB;
        int bc = 1, bp = 0, bn = 2;
        DMA(0, 0); DMA(KVBLK, 1); VM0(); __syncthreads();
        qkt<DQK>(pA0, pA1, K_lds, qr, qx, r32, hi); partialSM<DQK>(pA0, pA1, m_reg, mnA, alA);
#define STEP(PC0, PC1, mnC, alC, PP0, PP1, alP, j) do { \
        if ((j) + 1 < NT) DMA(((j) + 1) * KVBLK, bn); \
        SBAR(); qkt<DQK>(PC0, PC1, K_lds + bc * SHM_K, qr, qx, r32, hi); \
        finishSM(PP0, PP1, alP, l_reg, pa0, pa1, pa2, pa3); SBAR(); \
        pv_d0(o, vb0 + bp * SHM_V, pa0, pa1, pa2, pa3); partialSM<DQK>(PC0, PC1, m_reg, mnC, alC); \
        RESC(alC); VM0(); __syncthreads(); \
        { const int _t = bp; bp = bc; bc = bn; bn = _t; } } while (0)
        int j = 1;
        for (; j + 1 < NT; j += 2) { STEP(pB0, pB1, mnB, alB, pA0, pA1, alA, j); STEP(pA0, pA1, mnA, alA, pB0, pB1, alB, j + 1); }
        STEP(pB0, pB1, mnB, alB, pA0, pA1, alA, j);
#undef STEP
        finishSM(pB0, pB1, alB, l_reg, pa0, pa1, pa2, pa3); SBAR();
        pv_d0(o, vb0 + bp * SHM_V, pa0, pa1, pa2, pa3);
    } else {
        f32x16 p0, p1; float mn, al;
        DMA(0, 0); VM0(); __syncthreads();
        for (int j = 0; j < NT; ++j) {
            const int bs = j & 1;
            if (j + 1 < NT) DMA((j + 1) * KVBLK, bs ^ 1);
            SBAR(); qkt<DQK>(p0, p1, K_lds + bs * SHM_K, qr, qx, r32, hi); partialSM<DQK>(p0, p1, m_reg, mn, al);
            RESC(al);
            finishSM(p0, p1, al, l_reg, pa0, pa1, pa2, pa3); SBAR();
            pv_d0(o, vb0 + bs * SHM_V, pa0, pa1, pa2, pa3);
            VM0(); __syncthreads();
        }
    }
    if (hi == 0) li_l[r32] = l_reg; asm volatile("s_waitcnt lgkmcnt(0)" ::: "memory");
    float rli[16];
#pragma unroll
    for (int r = 0; r < 16; ++r) rli[r] = __builtin_amdgcn_rcpf(li_l[crow(r, hi)]);
    if constexpr (O8) { unsigned char* Ow = (unsigned char*)Ob + (long)(wid * QBLK) * ldo;
#pragma unroll
        for (int r = 0; r < 16; ++r) { const int orow = crow(r, hi);
#pragma unroll
            for (int d0 = 0; d0 < 4; ++d0) Ow[(long)orow * ldo + d0 * 32 + r32] = (unsigned char)__builtin_amdgcn_cvt_pk_fp8_f32(o[d0][r] * rli[r], 0.0f, 0, false); } }
    else { bf16_t* Ow = Ob + (long)(wid * QBLK) * ldo;
#pragma unroll
    for (int r = 0; r < 16; ++r) { const int orow = crow(r, hi);
#pragma unroll
        for (int d0 = 0; d0 < 4; ++d0) Ow[(long)orow * ldo + d0 * 32 + r32] = (bf16_t)f2bf(o[d0][r] * rli[r]); } }
    asm volatile("s_waitcnt vmcnt(0)" ::: "memory");
    __syncthreads();
#undef GLDS
#undef DMA
#undef VM0
#undef RESC
}
}

struct Args { const float* in[28]; float* out; unsigned char* ws; int ph_lo, ph_hi; };
typedef const __attribute__((address_space(4))) Args* KArgs;
struct Frame {
    LAS unsigned char* lds; char* ldsg;
    unsigned* ctl; unsigned char* ws; KArgs ka;
    int tid, lane, wave, vcu, G, gw, NGW;
};
#define PHASE_BEGIN(F) __syncthreads(); Frame P = (F); { int _l; asm volatile("v_mbcnt_lo_u32_b32 %0, -1, 0\n\tv_mbcnt_hi_u32_b32 %0, -1, %0" : "=v"(_l)); long _z = 0; asm volatile("" : "+s"(_z)); unsigned char* _w = (F).ka->ws + _z; P.ws = _w; P.ctl = (unsigned*)_w;     \
    P.lane = _l; P.tid = P.wave * 64 + _l; P.gw = P.vcu * 8 + P.wave; }
enum { I_X = 0, I_C, I_CTX, I_CCTX, I_ADAW, I_ADAB, I_LNMG, I_LNMB, I_LNFG, I_LNFB, I_ABWIN, I_ABWOUT, I_DLAM, I_SUBLN, I_QNG, I_KNG,
       I_MDOWN, I_MQNG, I_MUQ, I_MKVNG, I_MUKV, I_MWO, I_RW, I_RB, I_EWIN, I_EWOUT, I_SWIN, I_SWOUT };

__device__ __forceinline__ int tok_row(int layer, int t) { return layer ? (t >> 11) * RPB + CTXL + (t & 2047) : t; }

__constant__ float INV128[32] = { 1.f, 0.749894202f, 0.562341332f, 0.421696514f, 0.316227764f, 0.237137392f, 0.177827939f, 0.133352146f, 0.100000001f, 0.0749894157f, 0.0562341288f, 0.0421696492f,
    0.0316227786f, 0.0237137359f, 0.0177827943f, 0.0133352149f, 0.00999999978f, 0.00749894232f, 0.00562341325f, 0.00421696482f, 0.00316227786f, 0.00237137382f, 0.00177827943f, 0.00133352145f,
    0.00100000005f, 0.000749894185f, 0.000562341302f, 0.000421696546f, 0.000316227786f, 0.000237137385f, 0.00017782794f, 0.00013335215f };

__device__ __forceinline__ f32x2 sincos_d(double a) {
    const double twopi = 6.283185307179586476925287;
    const double k = __builtin_rint(a / twopi); const double r = a - k * twopi, r2 = r * r;
    double ts = r, tc = 1.0, ss = r, cc = 1.0;
#pragma unroll 1
    for (int n = 1; n <= 15; ++n) { tc *= -r2 / (double)((2 * n - 1) * (2 * n)); cc += tc; ts *= -r2 / (double)((2 * n) * (2 * n + 1)); ss += ts; }
    return (f32x2){(float)cc, (float)ss};
}

__device__ __forceinline__ int fresh_lane() { int l; asm volatile("v_mbcnt_lo_u32_b32 %0, -1, 0\n\tv_mbcnt_hi_u32_b32 %0, -1, %0" : "=v"(l)); return l; }
__device__ __forceinline__ int fresh_tid(const Frame& F) { return F.wave * 64 + fresh_lane(); }
__device__ __forceinline__ void transpose_item(const float* W, int K, int N, bf16_t* WT, int k0, int n0, int drow0, LAS float* scr, int lane) {
#pragma unroll 8
    for (int i = 0; i < 32; ++i) { const int kk = 2 * i + (lane >> 5); scr[kk * 33 + (lane & 31)] = W[(size_t)(k0 + kk) * N + n0 + (lane & 31)]; }
    asm volatile("s_waitcnt lgkmcnt(0)" ::: "memory");
    const int c = lane & 7;
#pragma unroll
    for (int j = 0; j < 4; ++j) { const int n = (lane >> 3) + 8 * j; const LAS float* s = scr + (8 * c) * 33 + n;
        u32x4 o; o.x = pk2(s[0 * 33], s[1 * 33]); o.y = pk2(s[2 * 33], s[3 * 33]); o.z = pk2(s[4 * 33], s[5 * 33]); o.w = pk2(s[6 * 33], s[7 * 33]);
        *(u32x4*)(WT + (size_t)(drow0 + n) * K + k0 + 8 * c) = o; }
    asm volatile("s_waitcnt lgkmcnt(0)" ::: "memory");
}
struct QItem { const float* W; int N, n0, drow; signed char* Q; float* SW; };
template <int KW, int NC, class Dec, bool F8 = false>
__device__ __forceinline__ void quant_loop(Frame& F, int nitems, const Dec& dec, int first) {
    LAS unsigned short* scr = (LAS unsigned short*)(F.lds + F.wave * 16384);
    LAS float* PM = (LAS float*)(F.lds + 131072);
    constexpr int K = 8 * KW, CH = KW / 16, LPR = NC / 4, RPI = 64 / LPR, NL = KW / RPI;
    static_assert(KW * NC * 2 <= 16384 && (NC == 32 || NC == 64), "quant_loop tile");
    const int k0 = F.wave * KW, rg = F.lane / LPR, c4 = (F.lane % LPR) * 4;
    f32x4 regs[NL]; QItem cur, nxt;
    int it = first; if (it >= nitems) return;
    dec(it, cur);
#pragma unroll
    for (int i = 0; i < NL; ++i) regs[i] = __builtin_nontemporal_load((const f32x4*)(cur.W + (size_t)(k0 + RPI * i + rg) * cur.N + cur.n0 + c4));
    for (;;) {
        f32x4 am = {0.f, 0.f, 0.f, 0.f};
#pragma unroll
        for (int i = 0; i < NL; ++i) { const f32x4 w = regs[i]; am[0] = fmaxf(am[0], fabsf(w[0])); am[1] = fmaxf(am[1], fabsf(w[1])); am[2] = fmaxf(am[2], fabsf(w[2])); am[3] = fmaxf(am[3], fabsf(w[3]));
            const int sw = (((RPI * i) >> 4) & 15) << 1;
            const unsigned lo = cvt_pk_bf16(w[0], w[1]), hi = cvt_pk_bf16(w[2], w[3]);
            *(LAS u32x2*)(scr + (RPI * i + rg) * NC + (c4 ^ (sw & 28))) = (sw & 2) ? (u32x2){hi, lo} : (u32x2){lo, hi}; }
        asm volatile("" : "+v"(am[0]), "+v"(am[1]), "+v"(am[2]), "+v"(am[3]) :: "memory"); __builtin_amdgcn_sched_barrier(0);
        const int itn = it + F.G; const bool has_next = itn < nitems;
        if (has_next) { dec(itn, nxt);
            const char* nbase = (const char*)(nxt.W + (size_t)k0 * nxt.N + nxt.n0); const size_t stepb = (size_t)RPI * nxt.N * 4; const unsigned voff = (unsigned)((rg * nxt.N + c4) * 4);
#pragma unroll
            for (int i = 0; i < NL; ++i) regs[i] = __builtin_nontemporal_load((const f32x4*)((nbase + (size_t)i * stepb) + voff)); }
#pragma unroll
        for (int q = 0; q < 4; ++q) { float v = am[q];
#pragma unroll
            for (int o = LPR; o < 64; o <<= 1) v = fmaxf(v, __shfl_xor(v, o));
            am[q] = v; }
        if (F.lane < LPR) *(LAS f32x4*)(PM + F.wave * NC + c4) = am;
        __syncthreads();
        if (F.tid < NC) { float m = 0.f;
#pragma unroll
            for (int w = 0; w < 8; ++w) m = fmaxf(m, PM[w * NC + F.tid]);
            PM[512 + F.tid] = m > 0.f ? (F8 ? 448.0f : 127.0f) / m : 0.f; cur.SW[cur.drow + F.tid] = m * (1.0f / (F8 ? 448.0f : 127.0f)); }
        __syncthreads();
#pragma unroll 1
        for (int pass = 0; pass < NC * CH / 64; ++pass) { const int cidx = pass * 64 + F.lane, n = cidx / CH, kb = (cidx % CH) * 16; const float inv = PM[512 + n]; u32x4 o;
#pragma unroll
            for (int d = 0; d < 4; ++d) { float x[4];
#pragma unroll
                for (int e = 0; e < 4; ++e) x[e] = bf2f(scr[(kb + d * 4 + e) * NC + (n ^ (((kb >> 4) & 15) << 1))]);
                if constexpr (F8) { int w = 0; w = __builtin_amdgcn_cvt_pk_fp8_f32(x[0] * inv, x[1] * inv, w, false); w = __builtin_amdgcn_cvt_pk_fp8_f32(x[2] * inv, x[3] * inv, w, true); o[d] = (unsigned)w; }
                else o[d] = q8x4(x[0], x[1], x[2], x[3], inv); }
            *(u32x4*)(cur.Q + (size_t)(cur.drow + n) * K + k0 + kb) = o; }
        __syncthreads();
        if (!has_next) break;
        it = itn; cur = nxt;
    }
}
struct DecDense256 { KArgs ka; unsigned char* ws;
    static constexpr int NITEMS = 144 + 64 + 34 + 64;
    __device__ __forceinline__ void operator()(int it, QItem& p) const { float* SWD = (float*)(ws + WS_SWD); int r = it;
        if (r < 144) { p.W = ka->in[I_ABWIN]; p.N = ABW; p.Q = (signed char*)(ws + WS_W_IN); p.SW = SWD + SWD_IN; }
        else if ((r -= 144) < 64) { p.W = ka->in[I_ABWOUT]; p.N = 2048; p.Q = (signed char*)(ws + WS_W_OUT); p.SW = SWD + SWD_OUT; }
        else if ((r -= 64) < 34) { p.W = ka->in[I_MDOWN]; p.N = 1088; p.Q = (signed char*)(ws + WS_W_DOWN); p.SW = SWD + SWD_DOWN; }
        else { r -= 34; p.W = ka->in[I_MWO]; p.N = 2048; p.Q = (signed char*)(ws + WS_W_O); p.SW = SWD + SWD_O; }
        p.n0 = r * 32; p.drow = p.n0; }
};
struct DecDense64 { KArgs ka; unsigned char* ws;
    static constexpr int NITEMS = 48 + 64;
    __device__ __forceinline__ void operator()(int it, QItem& p) const { float* SWD = (float*)(ws + WS_SWD); int r = it;
        if (r < 48) { p.W = ka->in[I_MUQ]; p.N = UQ_N; p.Q = (signed char*)(ws + WS_W_UQ); p.SW = SWD + SWD_UQ; }
        else { r -= 48; p.W = ka->in[I_MUKV]; p.N = UKV_N; p.Q = (signed char*)(ws + WS_W_UKV); p.SW = SWD + SWD_UKV; }
        p.n0 = r * 64; p.drow = p.n0; }
};
struct DecExpIn { KArgs ka; unsigned char* ws; int layer;
    static constexpr int NITEMS = 65 * 32;
    __device__ __forceinline__ void operator()(int it, QItem& p) const { const int e = it >> 5, m = layer * 65 + e; p.n0 = (it & 31) * 32; p.N = 1024;
        p.W = (e < 64) ? ka->in[I_EWIN] + ((size_t)layer * 64 + e) * 2048 * 1024 : ka->in[I_SWIN] + (size_t)layer * 2048 * 1024;
        p.drow = (p.n0 < 512) ? ((p.n0 >> 7) * 256 + (p.n0 & 127)) : (((p.n0 - 512) >> 7) * 256 + 128 + ((p.n0 - 512) & 127));
        p.Q = (signed char*)(ws + WS_EXP_IN + (size_t)m * EXP_IN_BYTES); p.SW = (float*)(ws + WS_SW) + (size_t)m * 1024; }
};
struct DecExpOut { KArgs ka; unsigned char* ws; int layer;
    static constexpr int NITEMS = 65 * 32;
    __device__ __forceinline__ void operator()(int it, QItem& p) const { const int e = it >> 5, m = layer * 65 + e; p.n0 = (it & 31) * 64; p.N = 2048;
        p.W = (e < 64) ? ka->in[I_EWOUT] + ((size_t)layer * 64 + e) * 512 * 2048 : ka->in[I_SWOUT] + (size_t)layer * 512 * 2048;
        p.Q = (signed char*)(ws + WS_EXP_OUT + (size_t)m * EXP_OUT_BYTES); p.SW = (float*)(ws + WS_SW2) + (size_t)m * 2048; p.drow = p.n0; }
};
__device__ __forceinline__ void side_quant_experts(Frame& F, int layer);
__device__ __forceinline__ void transpose_matrix(Frame& F, const float* W, int K, int N, bf16_t* WT, int mode, int& cursor) {
    LAS float* scr = (LAS float*)(F.lds + F.wave * 16384);
    const int nblk = N / 32, nitems = (K / 64) * nblk;
    int it = (F.gw - cursor) % F.NGW; if (it < 0) it += F.NGW;
    for (; it < nitems; it += F.NGW) { const int kb = it / nblk, nb = it % nblk, n0 = nb * 32;
        int drow = n0; if (mode == 1) drow = (n0 < 512) ? ((n0 >> 7) * 256 + (n0 & 127)) : (((n0 - 512) >> 7) * 256 + 128 + ((n0 - 512) & 127));
        transpose_item(W, K, N, WT, kb * 64, n0, drow, scr, F.lane); }
    cursor = (cursor + nitems) % F.NGW;
}

__device__ __forceinline__ void p0_prologue(Frame& F) {
    {
        LAS float* act = (LAS float*)F.lds;
        LAS float* part = (LAS float*)(F.lds + 9 * 2048 * 4);
        for (int i = F.tid; i < 9 * 2048; i += 512) { const int m = i >> 11, k = i & 2047; const float v = (m < 8) ? F.ka->in[I_C][m * 2048 + k] : F.ka->in[I_CCTX][k]; act[i] = v / (1.0f + __expf(-v)); }
        __syncthreads();
        float* MOD = (float*)(F.ws + WS_MOD);
        const int l16 = F.lane & 15, kg = (F.tid >> 4);
        for (int item = F.vcu; item < 2 * 192; item += F.G) {
            const int layer = item / 192, n0 = (item % 192) * 64;
            const float* W = F.ka->in[I_ADAW] + (size_t)layer * 2048 * 12288 + n0 + l16 * 4;
            f32x4 acc[9];
#pragma unroll
            for (int m = 0; m < 9; ++m) acc[m] = (f32x4){0.f, 0.f, 0.f, 0.f};
#pragma unroll 4
            for (int j = 0; j < 64; ++j) { const int k = kg + 32 * j; const f32x4 w = *(const f32x4*)(W + (size_t)k * 12288);
#pragma unroll
                for (int m = 0; m < 9; ++m) acc[m] += w * act[m * 2048 + k]; }
#pragma unroll
            for (int m = 0; m < 9; ++m)
#pragma unroll
                for (int q = 0; q < 4; ++q) { float v = acc[m][q]; v += __shfl_xor(v, 16); v += __shfl_xor(v, 32); acc[m][q] = v; }
            if (F.lane < 16) {
#pragma unroll
                for (int m = 0; m < 9; ++m) *(LAS f32x4*)(part + (F.wave * 9 + m) * 64 + l16 * 4) = acc[m]; }
            __syncthreads();
            for (int i = F.tid; i < 9 * 64; i += 512) { const int m = i >> 6, n = i & 63; float s = 0.f;
#pragma unroll
                for (int w = 0; w < 8; ++w) s += part[(w * 9 + m) * 64 + n];
                MOD[((size_t)layer * 9 + m) * 12288 + n0 + n] = s + F.ka->in[I_ADAB][layer * 12288 + n0 + n]; }
            __syncthreads();
        }
    }
    {
        f32x2* tab = (f32x2*)(F.ws + WS_TAB);
        for (int i = F.gw * 64 + F.lane; i < 512 + 1024 + 1024 + 2048; i += F.NGW * 64) {
            int pos, f; double inv; f32x2* dst;
            if (i < 512) { pos = i >> 4; f = i & 15; inv = (double)INV128[2 * f]; dst = tab + TAB64R / 8 + i; }
            else if (i < 1536) { const int j = i - 512; pos = j >> 4; f = j & 15; inv = (double)INV128[2 * f]; dst = tab + TAB64C / 8 + j; }
            else if (i < 2560) { const int j = i - 1536; pos = j >> 5; f = j & 31; inv = (double)INV128[f]; dst = tab + TAB128R / 8 + j; }
            else { const int j = i - 2560; pos = j >> 5; f = j & 31; inv = (double)INV128[f]; dst = tab + TAB128C / 8 + j; }
            *dst = sincos_d((double)(float)((float)pos * (float)inv));
        }
        u32x4* z = (u32x4*)(F.ws + WS_W_DOWN + (size_t)1088 * D);
        for (int i = F.gw * 64 + F.lane; i < (DOWN_N - 1088) * D / 16; i += F.NGW * 64) z[i] = (u32x4){0u, 0u, 0u, 0u};
        for (int i = F.gw * 64 + F.lane; i < DOWN_N - 1088; i += F.NGW * 64) ((float*)(F.ws + WS_SWD))[SWD_DOWN + 1088 + i] = 0.f;
    }
    {
        { DecDense256 d{F.ka, F.ws}; quant_loop<256, 32>(F, DecDense256::NITEMS - 64, d, F.vcu); __syncthreads();
          quant_loop<256, 32, DecDense256, true>(F, DecDense256::NITEMS, d, DecDense256::NITEMS - 64 + F.vcu); }
        __syncthreads();
        { DecDense64 d{F.ka, F.ws}; quant_loop<64, 64>(F, DecDense64::NITEMS, d, F.vcu); }
        __syncthreads();
        int cursor = 0;
        for (int l = 0; l < 2; ++l) transpose_matrix(F, F.ka->in[I_RW] + (size_t)l * 2048 * 64, 2048, 64, (bf16_t*)(F.ws + WS_ROUTER + (size_t)l * 64 * 2048 * 2), 0, cursor);
    }
}

__device__ __forceinline__ void side_quant_experts(Frame& F, int layer) {
    __syncthreads();
    const unsigned* qw = (const unsigned*)(F.ws + WS_CTL) + CW_QW + layer * 32;
    const int q0 = min((int)__hip_atomic_load(qw, RLX_AGENT), DecExpIn::NITEMS), q1 = min((int)__hip_atomic_load(qw + 16, RLX_AGENT), DecExpOut::NITEMS);
    { DecExpIn d{F.ka, F.ws, layer}; quant_loop<256, 32>(F, DecExpIn::NITEMS, d, q0 + (int)blockIdx.x); }
    __syncthreads();
    { DecExpOut d{F.ka, F.ws, layer}; quant_loop<64, 64, DecExpOut, true>(F, DecExpOut::NITEMS, d, q1 + (int)blockIdx.x); }
    __syncthreads();
}
__device__ __forceinline__ void tail_quant(Frame& F, int layer, int n_in, int n_out) {
    unsigned* qw = (unsigned*)(F.ws + WS_CTL) + CW_QW + layer * 32;
    LAS int* slot = (LAS int*)(F.lds + QSLOT_OFF);
#pragma unroll 1
    for (int n = 0; n < n_in; ++n) {
        __syncthreads();
        if (F.tid == 0) *slot = (int)__hip_atomic_fetch_add(qw, 1u, RLX_AGENT);
        __syncthreads();
        const int it = *slot;
        if (it < DecExpIn::NITEMS) { DecExpIn d{F.ka, F.ws, layer}; quant_loop<256, 32>(F, it + 1, d, it); }
    }
#pragma unroll 1
    for (int n = 0; n < n_out; ++n) {
        __syncthreads();
        if (F.tid == 0) *slot = (int)__hip_atomic_fetch_add(qw + 16, 1u, RLX_AGENT);
        __syncthreads();
        const int it = *slot;
        if (it < DecExpOut::NITEMS) { DecExpOut d{F.ka, F.ws, layer}; quant_loop<64, 64, DecExpOut, true>(F, it + 1, d, it); }
    }
    __syncthreads();
}
__device__ __forceinline__ bool is_tail_wg(int nunits, int G, int c) { const int mx = (nunits + G - 1) / G, mine = c < nunits ? (nunits - c + G - 1) / G : 0; return mine < mx; }
__device__ __forceinline__ const float* x_src(Frame& F, int layer, int r) {
    if (layer) return (const float*)(F.ws + WS_X) + (size_t)r * D;
    const int b = r / RPB, i = r - b * RPB;
    return (i < CTXL) ? F.ka->in[I_CTX] + ((size_t)b * CTXL + i) * D : F.ka->in[I_X] + ((size_t)b * SEQ + (i - CTXL)) * D;
}
__device__ __forceinline__ const float* mod_row(Frame& F, int layer, int r) { const int b = r / RPB, i = r - b * RPB; return (const float*)(F.ws + WS_MOD) + ((size_t)layer * 9 + ((i < CTXL) ? 8 : b)) * 12288; }

__device__ __forceinline__ void ld8f(const float* p, float (&v)[8]) { const f32x4 a = *(const f32x4*)p, b = *(const f32x4*)(p + 4); v[0] = a[0]; v[1] = a[1]; v[2] = a[2]; v[3] = a[3]; v[4] = b[0]; v[5] = b[1]; v[6] = b[2]; v[7] = b[3]; }
__device__ __forceinline__ void ld8f_nt(const float* p, float (&v)[8]) { const f32x4 a = __builtin_nontemporal_load((const f32x4*)p), b = __builtin_nontemporal_load((const f32x4*)(p + 4)); v[0] = a[0]; v[1] = a[1]; v[2] = a[2]; v[3] = a[3]; v[4] = b[0]; v[5] = b[1]; v[6] = b[2]; v[7] = b[3]; }
__device__ __forceinline__ void ld8l(const LAS float* p, float (&v)[8]) { const f32x4 a = *(const LAS f32x4*)p, b = *(const LAS f32x4*)(p + 4); v[0] = a[0]; v[1] = a[1]; v[2] = a[2]; v[3] = a[3]; v[4] = b[0]; v[5] = b[1]; v[6] = b[2]; v[7] = b[3]; }
__device__ __forceinline__ void st8f(float* p, const float (&v)[8]) { *(f32x4*)p = (f32x4){v[0], v[1], v[2], v[3]}; *(f32x4*)(p + 4) = (f32x4){v[4], v[5], v[6], v[7]}; }
__device__ __forceinline__ void unpk8(const u32x4 w, float (&v)[8]) {
#pragma unroll
    for (int e = 0; e < 4; ++e) { v[2 * e] = bflo(w[e]); v[2 * e + 1] = bfhi(w[e]); } }
__device__ __forceinline__ void unfp8(const u32x2 w, float (&v)[8]) {
#pragma unroll
    for (int d = 0; d < 2; ++d) { const f32x2 a = __builtin_amdgcn_cvt_pk_f32_fp8((int)w[d], false), b = __builtin_amdgcn_cvt_pk_f32_fp8((int)w[d], true); v[4 * d] = a.x; v[4 * d + 1] = a.y; v[4 * d + 2] = b.x; v[4 * d + 3] = b.y; } }
__device__ __forceinline__ u32x4 pk8(const float (&v)[8]) { u32x4 w;
#pragma unroll
    for (int e = 0; e < 4; ++e) w[e] = pk2(v[2 * e], v[2 * e + 1]);
    return w; }

__device__ __forceinline__ void quant_row_store(const float (&v)[4][8], signed char* dst, float* scale, int lane) {
    float am = 0.f;
#pragma unroll
    for (int j = 0; j < 4; ++j)
#pragma unroll
        for (int e = 0; e < 8; ++e) am = fmaxf(am, fabsf(v[j][e]));
#pragma unroll
    for (int o = 1; o < 64; o <<= 1) am = fmaxf(am, __shfl_xor(am, o));
    const float inv = am > 0.f ? 127.0f / am : 0.f;
    if (lane == 0) *scale = am * (1.0f / 127.0f);
#pragma unroll
    for (int j = 0; j < 4; ++j) { u32x2 w;
#pragma unroll
        for (int d = 0; d < 2; ++d) w[d] = q8x4(v[j][d * 4], v[j][d * 4 + 1], v[j][d * 4 + 2], v[j][d * 4 + 3], inv);
        *(u32x2*)(dst + 512 * j + 8 * lane) = w; }
}
__device__ __forceinline__ void quant_row512_store(const float (&v)[8], signed char* dst, float* scale, int lane) {
    float am = 0.f;
#pragma unroll
    for (int e = 0; e < 8; ++e) am = fmaxf(am, fabsf(v[e]));
#pragma unroll
    for (int o = 1; o < 64; o <<= 1) am = fmaxf(am, __shfl_xor(am, o));
    const float inv = am > 0.f ? 127.0f / am : 0.f;
    if (lane == 0) *scale = am * (1.0f / 127.0f);
    u32x2 w;
#pragma unroll
    for (int d = 0; d < 2; ++d) w[d] = q8x4(v[d * 4], v[d * 4 + 1], v[d * 4 + 2], v[d * 4 + 3], inv);
    *(u32x2*)(dst + 8 * lane) = w;
}

template <int R> __device__ __forceinline__ void p1_rows(Frame& F, int t0, int i) {
    const LAS float* PA = (const LAS float*)F.lds;
    float x[R][4][8]; int var[R];
#pragma unroll
    for (int q = 0; q < R; ++q) { const int r = t0 + i + 8 * q; const float* xs = x_src(F, 0, r); var[q] = ((r % RPB) < CTXL) ? 2 : 0;
#pragma unroll
        for (int j = 0; j < 4; ++j) ld8f_nt(xs + 512 * j + 8 * F.lane, x[q][j]); }
#pragma unroll
    for (int q = 0; q < R; ++q) { const int r = t0 + i + 8 * q;
#pragma unroll
        for (int j = 0; j < 4; ++j) { const int c = 512 * j + 8 * F.lane; float sh[8], sc[8]; ld8l(PA + var[q] * 2048 + c, sh); ld8l(PA + (var[q] + 1) * 2048 + c, sc);
#pragma unroll
            for (int e = 0; e < 8; ++e) x[q][j][e] = x[q][j][e] * (1.0f + sc[e]) + sh[e]; }
        quant_row_store(x[q], (signed char*)(F.ws + WS_H8) + (size_t)r * D, (float*)(F.ws + WS_SA) + r, F.lane); }
}
__device__ __forceinline__ void p1_modulate(Frame& F) {
    LAS float* PA = (LAS float*)F.lds;
    constexpr int BR = 72, nblk = T_ALL / BR;
    const float* MOD = (const float*)(F.ws + WS_MOD);
    for (int blk = F.vcu; blk < nblk; blk += F.G) {
        const int t0 = blk * BR, b = t0 / RPB;
        __syncthreads();
        { const int c = F.tid * 4; const float* mb = MOD + (size_t)b * 12288; const float* mc = MOD + (size_t)8 * 12288;
          *(LAS f32x4*)(PA + c) = *(const f32x4*)(mb + c); *(LAS f32x4*)(PA + 2048 + c) = *(const f32x4*)(mb + 2048 + c);
          *(LAS f32x4*)(PA + 4096 + c) = *(const f32x4*)(mc + c); *(LAS f32x4*)(PA + 6144 + c) = *(const f32x4*)(mc + 2048 + c); }
        __syncthreads();
        for (int i = F.wave; i < BR; i += 16) { if (i + 8 < BR) p1_rows<2>(F, t0, i); else p1_rows<1>(F, t0, i); }
    }
}

__device__ __forceinline__ void p_post_ab(Frame& F) {
    bf16_t* P = (bf16_t*)(F.ws + WS_PROJ);
    const f32x2* t64r = (const f32x2*)(F.ws + WS_TAB + TAB64R); const f32x2* t64c = (const f32x2*)(F.ws + WS_TAB + TAB64C);
    const f32x2* t128r = (const f32x2*)(F.ws + WS_TAB + TAB128R); const f32x2* t128c = (const f32x2*)(F.ws + WS_TAB + TAB128C);
    const float* qg = F.ka->in[I_QNG]; const float* kg = F.ka->in[I_KNG];
    for (int r = F.gw; r < T_ALL; r += F.NGW) {
        const int b = r / RPB, i = r - b * RPB; const bool lat = i >= CTXL; const int pos = i - CTXL, gr = pos >> 6, gc = pos & 63;
        bf16_t* row = P + (size_t)r * ABW;
        if (lat) {
            bf16_t* blk = row + F.lane * 32; const f32x2* tb = (F.lane & 1) ? t64c + gc * 16 : t64r + gr * 16;
            u32x4 w[4];
#pragma unroll
            for (int q = 0; q < 4; ++q) w[q] = *(const u32x4*)(blk + 8 * q);
#pragma unroll
            for (int q = 0; q < 2; ++q)
#pragma unroll
                for (int e = 0; e < 4; ++e) { const unsigned a = w[q][e], bq = w[q + 2][e]; const f32x2 c0 = tb[q * 8 + e * 2], c1 = tb[q * 8 + e * 2 + 1];
                    const float a0 = bflo(a), a1 = bfhi(a), b0 = bflo(bq), b1 = bfhi(bq);
                    w[q][e] = pk2(a0 * c0.x - b0 * c0.y, a1 * c1.x - b1 * c1.y); w[q + 2][e] = pk2(b0 * c0.x + a0 * c0.y, b1 * c1.x + a1 * c1.y); }
#pragma unroll
            for (int q = 0; q < 4; ++q) *(u32x4*)(blk + 8 * q) = w[q];
        }
#pragma unroll
        for (int pass = 0; pass < 2; ++pass) {
            const int head = pass * 8 + (F.lane >> 3), s = F.lane & 7; const bool act = head < 10;
            bf16_t* hp = row + (head < 8 ? QB_OFF + head * 128 : KB_OFF + (head - 8) * 128); const float* g = head < 8 ? qg : kg;
            float v[4][4]; float ss = 0.f;
            if (act) {
#pragma unroll
                for (int q = 0; q < 4; ++q) { const int c = (q >> 1) * 64 + (q & 1) * 32 + s * 4; const u32x2 w = *(const u32x2*)(hp + c);
                    v[q][0] = bflo(w.x); v[q][1] = bfhi(w.x); v[q][2] = bflo(w.y); v[q][3] = bfhi(w.y);
#pragma unroll
                    for (int e = 0; e < 4; ++e) ss += v[q][e] * v[q][e]; }
            }
            ss += __shfl_xor(ss, 1); ss += __shfl_xor(ss, 2); ss += __shfl_xor(ss, 4);
            if (act) {
                const float rs = 1.0f / sqrtf(ss * (1.0f / 128.0f) + 1e-6f);
#pragma unroll
                for (int q = 0; q < 4; ++q) { const int c = (q >> 1) * 64 + (q & 1) * 32 + s * 4;
#pragma unroll
                    for (int e = 0; e < 4; ++e) v[q][e] = v[q][e] * rs * g[c + e]; }
                if (lat) {
#pragma unroll
                    for (int half = 0; half < 2; ++half) { const f32x2* tb = (half ? t128c + gc * 32 : t128r + gr * 32) + s * 4;
#pragma unroll
                        for (int e = 0; e < 4; ++e) { const f32x2 cs = tb[e]; const float a = v[half * 2][e], bq = v[half * 2 + 1][e];
                            v[half * 2][e] = a * cs.x - bq * cs.y; v[half * 2 + 1][e] = bq * cs.x + a * cs.y; } }
                }
#pragma unroll
                for (int q = 0; q < 4; ++q) { const int c = (q >> 1) * 64 + (q & 1) * 32 + s * 4; u32x2 w; w.x = pk2(v[q][0], v[q][1]); w.y = pk2(v[q][2], v[q][3]); *(u32x2*)(hp + c) = w; }
            }
        }
    }
}

__device__ __forceinline__ void attn_ab_unit(Frame& F, int k) {
    const bf16_t* P = (const bf16_t*)(F.ws + WS_PROJ); bf16_t* MG = (bf16_t*)(F.ws + WS_MERGED); bf16_t* OA = (bf16_t*)(F.ws + WS_OA);
    if (k < 3) {
        const int u = (k < 2) ? F.vcu + k * F.G : 512 + F.vcu; if (k == 2 ? F.vcu >= 64 : u >= 512) return;
        int b, h, q0, nk;
        if (u < 512) { const int grp = u >> 5, w = u & 31; b = grp >> 1; h = (grp & 1) * 4 + (w >> 3); q0 = CTXL + (w & 7) * 256; nk = RPB; }
        else { const int v = u - 512; b = v >> 3; h = v & 7; q0 = 0; nk = CTXL; }
        const size_t kr = (size_t)b * RPB, qr = kr + q0; const int kvh = h >> 2;
        att::attn_unit<128, true, false>(P + qr * ABW + QB_OFF + h * 128, ABW, P + kr * ABW + KB_OFF + kvh * 128, ABW, nullptr, 0, P + kr * ABW + VB_OFF + kvh * 128, ABW,
                                         MG + qr * D + 1024 + h * 128, D, nk, 0, nullptr, nullptr, F.ldsg, F.lds, fresh_tid(F));
    } else {
        const int j = k - 3, u = (j < 4) ? F.vcu + j * F.G : 1024 + F.vcu; if (j == 4 ? F.vcu >= 128 : u >= 1024) return;
        int b, vh, q0, nk;
        if (u < 1024) { const int grp = u >> 4, w = u & 15; b = grp >> 3; vh = (grp & 7) * 2 + (w >> 3); q0 = CTXL + (w & 7) * 256; nk = RPB; }
        else { const int v = u - 1024; b = v >> 4; vh = v & 15; q0 = 0; nk = CTXL; }
        const size_t kr = (size_t)b * RPB, qr = kr + q0;
        att::attn_unit<64, true, false>(P + qr * ABW + QA_OFF + vh * 64, ABW, P + kr * ABW + KA_OFF + vh * 64, ABW, nullptr, 0, P + kr * ABW + VA_OFF + (vh >> 1) * 128, ABW,
                                        OA + qr * D + vh * 128, D, nk, 0, nullptr, nullptr, F.ldsg, F.lds, fresh_tid(F));
    }
}
__device__ __forceinline__ void p_attn_ab(Frame& F) {
    const int sk6 = min((int)blockIdx.x / 43, 5), side_k = (sk6 < 1) ? 1 : (sk6 < 2 ? 2 : sk6 + 2);
#pragma unroll 1
    for (int k = 0; k < side_k; ++k) attn_ab_unit(F, k);
    side_quant_experts(F, 0);
#pragma unroll 1
    for (int k = side_k; k < 8; ++k) attn_ab_unit(F, k);
}

__device__ __forceinline__ void p_diff_combine(Frame& F) {
    const bf16_t* OA = (const bf16_t*)(F.ws + WS_OA); const bf16_t* MG = (const bf16_t*)(F.ws + WS_MERGED);
    signed char* MG8 = (signed char*)(F.ws + WS_MG8); float* SMG = (float*)(F.ws + WS_SMG);
    const float* lp = F.ka->in[I_DLAM]; const float* sg = F.ka->in[I_SUBLN];
    const float d1 = wave_sum(lp[F.lane] * lp[64 + F.lane]), d2 = wave_sum(lp[128 + F.lane] * lp[192 + F.lane]);
    const float lam = __expf(d1) - __expf(d2) + LAM_INIT0;
    const int h = F.lane >> 3, s = F.lane & 7;
    float g[16];
#pragma unroll
    for (int e = 0; e < 16; ++e) g[e] = sg[s * 16 + e] * (1.0f - LAM_INIT0);
    for (int r = F.gw; r < T_ALL; r += F.NGW) {
        const bf16_t* o1 = OA + (size_t)r * D + (2 * h) * 128 + s * 16; const bf16_t* o2 = o1 + 128; const bf16_t* ob = MG + (size_t)r * D + 1024 + h * 128 + s * 16;
        float v[16], vb[16]; float ss = 0.f;
#pragma unroll
        for (int q = 0; q < 2; ++q) { const u32x4 a = *(const u32x4*)(o1 + 8 * q), bq = *(const u32x4*)(o2 + 8 * q), cq = *(const u32x4*)(ob + 8 * q);
#pragma unroll
            for (int e = 0; e < 4; ++e) { v[q * 8 + 2 * e] = bflo(a[e]) - lam * bflo(bq[e]); v[q * 8 + 2 * e + 1] = bfhi(a[e]) - lam * bfhi(bq[e]); vb[q * 8 + 2 * e] = bflo(cq[e]); vb[q * 8 + 2 * e + 1] = bfhi(cq[e]); } }
#pragma unroll
        for (int e = 0; e < 16; ++e) ss += v[e] * v[e];
        ss += __shfl_xor(ss, 1); ss += __shfl_xor(ss, 2); ss += __shfl_xor(ss, 4);
        const float rs = 1.0f / sqrtf(ss * (1.0f / 128.0f) + 1e-5f);
        float am = 0.f;
#pragma unroll
        for (int e = 0; e < 16; ++e) { v[e] = v[e] * rs * g[e]; am = fmaxf(am, fmaxf(fabsf(v[e]), fabsf(vb[e]))); }
#pragma unroll
        for (int o = 1; o < 64; o <<= 1) am = fmaxf(am, __shfl_xor(am, o));
        const float inv = am > 0.f ? 127.0f / am : 0.f;
        if (F.lane == 0) SMG[r] = am * (1.0f / 127.0f);
        u32x4 wa, wb;
#pragma unroll
        for (int d = 0; d < 4; ++d) { wa[d] = q8x4(v[d * 4], v[d * 4 + 1], v[d * 4 + 2], v[d * 4 + 3], inv); wb[d] = q8x4(vb[d * 4], vb[d * 4 + 1], vb[d * 4 + 2], vb[d * 4 + 3], inv); }
        *(u32x4*)(MG8 + (size_t)r * D + h * 128 + s * 16) = wa; *(u32x4*)(MG8 + (size_t)r * D + 1024 + h * 128 + s * 16) = wb;
    }
}

__device__ __forceinline__ void p_post_down(Frame& F) {
    const bf16_t* DN = (const bf16_t*)(F.ws + WS_DOWN); bf16_t* KPE = (bf16_t*)(F.ws + WS_KPE);
    const f32x2* t64r = (const f32x2*)(F.ws + WS_TAB + TAB64R); const f32x2* t64c = (const f32x2*)(F.ws + WS_TAB + TAB64C);
    const float* qg = F.ka->in[I_MQNG]; const float* kvg = F.ka->in[I_MKVNG];
    for (int r = F.gw; r < T_ALL; r += F.NGW) {
        const int b = r / RPB, i = r - b * RPB; const bool lat = i >= CTXL; const int pos = i - CTXL, gr = pos >> 6, gc = pos & 63;
        const bf16_t* row = DN + (size_t)r * DOWN_N;
#pragma unroll
        for (int which = 0; which < 2; ++which) {
            const u32x4 w = *(const u32x4*)(row + which * 512 + F.lane * 8); float v[8];
#pragma unroll
            for (int e = 0; e < 4; ++e) { v[2 * e] = bflo(w[e]); v[2 * e + 1] = bfhi(w[e]); }
            float ss = 0.f;
#pragma unroll
            for (int e = 0; e < 8; ++e) ss += v[e] * v[e];
            ss = wave_sum(ss); const float rs = 1.0f / sqrtf(ss * (1.0f / 512.0f) + 1e-6f); const float* g = (which ? kvg : qg) + F.lane * 8;
#pragma unroll
            for (int e = 0; e < 8; ++e) v[e] = v[e] * rs * g[e];
            quant_row512_store(v, (signed char*)(F.ws + (which ? WS_CKVN : WS_CQN)) + (size_t)r * 512, (float*)(F.ws + (which ? WS_SCKV : WS_SCQ)) + r, F.lane);
        }
        if (F.lane < 32) {
            const int blk = F.lane >> 4, f = F.lane & 15; const float a = bf2f(row[1024 + blk * 32 + f]), bq = bf2f(row[1024 + blk * 32 + 16 + f]);
            float oa = a, ob = bq;
            if (lat) { const f32x2 cs = blk ? t64c[gc * 16 + f] : t64r[gr * 16 + f]; oa = a * cs.x - bq * cs.y; ob = bq * cs.x + a * cs.y; }
            KPE[(size_t)r * 64 + blk * 32 + f] = (bf16_t)f2bf(oa); KPE[(size_t)r * 64 + blk * 32 + 16 + f] = (bf16_t)f2bf(ob);
        }
    }
}

__device__ __forceinline__ void attn_mla_unit(Frame& F, int u) {
    const bf16_t* QM = (const bf16_t*)(F.ws + WS_QM); const bf16_t* KVM = (const bf16_t*)(F.ws + WS_KVM); const bf16_t* KPE = (const bf16_t*)(F.ws + WS_KPE);
    const f32x2* t64r = (const f32x2*)(F.ws + WS_TAB + TAB64R); const f32x2* t64c = (const f32x2*)(F.ws + WS_TAB + TAB64C);
    const int grp = u >> 3, b = grp >> 4, h = grp & 15, qb = u & 7; const size_t kr = (size_t)b * RPB, qr = kr + CTXL + qb * 256;
    att::attn_unit<192, true, true, true>(QM + qr * UQ_N + h * 192, UQ_N, KVM + kr * UKV_N + h * 256, UKV_N, KPE + kr * 64, 64, KVM + kr * UKV_N + h * 256 + 128, UKV_N,
                                    (bf16_t*)(F.ws + WS_MG8 + qr * D + h * 128), D, RPB, qb * 256, t64r, t64c, F.ldsg, F.lds, fresh_tid(F));
}
__device__ __forceinline__ void p_attn_mla(Frame& F) {
    const int side_n = min((int)blockIdx.x / 64, 3) + 1; int u = F.vcu, n = 0;
#pragma unroll 1
    for (; u < 1024 && n < side_n; u += F.G, ++n) attn_mla_unit(F, u);
    side_quant_experts(F, 1);
#pragma unroll 1
    for (; u < 1024; u += F.G) attn_mla_unit(F, u);
}

template <int R> __device__ __forceinline__ void ln1_rows(Frame& F, int layer, int t0, int i) {
    const LAS float* PA = (const LAS float*)F.lds;
    const unsigned char* Y1 = (const unsigned char*)(F.ws + WS_Y1); bf16_t* XB = (bf16_t*)(F.ws + WS_X); bf16_t* H = (bf16_t*)(F.ws + WS_H);
    float v[R][4][8]; u32x2 yw[R][4]; int var[R], rr[R];
#pragma unroll
    for (int q = 0; q < R; ++q) { const int r = tok_row(layer, t0 + i + 8 * q); rr[q] = r; const float* xs = x_src(F, 0, r); var[q] = (layer == 0 && (r % RPB) < CTXL) ? 3 : 0;
#pragma unroll
        for (int j = 0; j < 4; ++j) { if (layer == 0) ld8f_nt(xs + 512 * j + 8 * F.lane, v[q][j]); else unpk8(*(const u32x4*)(XB + (size_t)r * D + 512 * j + 8 * F.lane), v[q][j]); yw[q][j] = __builtin_nontemporal_load((const u32x2*)(Y1 + (size_t)r * D + 512 * j + 8 * F.lane)); } }
#pragma unroll
    for (int q = 0; q < R; ++q) {
        float s = 0.f;
#pragma unroll
        for (int j = 0; j < 4; ++j) { const int c = 512 * j + 8 * F.lane; float g1[8], y[8]; ld8l(PA + (2 + var[q]) * 2048 + c, g1); unfp8(yw[q][j], y);
#pragma unroll
            for (int e = 0; e < 8; ++e) { v[q][j][e] = v[q][j][e] * ALPHA + g1[e] * y[e]; s += v[q][j][e]; } }
        const float mean = wave_sum(s) * (1.0f / D); float s2 = 0.f;
#pragma unroll
        for (int j = 0; j < 4; ++j)
#pragma unroll
            for (int e = 0; e < 8; ++e) { v[q][j][e] -= mean; s2 += v[q][j][e] * v[q][j][e]; }
        const float rstd = 1.0f / sqrtf(wave_sum(s2) * (1.0f / D) + 1e-5f);
#pragma unroll
        for (int j = 0; j < 4; ++j) { const int c = 512 * j + 8 * F.lane; float a[8], bq[8], xo[8], h[8];
            ld8l(PA + c, a); ld8l(PA + 2048 + c, bq);
#pragma unroll
            for (int e = 0; e < 8; ++e) xo[e] = v[q][j][e] * rstd * a[e] + bq[e];
            *(u32x4*)(XB + (size_t)rr[q] * D + c) = pk8(xo);
            ld8l(PA + (3 + var[q]) * 2048 + c, a); ld8l(PA + (4 + var[q]) * 2048 + c, bq);
#pragma unroll
            for (int e = 0; e < 8; ++e) { h[e] = v[q][j][e] * rstd * a[e] + bq[e]; v[q][j][e] = h[e]; }
            *(u32x4*)(H + (size_t)rr[q] * D + c) = pk8(h); }
        quant_row_store(v[q], (signed char*)(F.ws + WS_H8) + (size_t)rr[q] * D, (float*)(F.ws + WS_SA) + rr[q], F.lane);
    }
}
__device__ __forceinline__ void p_ln1(Frame& F, int layer) {
    LAS float* PA = (LAS float*)F.lds;
    const int NT = layer ? T_LAT : T_ALL, BR = layer ? 64 : 72, nblk = NT / BR, rpb = layer ? SEQ : RPB;
    const float* lg = F.ka->in[I_LNMG] + layer * D; const float* lb = F.ka->in[I_LNMB] + layer * D; const float* MOD = (const float*)(F.ws + WS_MOD) + (size_t)layer * 9 * 12288;
    for (int blk = F.vcu; blk < nblk; blk += F.G) {
        const int t0 = blk * BR, b = t0 / rpb;
        __syncthreads();
        { const int c = F.tid * 4; const f32x4 g = *(const f32x4*)(lg + c), bb = *(const f32x4*)(lb + c);
          *(LAS f32x4*)(PA + c) = g; *(LAS f32x4*)(PA + 2048 + c) = bb;
#pragma unroll
          for (int vv = 0; vv < 2; ++vv) { const float* m = MOD + (size_t)(vv ? 8 : b) * 12288; const f32x4 g1 = *(const f32x4*)(m + 2 * 2048 + c), sh2 = *(const f32x4*)(m + 3 * 2048 + c), sc2 = *(const f32x4*)(m + 4 * 2048 + c);
              *(LAS f32x4*)(PA + (2 + 3 * vv) * 2048 + c) = g1; *(LAS f32x4*)(PA + (3 + 3 * vv) * 2048 + c) = g * (1.0f + sc2); *(LAS f32x4*)(PA + (4 + 3 * vv) * 2048 + c) = bb * (1.0f + sc2) + sh2; } }
        __syncthreads();
        for (int i = F.wave; i < BR; i += 16) { if (i + 8 < BR) ln1_rows<2>(F, layer, t0, i); else ln1_rows<1>(F, layer, t0, i); }
    }
}

__device__ __forceinline__ void p_router(Frame& F, int layer) {
    const int NT = layer ? T_LAT : T_ALL, ngroups = NT / 32;
    const bf16_t* H = (const bf16_t*)(F.ws + WS_H); const bf16_t* RT = (const bf16_t*)(F.ws + WS_ROUTER + (size_t)layer * 64 * 2048 * 2);
    const float* rb = F.ka->in[I_RB] + layer * 64;
    int* LIST = (int*)(F.ws + WS_LIST); int* TS = (int*)(F.ws + WS_TOKSLOT); float* GATE = (float*)(F.ws + WS_GATE);
    unsigned* CNT = F.ctl + CW_CNT + layer * 64 * 16;
    LAS float* part = (LAS float*)F.lds;
    LAS float* SC = (LAS float*)(F.lds + 65536);
    LAS float* BS = (LAS float*)(F.lds + 65536 + 8448);
    LAS int* hist = (LAS int*)(F.lds + 65536 + 2 * 8448);
    LAS int* base = hist + 64;
    LAS int* SEL = base + 64;
    const int r32 = F.lane & 31, hi = F.lane >> 5;
    if (F.tid < 64) hist[F.tid] = 0;
    __syncthreads();
    int gi = 0;
    for (int g = F.vcu; g < ngroups; g += F.G, ++gi) {
        const int t0 = g * 32;
        {
            const bf16_t* ap = H + (size_t)tok_row(layer, t0 + r32) * D + F.wave * 256 + hi * 8;
            const bf16_t* b0p = RT + (size_t)r32 * D + F.wave * 256 + hi * 8; const bf16_t* b1p = b0p + (size_t)32 * D;
            f32x16 a0 = {}, a1 = {};
#pragma unroll
            for (int k = 0; k < 16; ++k) { const bf16x8 a = *(const bf16x8*)(ap + k * 16), w0 = *(const bf16x8*)(b0p + k * 16), w1 = *(const bf16x8*)(b1p + k * 16);
                a0 = __builtin_amdgcn_mfma_f32_32x32x16_bf16(a, w0, a0, 0, 0, 0); a1 = __builtin_amdgcn_mfma_f32_32x32x16_bf16(a, w1, a1, 0, 0, 0); }
#pragma unroll
            for (int r = 0; r < 16; ++r) { const int row = att::crow(r, hi); part[(F.wave * 32 + row) * 64 + r32] = a0[r]; part[(F.wave * 32 + row) * 64 + 32 + r32] = a1[r]; }
        }
        __syncthreads();
        for (int i = F.tid; i < 2048; i += 512) { float s = 0.f;
#pragma unroll
            for (int w = 0; w < 8; ++w) s += part[w * 2048 + i];
            const float sg = 1.0f / (1.0f + __expf(-s)); const int tk = i >> 6, e = i & 63; SC[tk * 65 + e] = sg; BS[tk * 65 + e] = sg + rb[e]; }
        __syncthreads();
        if (F.tid < 32) {
            const LAS float* bs = BS + F.tid * 65; const LAS float* sc = SC + F.tid * 65;
            float bv[64];
#pragma unroll
            for (int e = 0; e < 64; ++e) bv[e] = bs[e];
            float gs[8];
#pragma unroll
            for (int gq = 0; gq < 8; ++gq) { float m1 = -INFINITY, m2 = -INFINITY;
#pragma unroll
                for (int j = 0; j < 8; ++j) { const float v = bv[gq * 8 + j]; const float lo = fminf(v, m1); m1 = fmaxf(v, m1); m2 = fmaxf(m2, lo); }
                gs[gq] = m1 + m2; }
            unsigned gmask = 0u;
#pragma unroll
            for (int it = 0; it < 4; ++it) { float best = -INFINITY; int bi = 0;
#pragma unroll
                for (int gq = 0; gq < 8; ++gq) { const bool ok = !((gmask >> gq) & 1u) && gs[gq] > best; best = ok ? gs[gq] : best; bi = ok ? gq : bi; }
                gmask |= 1u << bi; }
#pragma unroll
            for (int e = 0; e < 64; ++e) bv[e] = ((gmask >> (e >> 3)) & 1u) ? bv[e] : -INFINITY;
            int sel[8]; float gv[8]; float gsum = 0.f;
#pragma unroll
            for (int k = 0; k < 8; ++k) { float best = -INFINITY; int be = 0;
#pragma unroll
                for (int e = 0; e < 64; ++e) { const bool ok = bv[e] > best; best = ok ? bv[e] : best; be = ok ? e : be; }
#pragma unroll
                for (int e = 0; e < 64; ++e) bv[e] = (e == be) ? -INFINITY : bv[e];
                sel[k] = be; gv[k] = sc[be]; gsum += gv[k]; }
            const int r = tok_row(layer, t0 + F.tid); const float inv = 2.5f / gsum;
#pragma unroll
            for (int k = 0; k < 8; ++k) { const int lp = atomicAdd((int*)(hist + sel[k]), 1); SEL[((gi & 3) * 32 + F.tid) * 8 + k] = (sel[k] << 16) | lp; GATE[(size_t)r * 8 + k] = gv[k] * inv; }
        }
        __syncthreads();
    }
    if (F.tid < 64) base[F.tid] = (int)__hip_atomic_fetch_add(CNT + F.tid * 16, (unsigned)hist[F.tid], RLX_AGENT);
    __syncthreads();
    gi = 0;
    for (int g = F.vcu; g < ngroups; g += F.G, ++gi) {
        if (F.tid < 256) { const int tk = F.tid >> 3, k = F.tid & 7; const int v = SEL[((gi & 3) * 32 + tk) * 8 + k], e = v >> 16, pos = base[e] + (v & 0xffff); const int r = tok_row(layer, g * 32 + tk);
            LIST[(size_t)e * LIST_CAP + pos] = r; TS[(size_t)r * 8 + k] = (e << 16) | pos; }
    }
    __syncthreads();
}

__device__ __forceinline__ int moe_tables(Frame& F, int layer) {
    LAS int* MISC = (LAS int*)(F.lds + MISC_OFF); LAS int* TT = (LAS int*)(F.lds + TTAB_OFF);
    const int NT = layer ? T_LAT : T_ALL;
    __syncthreads();
    if (F.wave == 0) {
        const unsigned* CNT = F.ctl + CW_CNT + layer * 64 * 16;
        const int c = (int)__hip_atomic_load(CNT + F.lane * 16, RLX_AGENT); const int nt = (c + 255) >> 8;
        int inc = nt;
#pragma unroll
        for (int o = 1; o < 64; o <<= 1) { const int v = __shfl_up(inc, o); if (F.lane >= o) inc += v; }
        const int start = inc - nt; MISC[F.lane] = start; MISC[80 + F.lane] = c;
        if (F.lane == 63) { MISC[64] = inc; MISC[65] = inc + NT / 256; }
    }
    __syncthreads();
    const int s64 = MISC[64], total = MISC[65];
    for (int tile = F.tid; tile < total; tile += 512) {
        int lo = 0, hi = 64;
#pragma unroll
        for (int it = 0; it < 7; ++it) { const int mid = (lo + hi + 1) >> 1; const bool ok = MISC[mid] <= tile; lo = ok ? mid : lo; hi = ok ? hi : mid - 1; }
        TT[tile] = (lo << 16) | (tile - MISC[lo]); }
    (void)s64;
    __syncthreads();
    return total;
}

__device__ __forceinline__ void p_moe_gemm1(Frame& F, int layer) {
    const int total = moe_tables(F, layer);
    LAS int* MISC = (LAS int*)(F.lds + MISC_OFF); LAS int* TT = (LAS int*)(F.lds + TTAB_OFF); LAS int* IDX = (LAS int*)(F.lds + IDXC_OFF);
    const int* LIST = (const int*)(F.ws + WS_LIST);
    typedef pg8::SchedMoe<4, EXP_IN_BYTES, (size_t)256 * D> Sch; Sch S; S.ntiles = total; S.G = F.G; S.vcu = F.vcu; S.ttab = TT; S.Bt = (const char*)(F.ws + WS_EXP_IN + (size_t)layer * 65 * EXP_IN_BYTES);
    {
        pg8::Unit u; const int fallback = tok_row(layer, 0);
        for (int i = 0; i < IDXC_UNITS && S.next(i, u); ++i) {
            if (F.tid < 256) { const int tile = u.row0 >> 8, tv = TT[tile], e = tv >> 16, p = (tv & 0xffff) * 256 + F.tid;
                int src; if (e < 64) src = (p < MISC[80 + e]) ? LIST[(size_t)e * LIST_CAP + p] : fallback; else src = tok_row(layer, p);
                IDX[i * 256 + F.tid] = src; }
        }
        __syncthreads();
    }
    pg8::EpiSwigluI8 E{(unsigned char*)(F.ws + WS_HMID), FDIM, (const float*)(F.ws + WS_SA), (const float*)(F.ws + WS_SW) + (size_t)layer * 65 * 1024, IDX};
    pg8::gemm_phase<pg8::EpiSwigluI8, Sch, true, 1>(F.lds, (const void*)(F.ws + WS_H8), D, S, E, IDX, fresh_tid(F));
    if (layer == 0 && is_tail_wg(total * 4, F.G, F.vcu)) tail_quant(F, 1, 1, 1);
}
__device__ __forceinline__ void p_moe_gemm2(Frame& F, int layer) {
    const int total = moe_tables(F, layer);
    LAS int* TT = (LAS int*)(F.lds + TTAB_OFF);
    typedef pg8::SchedMoe<8, EXP_OUT_BYTES, (size_t)256 * FDIM> Sch; Sch S; S.ntiles = total; S.G = F.G; S.vcu = F.vcu; S.ttab = TT; S.Bt = (const char*)(F.ws + WS_EXP_OUT + (size_t)layer * 65 * EXP_OUT_BYTES);
    pg8::EpiI8Fp8<2048, true> E{(unsigned char*)(F.ws + WS_Y2P), D, (const float*)(F.ws + WS_SW2), (const float*)(F.ws + WS_SW2) + (size_t)layer * 65 * 2048};
    pg8::gemm_phase<pg8::EpiI8Fp8<2048, true>, Sch, false, 2>(F.lds, (const void*)(F.ws + WS_HMID), FDIM, S, E, nullptr, fresh_tid(F));
}

__device__ __forceinline__ void p_combine_ln2(Frame& F, int layer) {
    (void)moe_tables(F, layer);
    LAS int* MISC = (LAS int*)(F.lds + MISC_OFF); LAS float* PA = (LAS float*)F.lds;
    const int NT = layer ? T_LAT : T_ALL, BR = layer ? 64 : 72, nblk = NT / BR, rpb = layer ? SEQ : RPB;
    const unsigned char* Y2 = (const unsigned char*)(F.ws + WS_Y2P);     const int* TS = (const int*)(F.ws + WS_TOKSLOT); const float* GATE = (const float*)(F.ws + WS_GATE);
    bf16_t* XB = (bf16_t*)(F.ws + WS_X); float* OUT = F.ka->out;
    const int sh0 = MISC[64] * 256;
    for (int blk = F.vcu; blk < nblk; blk += F.G) {
        const int t0 = blk * BR, b = t0 / rpb;
        __syncthreads();
        { int z = 0; asm volatile("" : "+s"(z));
          const float* lg = F.ka->in[I_LNFG + z] + layer * D; const float* lb = F.ka->in[I_LNFB + z] + layer * D; const float* MOD = (const float*)(F.ka->ws + WS_MOD) + z;
          const int c = fresh_tid(F) * 4; const f32x4 g = *(const f32x4*)(lg + c), bb = *(const f32x4*)(lb + c);
          *(LAS f32x4*)(PA + c) = g; *(LAS f32x4*)(PA + 2048 + c) = bb;
#pragma unroll
          for (int vv = 0; vv < 2; ++vv) { const float* m = MOD + ((size_t)layer * 9 + (vv ? 8 : b)) * 12288; const float* m1 = MOD + ((size_t)9 + (vv ? 8 : b)) * 12288;
              const f32x4 g2 = *(const f32x4*)(m + 5 * 2048 + c), sh1 = *(const f32x4*)(m1 + c), sc1 = *(const f32x4*)(m1 + 2048 + c);
              *(LAS f32x4*)(PA + (2 + 3 * vv) * 2048 + c) = g2; *(LAS f32x4*)(PA + (3 + 3 * vv) * 2048 + c) = g * (1.0f + sc1); *(LAS f32x4*)(PA + (4 + 3 * vv) * 2048 + c) = bb * (1.0f + sc1) + sh1; } }
        __syncthreads();
        int r = tok_row(layer, t0 + F.wave); int tsv = 0; float gtv = 0.f;
        { const int l0 = fresh_lane(); if (l0 < 8) { tsv = TS[(size_t)r * 8 + l0]; gtv = GATE[(size_t)r * 8 + l0]; } }
        for (int i = F.wave; i < BR; i += 8) {
            const int t = t0 + i, var = (layer == 0 && (r % RPB) < CTXL) ? 3 : 0;
            const int ln = fresh_lane();
            float xv[4][8]; float y[4][8]; const int tsc = tsv; const int gtc = __builtin_bit_cast(int, gtv);
#define YROW(k) (Y2 + (size_t)(__builtin_amdgcn_readfirstlane(MISC[__builtin_amdgcn_readlane(tsc, (k)) >> 16]) * 256 + (__builtin_amdgcn_readlane(tsc, (k)) & 0xffff)) * D)
#define GK(k) __builtin_bit_cast(float, __builtin_amdgcn_readlane(gtc, (k)))
            const int rcur = r;
            {
                u32x2 yw[5][4];
#pragma unroll
                for (int k = 0; k < 4; ++k)
#pragma unroll
                    for (int j = 0; j < 4; ++j) yw[k][j] = __builtin_nontemporal_load((const u32x2*)(YROW(k) + 8 * ln + 512 * j));
                { const unsigned char* yr = Y2 + (size_t)(sh0 + t) * D + 8 * ln;
#pragma unroll
                  for (int j = 0; j < 4; ++j) yw[4][j] = __builtin_nontemporal_load((const u32x2*)(yr + 512 * j)); }
                if (i + 8 < BR) { r = tok_row(layer, t + 8); if (ln < 8) { tsv = TS[(size_t)r * 8 + ln]; gtv = GATE[(size_t)r * 8 + ln]; } }
#pragma unroll
                for (int j = 0; j < 4; ++j) { float tmp[8]; unfp8(yw[4][j], y[j]);
#pragma unroll
                    for (int k = 0; k < 4; ++k) { unfp8(yw[k][j], tmp);
#pragma unroll
                        for (int e = 0; e < 8; ++e) y[j][e] += GK(k) * tmp[e]; } }
            }
            asm volatile("" ::: "memory");
            {
                u32x2 yw[4][4];
#pragma unroll
                for (int k = 0; k < 4; ++k)
#pragma unroll
                    for (int j = 0; j < 4; ++j) yw[k][j] = __builtin_nontemporal_load((const u32x2*)(YROW(4 + k) + 8 * ln + 512 * j));
#pragma unroll
                for (int j = 0; j < 4; ++j) unpk8(*(const u32x4*)(XB + (size_t)rcur * D + 512 * j + 8 * ln), xv[j]);
#pragma unroll
                for (int j = 0; j < 4; ++j) { float tmp[8];
#pragma unroll
                    for (int k = 0; k < 4; ++k) { unfp8(yw[k][j], tmp);
#pragma unroll
                        for (int e = 0; e < 8; ++e) y[j][e] += GK(4 + k) * tmp[e]; } }
            }
#undef YROW
#undef GK
            float s = 0.f;
#pragma unroll
            for (int j = 0; j < 4; ++j) { const int c = 512 * j + 8 * ln; float g2[8];
                ld8l(PA + (2 + var) * 2048 + c, g2);
#pragma unroll
                for (int e = 0; e < 8; ++e) { xv[j][e] = xv[j][e] * ALPHA + g2[e] * y[j][e]; s += xv[j][e]; } }
            const float mean = wave_sum(s) * (1.0f / D); float s2 = 0.f;
#pragma unroll
            for (int j = 0; j < 4; ++j)
#pragma unroll
                for (int e = 0; e < 8; ++e) { xv[j][e] -= mean; s2 += xv[j][e] * xv[j][e]; }
            const float rstd = 1.0f / sqrtf(wave_sum(s2) * (1.0f / D) + 1e-5f);
#pragma unroll
            for (int j = 0; j < 4; ++j) { const int c = 512 * j + 8 * ln; float a[8], bq[8], xo[8];
                ld8l(PA + c, a); ld8l(PA + 2048 + c, bq);
#pragma unroll
                for (int e = 0; e < 8; ++e) xo[e] = xv[j][e] * rstd * a[e] + bq[e];
                if (layer == 0) { *(u32x4*)(XB + (size_t)rcur * D + c) = pk8(xo); ld8l(PA + (3 + var) * 2048 + c, a); ld8l(PA + (4 + var) * 2048 + c, bq);
#pragma unroll
                    for (int e = 0; e < 8; ++e) xv[j][e] = xv[j][e] * rstd * a[e] + bq[e]; }
                else st8f(OUT + (size_t)t * D + c, xo); }
            if (layer == 0) quant_row_store(xv, (signed char*)(F.ws + WS_H8) + (size_t)rcur * D, (float*)(F.ws + WS_SA) + rcur, ln);
        }
    }
}

__device__ __forceinline__ void p_dense(Frame& F, const bf16_t* A, const bf16_t* Bt, int K, int nM, int nN, int latmap, bf16_t* O, int ldc) {
    pg8::SchedDense S; S.init(nM, nN, F.G, (int)blockIdx.x, latmap, Bt, K);
    pg8::EpiBf16 E{O, ldc};
    pg8::gemm_phase<pg8::EpiBf16, pg8::SchedDense, false>(F.lds, A, K, S, E, nullptr, F.tid);
}
__device__ __forceinline__ void p_dense_i8_fp8(Frame& F, const void* A, const float* SA, const void* Bt, const float* SW, int K, int nM, int nN, int latmap, unsigned char* O, int ldc) {
    pg8::SchedDense S; S.init(nM, nN, F.G, (int)blockIdx.x, latmap, (const bf16_t*)Bt, K); S.tstepB = (size_t)256 * K;
    pg8::EpiI8Fp8<0> E{O, ldc, SA, SW};
    pg8::gemm_phase<pg8::EpiI8Fp8<0>, pg8::SchedDense, false, 1>(F.lds, A, K, S, E, nullptr, fresh_tid(F));
}
__device__ __forceinline__ void p_dense_f8_fp8(Frame& F, const void* A, const void* Bt, const float* SW, int K, int nM, int nN, int latmap, unsigned char* O, int ldc) {
    pg8::SchedDense S; S.init(nM, nN, F.G, (int)blockIdx.x, latmap, (const bf16_t*)Bt, K); S.tstepB = (size_t)256 * K;
    pg8::EpiI8Fp8<0, true> E{O, ldc, SW, SW};
    pg8::gemm_phase<pg8::EpiI8Fp8<0, true>, pg8::SchedDense, false, 2>(F.lds, A, K, S, E, nullptr, fresh_tid(F));
}
__device__ __forceinline__ void p_dense_i8(Frame& F, const void* A, const float* SA, const void* Bt, const float* SW, int K, int nM, int nN, int latmap, bf16_t* O, int ldc) {
    pg8::SchedDense S; S.init(nM, nN, F.G, (int)blockIdx.x, latmap, (const bf16_t*)Bt, K); S.tstepB = (size_t)256 * K;
    pg8::EpiI8Bf16<0> E{O, ldc, SA, SW};
    pg8::gemm_phase<pg8::EpiI8Bf16<0>, pg8::SchedDense, false, 1>(F.lds, A, K, S, E, nullptr, fresh_tid(F));
}

constexpr int N_PHASES = 26;

__global__ void __launch_bounds__(512, 2) mk_fwd(Args args) {
    extern __shared__ __attribute__((aligned(16))) unsigned char lds_raw[];
    Frame F;
    F.lds = (LAS unsigned char*)lds_raw; F.ldsg = (char*)lds_raw;
    F.tid = threadIdx.x; F.lane = F.tid & 63; F.wave = __builtin_amdgcn_readfirstlane(F.tid >> 6);
    F.G = gridDim.x; { const int bx = blockIdx.x; F.vcu = (F.G % 8 == 0) ? (bx % 8) * (F.G / 8) + bx / 8 : bx; }
    F.gw = F.vcu * 8 + F.wave; F.NGW = F.G * 8;
    F.ka = (KArgs)__builtin_amdgcn_kernarg_segment_ptr();
    F.ws = F.ka->ws; F.ctl = (unsigned*)F.ws;
    const int lo = args.ph_lo, hi = args.ph_hi;
    volatile LAS unsigned* bw = (volatile LAS unsigned*)(F.lds + BARW_OFF);
    if (F.tid < 4) bw[F.tid] = 0u;
    __syncthreads();
    XcdBarrier bar; bar.bar = F.ctl + CW_BAR; bar.x = 0; bar.st = bw;
    if (hi - lo > 1) bar = xcd_barrier_post(F.ctl + CW_BAR, bw);
#ifndef MK_ONLY
#define MK_ONLY -1
#endif
#ifndef MK_REPMASK
#define MK_REPMASK 0u
#endif
#define IN(k) ((MK_ONLY < 0 || MK_ONLY == (k)) && lo <= (k) && (k) < hi)
#define NREP(k) ((int)(((unsigned)MK_REPMASK >> (k)) & 1u) + 1)
#define SEAM(k) do { if (lo <= (k) && (k) + 1 < hi) xcd_barrier(bar); } while (0)

    if (IN(0)) for (int rep = 0; rep < NREP(0); ++rep) { PHASE_BEGIN(F); p0_prologue(P); } SEAM(0);
    if (IN(1)) for (int rep = 0; rep < NREP(1); ++rep) { PHASE_BEGIN(F); p1_modulate(P); } SEAM(1);
#if defined(MK_UNROLL_LAYERS)
#pragma unroll
#else
#pragma unroll 1
#endif
    for (int layer = 0; layer < 2; ++layer) {
        const int pb = 2 + 12 * layer;
        if (IN(pb + 0)) for (int rep = 0; rep < NREP(pb + 0); ++rep) { PHASE_BEGIN(F);
            p_dense_i8(P, P.ws + WS_H8, (const float*)(P.ws + WS_SA), P.ws + (layer == 0 ? WS_W_IN : WS_W_DOWN), (const float*)(P.ws + WS_SWD) + (layer == 0 ? SWD_IN : SWD_DOWN), D, T_ALL / 256, layer == 0 ? ABW / 256 : DOWN_N / 256, 0,
                       (bf16_t*)(P.ws + (layer == 0 ? WS_PROJ : WS_DOWN)), layer == 0 ? ABW : DOWN_N);
            if (is_tail_wg((T_ALL / 256) * (layer == 0 ? ABW / 256 : DOWN_N / 256), P.G, (int)blockIdx.x)) tail_quant(P, layer, 1, layer == 0 ? 1 : 2);
        } SEAM(pb + 0);
        if (IN(pb + 1)) for (int rep = 0; rep < NREP(pb + 1); ++rep) { PHASE_BEGIN(F); if (layer == 0) p_post_ab(P); else p_post_down(P); } SEAM(pb + 1);
        if (IN(pb + 2)) for (int rep = 0; rep < NREP(pb + 2); ++rep) { PHASE_BEGIN(F);
            if (layer == 0) p_attn_ab(P);
            else {
#pragma unroll 1
                for (int w = 0; w < 2; ++w) {
                    p_dense_i8(P, P.ws + (w == 0 ? WS_CQN : WS_CKVN), (const float*)(P.ws + (w == 0 ? WS_SCQ : WS_SCKV)), P.ws + (w == 0 ? WS_W_UQ : WS_W_UKV), (const float*)(P.ws + WS_SWD) + (w == 0 ? SWD_UQ : SWD_UKV), 512,
                               w == 0 ? T_LAT / 256 : T_ALL / 256, w == 0 ? UQ_N / 256 : UKV_N / 256, w == 0 ? 1 : 0, (bf16_t*)(P.ws + (w == 0 ? WS_QM : WS_KVM)), w == 0 ? UQ_N : UKV_N); }
            }
        } SEAM(pb + 2);
        if (IN(pb + 3)) for (int rep = 0; rep < NREP(pb + 3); ++rep) { PHASE_BEGIN(F); if (layer == 0) p_diff_combine(P); else p_attn_mla(P); } SEAM(pb + 3);
        if (IN(pb + 5)) for (int rep = 0; rep < NREP(pb + 5); ++rep) { PHASE_BEGIN(F);
            if (layer == 0) p_dense_i8_fp8(P, P.ws + WS_MG8, (const float*)(P.ws + WS_SMG), P.ws + WS_W_OUT, (const float*)(P.ws + WS_SWD) + SWD_OUT, D, T_ALL / 256, D / 256, 0, (unsigned char*)(P.ws + WS_Y1), D);
            else p_dense_f8_fp8(P, P.ws + WS_MG8, P.ws + WS_W_O, (const float*)(P.ws + WS_SWD) + SWD_O, D, T_LAT / 256, D / 256, 1, (unsigned char*)(P.ws + WS_Y1), D);
            if (layer == 0 && is_tail_wg((T_ALL / 256) * (D / 256), P.G, (int)blockIdx.x)) tail_quant(P, 1, 1, 1);
        } SEAM(pb + 5);
        if (IN(pb + 6)) for (int rep = 0; rep < NREP(pb + 6); ++rep) { PHASE_BEGIN(F); p_ln1(P, layer); } SEAM(pb + 6);
        if (IN(pb + 7)) for (int rep = 0; rep < NREP(pb + 7); ++rep) { PHASE_BEGIN(F); p_router(P, layer); } SEAM(pb + 7);
        if (IN(pb + 8)) for (int rep = 0; rep < NREP(pb + 8); ++rep) { PHASE_BEGIN(F); p_moe_gemm1(P, layer); } SEAM(pb + 8);
        if (IN(pb + 10)) for (int rep = 0; rep < NREP(pb + 10); ++rep) { PHASE_BEGIN(F); p_moe_gemm2(P, layer); } SEAM(pb + 10);
        if (IN(pb + 11)) for (int rep = 0; rep < NREP(pb + 11); ++rep) { PHASE_BEGIN(F); p_combine_ln2(P, layer); } SEAM(pb + 11);
    }
#undef IN
#undef SEAM
}

extern "C" void kernel_launch(void* const* d_in, const int* in_sizes, int n_in, void* d_out, int out_size, void* d_ws, size_t ws_size, hipStream_t stream) {
    static int grid = 0;
    if (grid == 0) {
        if (n_in != 28 || out_size != T_LAT * D || ws_size < WS_END) { fprintf(stderr, "kernel_launch: expected 28 inputs, out %d, ws >= %zu; got n_in %d out %d ws %zu\n", T_LAT * D, (size_t)WS_END, n_in, out_size, ws_size); grid = -1; return; }
        int dev = 0, cus = 0, per_cu = 0;
        if (hipGetDevice(&dev) != hipSuccess || hipDeviceGetAttribute(&cus, hipDeviceAttributeMultiprocessorCount, dev) != hipSuccess) { fprintf(stderr, "kernel_launch: device query failed\n"); grid = -1; return; }
        if (hipFuncSetAttribute((const void*)mk_fwd, hipFuncAttributeMaxDynamicSharedMemorySize, LDS_BYTES) != hipSuccess) { fprintf(stderr, "kernel_launch: hipFuncSetAttribute failed\n"); grid = -1; return; }
        if (hipOccupancyMaxActiveBlocksPerMultiprocessor(&per_cu, (const void*)mk_fwd, 512, LDS_BYTES) != hipSuccess || per_cu < 1) fprintf(stderr, "kernel_launch: occupancy query reports %d\n", per_cu);
        (void)hipGetLastError();
        grid = cus;
        if (grid != 256) fprintf(stderr, "kernel_launch: note: %d CUs (tuned for 256)\n", grid);
    }
    if (grid < 0) return;
    if (hipMemsetAsync((char*)d_ws + WS_CTL, 0, CTL_BYTES, stream) != hipSuccess) { fprintf(stderr, "kernel_launch: memset failed\n"); return; }
    Args a{};
    for (int i = 0; i < 28; ++i) a.in[i] = (const float*)d_in[i];
    a.out = (float*)d_out; a.ws = (unsigned char*)d_ws;
#if MK_ONE_LAUNCH
    a.ph_lo = 0; a.ph_hi = N_PHASES;
    hipLaunchKernelGGL(mk_fwd, dim3(grid), dim3(512), LDS_BYTES, stream, a);
#else
    for (int p = 0; p < N_PHASES; ++p) { a.ph_lo = p; a.ph_hi = p + 1; hipLaunchKernelGGL(mk_fwd, dim3(grid), dim3(512), LDS_BYTES, stream, a); }
#endif
    const hipError_t le = hipPeekAtLastError();
    if (le != hipSuccess) fprintf(stderr, "kernel_launch: launch failed: %s\n", hipGetErrorName(le));
}
```

```cpp
#include <hip/hip_runtime.h>
#include <cstdio>
#include <cstdint>

#ifndef MK_ONE_LAUNCH
#define MK_ONE_LAUNCH 1
#endif

#define LAS __attribute__((address_space(3)))
typedef unsigned short bf16_t;
typedef short bf16x8 __attribute__((ext_vector_type(8)));
typedef short s16x4 __attribute__((ext_vector_type(4)));
typedef float f32x4 __attribute__((ext_vector_type(4)));
typedef float f32x2 __attribute__((ext_vector_type(2)));
typedef float f32x16 __attribute__((ext_vector_type(16)));
typedef unsigned u32x4 __attribute__((ext_vector_type(4)));
typedef unsigned u32x2 __attribute__((ext_vector_type(2)));
typedef int i32x4 __attribute__((ext_vector_type(4)));

constexpr int D = 2048, NB = 8, SEQ = 2048, CTXL = 256, RPB = SEQ + CTXL  ;
constexpr int T_ALL = NB * RPB  , T_LAT = NB * SEQ  ;
constexpr int NEXP = 64, FDIM = 512, TOPK = 8;
constexpr int ABW = 4608, QA_OFF = 0, KA_OFF = 1024, VA_OFF = 2048, QB_OFF = 3072, KB_OFF = 4096, VB_OFF = 4352;
constexpr int DOWN_N = 1280  , UQ_N = 3072, UKV_N = 4096;
constexpr float ALPHA = 1.41421356237f;
constexpr float LAM_INIT0 = 0.2f;
constexpr int LIST_CAP = T_ALL;
constexpr int MAX_TILES = 712;

constexpr size_t al4k(size_t x) { return (x + 4095) & ~(size_t)4095; }
constexpr size_t WS_CTL = 0, CTL_BYTES = 1u << 20;
constexpr size_t WS_TAB = WS_CTL + CTL_BYTES;
constexpr size_t WS_MOD = WS_TAB + (1u << 16);
constexpr size_t WS_W_IN = WS_MOD + (1u << 20);
constexpr size_t WS_W_OUT = WS_W_IN + al4k((size_t)ABW * D * 2);
constexpr size_t WS_W_DOWN = WS_W_OUT + al4k((size_t)D * D * 2);
constexpr size_t WS_W_UQ = WS_W_DOWN + al4k((size_t)DOWN_N * D * 2);
constexpr size_t WS_W_UKV = WS_W_UQ + al4k((size_t)UQ_N * 512 * 2);
constexpr size_t WS_W_O = WS_W_UKV + al4k((size_t)UKV_N * 512 * 2);
constexpr size_t WS_ROUTER = WS_W_O + al4k((size_t)D * D * 2);
constexpr size_t EXP_IN_BYTES = (size_t)1024 * D  , EXP_OUT_BYTES = (size_t)D * FDIM  ;
constexpr size_t WS_EXP_IN = WS_ROUTER + al4k((size_t)2 * 64 * D * 2);
constexpr size_t WS_EXP_OUT = WS_EXP_IN + (size_t)2 * 65 * EXP_IN_BYTES;
constexpr size_t WS_X = WS_EXP_OUT + (size_t)2 * 65 * EXP_OUT_BYTES;
constexpr size_t WS_H = WS_X + (size_t)T_ALL * D * 4;
constexpr size_t WS_PROJ = WS_H + (size_t)T_ALL * D * 2;
constexpr size_t WS_OA = WS_PROJ + (size_t)T_ALL * ABW * 2;
constexpr size_t WS_MERGED = WS_OA + (size_t)T_ALL * D * 2;
constexpr size_t WS_Y1 = WS_MERGED + (size_t)T_ALL * D * 2;
constexpr size_t P_MAX = (size_t)MAX_TILES * 256;
constexpr size_t WS_HMID = WS_Y1 + (size_t)T_ALL * D * 2;
constexpr size_t WS_Y2P = WS_HMID + P_MAX * FDIM * 2;
constexpr size_t WS_LIST = WS_Y2P + P_MAX * D * 2;
constexpr size_t WS_TOKSLOT = WS_LIST + (size_t)64 * LIST_CAP * 4;
constexpr size_t WS_GATE = WS_TOKSLOT + (size_t)T_ALL * 8 * 4;
constexpr size_t WS_DOWN = WS_GATE + (size_t)T_ALL * 8 * 4;
constexpr size_t WS_CQN = WS_DOWN + (size_t)T_ALL * DOWN_N * 2;
constexpr size_t WS_CKVN = WS_CQN + (size_t)T_ALL * 512 * 2;
constexpr size_t WS_KPE = WS_CKVN + (size_t)T_ALL * 512 * 2;
constexpr size_t WS_QM = WS_KPE + (size_t)T_ALL * 64 * 2;
constexpr size_t WS_KVM = WS_QM + (size_t)T_ALL * UQ_N * 2;
constexpr size_t WS_SW = WS_KVM + (size_t)T_ALL * UKV_N * 2;
constexpr size_t WS_H8 = WS_SW + al4k((size_t)2 * 65 * 1024 * 4);
constexpr size_t WS_SA = WS_H8 + (size_t)T_ALL * D;
constexpr size_t WS_SWD = WS_SA + al4k((size_t)T_ALL * 4);
constexpr int SWD_IN = 0, SWD_OUT = 4608, SWD_DOWN = 6656, SWD_UQ = 7936, SWD_UKV = 11008, SWD_O = 15104, SWD_N = 17152;
constexpr size_t WS_SW2 = WS_SWD + al4k((size_t)SWD_N * 4);
constexpr size_t WS_SCQ = WS_SW2 + al4k((size_t)2 * 65 * 2048 * 4);
constexpr size_t WS_SCKV = WS_SCQ + al4k((size_t)T_ALL * 4);
constexpr size_t WS_SMG = WS_SCKV + al4k((size_t)T_ALL * 4);
constexpr size_t WS_SHM = WS_SMG + al4k((size_t)T_ALL * 4);
constexpr size_t WS_HM8 = WS_SHM + al4k(P_MAX * 4);
constexpr size_t WS_MG8 = WS_HM8 + P_MAX * FDIM;
constexpr size_t WS_END = WS_MG8 + (size_t)T_ALL * D;
constexpr size_t TAB64R = 0, TAB64C = 4096, TAB128R = 12288, TAB128C = 20480;
constexpr int CW_BAR = 4096, CW_CNT = 16384;
constexpr int CW_QW = 20480;
constexpr int QSLOT_OFF = 163776;

constexpr int RING_BYTES = 131072;
constexpr int IDXC_OFF = 131072, IDXC_UNITS = 16;
constexpr int TTAB_OFF = IDXC_OFF + IDXC_UNITS * 1024;
constexpr int MISC_OFF = TTAB_OFF + 4096;
constexpr int LDS_BYTES = 163840;
constexpr int BARW_OFF = LDS_BYTES - 16;
constexpr int SCL_OFF = MISC_OFF + 2048;

#define RLX_AGENT __ATOMIC_RELAXED, __HIP_MEMORY_SCOPE_AGENT
__device__ __forceinline__ unsigned f2bf(float f) { unsigned u = __builtin_bit_cast(unsigned, f); return (u + 0x7fffu + ((u >> 16) & 1u)) >> 16; }
__device__ __forceinline__ unsigned pk2(float lo, float hi) { return f2bf(lo) | (f2bf(hi) << 16); }
__device__ __forceinline__ float bf2f(unsigned short b) { return __builtin_bit_cast(float, ((unsigned)b) << 16); }
__device__ __forceinline__ float bflo(unsigned w) { return __builtin_bit_cast(float, w << 16); }
__device__ __forceinline__ float bfhi(unsigned w) { return __builtin_bit_cast(float, w & 0xffff0000u); }
__device__ __forceinline__ unsigned cvt_pk_bf16(float lo, float hi) { unsigned r; asm volatile("v_cvt_pk_bf16_f32 %0, %1, %2" : "=v"(r) : "v"(lo), "v"(hi)); return r; }
__device__ __forceinline__ unsigned q8x4(float a, float b, float c, float d, float inv) {
    unsigned w = 0;
    w = __builtin_amdgcn_cvt_pk_u8_f32(__builtin_rintf(fmaf(a, inv, 128.0f)), 0, w); w = __builtin_amdgcn_cvt_pk_u8_f32(__builtin_rintf(fmaf(b, inv, 128.0f)), 1, w);
    w = __builtin_amdgcn_cvt_pk_u8_f32(__builtin_rintf(fmaf(c, inv, 128.0f)), 2, w); w = __builtin_amdgcn_cvt_pk_u8_f32(__builtin_rintf(fmaf(d, inv, 128.0f)), 3, w);
    return w ^ 0x80808080u;
}
__device__ __forceinline__ float wave_sum(float v) {
#pragma unroll
    for (int o = 1; o < 64; o <<= 1) v += __shfl_xor(v, o);
    return v;
}

#define XB_TMO      128
#define XB_XCNT(j)  (256  + 64 * (j))
#define XB_XSUB(j)  (1280 + 64 * (j))
#define XB_XGEN(j)  (2304 + 64 * (j))
#define XB_TOP      3328
#define XB_TOPGEN   3392
#define XCD_BAR_WORDS 3456
#define XB_SPIN_CAP (1u << 18)
__device__ __forceinline__ unsigned xb_ld(unsigned* p)              { return __hip_atomic_load(p, __ATOMIC_RELAXED, __HIP_MEMORY_SCOPE_AGENT); }
__device__ __forceinline__ unsigned xb_add(unsigned* p, unsigned v) { return __hip_atomic_fetch_add(p, v, __ATOMIC_RELAXED, __HIP_MEMORY_SCOPE_AGENT); }
__device__ __forceinline__ unsigned xb_xcc_id() { return (unsigned)__builtin_amdgcn_s_getreg((3 << 11) | 20) & 0xFu; }
#define XB_SPIN(cond, bar) do { unsigned _sp = 0; while (cond) { __builtin_amdgcn_s_sleep(1); \
    if ((++_sp & 255u) == 0u) { if (xb_ld(&(bar)[XB_TMO])) break; if (_sp > XB_SPIN_CAP) { atomicAdd(&(bar)[XB_TMO], 1u); break; } } } } while (0)
struct XcdBarrier { unsigned* bar; unsigned x; volatile LAS unsigned* st; };
__device__ __forceinline__ XcdBarrier xcd_barrier_post(unsigned* bar, volatile LAS unsigned* st) {
    XcdBarrier b; b.bar = bar; b.x = xb_xcc_id(); b.st = st;
    if (threadIdx.x == 0) (void)xb_add(&bar[XB_XCNT(b.x)], 1u);
    return b;
}
__device__ __forceinline__ void xcd_barrier_complete(unsigned* bar, unsigned x, unsigned& nloc, unsigned& nx) {
    const unsigned G = gridDim.x * gridDim.y * gridDim.z;
    unsigned sum, cnt, mine, sp = 0u;
    for (;;) {
        sum = 0u; cnt = 0u; mine = 0u;
#pragma unroll
        for (unsigned j = 0; j < 16; ++j) { const unsigned c = xb_ld(&bar[XB_XCNT(j)]); sum += c; cnt += (c > 0u) ? 1u : 0u; mine = (j == x) ? c : mine; }
        if (sum == G) break;
        __builtin_amdgcn_s_sleep(1);
        if ((++sp & 255u) == 0u) { if (xb_ld(&bar[XB_TMO])) break; if (sp > XB_SPIN_CAP) { atomicAdd(&bar[XB_TMO], 1u); break; } }
    }
    nloc = mine > 0u ? mine : 1u; nx = cnt > 0u ? cnt : 1u;
}
__device__ __forceinline__ void xcd_barrier(const XcdBarrier& b) {
    asm volatile("s_waitcnt vmcnt(0)" ::: "memory");
    __syncthreads();
    if (threadIdx.x == 0) {
        unsigned* bar = b.bar;
        __builtin_amdgcn_s_waitcnt(0);
        unsigned nloc = b.st[0], nx = b.st[1];
        if (nloc == 0u) { xcd_barrier_complete(bar, b.x, nloc, nx); b.st[0] = nloc; b.st[1] = nx; }
        const unsigned old = xb_add(&bar[XB_XSUB(b.x)], 1u);
        const unsigned gen = old / nloc;
        if (old + 1u == (gen + 1u) * nloc) {
            __builtin_amdgcn_fence(__ATOMIC_RELEASE, "agent");
            asm volatile("s_waitcnt vmcnt(0)" ::: "memory");
            const unsigned og = xb_add(&bar[XB_TOP], 1u);
            const unsigned tg = og / nx;
            if (og + 1u == (tg + 1u) * nx) xb_add(&bar[XB_TOPGEN], 1u);
            else XB_SPIN(xb_ld(&bar[XB_TOPGEN]) == tg, bar);
            __builtin_amdgcn_fence(__ATOMIC_ACQUIRE, "agent");
            xb_add(&bar[XB_XGEN(b.x)], 1u);
            asm volatile("s_waitcnt vmcnt(0)" ::: "memory");
        } else {
            XB_SPIN(xb_ld(&bar[XB_XGEN(b.x)]) == gen, bar);
            __builtin_amdgcn_fence(__ATOMIC_ACQUIRE, "agent");
            asm volatile("s_waitcnt vmcnt(0)" ::: "memory");
        }
    }
    __syncthreads();
}

namespace pg8 {
constexpr int BM = 256, BK = 64, HALF = 128, HTB = HALF * BK * 2, STAGE_BYTES = 8 * HTB;
__device__ __forceinline__ int lds_byte(int r, int c) { const int st = (r >> 4) * 2 + (c >> 5), rr = r & 15, cc = c & 31, ob = rr * 64 + cc * 2; return st * 1024 + (ob ^ (((ob >> 9) & 1) << 5)); }
__device__ __forceinline__ void stage_rc(int b, int& R, int& C) { const int st = b / 1024, sb = b % 1024, swz = sb ^ (((sb >> 9) & 1) << 5); R = (st >> 1) * 16 + swz / 64; C = (st & 1) * 32 + (swz % 64) / 2; }
__device__ __forceinline__ int perm32(int rho) { const int n = rho >> 4, i = rho & 15; return 8 * (i >> 2) + 4 * n + (i & 3); }

struct Unit { int row0; int pn; int e; const char* B; };

struct SchedDense {
    int nM, nN, nwg, G, c, latmap; const char* Bt; size_t tstepB;
    __device__ __forceinline__ void init(int nM_, int nN_, int G_, int c_, int latmap_, const bf16_t* Bt_, int K) { nM = nM_; nN = nN_; nwg = nM * nN; G = G_; c = c_; latmap = latmap_; Bt = (const char*)Bt_; tstepB = (size_t)BM * K * 2; }
    __device__ __forceinline__ bool next(int i, Unit& u) const {
        const long L = (long)i * G + c; if (L >= nwg) return false;
        int wgid = (int)L; { const int q = nwg / 8, r = nwg % 8, xcd = wgid % 8, off = wgid / 8; wgid = (xcd < r ? xcd * (q + 1) : r * (q + 1) + (xcd - r) * q) + off; }
        const int nig = 8 * nN, gid = wgid / nig, fm = gid * 8, gsz = (nM - fm) < 8 ? (nM - fm) : 8;
        int pm = fm + ((wgid % nig) % gsz); u.pn = (wgid % nig) / gsz;
        if (latmap) pm = (pm >> 3) * 9 + 1 + (pm & 7);
        u.row0 = pm * BM; u.e = 0; u.B = Bt + (size_t)u.pn * tstepB; return true;
    }
};
template <int NN, size_t GSTRIDE, size_t TSTEPB> struct SchedMoe {
    int ntiles, G, vcu; const LAS int* ttab; const char* Bt;
    __device__ __forceinline__ bool next(int i, Unit& u) const {
        const int L = i * G + vcu; if (L >= ntiles * NN) return false;
        const int tile = L / NN; u.pn = L - tile * NN; const int e = ttab[tile] >> 16;
        u.row0 = tile * BM; u.e = e; u.B = Bt + (size_t)e * GSTRIDE + (size_t)u.pn * TSTEPB; return true;
    }
};
struct EpiBf16 {
    static constexpr bool PERM = true; static constexpr int NVM = 16;
    bf16_t* O; int ldc;
    __device__ __forceinline__ const float* sa_src(const Unit& u, int ui, int r) const { return (const float*)O; }
    __device__ __forceinline__ const float* sw_src(const Unit& u, int c) const { return (const float*)O; }
    __device__ __forceinline__ void operator()(const f32x4 (&acc)[2][2][4][2], const Unit& u, int ui, int wr, int wc, int fr, int fq, const LAS float* scl) const {
        const int row0 = u.row0 + wr * 64 + fr, col0 = u.pn * BM + wc * 32 + 8 * fq;
#pragma unroll
        for (int ai = 0; ai < 2; ++ai)
#pragma unroll
            for (int m = 0; m < 4; ++m) { bf16_t* rowp = O + (size_t)(row0 + ai * HALF + m * 16) * ldc + col0;
#pragma unroll
                for (int bj = 0; bj < 2; ++bj) { const f32x4 v0 = acc[ai][bj][m][0], v1 = acc[ai][bj][m][1];
                    u32x4 w; w.x = cvt_pk_bf16(v0[0], v0[1]); w.y = cvt_pk_bf16(v0[2], v0[3]); w.z = cvt_pk_bf16(v1[0], v1[1]); w.w = cvt_pk_bf16(v1[2], v1[3]);
                    *(u32x4*)(rowp + bj * HALF) = w; } }
    }
};
__device__ __forceinline__ float silu_mul(float g, float u) { return g * __builtin_amdgcn_rcpf(1.0f + __builtin_amdgcn_exp2f(-1.4426950408889634f * g)) * u; }
template <int SWG> struct EpiI8Bf16 {
    static constexpr bool PERM = true; static constexpr int NVM = 16;
    bf16_t* O; int ldc; const float* SA; const float* SW;
    __device__ __forceinline__ const float* sa_src(const Unit& u, int ui, int r) const { return SA + u.row0 + r; }
    __device__ __forceinline__ const float* sw_src(const Unit& u, int c) const { return SW + (size_t)u.e * SWG + u.pn * BM + c; }
    __device__ __forceinline__ void operator()(const i32x4 (&acc)[2][2][4][2], const Unit& u, int ui, int wr, int wc, int fr, int fq, const LAS float* scl) const {
        const int lrow = wr * 64 + fr, row0 = u.row0 + lrow, col0 = u.pn * BM + wc * 32 + 8 * fq;
#pragma unroll
        for (int bj = 0; bj < 2; ++bj) { const f32x4 w0 = *(const LAS f32x4*)(scl + 256 + bj * HALF + wc * 32 + 8 * fq), w1 = *(const LAS f32x4*)(scl + 256 + bj * HALF + wc * 32 + 8 * fq + 4);
#pragma unroll
            for (int ai = 0; ai < 2; ++ai)
#pragma unroll
                for (int m = 0; m < 4; ++m) { const int r = row0 + ai * HALF + m * 16; bf16_t* rowp = O + (size_t)r * ldc + col0 + bj * HALF; const float sa = scl[lrow + ai * HALF + m * 16];
                    const i32x4 v0 = acc[ai][bj][m][0], v1 = acc[ai][bj][m][1]; const f32x4 s0 = w0 * sa, s1 = w1 * sa;
                    const f32x4 f0 = __builtin_convertvector(v0, f32x4) * s0, f1 = __builtin_convertvector(v1, f32x4) * s1;
                    u32x4 w; w.x = cvt_pk_bf16(f0[0], f0[1]); w.y = cvt_pk_bf16(f0[2], f0[3]); w.z = cvt_pk_bf16(f1[0], f1[1]); w.w = cvt_pk_bf16(f1[2], f1[3]);
                    *(u32x4*)rowp = w; } }
    }
};
template <int SWG, bool SA1 = false> struct EpiI8Fp8 {
    static constexpr bool PERM = true; static constexpr int NVM = 16;
    unsigned char* O; int ldc; const float* SA; const float* SW;
    __device__ __forceinline__ const float* sa_src(const Unit& u, int ui, int r) const { return SA1 ? SW : SA + u.row0 + r; }
    __device__ __forceinline__ const float* sw_src(const Unit& u, int c) const { return SW + (size_t)u.e * SWG + u.pn * BM + c; }
    template <class AV> __device__ __forceinline__ void operator()(const AV (&acc)[2][2][4][2], const Unit& u, int ui, int wr, int wc, int fr, int fq, const LAS float* scl) const {
        const int lrow = wr * 64 + fr, row0 = u.row0 + lrow, col0 = u.pn * BM + wc * 32 + 8 * fq;
#pragma unroll
        for (int bj = 0; bj < 2; ++bj) { const f32x4 w0 = *(const LAS f32x4*)(scl + 256 + bj * HALF + wc * 32 + 8 * fq), w1 = *(const LAS f32x4*)(scl + 256 + bj * HALF + wc * 32 + 8 * fq + 4);
#pragma unroll
            for (int ai = 0; ai < 2; ++ai)
#pragma unroll
                for (int m = 0; m < 4; ++m) { const int r = row0 + ai * HALF + m * 16; unsigned char* rowp = O + (size_t)r * ldc + col0 + bj * HALF; const float sa = SA1 ? 1.0f : scl[lrow + ai * HALF + m * 16];
                    const AV v0 = acc[ai][bj][m][0], v1 = acc[ai][bj][m][1]; const f32x4 s0 = w0 * sa, s1 = w1 * sa;
                    const f32x4 f0 = __builtin_convertvector(v0, f32x4) * s0, f1 = __builtin_convertvector(v1, f32x4) * s1;
                    int lo = 0, hi = 0;
                    lo = __builtin_amdgcn_cvt_pk_fp8_f32(f0[0], f0[1], lo, false); lo = __builtin_amdgcn_cvt_pk_fp8_f32(f0[2], f0[3], lo, true);
                    hi = __builtin_amdgcn_cvt_pk_fp8_f32(f1[0], f1[1], hi, false); hi = __builtin_amdgcn_cvt_pk_fp8_f32(f1[2], f1[3], hi, true);
                    *(u32x2*)rowp = (u32x2){(unsigned)lo, (unsigned)hi}; } }
    }
};
struct EpiSwigluI8 {
    static constexpr bool PERM = true; static constexpr int NVM = 8;
    unsigned char* O; int ldc; const float* SA; const float* SW; const LAS int* idxc;
    __device__ __forceinline__ const float* sa_src(const Unit& u, int ui, int r) const { return SA + idxc[(ui & (IDXC_UNITS - 1)) * 256 + r]; }
    __device__ __forceinline__ const float* sw_src(const Unit& u, int c) const { return SW + (size_t)u.e * 1024 + u.pn * BM + c; }
    __device__ __forceinline__ void operator()(const i32x4 (&acc)[2][2][4][2], const Unit& u, int ui, int wr, int wc, int fr, int fq, const LAS float* scl) const {
        const int lrow = wr * 64 + fr, row0 = u.row0 + lrow, col0 = u.pn * HALF + wc * 32 + 8 * fq;
        const LAS float* sw = scl + 256 + wc * 32 + 8 * fq;
        const f32x4 wg0 = *(const LAS f32x4*)sw, wg1 = *(const LAS f32x4*)(sw + 4), wu0 = *(const LAS f32x4*)(sw + HALF), wu1 = *(const LAS f32x4*)(sw + HALF + 4);
#pragma unroll
        for (int ai = 0; ai < 2; ++ai)
#pragma unroll
            for (int m = 0; m < 4; ++m) { unsigned char* rowp = O + (size_t)(row0 + ai * HALF + m * 16) * ldc + col0;
                const float sa = scl[lrow + ai * HALF + m * 16];
                const i32x4 g0 = acc[ai][0][m][0], g1 = acc[ai][0][m][1], u0 = acc[ai][1][m][0], u1 = acc[ai][1][m][1];
                float o[8];
#pragma unroll
                for (int j = 0; j < 4; ++j) { o[j] = silu_mul((float)g0[j] * (sa * wg0[j]), (float)u0[j] * (sa * wu0[j])); o[4 + j] = silu_mul((float)g1[j] * (sa * wg1[j]), (float)u1[j] * (sa * wu1[j])); }
                int lo = 0, hi = 0;
                lo = __builtin_amdgcn_cvt_pk_fp8_f32(o[0], o[1], lo, false); lo = __builtin_amdgcn_cvt_pk_fp8_f32(o[2], o[3], lo, true);
                hi = __builtin_amdgcn_cvt_pk_fp8_f32(o[4], o[5], hi, false); hi = __builtin_amdgcn_cvt_pk_fp8_f32(o[6], o[7], hi, true);
                *(u32x2*)rowp = (u32x2){(unsigned)lo, (unsigned)hi}; }
    }
};

template <int I8> struct AccT { typedef f32x4 T; };
template <> struct AccT<1> { typedef i32x4 T; };
__device__ __forceinline__ f32x4 mma16(bf16x8 b, bf16x8 a, f32x4 c) { return __builtin_amdgcn_mfma_f32_16x16x32_bf16(b, a, c, 0, 0, 0); }
__device__ __forceinline__ i32x4 mma16(bf16x8 b, bf16x8 a, i32x4 c) { return __builtin_amdgcn_mfma_i32_16x16x64_i8(__builtin_bit_cast(i32x4, b), __builtin_bit_cast(i32x4, a), c, 0, 0, 0); }
typedef int i32x8 __attribute__((ext_vector_type(8)));
__device__ __forceinline__ f32x4 mma_f8(bf16x8 b0, bf16x8 b1, bf16x8 a0, bf16x8 a1, f32x4 c) {
    const i32x8 bb = __builtin_shufflevector(__builtin_bit_cast(i32x4, b0), __builtin_bit_cast(i32x4, b1), 0, 1, 2, 3, 4, 5, 6, 7);
    const i32x8 aa = __builtin_shufflevector(__builtin_bit_cast(i32x4, a0), __builtin_bit_cast(i32x4, a1), 0, 1, 2, 3, 4, 5, 6, 7);
    return __builtin_amdgcn_mfma_scale_f32_16x16x128_f8f6f4(bb, aa, c, 0, 0, 0, 0, 0, 0);
}
template <class Epi, class Sched, bool GATHER, int I8 = 0>
__device__ __forceinline__ void gemm_phase(LAS unsigned char* lds, const void* Abase, const int K, const Sched& S, const Epi& E, const LAS int* idxc, const int tid) {
    const int wid = __builtin_amdgcn_readfirstlane(tid >> 6), lane = tid & 63, wr = wid >> 2, wc = wid & 3, fr = lane & 15, fq = lane >> 4;
    const int RB = I8 ? K : K * 2, nt = RB / 128;
    int Ri[2], Ci[2]; unsigned voffB[2];
#pragma unroll
    for (int i = 0; i < 2; ++i) { int R, C; stage_rc(tid * 16 + i * 8192, R, C); Ri[i] = R; Ci[i] = C; const int Rb = Epi::PERM ? ((R & ~31) + perm32(R & 31)) : R; voffB[i] = (unsigned)(Rb * RB + C * 2); }
    const size_t kstep = 128;
    const size_t hstep = (size_t)HALF * RB;
    const unsigned ldsw = (unsigned)wid * 1024u;
    const int aoff = lds_byte(wr * 64 + fr, fq * 8), boff = lds_byte(wc * 32 + fr, fq * 8);
#define PG8_SA(b, h) (((b) * 2 + (h)) * HTB)
#define PG8_SB(b, h) ((4 + (b) * 2 + (h)) * HTB)
#define PG8_STAGE(bufoff, gbase, voff) do { _Pragma("unroll") for (int _i = 0; _i < 2; ++_i) \
        __builtin_amdgcn_global_load_lds((const unsigned*)((const char*)(gbase) + (voff)[_i]), (LAS unsigned*)(lds + (bufoff) + ldsw + _i * 8192), 16, 0, 0); } while (0)
#define PG8_LDA(dst, b, h) do { _Pragma("unroll") for (int m = 0; m < 4; ++m) _Pragma("unroll") for (int k = 0; k < 2; ++k) dst[m][k] = *(const LAS bf16x8*)(lds + PG8_SA(b, h) + aoff + m * 2048 + k * 1024); } while (0)
#define PG8_LDB(dst, b, h) do { _Pragma("unroll") for (int n = 0; n < 2; ++n) _Pragma("unroll") for (int k = 0; k < 2; ++k) dst[n][k] = *(const LAS bf16x8*)(lds + PG8_SB(b, h) + boff + n * 2048 + k * 1024); } while (0)
#define PG8_MMA(ai, bj, At, Bt) do { __builtin_amdgcn_s_setprio(1); _Pragma("unroll") for (int m = 0; m < 4; ++m) _Pragma("unroll") for (int n = 0; n < 2; ++n) { \
        if constexpr (I8 == 2) acc[ai][bj][m][n] = mma_f8(Bt[n][0], Bt[n][1], At[m][0], At[m][1], acc[ai][bj][m][n]); \
        else { _Pragma("unroll") for (int k = 0; k < 2; ++k) acc[ai][bj][m][n] = mma16(Bt[n][k], At[m][k], acc[ai][bj][m][n]); } } __builtin_amdgcn_s_setprio(0); } while (0)
#define PG8_WAIT_V(n) asm volatile("s_waitcnt vmcnt(" #n ")" ::: "memory")
#define PG8_WAIT_L(n) asm volatile("s_waitcnt lgkmcnt(" #n ")" ::: "memory")
#define PG8_BAR __builtin_amdgcn_s_barrier()
#define PG8_SCHED __builtin_amdgcn_sched_barrier(0)
#define PG8_MKA(dst, ui, u_) do { _Pragma("unroll") for (int _h = 0; _h < 2; ++_h) _Pragma("unroll") for (int _i = 0; _i < 2; ++_i) { \
        if constexpr (GATHER) dst[_h][_i] = (unsigned)idxc[((ui) & (IDXC_UNITS - 1)) * 256 + _h * HALF + Ri[_i]] * (unsigned)RB + (unsigned)(Ci[_i] * 2); \
        else dst[_h][_i] = (unsigned)((_h * HALF + Ri[_i]) * RB + Ci[_i] * 2); } } while (0)
    Unit cur, nxt; int ui = 0;
    if (!S.next(0, cur)) return;
    LAS float* const sclb = (LAS float*)(lds + SCL_OFF);
#define PG8_SCALES(u_, ui_) do { const float* _src = (wid < 4) ? E.sa_src(u_, ui_, wid * 64 + lane) : E.sw_src(u_, (wid - 4) * 64 + lane); \
        __builtin_amdgcn_global_load_lds((const unsigned*)_src, (LAS unsigned*)(sclb + ((ui_) & 1) * 512 + wid * 64), 4, 0, 0); } while (0)
    constexpr int NEPI = Epi::NVM;
    typedef typename AccT<I8>::T acc_t;
    acc_t acc[2][2][4][2];
#pragma unroll
    for (int a = 0; a < 2; ++a)
#pragma unroll
        for (int b = 0; b < 2; ++b)
#pragma unroll
            for (int m = 0; m < 4; ++m)
#pragma unroll
                for (int n = 0; n < 2; ++n) acc[a][b][m][n] = acc_t{};
    bf16x8 At[4][2], B0[2][2], B1[2][2];
    unsigned curA[2][2], nxtA[2][2];
    PG8_MKA(curA, 0, cur);
    PG8_SCALES(cur, 0);
    const char* cA = GATHER ? (const char*)Abase : (const char*)Abase + (size_t)cur.row0 * RB; const char* cB = cur.B;
    PG8_STAGE(PG8_SB(0, 0), cB, voffB); PG8_STAGE(PG8_SB(0, 1), cB + hstep, voffB); PG8_STAGE(PG8_SA(0, 0), cA, curA[0]); PG8_STAGE(PG8_SA(0, 1), cA, curA[1]);
    if (wr == 1) PG8_BAR;
    PG8_WAIT_V(2); PG8_BAR;
    PG8_STAGE(PG8_SB(1, 0), cB + kstep, voffB); PG8_STAGE(PG8_SA(1, 0), cA + kstep, curA[0]); PG8_STAGE(PG8_SB(1, 1), cB + hstep + kstep, voffB);
    PG8_WAIT_V(6); PG8_BAR;
    for (;;) {
        const bool has_next = S.next(ui + 1, nxt);
        const char* nA = has_next ? (GATHER ? (const char*)Abase : (const char*)Abase + (size_t)nxt.row0 * RB) : cA; const char* nB = has_next ? nxt.B : cB;
        if constexpr (GATHER) { if (has_next) { PG8_MKA(nxtA, ui + 1, nxt); } else {
#pragma unroll
            for (int h = 0; h < 2; ++h)
#pragma unroll
                for (int i = 0; i < 2; ++i) nxtA[h][i] = curA[h][i]; } }
#pragma unroll 1
        for (int t = 0; t < nt; t += 2) {
            const bool last = (t == nt - 2);
            const char* a1 = cA + (size_t)(t + 1) * kstep;
            const char* a2 = last ? nA : cA + (size_t)(t + 2) * kstep; const char* b2 = last ? nB : cB + (size_t)(t + 2) * kstep;
            const char* a3 = a2 + kstep; const char* b3 = b2 + kstep;
            unsigned s0[2], s1[2];
#pragma unroll
            for (int i = 0; i < 2; ++i) { if constexpr (GATHER) { s0[i] = last ? nxtA[0][i] : curA[0][i]; s1[i] = last ? nxtA[1][i] : curA[1][i]; } else { s0[i] = curA[0][i]; s1[i] = curA[1][i]; } }
            const bool relax = (t == 0) && (ui > 0);
            PG8_LDB(B0, 0, 0); PG8_LDB(B1, 0, 1); PG8_SCHED; PG8_LDA(At, 0, 0); PG8_STAGE(PG8_SA(1, 1), a1, curA[1]);
            if (relax) { if constexpr (NEPI == 16) PG8_WAIT_V(24); else PG8_WAIT_V(16); } else PG8_WAIT_V(8);
            PG8_WAIT_L(0); PG8_BAR; PG8_MMA(0, 0, At, B0); PG8_MMA(0, 1, At, B1); PG8_BAR; PG8_SCHED;
            PG8_LDA(At, 0, 1); PG8_STAGE(PG8_SB(0, 0), b2, voffB); PG8_STAGE(PG8_SB(0, 1), b2 + hstep, voffB); PG8_STAGE(PG8_SA(0, 0), a2, s0);
            if (relax) { if constexpr (NEPI == 16) PG8_WAIT_V(24); else PG8_WAIT_V(16); } else PG8_WAIT_V(8);
            PG8_WAIT_L(0); PG8_BAR; PG8_MMA(1, 0, At, B0); PG8_MMA(1, 1, At, B1); PG8_BAR; PG8_SCHED;
            PG8_LDB(B0, 1, 0); PG8_LDB(B1, 1, 1); PG8_SCHED; PG8_LDA(At, 1, 0); PG8_STAGE(PG8_SA(0, 1), a2, s1);
            PG8_WAIT_V(8); PG8_WAIT_L(0); PG8_BAR; PG8_MMA(0, 0, At, B0); PG8_MMA(0, 1, At, B1); PG8_BAR; PG8_SCHED;
            PG8_LDA(At, 1, 1); PG8_STAGE(PG8_SB(1, 0), b3, voffB); PG8_STAGE(PG8_SB(1, 1), b3 + hstep, voffB); PG8_STAGE(PG8_SA(1, 0), a3, s0);
            PG8_WAIT_V(8); PG8_WAIT_L(0); PG8_BAR; PG8_MMA(1, 0, At, B0); PG8_MMA(1, 1, At, B1); PG8_BAR; PG8_SCHED;
        }
        if (wr == 0) PG8_BAR;
        E(acc, cur, ui, wr, wc, fr, fq, sclb + (ui & 1) * 512);
        if (!has_next) break;
#pragma unroll
        for (int a = 0; a < 2; ++a)
#pragma unroll
            for (int b = 0; b < 2; ++b)
#pragma unroll
                for (int m = 0; m < 4; ++m)
#pragma unroll
                    for (int n = 0; n < 2; ++n) acc[a][b][m][n] = acc_t{};
        cur = nxt; cA = nA; cB = nB; ++ui;
        PG8_SCALES(cur, ui);
        if constexpr (GATHER) {
#pragma unroll
            for (int h = 0; h < 2; ++h)
#pragma unroll
                for (int i = 0; i < 2; ++i) curA[h][i] = nxtA[h][i]; }
        if (wr == 1) PG8_BAR;
    }
    PG8_WAIT_V(0);
    PG8_BAR;
#undef PG8_SA
#undef PG8_SB
#undef PG8_STAGE
#undef PG8_LDA
#undef PG8_LDB
#undef PG8_MMA
#undef PG8_WAIT_V
#undef PG8_WAIT_L
#undef PG8_BAR
#undef PG8_SCHED
#undef PG8_MKA
#undef PG8_SCALES
}
}

namespace att {
constexpr int DV = 128, NW = 8, QBLK = 32, KVBLK = 64;
constexpr float THR = 8.f;
#define SBAR() __builtin_amdgcn_sched_barrier(0)
__device__ __forceinline__ int crow(int r, int hi) { return (r & 3) + 8 * (r >> 2) + 4 * hi; }
template <int DQK> struct Cfg {
    static constexpr int NQ = DQK / 16, SHM_K = KVBLK * DQK * 2, KCH = DQK / 64;
    static constexpr int RB0 = DQK >= 128 ? 256 : 128;
    static constexpr int KCH0 = DQK >= 128 ? 2 : 1, KCH1 = DQK == 192 ? 1 : 0, REG1 = KVBLK * RB0;
    static constexpr float SCALE = DQK == 64 ? 0.125f : (DQK == 128 ? 0.088388347648318440f : 0.072168783648703220f);
};
constexpr int SHM_V = KVBLK * DV * 2;

template <int DQK> __device__ __forceinline__ void partialSM(f32x16& p0, f32x16& p1, float& m_reg, float& mn, float& alpha) {
    constexpr float SCALE = Cfg<DQK>::SCALE, C = SCALE * 1.4426950408889634f;
    float pmax = p0[0];
#pragma unroll
    for (int r = 1; r < 16; ++r) pmax = fmaxf(pmax, p0[r]);
#pragma unroll
    for (int r = 0; r < 16; ++r) pmax = fmaxf(pmax, p1[r]);
    { auto rr = __builtin_amdgcn_permlane32_swap(__float_as_uint(pmax), __float_as_uint(pmax), false, false);
      pmax = fmaxf(__uint_as_float(rr[0]), __uint_as_float(rr[1])); }
    if (__builtin_expect(__all(pmax - m_reg <= THR / SCALE), 1)) { mn = m_reg; alpha = 1.f; }
    else { mn = fmaxf(m_reg, pmax); alpha = __builtin_amdgcn_exp2f((m_reg - mn) * C); m_reg = mn; }
    const float mnC = -mn * C;
#pragma unroll
    for (int r = 0; r < 16; ++r) p0[r] = fmaf(p0[r], C, mnC);
#pragma unroll
    for (int r = 0; r < 16; ++r) p1[r] = fmaf(p1[r], C, mnC);
#pragma unroll
    for (int r = 0; r < 16; ++r) p0[r] = __builtin_amdgcn_exp2f(p0[r]);
}
__device__ __forceinline__ void finishSM(f32x16& p0, f32x16& p1, float alpha, float& l_reg, bf16x8& pa0, bf16x8& pa1, bf16x8& pa2, bf16x8& pa3) {
#pragma unroll
    for (int r = 0; r < 16; ++r) p1[r] = __builtin_amdgcn_exp2f(p1[r]);
    float ps = 0;
#pragma unroll
    for (int r = 0; r < 16; ++r) ps += p0[r];
#pragma unroll
    for (int r = 0; r < 16; ++r) ps += p1[r];
    { auto rr = __builtin_amdgcn_permlane32_swap(__float_as_uint(ps), __float_as_uint(ps), false, false);
      ps = __uint_as_float(rr[0]) + __uint_as_float(rr[1]); }
    l_reg = l_reg * alpha + ps;
#define PK4(P, BASE, OUT) do { unsigned a0 = cvt_pk_bf16(P[BASE + 0], P[BASE + 1]), a1 = cvt_pk_bf16(P[BASE + 2], P[BASE + 3]);   \
    unsigned b0 = cvt_pk_bf16(P[BASE + 4], P[BASE + 5]), b1 = cvt_pk_bf16(P[BASE + 6], P[BASE + 7]);                              \
    auto r0 = __builtin_amdgcn_permlane32_swap(a0, b0, false, false); auto r1 = __builtin_amdgcn_permlane32_swap(a1, b1, false, false); \
    u32x4 w = {r0[0], r1[0], r0[1], r1[1]}; OUT = *reinterpret_cast<bf16x8*>(&w); } while (0)
    PK4(p0, 0, pa0); PK4(p0, 8, pa1); PK4(p1, 0, pa2); PK4(p1, 8, pa3);
#undef PK4
}
template <int DQK> __device__ __forceinline__ void qkt(f32x16& p0, f32x16& p1, const char* Ks, const bf16x8* qr, const char* qx, int r32, int hi) {
    p0 = f32x16{}; p1 = f32x16{};
    constexpr int RB0 = Cfg<DQK>::RB0;
#pragma unroll
    for (int d0 = 0; d0 < Cfg<DQK>::NQ; ++d0) {
        bf16x8 b0, b1, q;
        if (d0 < 8) { const int cb = (d0 * 16 + hi * 8) * 2;
            const int sw = (RB0 == 256 ? (r32 & 15) : ((r32 >> 1) & 7)) << 4;
            b0 = *reinterpret_cast<const bf16x8*>(Ks + r32 * RB0 + (cb ^ sw));
            b1 = *reinterpret_cast<const bf16x8*>(Ks + (32 + r32) * RB0 + (cb ^ sw));
            q = qr[d0 < 8 ? d0 : 0];
        } else { const int cb = ((d0 - 8) * 16 + hi * 8) * 2;
            const int sw = ((r32 >> 1) & 7) << 4;
            b0 = *reinterpret_cast<const bf16x8*>(Ks + Cfg<DQK>::REG1 + r32 * 128 + (cb ^ sw));
            b1 = *reinterpret_cast<const bf16x8*>(Ks + Cfg<DQK>::REG1 + (32 + r32) * 128 + (cb ^ sw));
            q = *reinterpret_cast<const bf16x8*>(qx + (d0 - 8) * 1024);
        }
        p0 = __builtin_amdgcn_mfma_f32_32x32x16_bf16(b0, q, p0, 0, 0, 0);
        p1 = __builtin_amdgcn_mfma_f32_32x32x16_bf16(b1, q, p1, 0, 0, 0); }
}
__device__ __forceinline__ int v_rd_base(int lane) { return ((lane & 3) << 3) | (((lane >> 2) & 3) << 6) | (((lane >> 4) & 1) << 5) | (((lane >> 5) & 1) << 8); }
constexpr int v_rd_off(int d0, int ks, int half) { return d0 * 512 + ks * 4096 + half * 2048; }
template <int OFF> __device__ __forceinline__ s16x4 tr_read(int vb) {
    s16x4 r; asm volatile("ds_read_b64_tr_b16 %0, %1 offset:%2" : "=&v"(r) : "v"(vb), "i"(OFF) : "memory"); return r;
}
template <int D0> __device__ __forceinline__ void pv_one(f32x16& od, int vb, bf16x8 pa0, bf16x8 pa1, bf16x8 pa2, bf16x8 pa3) {
    const s16x4 l0 = tr_read<v_rd_off(D0, 0, 0)>(vb), h0 = tr_read<v_rd_off(D0, 0, 1)>(vb), l1 = tr_read<v_rd_off(D0, 1, 0)>(vb), h1 = tr_read<v_rd_off(D0, 1, 1)>(vb);
    const s16x4 l2 = tr_read<v_rd_off(D0, 2, 0)>(vb), h2 = tr_read<v_rd_off(D0, 2, 1)>(vb), l3 = tr_read<v_rd_off(D0, 3, 0)>(vb), h3 = tr_read<v_rd_off(D0, 3, 1)>(vb);
    asm volatile("s_waitcnt lgkmcnt(0)" ::: "memory"); SBAR();
#define PK(L, H) (bf16x8){L[0], L[1], L[2], L[3], H[0], H[1], H[2], H[3]}
    od = __builtin_amdgcn_mfma_f32_32x32x16_bf16(pa0, PK(l0, h0), od, 0, 0, 0);
    od = __builtin_amdgcn_mfma_f32_32x32x16_bf16(pa1, PK(l1, h1), od, 0, 0, 0);
    od = __builtin_amdgcn_mfma_f32_32x32x16_bf16(pa2, PK(l2, h2), od, 0, 0, 0);
    od = __builtin_amdgcn_mfma_f32_32x32x16_bf16(pa3, PK(l3, h3), od, 0, 0, 0);
#undef PK
}
__device__ __forceinline__ void pv_d0(f32x16* o, int vb, bf16x8 pa0, bf16x8 pa1, bf16x8 pa2, bf16x8 pa3) {
    pv_one<0>(o[0], vb, pa0, pa1, pa2, pa3); pv_one<1>(o[1], vb, pa0, pa1, pa2, pa3); pv_one<2>(o[2], vb, pa0, pa1, pa2, pa3); pv_one<3>(o[3], vb, pa0, pa1, pa2, pa3);
}

template <int DQK, bool PIPE, bool QROPE, bool O8 = false>
__device__ __forceinline__ void attn_unit(const bf16_t* __restrict__ Qb, int ldq, const bf16_t* __restrict__ K0, int ldk0, const bf16_t* __restrict__ K1, int ldk1,
                                          const bf16_t* __restrict__ Vh, int ldv, bf16_t* __restrict__ Ob, int ldo, int nkeys, int qpos0, const f32x2* ropeR, const f32x2* ropeC,
                                          char* lds, LAS unsigned char* ldsl, const int tid) {
    using C = Cfg<DQK>; constexpr int NQ = C::NQ, SHM_K = C::SHM_K, NB = PIPE ? 3 : 2, KCH0 = C::KCH0, KCH1 = C::KCH1;
    const int wid = __builtin_amdgcn_readfirstlane(tid >> 6), lane = tid & 63, r32 = lane & 31, hi = lane >> 5;
    char* V_lds = lds; char* K_lds = lds + NB * SHM_V;
    float* ws = (float*)(lds + NB * SHM_V + NB * SHM_K) + wid * 64; float* li_l = ws; float* al_l = ws + 32;
    float m_reg = -1e30f, l_reg = 0; f32x16 o[4] = {}; constexpr int NQR = NQ < 8 ? NQ : 8; bf16x8 qr[NQR];
    char* qx = lds + NB * SHM_V + NB * SHM_K + 2048 + wid * 4096 + lane * 16;
    const bf16_t* Qw = Qb + (long)(wid * QBLK + r32) * ldq + hi * 8;
#pragma unroll
    for (int d0 = 0; d0 < NQR; ++d0) qr[d0] = *reinterpret_cast<const bf16x8*>(Qw + d0 * 16);
    if constexpr (QROPE) {
        static_assert(DQK == 192, "QROPE: MLA layout");
        const int pos = qpos0 + wid * QBLK + r32, gr = pos >> 6, gc = pos & 63;
#pragma unroll
        for (int blk = 0; blk < 2; ++blk) { const f32x2* tb = (blk == 0 ? ropeR + gr * 16 : ropeC + gc * 16) + hi * 8;
            bf16x8 x1 = *reinterpret_cast<const bf16x8*>(Qw + (8 + 2 * blk) * 16), x2 = *reinterpret_cast<const bf16x8*>(Qw + (9 + 2 * blk) * 16);
#pragma unroll
            for (int i = 0; i < 8; ++i) { const f32x2 cs = tb[i]; const float a = bf2f((unsigned short)x1[i]), b = bf2f((unsigned short)x2[i]);
                x1[i] = (short)f2bf(a * cs.x - b * cs.y); x2[i] = (short)f2bf(b * cs.x + a * cs.y); }
            *reinterpret_cast<bf16x8*>(qx + (2 * blk) * 1024) = x1; *reinterpret_cast<bf16x8*>(qx + (2 * blk + 1) * 1024) = x2; }
    } else { static_assert(NQ <= 8, "fragments beyond 8 need the LDS path"); }
    unsigned voffv[2], koff[KCH0 + (KCH1 ? 1 : 0)];
#pragma unroll
    for (int i = 0; i < 2; ++i) { const int st = 4 * wid + 2 * i + (lane >> 5), kk = (st >> 2) * 8 + ((lane & 31) >> 2), k = (kk & ~0xC) | ((kk & 4) << 1) | ((kk & 8) >> 1), c = (st & 3) * 32 + (lane & 3) * 8;
        voffv[i] = (unsigned)(k * ldv + c) * 2u; }
#pragma unroll
    for (int i = 0; i < KCH0; ++i) { const int sgm = KCH0 * wid + i; int row, q; if (C::RB0 == 256) { row = 4 * sgm + (lane >> 4); q = lane & 15; } else { row = 8 * sgm + (lane >> 3); q = lane & 7; }
        koff[i] = (unsigned)(row * ldk0 + (q ^ (C::RB0 == 256 ? (row & 15) : ((row >> 1) & 7))) * 8) * 2u; }
    if constexpr (KCH1) { const int row = 8 * wid + (lane >> 3), q = lane & 7; koff[KCH0] = (unsigned)(row * ldk1 + (q ^ ((row >> 1) & 7)) * 8) * 2u; }
    const int vb0 = (int)(uintptr_t)V_lds + v_rd_base(lane);
    LAS unsigned char* Vl = ldsl; LAS unsigned char* Kl = ldsl + NB * SHM_V;
#define GLDS(gp, lp) __builtin_amdgcn_global_load_lds((const unsigned*)(gp), (LAS unsigned*)(lp), 16, 0, 0)
#define DMA(k0, b) do { const char* _vb = (const char*)(Vh + (long)(k0) * ldv); const char* _kb0 = (const char*)(K0 + (long)(k0) * ldk0); \
    _Pragma("unroll") for (int _i = 0; _i < 2; ++_i) GLDS(_vb + voffv[_i], Vl + (b) * SHM_V + (2 * wid + _i) * 1024); \
    _Pragma("unroll") for (int _i = 0; _i < KCH0; ++_i) GLDS(_kb0 + koff[_i], Kl + (b) * SHM_K + (KCH0 * wid + _i) * 1024); \
    if constexpr (KCH1) { const char* _kb1 = (const char*)(K1 + (long)(k0) * ldk1); GLDS(_kb1 + koff[KCH0], Kl + (b) * SHM_K + C::REG1 + wid * 1024); } } while (0)
#define VM0() asm volatile("s_waitcnt vmcnt(0)" ::: "memory")
#define RESC(a) do { if (__any((a) < 1.f)) { if (hi == 0) al_l[r32] = (a); asm volatile("s_waitcnt lgkmcnt(0)" ::: "memory"); \
    _Pragma("unroll") for (int d = 0; d < 4; ++d) _Pragma("unroll") for (int r = 0; r < 16; ++r) o[d][r] *= al_l[crow(r, hi)]; } } while (0)
    bf16x8 pa0, pa1, pa2, pa3; const int NT = nkeys / KVBLK;
    if constexpr (PIPE) {
        f32x16 pA0, pA1, pB0, pB1; float mnA, mnB, alA, alB;
        int bc = 1, bp = 0, bn = 2;
        DMA(0, 0); DMA(KVBLK, 1); VM0(); __syncthreads();
        qkt<DQK>(pA0, pA1, K_lds, qr, qx, r32, hi); partialSM<DQK>(pA0, pA1, m_reg, mnA, alA);
#define STEP(PC0, PC1, mnC, alC, PP0, PP1, alP, j) do { \
        if ((j) + 1 < NT) DMA(((j) + 1) * KVBLK, bn); \
        SBAR(); qkt<DQK>(PC0, PC1, K_lds + bc * SHM_K, qr, qx, r32, hi); \
        finishSM(PP0, PP1, alP, l_reg, pa0, pa1, pa2, pa3); SBAR(); \
        pv_d0(o, vb0 + bp * SHM_V, pa0, pa1, pa2, pa3); partialSM<DQK>(PC0, PC1, m_reg, mnC, alC); \
        RESC(alC); VM0(); __syncthreads(); \
        { const int _t = bp; bp = bc; bc = bn; bn = _t; } } while (0)
        int j = 1;
        for (; j + 1 < NT; j += 2) { STEP(pB0, pB1, mnB, alB, pA0, pA1, alA, j); STEP(pA0, pA1, mnA, alA, pB0, pB1, alB, j + 1); }
        STEP(pB0, pB1, mnB, alB, pA0, pA1, alA, j);
#undef STEP
        finishSM(pB0, pB1, alB, l_reg, pa0, pa1, pa2, pa3); SBAR();
        pv_d0(o, vb0 + bp * SHM_V, pa0, pa1, pa2, pa3);
    } else {
        f32x16 p0, p1; float mn, al;
        DMA(0, 0); VM0(); __syncthreads();
        for (int j = 0; j < NT; ++j) {
            const int bs = j & 1;
            if (j + 1 < NT) DMA((j + 1) * KVBLK, bs ^ 1);
            SBAR(); qkt<DQK>(p0, p1, K_lds + bs * SHM_K, qr, qx, r32, hi); partialSM<DQK>(p0, p1, m_reg, mn, al);
            RESC(al);
            finishSM(p0, p1, al, l_reg, pa0, pa1, pa2, pa3); SBAR();
            pv_d0(o, vb0 + bs * SHM_V, pa0, pa1, pa2, pa3);
            VM0(); __syncthreads();
        }
    }
    if (hi == 0) li_l[r32] = l_reg; asm volatile("s_waitcnt lgkmcnt(0)" ::: "memory");
    float rli[16];
#pragma unroll
    for (int r = 0; r < 16; ++r) rli[r] = __builtin_amdgcn_rcpf(li_l[crow(r, hi)]);
    if constexpr (O8) { unsigned char* Ow = (unsigned char*)Ob + (long)(wid * QBLK) * ldo;
#pragma unroll
        for (int r = 0; r < 16; ++r) { const int orow = crow(r, hi);
#pragma unroll
            for (int d0 = 0; d0 < 4; ++d0) Ow[(long)orow * ldo + d0 * 32 + r32] = (unsigned char)__builtin_amdgcn_cvt_pk_fp8_f32(o[d0][r] * rli[r], 0.0f, 0, false); } }
    else { bf16_t* Ow = Ob + (long)(wid * QBLK) * ldo;
#pragma unroll
    for (int r = 0; r < 16; ++r) { const int orow = crow(r, hi);
#pragma unroll
        for (int d0 = 0; d0 < 4; ++d0) Ow[(long)orow * ldo + d0 * 32 + r32] = (bf16_t)f2bf(o[d0][r] * rli[r]); } }
    asm volatile("s_waitcnt vmcnt(0)" ::: "memory");
    __syncthreads();
#undef GLDS
#undef DMA
#undef VM0
#undef RESC
}
}

struct Args { const float* in[28]; float* out; unsigned char* ws; int ph_lo, ph_hi; };
typedef const __attribute__((address_space(4))) Args* KArgs;
struct Frame {
    LAS unsigned char* lds; char* ldsg;
    unsigned* ctl; unsigned char* ws; KArgs ka;
    int tid, lane, wave, vcu, G, gw, NGW;
};
#define PHASE_BEGIN(F) __syncthreads(); Frame P = (F); { int _l; asm volatile("v_mbcnt_lo_u32_b32 %0, -1, 0\n\tv_mbcnt_hi_u32_b32 %0, -1, %0" : "=v"(_l)); long _z = 0; asm volatile("" : "+s"(_z)); unsigned char* _w = (F).ka->ws + _z; P.ws = _w; P.ctl = (unsigned*)_w;     \
    P.lane = _l; P.tid = P.wave * 64 + _l; P.gw = P.vcu * 8 + P.wave; }
enum { I_X = 0, I_C, I_CTX, I_CCTX, I_ADAW, I_ADAB, I_LNMG, I_LNMB, I_LNFG, I_LNFB, I_ABWIN, I_ABWOUT, I_DLAM, I_SUBLN, I_QNG, I_KNG,
       I_MDOWN, I_MQNG, I_MUQ, I_MKVNG, I_MUKV, I_MWO, I_RW, I_RB, I_EWIN, I_EWOUT, I_SWIN, I_SWOUT };

__device__ __forceinline__ int tok_row(int layer, int t) { return layer ? (t >> 11) * RPB + CTXL + (t & 2047) : t; }

__constant__ float INV128[32] = { 1.f, 0.749894202f, 0.562341332f, 0.421696514f, 0.316227764f, 0.237137392f, 0.177827939f, 0.133352146f, 0.100000001f, 0.0749894157f, 0.0562341288f, 0.0421696492f,
    0.0316227786f, 0.0237137359f, 0.0177827943f, 0.0133352149f, 0.00999999978f, 0.00749894232f, 0.00562341325f, 0.00421696482f, 0.00316227786f, 0.00237137382f, 0.00177827943f, 0.00133352145f,
    0.00100000005f, 0.000749894185f, 0.000562341302f, 0.000421696546f, 0.000316227786f, 0.000237137385f, 0.00017782794f, 0.00013335215f };

__device__ __forceinline__ f32x2 sincos_d(double a) {
    const double twopi = 6.283185307179586476925287;
    const double k = __builtin_rint(a / twopi); const double r = a - k * twopi, r2 = r * r;
    double ts = r, tc = 1.0, ss = r, cc = 1.0;
#pragma unroll 1
    for (int n = 1; n <= 15; ++n) { tc *= -r2 / (double)((2 * n - 1) * (2 * n)); cc += tc; ts *= -r2 / (double)((2 * n) * (2 * n + 1)); ss += ts; }
    return (f32x2){(float)cc, (float)ss};
}

__device__ __forceinline__ int fresh_lane() { int l; asm volatile("v_mbcnt_lo_u32_b32 %0, -1, 0\n\tv_mbcnt_hi_u32_b32 %0, -1, %0" : "=v"(l)); return l; }
__device__ __forceinline__ int fresh_tid(const Frame& F) { return F.wave * 64 + fresh_lane(); }
__device__ __forceinline__ void transpose_item(const float* W, int K, int N, bf16_t* WT, int k0, int n0, int drow0, LAS float* scr, int lane) {
#pragma unroll 8
    for (int i = 0; i < 32; ++i) { const int kk = 2 * i + (lane >> 5); scr[kk * 33 + (lane & 31)] = W[(size_t)(k0 + kk) * N + n0 + (lane & 31)]; }
    asm volatile("s_waitcnt lgkmcnt(0)" ::: "memory");
    const int c = lane & 7;
#pragma unroll
    for (int j = 0; j < 4; ++j) { const int n = (lane >> 3) + 8 * j; const LAS float* s = scr + (8 * c) * 33 + n;
        u32x4 o; o.x = pk2(s[0 * 33], s[1 * 33]); o.y = pk2(s[2 * 33], s[3 * 33]); o.z = pk2(s[4 * 33], s[5 * 33]); o.w = pk2(s[6 * 33], s[7 * 33]);
        *(u32x4*)(WT + (size_t)(drow0 + n) * K + k0 + 8 * c) = o; }
    asm volatile("s_waitcnt lgkmcnt(0)" ::: "memory");
}
struct QItem { const float* W; int N, n0, drow; signed char* Q; float* SW; };
template <int KW, int NC, class Dec, bool F8 = false>
__device__ __forceinline__ void quant_loop(Frame& F, int nitems, const Dec& dec, int first) {
    LAS unsigned short* scr = (LAS unsigned short*)(F.lds + F.wave * 16384);
    LAS float* PM = (LAS float*)(F.lds + 131072);
    constexpr int K = 8 * KW, CH = KW / 16, LPR = NC / 4, RPI = 64 / LPR, NL = KW / RPI;
    static_assert(KW * NC * 2 <= 16384 && (NC == 32 || NC == 64), "quant_loop tile");
    const int k0 = F.wave * KW, rg = F.lane / LPR, c4 = (F.lane % LPR) * 4;
    f32x4 regs[NL]; QItem cur, nxt;
    int it = first; if (it >= nitems) return;
    dec(it, cur);
#pragma unroll
    for (int i = 0; i < NL; ++i) regs[i] = __builtin_nontemporal_load((const f32x4*)(cur.W + (size_t)(k0 + RPI * i + rg) * cur.N + cur.n0 + c4));
    for (;;) {
        f32x4 am = {0.f, 0.f, 0.f, 0.f};
#pragma unroll
        for (int i = 0; i < NL; ++i) { const f32x4 w = regs[i]; am[0] = fmaxf(am[0], fabsf(w[0])); am[1] = fmaxf(am[1], fabsf(w[1])); am[2] = fmaxf(am[2], fabsf(w[2])); am[3] = fmaxf(am[3], fabsf(w[3]));
            const int sw = (((RPI * i) >> 4) & 15) << 1;
            const unsigned lo = cvt_pk_bf16(w[0], w[1]), hi = cvt_pk_bf16(w[2], w[3]);
            *(LAS u32x2*)(scr + (RPI * i + rg) * NC + (c4 ^ (sw & 28))) = (sw & 2) ? (u32x2){hi, lo} : (u32x2){lo, hi}; }
        asm volatile("" : "+v"(am[0]), "+v"(am[1]), "+v"(am[2]), "+v"(am[3]) :: "memory"); __builtin_amdgcn_sched_barrier(0);
        const int itn = it + F.G; const bool has_next = itn < nitems;
        if (has_next) { dec(itn, nxt);
            const char* nbase = (const char*)(nxt.W + (size_t)k0 * nxt.N + nxt.n0); const size_t stepb = (size_t)RPI * nxt.N * 4; const unsigned voff = (unsigned)((rg * nxt.N + c4) * 4);
#pragma unroll
            for (int i = 0; i < NL; ++i) regs[i] = __builtin_nontemporal_load((const f32x4*)((nbase + (size_t)i * stepb) + voff)); }
#pragma unroll
        for (int q = 0; q < 4; ++q) { float v = am[q];
#pragma unroll
            for (int o = LPR; o < 64; o <<= 1) v = fmaxf(v, __shfl_xor(v, o));
            am[q] = v; }
        if (F.lane < LPR) *(LAS f32x4*)(PM + F.wave * NC + c4) = am;
        __syncthreads();
        if (F.tid < NC) { float m = 0.f;
#pragma unroll
            for (int w = 0; w < 8; ++w) m = fmaxf(m, PM[w * NC + F.tid]);
            PM[512 + F.tid] = m > 0.f ? (F8 ? 448.0f : 127.0f) / m : 0.f; cur.SW[cur.drow + F.tid] = m * (1.0f / (F8 ? 448.0f : 127.0f)); }
        __syncthreads();
#pragma unroll 1
        for (int pass = 0; pass < NC * CH / 64; ++pass) { const int cidx = pass * 64 + F.lane, n = cidx / CH, kb = (cidx % CH) * 16; const float inv = PM[512 + n]; u32x4 o;
#pragma unroll
            for (int d = 0; d < 4; ++d) { float x[4];
#pragma unroll
                for (int e = 0; e < 4; ++e) x[e] = bf2f(scr[(kb + d * 4 + e) * NC + (n ^ (((kb >> 4) & 15) << 1))]);
                if constexpr (F8) { int w = 0; w = __builtin_amdgcn_cvt_pk_fp8_f32(x[0] * inv, x[1] * inv, w, false); w = __builtin_amdgcn_cvt_pk_fp8_f32(x[2] * inv, x[3] * inv, w, true); o[d] = (unsigned)w; }
                else o[d] = q8x4(x[0], x[1], x[2], x[3], inv); }
            *(u32x4*)(cur.Q + (size_t)(cur.drow + n) * K + k0 + kb) = o; }
        __syncthreads();
        if (!has_next) break;
        it = itn; cur = nxt;
    }
}
struct DecDense256 { KArgs ka; unsigned char* ws;
    static constexpr int NITEMS = 144 + 64 + 34 + 64;
    __device__ __forceinline__ void operator()(int it, QItem& p) const { float* SWD = (float*)(ws + WS_SWD); int r = it;
        if (r < 144) { p.W = ka->in[I_ABWIN]; p.N = ABW; p.Q = (signed char*)(ws + WS_W_IN); p.SW = SWD + SWD_IN; }
        else if ((r -= 144) < 64) { p.W = ka->in[I_ABWOUT]; p.N = 2048; p.Q = (signed char*)(ws + WS_W_OUT); p.SW = SWD + SWD_OUT; }
        else if ((r -= 64) < 34) { p.W = ka->in[I_MDOWN]; p.N = 1088; p.Q = (signed char*)(ws + WS_W_DOWN); p.SW = SWD + SWD_DOWN; }
        else { r -= 34; p.W = ka->in[I_MWO]; p.N = 2048; p.Q = (signed char*)(ws + WS_W_O); p.SW = SWD + SWD_O; }
        p.n0 = r * 32; p.drow = p.n0; }
};
struct DecDense64 { KArgs ka; unsigned char* ws;
    static constexpr int NITEMS = 48 + 64;
    __device__ __forceinline__ void operator()(int it, QItem& p) const { float* SWD = (float*)(ws + WS_SWD); int r = it;
        if (r < 48) { p.W = ka->in[I_MUQ]; p.N = UQ_N; p.Q = (signed char*)(ws + WS_W_UQ); p.SW = SWD + SWD_UQ; }
        else { r -= 48; p.W = ka->in[I_MUKV]; p.N = UKV_N; p.Q = (signed char*)(ws + WS_W_UKV); p.SW = SWD + SWD_UKV; }
        p.n0 = r * 64; p.drow = p.n0; }
};
struct DecExpIn { KArgs ka; unsigned char* ws; int layer;
    static constexpr int NITEMS = 65 * 32;
    __device__ __forceinline__ void operator()(int it, QItem& p) const { const int e = it >> 5, m = layer * 65 + e; p.n0 = (it & 31) * 32; p.N = 1024;
        p.W = (e < 64) ? ka->in[I_EWIN] + ((size_t)layer * 64 + e) * 2048 * 1024 : ka->in[I_SWIN] + (size_t)layer * 2048 * 1024;
        p.drow = (p.n0 < 512) ? ((p.n0 >> 7) * 256 + (p.n0 & 127)) : (((p.n0 - 512) >> 7) * 256 + 128 + ((p.n0 - 512) & 127));
        p.Q = (signed char*)(ws + WS_EXP_IN + (size_t)m * EXP_IN_BYTES); p.SW = (float*)(ws + WS_SW) + (size_t)m * 1024; }
};
struct DecExpOut { KArgs ka; unsigned char* ws; int layer;
    static constexpr int NITEMS = 65 * 32;
    __device__ __forceinline__ void operator()(int it, QItem& p) const { const int e = it >> 5, m = layer * 65 + e; p.n0 = (it & 31) * 64; p.N = 2048;
        p.W = (e < 64) ? ka->in[I_EWOUT] + ((size_t)layer * 64 + e) * 512 * 2048 : ka->in[I_SWOUT] + (size_t)layer * 512 * 2048;
        p.Q = (signed char*)(ws + WS_EXP_OUT + (size_t)m * EXP_OUT_BYTES); p.SW = (float*)(ws + WS_SW2) + (size_t)m * 2048; p.drow = p.n0; }
};
__device__ __forceinline__ void side_quant_experts(Frame& F, int layer);
__device__ __forceinline__ void transpose_matrix(Frame& F, const float* W, int K, int N, bf16_t* WT, int mode, int& cursor) {
    LAS float* scr = (LAS float*)(F.lds + F.wave * 16384);
    const int nblk = N / 32, nitems = (K / 64) * nblk;
    int it = (F.gw - cursor) % F.NGW; if (it < 0) it += F.NGW;
    for (; it < nitems; it += F.NGW) { const int kb = it / nblk, nb = it % nblk, n0 = nb * 32;
        int drow = n0; if (mode == 1) drow = (n0 < 512) ? ((n0 >> 7) * 256 + (n0 & 127)) : (((n0 - 512) >> 7) * 256 + 128 + ((n0 - 512) & 127));
        transpose_item(W, K, N, WT, kb * 64, n0, drow, scr, F.lane); }
    cursor = (cursor + nitems) % F.NGW;
}

__device__ __forceinline__ void p0_prologue(Frame& F) {
    {
        LAS float* act = (LAS float*)F.lds;
        LAS float* part = (LAS float*)(F.lds + 9 * 2048 * 4);
        for (int i = F.tid; i < 9 * 2048; i += 512) { const int m = i >> 11, k = i & 2047; const float v = (m < 8) ? F.ka->in[I_C][m * 2048 + k] : F.ka->in[I_CCTX][k]; act[i] = v / (1.0f + __expf(-v)); }
        __syncthreads();
        float* MOD = (float*)(F.ws + WS_MOD);
        const int l16 = F.lane & 15, kg = (F.tid >> 4);
        for (int item = F.vcu; item < 2 * 192; item += F.G) {
            const int layer = item / 192, n0 = (item % 192) * 64;
            const float* W = F.ka->in[I_ADAW] + (size_t)layer * 2048 * 12288 + n0 + l16 * 4;
            f32x4 acc[9];
#pragma unroll
            for (int m = 0; m < 9; ++m) acc[m] = (f32x4){0.f, 0.f, 0.f, 0.f};
#pragma unroll 1
            for (int j0 = 0; j0 < 64; j0 += 8) { f32x4 w[8];
#pragma unroll
                for (int jj = 0; jj < 8; ++jj) w[jj] = __builtin_nontemporal_load((const f32x4*)(W + (size_t)(kg + 32 * (j0 + jj)) * 12288));
#pragma unroll
                for (int jj = 0; jj < 8; ++jj) { const int k = kg + 32 * (j0 + jj);
#pragma unroll
                    for (int m = 0; m < 9; ++m) acc[m] += w[jj] * act[m * 2048 + k]; } }
#pragma unroll
            for (int m = 0; m < 9; ++m)
#pragma unroll
                for (int q = 0; q < 4; ++q) { float v = acc[m][q]; v += __shfl_xor(v, 16); v += __shfl_xor(v, 32); acc[m][q] = v; }
            if (F.lane < 16) {
#pragma unroll
                for (int m = 0; m < 9; ++m) *(LAS f32x4*)(part + (F.wave * 9 + m) * 64 + l16 * 4) = acc[m]; }
            __syncthreads();
            for (int i = F.tid; i < 9 * 64; i += 512) { const int m = i >> 6, n = i & 63; float s = 0.f;
#pragma unroll
                for (int w = 0; w < 8; ++w) s += part[(w * 9 + m) * 64 + n];
                MOD[((size_t)layer * 9 + m) * 12288 + n0 + n] = s + F.ka->in[I_ADAB][layer * 12288 + n0 + n]; }
            __syncthreads();
        }
    }
    {
        f32x2* tab = (f32x2*)(F.ws + WS_TAB);
        for (int i = F.gw * 64 + F.lane; i < 512 + 1024 + 1024 + 2048; i += F.NGW * 64) {
            int pos, f; double inv; f32x2* dst;
            if (i < 512) { pos = i >> 4; f = i & 15; inv = (double)INV128[2 * f]; dst = tab + TAB64R / 8 + i; }
            else if (i < 1536) { const int j = i - 512; pos = j >> 4; f = j & 15; inv = (double)INV128[2 * f]; dst = tab + TAB64C / 8 + j; }
            else if (i < 2560) { const int j = i - 1536; pos = j >> 5; f = j & 31; inv = (double)INV128[f]; dst = tab + TAB128R / 8 + j; }
            else { const int j = i - 2560; pos = j >> 5; f = j & 31; inv = (double)INV128[f]; dst = tab + TAB128C / 8 + j; }
            *dst = sincos_d((double)(float)((float)pos * (float)inv));
        }
        u32x4* z = (u32x4*)(F.ws + WS_W_DOWN + (size_t)1088 * D);
        for (int i = F.gw * 64 + F.lane; i < (DOWN_N - 1088) * D / 16; i += F.NGW * 64) z[i] = (u32x4){0u, 0u, 0u, 0u};
        for (int i = F.gw * 64 + F.lane; i < DOWN_N - 1088; i += F.NGW * 64) ((float*)(F.ws + WS_SWD))[SWD_DOWN + 1088 + i] = 0.f;
    }
    {
        { DecDense256 d{F.ka, F.ws}; quant_loop<256, 32>(F, DecDense256::NITEMS - 64, d, F.vcu); __syncthreads();
          quant_loop<256, 32, DecDense256, true>(F, DecDense256::NITEMS, d, DecDense256::NITEMS - 64 + F.vcu); }
        __syncthreads();
        { DecDense64 d{F.ka, F.ws}; quant_loop<64, 64>(F, DecDense64::NITEMS, d, F.vcu); }
        __syncthreads();
        int cursor = 0;
        for (int l = 0; l < 2; ++l) transpose_matrix(F, F.ka->in[I_RW] + (size_t)l * 2048 * 64, 2048, 64, (bf16_t*)(F.ws + WS_ROUTER + (size_t)l * 64 * 2048 * 2), 0, cursor);
    }
}

__device__ __forceinline__ void side_quant_experts(Frame& F, int layer) {
    __syncthreads();
    const unsigned* qw = (const unsigned*)(F.ws + WS_CTL) + CW_QW + layer * 32;
    const int q0 = min((int)__hip_atomic_load(qw, RLX_AGENT), DecExpIn::NITEMS), q1 = min((int)__hip_atomic_load(qw + 16, RLX_AGENT), DecExpOut::NITEMS);
    { DecExpIn d{F.ka, F.ws, layer}; quant_loop<256, 32>(F, DecExpIn::NITEMS, d, q0 + (int)blockIdx.x); }
    __syncthreads();
    { DecExpOut d{F.ka, F.ws, layer}; quant_loop<64, 64, DecExpOut, true>(F, DecExpOut::NITEMS, d, q1 + (int)blockIdx.x); }
    __syncthreads();
}
__device__ __forceinline__ void tail_quant(Frame& F, int layer, int n_in, int n_out) {
    unsigned* qw = (unsigned*)(F.ws + WS_CTL) + CW_QW + layer * 32;
    LAS int* slot = (LAS int*)(F.lds + QSLOT_OFF);
#pragma unroll 1
    for (int n = 0; n < n_in; ++n) {
        __syncthreads();
        if (F.tid == 0) *slot = (int)__hip_atomic_fetch_add(qw, 1u, RLX_AGENT);
        __syncthreads();
        const int it = *slot;
        if (it < DecExpIn::NITEMS) { DecExpIn d{F.ka, F.ws, layer}; quant_loop<256, 32>(F, it + 1, d, it); }
    }
#pragma unroll 1
    for (int n = 0; n < n_out; ++n) {
        __syncthreads();
        if (F.tid == 0) *slot = (int)__hip_atomic_fetch_add(qw + 16, 1u, RLX_AGENT);
        __syncthreads();
        const int it = *slot;
        if (it < DecExpOut::NITEMS) { DecExpOut d{F.ka, F.ws, layer}; quant_loop<64, 64, DecExpOut, true>(F, it + 1, d, it); }
    }
    __syncthreads();
}
__device__ __forceinline__ bool is_tail_wg(int nunits, int G, int c) { const int mx = (nunits + G - 1) / G, mine = c < nunits ? (nunits - c + G - 1) / G : 0; return mine < mx; }
__device__ __forceinline__ const float* x_src(Frame& F, int layer, int r) {
    if (layer) return (const float*)(F.ws + WS_X) + (size_t)r * D;
    const int b = r / RPB, i = r - b * RPB;
    return (i < CTXL) ? F.ka->in[I_CTX] + ((size_t)b * CTXL + i) * D : F.ka->in[I_X] + ((size_t)b * SEQ + (i - CTXL)) * D;
}
__device__ __forceinline__ const float* mod_row(Frame& F, int layer, int r) { const int b = r / RPB, i = r - b * RPB; return (const float*)(F.ws + WS_MOD) + ((size_t)layer * 9 + ((i < CTXL) ? 8 : b)) * 12288; }

__device__ __forceinline__ void ld8f(const float* p, float (&v)[8]) { const f32x4 a = *(const f32x4*)p, b = *(const f32x4*)(p + 4); v[0] = a[0]; v[1] = a[1]; v[2] = a[2]; v[3] = a[3]; v[4] = b[0]; v[5] = b[1]; v[6] = b[2]; v[7] = b[3]; }
__device__ __forceinline__ void ld8f_nt(const float* p, float (&v)[8]) { const f32x4 a = __builtin_nontemporal_load((const f32x4*)p), b = __builtin_nontemporal_load((const f32x4*)(p + 4)); v[0] = a[0]; v[1] = a[1]; v[2] = a[2]; v[3] = a[3]; v[4] = b[0]; v[5] = b[1]; v[6] = b[2]; v[7] = b[3]; }
__device__ __forceinline__ void ld8l(const LAS float* p, float (&v)[8]) { const f32x4 a = *(const LAS f32x4*)p, b = *(const LAS f32x4*)(p + 4); v[0] = a[0]; v[1] = a[1]; v[2] = a[2]; v[3] = a[3]; v[4] = b[0]; v[5] = b[1]; v[6] = b[2]; v[7] = b[3]; }
__device__ __forceinline__ void st8f(float* p, const float (&v)[8]) { *(f32x4*)p = (f32x4){v[0], v[1], v[2], v[3]}; *(f32x4*)(p + 4) = (f32x4){v[4], v[5], v[6], v[7]}; }
__device__ __forceinline__ void unpk8(const u32x4 w, float (&v)[8]) {
#pragma unroll
    for (int e = 0; e < 4; ++e) { v[2 * e] = bflo(w[e]); v[2 * e + 1] = bfhi(w[e]); } }
__device__ __forceinline__ void unfp8(const u32x2 w, float (&v)[8]) {
#pragma unroll
    for (int d = 0; d < 2; ++d) { const f32x2 a = __builtin_amdgcn_cvt_pk_f32_fp8((int)w[d], false), b = __builtin_amdgcn_cvt_pk_f32_fp8((int)w[d], true); v[4 * d] = a.x; v[4 * d + 1] = a.y; v[4 * d + 2] = b.x; v[4 * d + 3] = b.y; } }
__device__ __forceinline__ u32x4 pk8(const float (&v)[8]) { u32x4 w;
#pragma unroll
    for (int e = 0; e < 4; ++e) w[e] = pk2(v[2 * e], v[2 * e + 1]);
    return w; }

__device__ __forceinline__ void quant_row_store(const float (&v)[4][8], signed char* dst, float* scale, int lane) {
    float am = 0.f;
#pragma unroll
    for (int j = 0; j < 4; ++j)
#pragma unroll
        for (int e = 0; e < 8; ++e) am = fmaxf(am, fabsf(v[j][e]));
#pragma unroll
    for (int o = 1; o < 64; o <<= 1) am = fmaxf(am, __shfl_xor(am, o));
    const float inv = am > 0.f ? 127.0f / am : 0.f;
    if (lane == 0) *scale = am * (1.0f / 127.0f);
#pragma unroll
    for (int j = 0; j < 4; ++j) { u32x2 w;
#pragma unroll
        for (int d = 0; d < 2; ++d) w[d] = q8x4(v[j][d * 4], v[j][d * 4 + 1], v[j][d * 4 + 2], v[j][d * 4 + 3], inv);
        *(u32x2*)(dst + 512 * j + 8 * lane) = w; }
}
__device__ __forceinline__ void quant_row512_store(const float (&v)[8], signed char* dst, float* scale, int lane) {
    float am = 0.f;
#pragma unroll
    for (int e = 0; e < 8; ++e) am = fmaxf(am, fabsf(v[e]));
#pragma unroll
    for (int o = 1; o < 64; o <<= 1) am = fmaxf(am, __shfl_xor(am, o));
    const float inv = am > 0.f ? 127.0f / am : 0.f;
    if (lane == 0) *scale = am * (1.0f / 127.0f);
    u32x2 w;
#pragma unroll
    for (int d = 0; d < 2; ++d) w[d] = q8x4(v[d * 4], v[d * 4 + 1], v[d * 4 + 2], v[d * 4 + 3], inv);
    *(u32x2*)(dst + 8 * lane) = w;
}

template <int R> __device__ __forceinline__ void p1_rows(Frame& F, int t0, int i) {
    const LAS float* PA = (const LAS float*)F.lds;
    float x[R][4][8]; int var[R];
#pragma unroll
    for (int q = 0; q < R; ++q) { const int r = t0 + i + 8 * q; const float* xs = x_src(F, 0, r); var[q] = ((r % RPB) < CTXL) ? 2 : 0;
#pragma unroll
        for (int j = 0; j < 4; ++j) ld8f_nt(xs + 512 * j + 8 * F.lane, x[q][j]); }
#pragma unroll
    for (int q = 0; q < R; ++q) { const int r = t0 + i + 8 * q;
#pragma unroll
        for (int j = 0; j < 4; ++j) { const int c = 512 * j + 8 * F.lane; float sh[8], sc[8]; ld8l(PA + var[q] * 2048 + c, sh); ld8l(PA + (var[q] + 1) * 2048 + c, sc);
#pragma unroll
            for (int e = 0; e < 8; ++e) x[q][j][e] = x[q][j][e] * (1.0f + sc[e]) + sh[e]; }
        quant_row_store(x[q], (signed char*)(F.ws + WS_H8) + (size_t)r * D, (float*)(F.ws + WS_SA) + r, F.lane); }
}
__device__ __forceinline__ void p1_modulate(Frame& F) {
    LAS float* PA = (LAS float*)F.lds;
    constexpr int BR = 72, nblk = T_ALL / BR;
    const float* MOD = (const float*)(F.ws + WS_MOD);
    for (int blk = F.vcu; blk < nblk; blk += F.G) {
        const int t0 = blk * BR, b = t0 / RPB;
        __syncthreads();
        { const int c = F.tid * 4; const float* mb = MOD + (size_t)b * 12288; const float* mc = MOD + (size_t)8 * 12288;
          *(LAS f32x4*)(PA + c) = *(const f32x4*)(mb + c); *(LAS f32x4*)(PA + 2048 + c) = *(const f32x4*)(mb + 2048 + c);
          *(LAS f32x4*)(PA + 4096 + c) = *(const f32x4*)(mc + c); *(LAS f32x4*)(PA + 6144 + c) = *(const f32x4*)(mc + 2048 + c); }
        __syncthreads();
        for (int i = F.wave; i < BR; i += 16) { if (i + 8 < BR) p1_rows<2>(F, t0, i); else p1_rows<1>(F, t0, i); }
    }
}

__device__ __forceinline__ void p_post_ab(Frame& F) {
    bf16_t* P = (bf16_t*)(F.ws + WS_PROJ);
    const f32x2* t64r = (const f32x2*)(F.ws + WS_TAB + TAB64R); const f32x2* t64c = (const f32x2*)(F.ws + WS_TAB + TAB64C);
    const f32x2* t128r = (const f32x2*)(F.ws + WS_TAB + TAB128R); const f32x2* t128c = (const f32x2*)(F.ws + WS_TAB + TAB128C);
    const float* qg = F.ka->in[I_QNG]; const float* kg = F.ka->in[I_KNG];
    for (int r = F.gw; r < T_ALL; r += F.NGW) {
        const int b = r / RPB, i = r - b * RPB; const bool lat = i >= CTXL; const int pos = i - CTXL, gr = pos >> 6, gc = pos & 63;
        bf16_t* row = P + (size_t)r * ABW;
        if (lat) {
            bf16_t* blk = row + F.lane * 32; const f32x2* tb = (F.lane & 1) ? t64c + gc * 16 : t64r + gr * 16;
            u32x4 w[4];
#pragma unroll
            for (int q = 0; q < 4; ++q) w[q] = *(const u32x4*)(blk + 8 * q);
#pragma unroll
            for (int q = 0; q < 2; ++q)
#pragma unroll
                for (int e = 0; e < 4; ++e) { const unsigned a = w[q][e], bq = w[q + 2][e]; const f32x2 c0 = tb[q * 8 + e * 2], c1 = tb[q * 8 + e * 2 + 1];
                    const float a0 = bflo(a), a1 = bfhi(a), b0 = bflo(bq), b1 = bfhi(bq);
                    w[q][e] = pk2(a0 * c0.x - b0 * c0.y, a1 * c1.x - b1 * c1.y); w[q + 2][e] = pk2(b0 * c0.x + a0 * c0.y, b1 * c1.x + a1 * c1.y); }
#pragma unroll
            for (int q = 0; q < 4; ++q) *(u32x4*)(blk + 8 * q) = w[q];
        }
#pragma unroll
        for (int pass = 0; pass < 2; ++pass) {
            const int head = pass * 8 + (F.lane >> 3), s = F.lane & 7; const bool act = head < 10;
            bf16_t* hp = row + (head < 8 ? QB_OFF + head * 128 : KB_OFF + (head - 8) * 128); const float* g = head < 8 ? qg : kg;
            float v[4][4]; float ss = 0.f;
            if (act) {
#pragma unroll
                for (int q = 0; q < 4; ++q) { const int c = (q >> 1) * 64 + (q & 1) * 32 + s * 4; const u32x2 w = *(const u32x2*)(hp + c);
                    v[q][0] = bflo(w.x); v[q][1] = bfhi(w.x); v[q][2] = bflo(w.y); v[q][3] = bfhi(w.y);
#pragma unroll
                    for (int e = 0; e < 4; ++e) ss += v[q][e] * v[q][e]; }
            }
            ss += __shfl_xor(ss, 1); ss += __shfl_xor(ss, 2); ss += __shfl_xor(ss, 4);
            if (act) {
                const float rs = 1.0f / sqrtf(ss * (1.0f / 128.0f) + 1e-6f);
#pragma unroll
                for (int q = 0; q < 4; ++q) { const int c = (q >> 1) * 64 + (q & 1) * 32 + s * 4;
#pragma unroll
                    for (int e = 0; e < 4; ++e) v[q][e] = v[q][e] * rs * g[c + e]; }
                if (lat) {
#pragma unroll
                    for (int half = 0; half < 2; ++half) { const f32x2* tb = (half ? t128c + gc * 32 : t128r + gr * 32) + s * 4;
#pragma unroll
                        for (int e = 0; e < 4; ++e) { const f32x2 cs = tb[e]; const float a = v[half * 2][e], bq = v[half * 2 + 1][e];
                            v[half * 2][e] = a * cs.x - bq * cs.y; v[half * 2 + 1][e] = bq * cs.x + a * cs.y; } }
                }
#pragma unroll
                for (int q = 0; q < 4; ++q) { const int c = (q >> 1) * 64 + (q & 1) * 32 + s * 4; u32x2 w; w.x = pk2(v[q][0], v[q][1]); w.y = pk2(v[q][2], v[q][3]); *(u32x2*)(hp + c) = w; }
            }
        }
    }
}

__device__ __forceinline__ void attn_ab_unit(Frame& F, int k) {
    const bf16_t* P = (const bf16_t*)(F.ws + WS_PROJ); bf16_t* MG = (bf16_t*)(F.ws + WS_MERGED); bf16_t* OA = (bf16_t*)(F.ws + WS_OA);
    if (k < 3) {
        const int u = (k < 2) ? F.vcu + k * F.G : 512 + F.vcu; if (k == 2 ? F.vcu >= 64 : u >= 512) return;
        int b, h, q0, nk;
        if (u < 512) { const int grp = u >> 5, w = u & 31; b = grp >> 1; h = (grp & 1) * 4 + (w >> 3); q0 = CTXL + (w & 7) * 256; nk = RPB; }
        else { const int v = u - 512; b = v >> 3; h = v & 7; q0 = 0; nk = CTXL; }
        const size_t kr = (size_t)b * RPB, qr = kr + q0; const int kvh = h >> 2;
        att::attn_unit<128, true, false>(P + qr * ABW + QB_OFF + h * 128, ABW, P + kr * ABW + KB_OFF + kvh * 128, ABW, nullptr, 0, P + kr * ABW + VB_OFF + kvh * 128, ABW,
                                         MG + qr * D + 1024 + h * 128, D, nk, 0, nullptr, nullptr, F.ldsg, F.lds, fresh_tid(F));
    } else {
        const int j = k - 3, u = (j < 4) ? F.vcu + j * F.G : 1024 + F.vcu; if (j == 4 ? F.vcu >= 128 : u >= 1024) return;
        int b, vh, q0, nk;
        if (u < 1024) { const int grp = u >> 4, w = u & 15; b = grp >> 3; vh = (grp & 7) * 2 + (w >> 3); q0 = CTXL + (w & 7) * 256; nk = RPB; }
        else { const int v = u - 1024; b = v >> 4; vh = v & 15; q0 = 0; nk = CTXL; }
        const size_t kr = (size_t)b * RPB, qr = kr + q0;
        att::attn_unit<64, true, false>(P + qr * ABW + QA_OFF + vh * 64, ABW, P + kr * ABW + KA_OFF + vh * 64, ABW, nullptr, 0, P + kr * ABW + VA_OFF + (vh >> 1) * 128, ABW,
                                        OA + qr * D + vh * 128, D, nk, 0, nullptr, nullptr, F.ldsg, F.lds, fresh_tid(F));
    }
}
__device__ __forceinline__ void p_attn_ab(Frame& F) {
    const int sk6 = min((int)blockIdx.x / 43, 5), side_k = (sk6 < 1) ? 1 : (sk6 < 2 ? 2 : sk6 + 2);
#pragma unroll 1
    for (int k = 0; k < side_k; ++k) attn_ab_unit(F, k);
    side_quant_experts(F, 0);
#pragma unroll 1
    for (int k = side_k; k < 8; ++k) attn_ab_unit(F, k);
}

__device__ __forceinline__ void p_diff_combine(Frame& F) {
    const bf16_t* OA = (const bf16_t*)(F.ws + WS_OA); const bf16_t* MG = (const bf16_t*)(F.ws + WS_MERGED);
    signed char* MG8 = (signed char*)(F.ws + WS_MG8); float* SMG = (float*)(F.ws + WS_SMG);
    const float* lp = F.ka->in[I_DLAM]; const float* sg = F.ka->in[I_SUBLN];
    const float d1 = wave_sum(lp[F.lane] * lp[64 + F.lane]), d2 = wave_sum(lp[128 + F.lane] * lp[192 + F.lane]);
    const float lam = __expf(d1) - __expf(d2) + LAM_INIT0;
    const int h = F.lane >> 3, s = F.lane & 7;
    float g[16];
#pragma unroll
    for (int e = 0; e < 16; ++e) g[e] = sg[s * 16 + e] * (1.0f - LAM_INIT0);
    for (int r = F.gw; r < T_ALL; r += F.NGW) {
        const bf16_t* o1 = OA + (size_t)r * D + (2 * h) * 128 + s * 16; const bf16_t* o2 = o1 + 128; const bf16_t* ob = MG + (size_t)r * D + 1024 + h * 128 + s * 16;
        float v[16], vb[16]; float ss = 0.f;
#pragma unroll
        for (int q = 0; q < 2; ++q) { const u32x4 a = *(const u32x4*)(o1 + 8 * q), bq = *(const u32x4*)(o2 + 8 * q), cq = *(const u32x4*)(ob + 8 * q);
#pragma unroll
            for (int e = 0; e < 4; ++e) { v[q * 8 + 2 * e] = bflo(a[e]) - lam * bflo(bq[e]); v[q * 8 + 2 * e + 1] = bfhi(a[e]) - lam * bfhi(bq[e]); vb[q * 8 + 2 * e] = bflo(cq[e]); vb[q * 8 + 2 * e + 1] = bfhi(cq[e]); } }
#pragma unroll
        for (int e = 0; e < 16; ++e) ss += v[e] * v[e];
        ss += __shfl_xor(ss, 1); ss += __shfl_xor(ss, 2); ss += __shfl_xor(ss, 4);
        const float rs = 1.0f / sqrtf(ss * (1.0f / 128.0f) + 1e-5f);
        float am = 0.f;
#pragma unroll
        for (int e = 0; e < 16; ++e) { v[e] = v[e] * rs * g[e]; am = fmaxf(am, fmaxf(fabsf(v[e]), fabsf(vb[e]))); }
#pragma unroll
        for (int o = 1; o < 64; o <<= 1) am = fmaxf(am, __shfl_xor(am, o));
        const float inv = am > 0.f ? 127.0f / am : 0.f;
        if (F.lane == 0) SMG[r] = am * (1.0f / 127.0f);
        u32x4 wa, wb;
#pragma unroll
        for (int d = 0; d < 4; ++d) { wa[d] = q8x4(v[d * 4], v[d * 4 + 1], v[d * 4 + 2], v[d * 4 + 3], inv); wb[d] = q8x4(vb[d * 4], vb[d * 4 + 1], vb[d * 4 + 2], vb[d * 4 + 3], inv); }
        *(u32x4*)(MG8 + (size_t)r * D + h * 128 + s * 16) = wa; *(u32x4*)(MG8 + (size_t)r * D + 1024 + h * 128 + s * 16) = wb;
    }
}

__device__ __forceinline__ void p_post_down(Frame& F) {
    const bf16_t* DN = (const bf16_t*)(F.ws + WS_DOWN); bf16_t* KPE = (bf16_t*)(F.ws + WS_KPE);
    const f32x2* t64r = (const f32x2*)(F.ws + WS_TAB + TAB64R); const f32x2* t64c = (const f32x2*)(F.ws + WS_TAB + TAB64C);
    const float* qg = F.ka->in[I_MQNG]; const float* kvg = F.ka->in[I_MKVNG];
    for (int r = F.gw; r < T_ALL; r += F.NGW) {
        const int b = r / RPB, i = r - b * RPB; const bool lat = i >= CTXL; const int pos = i - CTXL, gr = pos >> 6, gc = pos & 63;
        const bf16_t* row = DN + (size_t)r * DOWN_N;
#pragma unroll
        for (int which = 0; which < 2; ++which) {
            const u32x4 w = *(const u32x4*)(row + which * 512 + F.lane * 8); float v[8];
#pragma unroll
            for (int e = 0; e < 4; ++e) { v[2 * e] = bflo(w[e]); v[2 * e + 1] = bfhi(w[e]); }
            float ss = 0.f;
#pragma unroll
            for (int e = 0; e < 8; ++e) ss += v[e] * v[e];
            ss = wave_sum(ss); const float rs = 1.0f / sqrtf(ss * (1.0f / 512.0f) + 1e-6f); const float* g = (which ? kvg : qg) + F.lane * 8;
#pragma unroll
            for (int e = 0; e < 8; ++e) v[e] = v[e] * rs * g[e];
            quant_row512_store(v, (signed char*)(F.ws + (which ? WS_CKVN : WS_CQN)) + (size_t)r * 512, (float*)(F.ws + (which ? WS_SCKV : WS_SCQ)) + r, F.lane);
        }
        if (F.lane < 32) {
            const int blk = F.lane >> 4, f = F.lane & 15; const float a = bf2f(row[1024 + blk * 32 + f]), bq = bf2f(row[1024 + blk * 32 + 16 + f]);
            float oa = a, ob = bq;
            if (lat) { const f32x2 cs = blk ? t64c[gc * 16 + f] : t64r[gr * 16 + f]; oa = a * cs.x - bq * cs.y; ob = bq * cs.x + a * cs.y; }
            KPE[(size_t)r * 64 + blk * 32 + f] = (bf16_t)f2bf(oa); KPE[(size_t)r * 64 + blk * 32 + 16 + f] = (bf16_t)f2bf(ob);
        }
    }
}

__device__ __forceinline__ void attn_mla_unit(Frame& F, int u) {
    const bf16_t* QM = (const bf16_t*)(F.ws + WS_QM); const bf16_t* KVM = (const bf16_t*)(F.ws + WS_KVM); const bf16_t* KPE = (const bf16_t*)(F.ws + WS_KPE);
    const f32x2* t64r = (const f32x2*)(F.ws + WS_TAB + TAB64R); const f32x2* t64c = (const f32x2*)(F.ws + WS_TAB + TAB64C);
    const int grp = u >> 3, b = grp >> 4, h = grp & 15, qb = u & 7; const size_t kr = (size_t)b * RPB, qr = kr + CTXL + qb * 256;
    att::attn_unit<192, true, true, true>(QM + qr * UQ_N + h * 192, UQ_N, KVM + kr * UKV_N + h * 256, UKV_N, KPE + kr * 64, 64, KVM + kr * UKV_N + h * 256 + 128, UKV_N,
                                    (bf16_t*)(F.ws + WS_MG8 + qr * D + h * 128), D, RPB, qb * 256, t64r, t64c, F.ldsg, F.lds, fresh_tid(F));
}
__device__ __forceinline__ void p_attn_mla(Frame& F) {
    const int side_n = min((int)blockIdx.x / 64, 3) + 1; int u = F.vcu, n = 0;
#pragma unroll 1
    for (; u < 1024 && n < side_n; u += F.G, ++n) attn_mla_unit(F, u);
    side_quant_experts(F, 1);
#pragma unroll 1
    for (; u < 1024; u += F.G) attn_mla_unit(F, u);
}

template <int R> __device__ __forceinline__ void ln1_rows(Frame& F, int layer, int t0, int i) {
    const LAS float* PA = (const LAS float*)F.lds;
    const unsigned char* Y1 = (const unsigned char*)(F.ws + WS_Y1); bf16_t* XB = (bf16_t*)(F.ws + WS_X); bf16_t* H = (bf16_t*)(F.ws + WS_H);
    float v[R][4][8]; u32x2 yw[R][4]; int var[R], rr[R];
#pragma unroll
    for (int q = 0; q < R; ++q) { const int r = tok_row(layer, t0 + i + 8 * q); rr[q] = r; const float* xs = x_src(F, 0, r); var[q] = (layer == 0 && (r % RPB) < CTXL) ? 3 : 0;
#pragma unroll
        for (int j = 0; j < 4; ++j) { if (layer == 0) ld8f_nt(xs + 512 * j + 8 * F.lane, v[q][j]); else unpk8(*(const u32x4*)(XB + (size_t)r * D + 512 * j + 8 * F.lane), v[q][j]); yw[q][j] = __builtin_nontemporal_load((const u32x2*)(Y1 + (size_t)r * D + 512 * j + 8 * F.lane)); } }
#pragma unroll
    for (int q = 0; q < R; ++q) {
        float s = 0.f;
#pragma unroll
        for (int j = 0; j < 4; ++j) { const int c = 512 * j + 8 * F.lane; float g1[8], y[8]; ld8l(PA + (2 + var[q]) * 2048 + c, g1); unfp8(yw[q][j], y);
#pragma unroll
            for (int e = 0; e < 8; ++e) { v[q][j][e] = v[q][j][e] * ALPHA + g1[e] * y[e]; s += v[q][j][e]; } }
        const float mean = wave_sum(s) * (1.0f / D); float s2 = 0.f;
#pragma unroll
        for (int j = 0; j < 4; ++j)
#pragma unroll
            for (int e = 0; e < 8; ++e) { v[q][j][e] -= mean; s2 += v[q][j][e] * v[q][j][e]; }
        const float rstd = 1.0f / sqrtf(wave_sum(s2) * (1.0f / D) + 1e-5f);
#pragma unroll
        for (int j = 0; j < 4; ++j) { const int c = 512 * j + 8 * F.lane; float a[8], bq[8], xo[8], h[8];
            ld8l(PA + c, a); ld8l(PA + 2048 + c, bq);
#pragma unroll
            for (int e = 0; e < 8; ++e) xo[e] = v[q][j][e] * rstd * a[e] + bq[e];
            *(u32x4*)(XB + (size_t)rr[q] * D + c) = pk8(xo);
            ld8l(PA + (3 + var[q]) * 2048 + c, a); ld8l(PA + (4 + var[q]) * 2048 + c, bq);
#pragma unroll
            for (int e = 0; e < 8; ++e) { h[e] = v[q][j][e] * rstd * a[e] + bq[e]; v[q][j][e] = h[e]; }
            *(u32x4*)(H + (size_t)rr[q] * D + c) = pk8(h); }
        quant_row_store(v[q], (signed char*)(F.ws + WS_H8) + (size_t)rr[q] * D, (float*)(F.ws + WS_SA) + rr[q], F.lane);
    }
}
__device__ __forceinline__ void p_ln1(Frame& F, int layer) {
    LAS float* PA = (LAS float*)F.lds;
    const int NT = layer ? T_LAT : T_ALL, BR = layer ? 64 : 72, nblk = NT / BR, rpb = layer ? SEQ : RPB;
    const float* lg = F.ka->in[I_LNMG] + layer * D; const float* lb = F.ka->in[I_LNMB] + layer * D; const float* MOD = (const float*)(F.ws + WS_MOD) + (size_t)layer * 9 * 12288;
    for (int blk = F.vcu; blk < nblk; blk += F.G) {
        const int t0 = blk * BR, b = t0 / rpb;
        __syncthreads();
        { const int c = F.tid * 4; const f32x4 g = *(const f32x4*)(lg + c), bb = *(const f32x4*)(lb + c);
          *(LAS f32x4*)(PA + c) = g; *(LAS f32x4*)(PA + 2048 + c) = bb;
#pragma unroll
          for (int vv = 0; vv < 2; ++vv) { const float* m = MOD + (size_t)(vv ? 8 : b) * 12288; const f32x4 g1 = *(const f32x4*)(m + 2 * 2048 + c), sh2 = *(const f32x4*)(m + 3 * 2048 + c), sc2 = *(const f32x4*)(m + 4 * 2048 + c);
              *(LAS f32x4*)(PA + (2 + 3 * vv) * 2048 + c) = g1; *(LAS f32x4*)(PA + (3 + 3 * vv) * 2048 + c) = g * (1.0f + sc2); *(LAS f32x4*)(PA + (4 + 3 * vv) * 2048 + c) = bb * (1.0f + sc2) + sh2; } }
        __syncthreads();
        for (int i = F.wave; i < BR; i += 16) { if (i + 8 < BR) ln1_rows<2>(F, layer, t0, i); else ln1_rows<1>(F, layer, t0, i); }
    }
}

__device__ __forceinline__ void p_router(Frame& F, int layer) {
    const int NT = layer ? T_LAT : T_ALL, ngroups = NT / 32;
    const bf16_t* H = (const bf16_t*)(F.ws + WS_H); const bf16_t* RT = (const bf16_t*)(F.ws + WS_ROUTER + (size_t)layer * 64 * 2048 * 2);
    const float* rb = F.ka->in[I_RB] + layer * 64;
    int* LIST = (int*)(F.ws + WS_LIST); int* TS = (int*)(F.ws + WS_TOKSLOT); float* GATE = (float*)(F.ws + WS_GATE);
    unsigned* CNT = F.ctl + CW_CNT + layer * 64 * 16;
    LAS float* part = (LAS float*)F.lds;
    LAS float* SC = (LAS float*)(F.lds + 65536);
    LAS float* BS = (LAS float*)(F.lds + 65536 + 8448);
    LAS int* hist = (LAS int*)(F.lds + 65536 + 2 * 8448);
    LAS int* base = hist + 64;
    LAS int* SEL = base + 64;
    const int r32 = F.lane & 31, hi = F.lane >> 5;
    if (F.tid < 64) hist[F.tid] = 0;
    __syncthreads();
    int gi = 0;
    for (int g = F.vcu; g < ngroups; g += F.G, ++gi) {
        const int t0 = g * 32;
        {
            const bf16_t* ap = H + (size_t)tok_row(layer, t0 + r32) * D + F.wave * 256 + hi * 8;
            const bf16_t* b0p = RT + (size_t)r32 * D + F.wave * 256 + hi * 8; const bf16_t* b1p = b0p + (size_t)32 * D;
            f32x16 a0 = {}, a1 = {};
#pragma unroll
            for (int k = 0; k < 16; ++k) { const bf16x8 a = *(const bf16x8*)(ap + k * 16), w0 = *(const bf16x8*)(b0p + k * 16), w1 = *(const bf16x8*)(b1p + k * 16);
                a0 = __builtin_amdgcn_mfma_f32_32x32x16_bf16(a, w0, a0, 0, 0, 0); a1 = __builtin_amdgcn_mfma_f32_32x32x16_bf16(a, w1, a1, 0, 0, 0); }
#pragma unroll
            for (int r = 0; r < 16; ++r) { const int row = att::crow(r, hi); part[(F.wave * 32 + row) * 64 + r32] = a0[r]; part[(F.wave * 32 + row) * 64 + 32 + r32] = a1[r]; }
        }
        __syncthreads();
        for (int i = F.tid; i < 2048; i += 512) { float s = 0.f;
#pragma unroll
            for (int w = 0; w < 8; ++w) s += part[w * 2048 + i];
            const float sg = 1.0f / (1.0f + __expf(-s)); const int tk = i >> 6, e = i & 63; SC[tk * 65 + e] = sg; BS[tk * 65 + e] = sg + rb[e]; }
        __syncthreads();
        if (F.tid < 32) {
            const LAS float* bs = BS + F.tid * 65; const LAS float* sc = SC + F.tid * 65;
            float bv[64];
#pragma unroll
            for (int e = 0; e < 64; ++e) bv[e] = bs[e];
            float gs[8];
#pragma unroll
            for (int gq = 0; gq < 8; ++gq) { float m1 = -INFINITY, m2 = -INFINITY;
#pragma unroll
                for (int j = 0; j < 8; ++j) { const float v = bv[gq * 8 + j]; const float lo = fminf(v, m1); m1 = fmaxf(v, m1); m2 = fmaxf(m2, lo); }
                gs[gq] = m1 + m2; }
            unsigned gmask = 0u;
#pragma unroll
            for (int it = 0; it < 4; ++it) { float best = -INFINITY; int bi = 0;
#pragma unroll
                for (int gq = 0; gq < 8; ++gq) { const bool ok = !((gmask >> gq) & 1u) && gs[gq] > best; best = ok ? gs[gq] : best; bi = ok ? gq : bi; }
                gmask |= 1u << bi; }
#pragma unroll
            for (int e = 0; e < 64; ++e) bv[e] = ((gmask >> (e >> 3)) & 1u) ? bv[e] : -INFINITY;
            int sel[8]; float gv[8]; float gsum = 0.f;
#pragma unroll
            for (int k = 0; k < 8; ++k) { float best = -INFINITY; int be = 0;
#pragma unroll
                for (int e = 0; e < 64; ++e) { const bool ok = bv[e] > best; best = ok ? bv[e] : best; be = ok ? e : be; }
#pragma unroll
                for (int e = 0; e < 64; ++e) bv[e] = (e == be) ? -INFINITY : bv[e];
                sel[k] = be; gv[k] = sc[be]; gsum += gv[k]; }
            const int r = tok_row(layer, t0 + F.tid); const float inv = 2.5f / gsum;
#pragma unroll
            for (int k = 0; k < 8; ++k) { const int lp = atomicAdd((int*)(hist + sel[k]), 1); SEL[((gi & 3) * 32 + F.tid) * 8 + k] = (sel[k] << 16) | lp; GATE[(size_t)r * 8 + k] = gv[k] * inv; }
        }
        __syncthreads();
    }
    if (F.tid < 64) base[F.tid] = (int)__hip_atomic_fetch_add(CNT + F.tid * 16, (unsigned)hist[F.tid], RLX_AGENT);
    __syncthreads();
    gi = 0;
    for (int g = F.vcu; g < ngroups; g += F.G, ++gi) {
        if (F.tid < 256) { const int tk = F.tid >> 3, k = F.tid & 7; const int v = SEL[((gi & 3) * 32 + tk) * 8 + k], e = v >> 16, pos = base[e] + (v & 0xffff); const int r = tok_row(layer, g * 32 + tk);
            LIST[(size_t)e * LIST_CAP + pos] = r; TS[(size_t)r * 8 + k] = (e << 16) | pos; }
    }
    __syncthreads();
}

__device__ __forceinline__ int moe_tables(Frame& F, int layer) {
    LAS int* MISC = (LAS int*)(F.lds + MISC_OFF); LAS int* TT = (LAS int*)(F.lds + TTAB_OFF);
    const int NT = layer ? T_LAT : T_ALL;
    __syncthreads();
    if (F.wave == 0) {
        const unsigned* CNT = F.ctl + CW_CNT + layer * 64 * 16;
        const int c = (int)__hip_atomic_load(CNT + F.lane * 16, RLX_AGENT); const int nt = (c + 255) >> 8;
        int inc = nt;
#pragma unroll
        for (int o = 1; o < 64; o <<= 1) { const int v = __shfl_up(inc, o); if (F.lane >= o) inc += v; }
        const int start = inc - nt; MISC[F.lane] = start; MISC[80 + F.lane] = c;
        if (F.lane == 63) { MISC[64] = inc; MISC[65] = inc + NT / 256; }
    }
    __syncthreads();
    const int s64 = MISC[64], total = MISC[65];
    for (int tile = F.tid; tile < total; tile += 512) {
        int lo = 0, hi = 64;
#pragma unroll
        for (int it = 0; it < 7; ++it) { const int mid = (lo + hi + 1) >> 1; const bool ok = MISC[mid] <= tile; lo = ok ? mid : lo; hi = ok ? hi : mid - 1; }
        TT[tile] = (lo << 16) | (tile - MISC[lo]); }
    (void)s64;
    __syncthreads();
    return total;
}

__device__ __forceinline__ void p_moe_gemm1(Frame& F, int layer) {
    const int total = moe_tables(F, layer);
    LAS int* MISC = (LAS int*)(F.lds + MISC_OFF); LAS int* TT = (LAS int*)(F.lds + TTAB_OFF); LAS int* IDX = (LAS int*)(F.lds + IDXC_OFF);
    const int* LIST = (const int*)(F.ws + WS_LIST);
    typedef pg8::SchedMoe<4, EXP_IN_BYTES, (size_t)256 * D> Sch; Sch S; S.ntiles = total; S.G = F.G; S.vcu = F.vcu; S.ttab = TT; S.Bt = (const char*)(F.ws + WS_EXP_IN + (size_t)layer * 65 * EXP_IN_BYTES);
    {
        pg8::Unit u; const int fallback = tok_row(layer, 0);
        for (int i = 0; i < IDXC_UNITS && S.next(i, u); ++i) {
            if (F.tid < 256) { const int tile = u.row0 >> 8, tv = TT[tile], e = tv >> 16, p = (tv & 0xffff) * 256 + F.tid;
                int src; if (e < 64) src = (p < MISC[80 + e]) ? LIST[(size_t)e * LIST_CAP + p] : fallback; else src = tok_row(layer, p);
                IDX[i * 256 + F.tid] = src; }
        }
        __syncthreads();
    }
    pg8::EpiSwigluI8 E{(unsigned char*)(F.ws + WS_HMID), FDIM, (const float*)(F.ws + WS_SA), (const float*)(F.ws + WS_SW) + (size_t)layer * 65 * 1024, IDX};
    pg8::gemm_phase<pg8::EpiSwigluI8, Sch, true, 1>(F.lds, (const void*)(F.ws + WS_H8), D, S, E, IDX, fresh_tid(F));
    if (layer == 0 && is_tail_wg(total * 4, F.G, F.vcu)) tail_quant(F, 1, 1, 1);
}
__device__ __forceinline__ void p_moe_gemm2(Frame& F, int layer) {
    const int total = moe_tables(F, layer);
    LAS int* TT = (LAS int*)(F.lds + TTAB_OFF);
    typedef pg8::SchedMoe<8, EXP_OUT_BYTES, (size_t)256 * FDIM> Sch; Sch S; S.ntiles = total; S.G = F.G; S.vcu = F.vcu; S.ttab = TT; S.Bt = (const char*)(F.ws + WS_EXP_OUT + (size_t)layer * 65 * EXP_OUT_BYTES);
    pg8::EpiI8Fp8<2048, true> E{(unsigned char*)(F.ws + WS_Y2P), D, (const float*)(F.ws + WS_SW2), (const float*)(F.ws + WS_SW2) + (size_t)layer * 65 * 2048};
    pg8::gemm_phase<pg8::EpiI8Fp8<2048, true>, Sch, false, 2>(F.lds, (const void*)(F.ws + WS_HMID), FDIM, S, E, nullptr, fresh_tid(F));
}

__device__ __forceinline__ void p_combine_ln2(Frame& F, int layer) {
    (void)moe_tables(F, layer);
    LAS int* MISC = (LAS int*)(F.lds + MISC_OFF); LAS float* PA = (LAS float*)F.lds;
    const int NT = layer ? T_LAT : T_ALL, BR = layer ? 64 : 72, nblk = NT / BR, rpb = layer ? SEQ : RPB;
    const unsigned char* Y2 = (const unsigned char*)(F.ws + WS_Y2P);     const int* TS = (const int*)(F.ws + WS_TOKSLOT); const float* GATE = (const float*)(F.ws + WS_GATE);
    bf16_t* XB = (bf16_t*)(F.ws + WS_X); float* OUT = F.ka->out;
    const int sh0 = MISC[64] * 256;
    for (int blk = F.vcu; blk < nblk; blk += F.G) {
        const int t0 = blk * BR, b = t0 / rpb;
        __syncthreads();
        { int z = 0; asm volatile("" : "+s"(z));
          const float* lg = F.ka->in[I_LNFG + z] + layer * D; const float* lb = F.ka->in[I_LNFB + z] + layer * D; const float* MOD = (const float*)(F.ka->ws + WS_MOD) + z;
          const int c = fresh_tid(F) * 4; const f32x4 g = *(const f32x4*)(lg + c), bb = *(const f32x4*)(lb + c);
          *(LAS f32x4*)(PA + c) = g; *(LAS f32x4*)(PA + 2048 + c) = bb;
#pragma unroll
          for (int vv = 0; vv < 2; ++vv) { const float* m = MOD + ((size_t)layer * 9 + (vv ? 8 : b)) * 12288; const float* m1 = MOD + ((size_t)9 + (vv ? 8 : b)) * 12288;
              const f32x4 g2 = *(const f32x4*)(m + 5 * 2048 + c), sh1 = *(const f32x4*)(m1 + c), sc1 = *(const f32x4*)(m1 + 2048 + c);
              *(LAS f32x4*)(PA + (2 + 3 * vv) * 2048 + c) = g2; *(LAS f32x4*)(PA + (3 + 3 * vv) * 2048 + c) = g * (1.0f + sc1); *(LAS f32x4*)(PA + (4 + 3 * vv) * 2048 + c) = bb * (1.0f + sc1) + sh1; } }
        __syncthreads();
        int r = tok_row(layer, t0 + F.wave); int tsv = 0; float gtv = 0.f;
        { const int l0 = fresh_lane(); if (l0 < 8) { tsv = TS[(size_t)r * 8 + l0]; gtv = GATE[(size_t)r * 8 + l0]; } }
        for (int i = F.wave; i < BR; i += 8) {
            const int t = t0 + i, var = (layer == 0 && (r % RPB) < CTXL) ? 3 : 0;
            const int ln = fresh_lane();
            float xv[4][8]; float y[4][8]; const int tsc = tsv; const int gtc = __builtin_bit_cast(int, gtv);
#define YROW(k) (Y2 + (size_t)(__builtin_amdgcn_readfirstlane(MISC[__builtin_amdgcn_readlane(tsc, (k)) >> 16]) * 256 + (__builtin_amdgcn_readlane(tsc, (k)) & 0xffff)) * D)
#define GK(k) __builtin_bit_cast(float, __builtin_amdgcn_readlane(gtc, (k)))
            const int rcur = r;
            {
                u32x2 yw[5][4];
#pragma unroll
                for (int k = 0; k < 4; ++k)
#pragma unroll
                    for (int j = 0; j < 4; ++j) yw[k][j] = __builtin_nontemporal_load((const u32x2*)(YROW(k) + 8 * ln + 512 * j));
                { const unsigned char* yr = Y2 + (size_t)(sh0 + t) * D + 8 * ln;
#pragma unroll
                  for (int j = 0; j < 4; ++j) yw[4][j] = __builtin_nontemporal_load((const u32x2*)(yr + 512 * j)); }
                if (i + 8 < BR) { r = tok_row(layer, t + 8); if (ln < 8) { tsv = TS[(size_t)r * 8 + ln]; gtv = GATE[(size_t)r * 8 + ln]; } }
#pragma unroll
                for (int j = 0; j < 4; ++j) { float tmp[8]; unfp8(yw[4][j], y[j]);
#pragma unroll
                    for (int k = 0; k < 4; ++k) { unfp8(yw[k][j], tmp);
#pragma unroll
                        for (int e = 0; e < 8; ++e) y[j][e] += GK(k) * tmp[e]; } }
            }
            asm volatile("" ::: "memory");
            {
                u32x2 yw[4][4];
#pragma unroll
                for (int k = 0; k < 4; ++k)
#pragma unroll
                    for (int j = 0; j < 4; ++j) yw[k][j] = __builtin_nontemporal_load((const u32x2*)(YROW(4 + k) + 8 * ln + 512 * j));
#pragma unroll
                for (int j = 0; j < 4; ++j) unpk8(*(const u32x4*)(XB + (size_t)rcur * D + 512 * j + 8 * ln), xv[j]);
#pragma unroll
                for (int j = 0; j < 4; ++j) { float tmp[8];
#pragma unroll
                    for (int k = 0; k < 4; ++k) { unfp8(yw[k][j], tmp);
#pragma unroll
                        for (int e = 0; e < 8; ++e) y[j][e] += GK(4 + k) * tmp[e]; } }
            }
#undef YROW
#undef GK
            float s = 0.f;
#pragma unroll
            for (int j = 0; j < 4; ++j) { const int c = 512 * j + 8 * ln; float g2[8];
                ld8l(PA + (2 + var) * 2048 + c, g2);
#pragma unroll
                for (int e = 0; e < 8; ++e) { xv[j][e] = xv[j][e] * ALPHA + g2[e] * y[j][e]; s += xv[j][e]; } }
            const float mean = wave_sum(s) * (1.0f / D); float s2 = 0.f;
#pragma unroll
            for (int j = 0; j < 4; ++j)
#pragma unroll
                for (int e = 0; e < 8; ++e) { xv[j][e] -= mean; s2 += xv[j][e] * xv[j][e]; }
            const float rstd = 1.0f / sqrtf(wave_sum(s2) * (1.0f / D) + 1e-5f);
#pragma unroll
            for (int j = 0; j < 4; ++j) { const int c = 512 * j + 8 * ln; float a[8], bq[8], xo[8];
                ld8l(PA + c, a); ld8l(PA + 2048 + c, bq);
#pragma unroll
                for (int e = 0; e < 8; ++e) xo[e] = xv[j][e] * rstd * a[e] + bq[e];
                if (layer == 0) { *(u32x4*)(XB + (size_t)rcur * D + c) = pk8(xo); ld8l(PA + (3 + var) * 2048 + c, a); ld8l(PA + (4 + var) * 2048 + c, bq);
#pragma unroll
                    for (int e = 0; e < 8; ++e) xv[j][e] = xv[j][e] * rstd * a[e] + bq[e]; }
                else st8f(OUT + (size_t)t * D + c, xo); }
            if (layer == 0) quant_row_store(xv, (signed char*)(F.ws + WS_H8) + (size_t)rcur * D, (float*)(F.ws + WS_SA) + rcur, ln);
        }
    }
}

__device__ __forceinline__ void p_dense(Frame& F, const bf16_t* A, const bf16_t* Bt, int K, int nM, int nN, int latmap, bf16_t* O, int ldc) {
    pg8::SchedDense S; S.init(nM, nN, F.G, (int)blockIdx.x, latmap, Bt, K);
    pg8::EpiBf16 E{O, ldc};
    pg8::gemm_phase<pg8::EpiBf16, pg8::SchedDense, false>(F.lds, A, K, S, E, nullptr, F.tid);
}
__device__ __forceinline__ void p_dense_i8_fp8(Frame& F, const void* A, const float* SA, const void* Bt, const float* SW, int K, int nM, int nN, int latmap, unsigned char* O, int ldc) {
    pg8::SchedDense S; S.init(nM, nN, F.G, (int)blockIdx.x, latmap, (const bf16_t*)Bt, K); S.tstepB = (size_t)256 * K;
    pg8::EpiI8Fp8<0> E{O, ldc, SA, SW};
    pg8::gemm_phase<pg8::EpiI8Fp8<0>, pg8::SchedDense, false, 1>(F.lds, A, K, S, E, nullptr, fresh_tid(F));
}
__device__ __forceinline__ void p_dense_f8_fp8(Frame& F, const void* A, const void* Bt, const float* SW, int K, int nM, int nN, int latmap, unsigned char* O, int ldc) {
    pg8::SchedDense S; S.init(nM, nN, F.G, (int)blockIdx.x, latmap, (const bf16_t*)Bt, K); S.tstepB = (size_t)256 * K;
    pg8::EpiI8Fp8<0, true> E{O, ldc, SW, SW};
    pg8::gemm_phase<pg8::EpiI8Fp8<0, true>, pg8::SchedDense, false, 2>(F.lds, A, K, S, E, nullptr, fresh_tid(F));
}
__device__ __forceinline__ void p_dense_i8(Frame& F, const void* A, const float* SA, const void* Bt, const float* SW, int K, int nM, int nN, int latmap, bf16_t* O, int ldc) {
    pg8::SchedDense S; S.init(nM, nN, F.G, (int)blockIdx.x, latmap, (const bf16_t*)Bt, K); S.tstepB = (size_t)256 * K;
    pg8::EpiI8Bf16<0> E{O, ldc, SA, SW};
    pg8::gemm_phase<pg8::EpiI8Bf16<0>, pg8::SchedDense, false, 1>(F.lds, A, K, S, E, nullptr, fresh_tid(F));
}

constexpr int N_PHASES = 26;

__global__ void __launch_bounds__(512, 2) mk_fwd(Args args) {
    extern __shared__ __attribute__((aligned(16))) unsigned char lds_raw[];
    Frame F;
    F.lds = (LAS unsigned char*)lds_raw; F.ldsg = (char*)lds_raw;
    F.tid = threadIdx.x; F.lane = F.tid & 63; F.wave = __builtin_amdgcn_readfirstlane(F.tid >> 6);
    F.G = gridDim.x; { const int bx = blockIdx.x; F.vcu = (F.G % 8 == 0) ? (bx % 8) * (F.G / 8) + bx / 8 : bx; }
    F.gw = F.vcu * 8 + F.wave; F.NGW = F.G * 8;
    F.ka = (KArgs)__builtin_amdgcn_kernarg_segment_ptr();
    F.ws = F.ka->ws; F.ctl = (unsigned*)F.ws;
    const int lo = args.ph_lo, hi = args.ph_hi;
    volatile LAS unsigned* bw = (volatile LAS unsigned*)(F.lds + BARW_OFF);
    if (F.tid < 4) bw[F.tid] = 0u;
    __syncthreads();
    XcdBarrier bar; bar.bar = F.ctl + CW_BAR; bar.x = 0; bar.st = bw;
    if (hi - lo > 1) bar = xcd_barrier_post(F.ctl + CW_BAR, bw);
#ifndef MK_ONLY
#define MK_ONLY -1
#endif
#ifndef MK_REPMASK
#define MK_REPMASK 0u
#endif
#define IN(k) ((MK_ONLY < 0 || MK_ONLY == (k)) && lo <= (k) && (k) < hi)
#define NREP(k) ((int)(((unsigned)MK_REPMASK >> (k)) & 1u) + 1)
#define SEAM(k) do { if (lo <= (k) && (k) + 1 < hi) xcd_barrier(bar); } while (0)

    if (IN(0)) for (int rep = 0; rep < NREP(0); ++rep) { PHASE_BEGIN(F); p0_prologue(P); } SEAM(0);
    if (IN(1)) for (int rep = 0; rep < NREP(1); ++rep) { PHASE_BEGIN(F); p1_modulate(P); } SEAM(1);
#if defined(MK_UNROLL_LAYERS)
#pragma unroll
#else
#pragma unroll 1
#endif
    for (int layer = 0; layer < 2; ++layer) {
        const int pb = 2 + 12 * layer;
        if (IN(pb + 0)) for (int rep = 0; rep < NREP(pb + 0); ++rep) { PHASE_BEGIN(F);
            p_dense_i8(P, P.ws + WS_H8, (const float*)(P.ws + WS_SA), P.ws + (layer == 0 ? WS_W_IN : WS_W_DOWN), (const float*)(P.ws + WS_SWD) + (layer == 0 ? SWD_IN : SWD_DOWN), D, T_ALL / 256, layer == 0 ? ABW / 256 : DOWN_N / 256, 0,
                       (bf16_t*)(P.ws + (layer == 0 ? WS_PROJ : WS_DOWN)), layer == 0 ? ABW : DOWN_N);
            if (is_tail_wg((T_ALL / 256) * (layer == 0 ? ABW / 256 : DOWN_N / 256), P.G, (int)blockIdx.x)) tail_quant(P, layer, 1, layer == 0 ? 1 : 2);
        } SEAM(pb + 0);
        if (IN(pb + 1)) for (int rep = 0; rep < NREP(pb + 1); ++rep) { PHASE_BEGIN(F); if (layer == 0) p_post_ab(P); else p_post_down(P); } SEAM(pb + 1);
        if (IN(pb + 2)) for (int rep = 0; rep < NREP(pb + 2); ++rep) { PHASE_BEGIN(F);
            if (layer == 0) p_attn_ab(P);
            else {
#pragma unroll 1
                for (int w = 0; w < 2; ++w) {
                    p_dense_i8(P, P.ws + (w == 0 ? WS_CQN : WS_CKVN), (const float*)(P.ws + (w == 0 ? WS_SCQ : WS_SCKV)), P.ws + (w == 0 ? WS_W_UQ : WS_W_UKV), (const float*)(P.ws + WS_SWD) + (w == 0 ? SWD_UQ : SWD_UKV), 512,
                               w == 0 ? T_LAT / 256 : T_ALL / 256, w == 0 ? UQ_N / 256 : UKV_N / 256, w == 0 ? 1 : 0, (bf16_t*)(P.ws + (w == 0 ? WS_QM : WS_KVM)), w == 0 ? UQ_N : UKV_N); }
            }
        } SEAM(pb + 2);
        if (IN(pb + 3)) for (int rep = 0; rep < NREP(pb + 3); ++rep) { PHASE_BEGIN(F); if (layer == 0) p_diff_combine(P); else p_attn_mla(P); } SEAM(pb + 3);
        if (IN(pb + 5)) for (int rep = 0; rep < NREP(pb + 5); ++rep) { PHASE_BEGIN(F);
            if (layer == 0) p_dense_i8_fp8(P, P.ws + WS_MG8, (const float*)(P.ws + WS_SMG), P.ws + WS_W_OUT, (const float*)(P.ws + WS_SWD) + SWD_OUT, D, T_ALL / 256, D / 256, 0, (unsigned char*)(P.ws + WS_Y1), D);
            else p_dense_f8_fp8(P, P.ws + WS_MG8, P.ws + WS_W_O, (const float*)(P.ws + WS_SWD) + SWD_O, D, T_LAT / 256, D / 256, 1, (unsigned char*)(P.ws + WS_Y1), D);
            if (layer == 0 && is_tail_wg((T_ALL / 256) * (D / 256), P.G, (int)blockIdx.x)) tail_quant(P, 1, 1, 1);
        } SEAM(pb + 5);
        if (IN(pb + 6)) for (int rep = 0; rep < NREP(pb + 6); ++rep) { PHASE_BEGIN(F); p_ln1(P, layer); } SEAM(pb + 6);
        if (IN(pb + 7)) for (int rep = 0; rep < NREP(pb + 7); ++rep) { PHASE_BEGIN(F); p_router(P, layer); } SEAM(pb + 7);
        if (IN(pb + 8)) for (int rep = 0; rep < NREP(pb + 8); ++rep) { PHASE_BEGIN(F); p_moe_gemm1(P, layer); } SEAM(pb + 8);
        if (IN(pb + 10)) for (int rep = 0; rep < NREP(pb + 10); ++rep) { PHASE_BEGIN(F); p_moe_gemm2(P, layer); } SEAM(pb + 10);
        if (IN(pb + 11)) for (int rep = 0; rep < NREP(pb + 11); ++rep) { PHASE_BEGIN(F); p_combine_ln2(P, layer); } SEAM(pb + 11);
    }
#undef IN
#undef SEAM
}

extern "C" void kernel_launch(void* const* d_in, const int* in_sizes, int n_in, void* d_out, int out_size, void* d_ws, size_t ws_size, hipStream_t stream) {
    static int grid = 0;
    if (grid == 0) {
        if (n_in != 28 || out_size != T_LAT * D || ws_size < WS_END) { fprintf(stderr, "kernel_launch: expected 28 inputs, out %d, ws >= %zu; got n_in %d out %d ws %zu\n", T_LAT * D, (size_t)WS_END, n_in, out_size, ws_size); grid = -1; return; }
        int dev = 0, cus = 0, per_cu = 0;
        if (hipGetDevice(&dev) != hipSuccess || hipDeviceGetAttribute(&cus, hipDeviceAttributeMultiprocessorCount, dev) != hipSuccess) { fprintf(stderr, "kernel_launch: device query failed\n"); grid = -1; return; }
        if (hipFuncSetAttribute((const void*)mk_fwd, hipFuncAttributeMaxDynamicSharedMemorySize, LDS_BYTES) != hipSuccess) { fprintf(stderr, "kernel_launch: hipFuncSetAttribute failed\n"); grid = -1; return; }
        if (hipOccupancyMaxActiveBlocksPerMultiprocessor(&per_cu, (const void*)mk_fwd, 512, LDS_BYTES) != hipSuccess || per_cu < 1) fprintf(stderr, "kernel_launch: occupancy query reports %d\n", per_cu);
        (void)hipGetLastError();
        grid = cus;
        if (grid != 256) fprintf(stderr, "kernel_launch: note: %d CUs (tuned for 256)\n", grid);
    }
    if (grid < 0) return;
    if (hipMemsetAsync((char*)d_ws + WS_CTL, 0, CTL_BYTES, stream) != hipSuccess) { fprintf(stderr, "kernel_launch: memset failed\n"); return; }
    Args a{};
    for (int i = 0; i < 28; ++i) a.in[i] = (const float*)d_in[i];
    a.out = (float*)d_out; a.ws = (unsigned char*)d_ws;
#if MK_ONE_LAUNCH
    a.ph_lo = 0; a.ph_hi = N_PHASES;
    hipLaunchKernelGGL(mk_fwd, dim3(grid), dim3(512), LDS_BYTES, stream, a);
#else
    for (int p = 0; p < N_PHASES; ++p) { a.ph_lo = p; a.ph_hi = p + 1; hipLaunchKernelGGL(mk_fwd, dim3(grid), dim3(512), LDS_BYTES, stream, a); }
#endif
    const hipError_t le = hipPeekAtLastError();
    if (le != hipSuccess) fprintf(stderr, "kernel_launch: launch failed: %s\n", hipGetErrorName(le));
}
```
